# Optimizing an MI355X kernel written in HIP

```python
import math
import jax, jax.numpy as jnp
from jax import lax
import numpy as np

D_MODEL = 1024
BATCH = 8
SEQ = 2048
DEPTH = 4

GRID_W = 64
CTX_LEN = 256
MIX_WIDTH = D_MODEL
DN_WIDTH = MIX_WIDTH // 2
DN_HEADS = 4
DN_HEAD_DIM = DN_WIDTH // DN_HEADS
N_DIR = 2
CONV_K = 4
CHUNK = 64
POOL_WIDTH = MIX_WIDTH - DN_WIDTH
POOL_WINDOWS = (2, 4, 8, 16)
POOL_GROUPS = len(POOL_WINDOWS)
POOL_GROUP_DIM = POOL_WIDTH // POOL_GROUPS
N_EXPERTS = 16
EC_CAPACITY = 2
EXPERT_FF = D_MODEL
EPS = 1e-6
QKV_COLS = 3 * DN_WIDTH
GATE_COLS = N_DIR * DN_HEADS
STATE_COLS = QKV_COLS + 2 * GATE_COLS
IN_COLS = STATE_COLS + DN_WIDTH + POOL_WIDTH

kernel_name = 'hybrid_pool_gdn_ec_flow_trunk'


def rmsnorm(x, g):
    xf = x.astype(jnp.float32)
    y = xf * lax.rsqrt(jnp.mean(xf * xf, axis=-1, keepdims=True) + EPS)
    return (y * g.astype(jnp.float32)).astype(x.dtype)


def l2norm(x):
    xf = x.astype(jnp.float32)
    return xf * lax.rsqrt(jnp.sum(xf * xf, axis=-1, keepdims=True) + EPS)


def adaln_params(cond, w_mod, b_mod):
    return jnp.split(jax.nn.silu(cond) @ w_mod + b_mod, 6, axis=-1)


def modulate(h, shift, scale):
    return h * (1 + scale) + shift


def window_bounds(n, w):
    pos = jnp.arange(n)
    return jnp.clip(pos - w // 2, 0, n), jnp.clip(pos - w // 2 + w, 0, n)


def centred_box_mean(u, rows):
    B_, L, C = u.shape
    uf = u.astype(jnp.float32)
    outs = []
    if rows is None:
        s = jnp.pad(jnp.cumsum(uf, axis=1), ((0, 0), (1, 0), (0, 0)))
        for i, w in enumerate(POOL_WINDOWS):
            sg = s[..., i * POOL_GROUP_DIM:(i + 1) * POOL_GROUP_DIM]
            lo, hi = window_bounds(L, w)
            cnt = (hi - lo).astype(jnp.float32)
            outs.append((jnp.take(sg, hi, axis=1) - jnp.take(sg, lo, axis=1)) / cnt[None, :, None])
        return jnp.concatenate(outs, axis=-1)
    grid = uf.reshape(B_, rows, GRID_W, C)
    s = jnp.pad(jnp.cumsum(jnp.cumsum(grid, axis=1), axis=2), ((0, 0), (1, 0), (1, 0), (0, 0)))
    for i, w in enumerate(POOL_WINDOWS):
        sg = s[..., i * POOL_GROUP_DIM:(i + 1) * POOL_GROUP_DIM]
        lr, hr = window_bounds(rows, w)
        lc, hc = window_bounds(GRID_W, w)
        s_hi = jnp.take(sg, hr, axis=1)
        s_lo = jnp.take(sg, lr, axis=1)
        tot = (jnp.take(s_hi, hc, axis=2) - jnp.take(s_hi, lc, axis=2)
               - jnp.take(s_lo, hc, axis=2) + jnp.take(s_lo, lc, axis=2))
        cnt = ((hr - lr)[:, None] * (hc - lc)[None, :]).astype(jnp.float32)
        outs.append(tot / cnt[None, :, :, None])
    return jnp.concatenate(outs, axis=-1).reshape(B_, L, C)


def pool_mixer(u, pool_w, pool_scale, rows):
    B_, L, _ = u.shape
    m = (centred_box_mean(u, rows) - u.astype(jnp.float32)).astype(u.dtype)
    m = m.reshape(B_, L, POOL_GROUPS, POOL_GROUP_DIM)
    y = jnp.einsum('blgc,gcd->blgd', m, pool_w).reshape(B_, L, POOL_WIDTH)
    return y * pool_scale


def short_conv(x, w):
    C = x.shape[-1]
    return lax.conv_general_dilated(
        x, w[:, None, :], window_strides=(1,),
        padding=[(CONV_K // 2, CONV_K - 1 - CONV_K // 2)],
        dimension_numbers=('NWC', 'WIO', 'NWC'), feature_group_count=C)


def deltanet_inputs(feat_pre, ab_pre, conv_w, a_log, dt_bias):
    B_, L, _ = feat_pre.shape
    feats = jax.nn.silu(short_conv(feat_pre, conv_w))
    heads = lambda t: jnp.transpose(t.reshape(B_, L, DN_HEADS, DN_HEAD_DIM), (0, 2, 1, 3))
    parts = [heads(t) for t in jnp.split(feats, feats.shape[-1] // DN_WIDTH, axis=-1)]
    ab = ab_pre.astype(jnp.float32).reshape(B_, L, 2, N_DIR, DN_HEADS)
    log_a = -jnp.exp(a_log.astype(jnp.float32)) * jax.nn.softplus(ab[:, :, 0] + dt_bias.astype(jnp.float32))
    beta = jax.nn.sigmoid(ab[:, :, 1])
    to_dir = lambda t: jnp.transpose(t, (2, 0, 3, 1))
    return parts, to_dir(log_a), to_dir(beta)


def chunk_gated_delta(q, k, v, log_a, beta, s0):
    B_, H, L, _ = k.shape
    n = L // CHUNK
    f32 = jnp.float32
    blocks = lambda t: t.astype(f32).reshape(B_, H, n, CHUNK, t.shape[-1])
    kc, vc = blocks(k), blocks(v)
    g = jnp.cumsum(log_a.astype(f32).reshape(B_, H, n, CHUNK), axis=-1)
    bc = beta.astype(f32).reshape(B_, H, n, CHUNK, 1)
    idx = jnp.arange(CHUNK)
    incl = idx[:, None] >= idx[None, :]
    decay = jnp.where(incl, jnp.exp(jnp.minimum(g[..., :, None] - g[..., None, :], 0.0)), 0.0)
    k_beta = kc * bc
    m = jnp.where(idx[:, None] > idx[None, :], jnp.einsum('bhnik,bhnjk->bhnij', k_beta, kc) * decay, 0.0)
    eye = jnp.eye(CHUNK, dtype=f32)
    p = -m
    t_inv = eye + p
    for _ in range(CHUNK.bit_length() - 2):
        p = p @ p
        t_inv = t_inv @ (eye + p)
    w_blk = jnp.einsum('bhnij,bhnjk->bhnik', t_inv, k_beta * jnp.exp(g)[..., None])
    u_blk = jnp.einsum('bhnij,bhnjv->bhniv', t_inv, vc * bc)
    g_last = g[..., -1:]
    k_tail = kc * jnp.exp(g_last - g)[..., None]
    s_decay = jnp.exp(g_last)[..., None]
    first = lambda t: jnp.moveaxis(t, 2, 0)

    def advance(s, w_n, u_n, kt_n, sd_n):
        u_new = u_n - jnp.einsum('bhik,bhkv->bhiv', w_n, s)
        return s * sd_n + jnp.einsum('bhik,bhiv->bhkv', kt_n, u_new), u_new

    if q is None:
        def state_step(s, xs):
            s_next, _ = advance(s, *xs)
            return s_next, None
        s_fin, _ = lax.scan(state_step, s0, tuple(map(first, (w_blk, u_blk, k_tail, s_decay))))
        return None, s_fin

    qc = blocks(q)
    q_dec = qc * jnp.exp(g)[..., None]
    qk = jnp.einsum('bhnik,bhnjk->bhnij', qc, kc) * decay

    def out_step(s, xs):
        w_n, u_n, kt_n, sd_n, qd_n, qk_n = xs
        s_next, u_new = advance(s, w_n, u_n, kt_n, sd_n)
        o_n = jnp.einsum('bhik,bhkv->bhiv', qd_n, s) + jnp.einsum('bhij,bhjv->bhiv', qk_n, u_new)
        return s_next, o_n

    s_fin, o = lax.scan(out_step, s0, tuple(map(first, (w_blk, u_blk, k_tail, s_decay, q_dec, qk))))
    return jnp.moveaxis(o, 0, 2).reshape(B_, H, L, -1), s_fin


def bidir_delta(q, k, v, log_a, beta, s0):
    rev = lambda t: None if t is None else jnp.flip(t, axis=2)
    o_f, s_f = chunk_gated_delta(q, k, v, log_a[0], beta[0], s0[0])
    o_b, s_b = chunk_gated_delta(rev(q), rev(k), rev(v), rev(log_a[1]), rev(beta[1]), s0[1])
    o = None if q is None else o_f + rev(o_b)
    return o, (s_f, s_b)


def token_mixer(h, w_in, conv_w, a_log, dt_bias, dn_norm, pool_w, pool_scale, w_out, s0, rows):
    B_, L, _ = h.shape
    proj = h @ w_in
    (q, k, v), log_a, beta = deltanet_inputs(proj[..., :QKV_COLS], proj[..., QKV_COLS:STATE_COLS],
                                             conv_w, a_log, dt_bias)
    q = l2norm(q) * DN_HEAD_DIM ** -0.5
    k = l2norm(k)
    o, states = bidir_delta(q, k, v, log_a, beta, s0)
    o = jnp.transpose(o, (0, 2, 1, 3))
    gate = proj[..., STATE_COLS:STATE_COLS + DN_WIDTH].reshape(B_, L, DN_HEADS, DN_HEAD_DIM)
    o = (rmsnorm(o, dn_norm) * jax.nn.silu(gate.astype(jnp.float32))).astype(h.dtype)
    o = o.reshape(B_, L, DN_WIDTH)
    pooled = pool_mixer(proj[..., STATE_COLS + DN_WIDTH:], pool_w, pool_scale, rows)
    return jnp.concatenate([o, pooled], axis=-1) @ w_out, states


def context_states(h, w_in, conv_w, a_log, dt_bias, s0):
    proj = h @ w_in[:, DN_WIDTH:STATE_COLS]
    (k, v), log_a, beta = deltanet_inputs(proj[..., :2 * DN_WIDTH], proj[..., 2 * DN_WIDTH:],
                                          conv_w[:, DN_WIDTH:], a_log, dt_bias)
    _, states = bidir_delta(None, l2norm(k), v, log_a, beta, s0)
    return states


def expert_choice_ffn(h, w_router, w_gate, w_up, w_down):
    B_, L, D = h.shape
    cap = EC_CAPACITY * L // N_EXPERTS
    aff = jax.nn.softmax((h @ w_router).astype(jnp.float32), axis=-1)
    top_aff, top_idx = lax.top_k(jnp.swapaxes(aff, 1, 2), cap)
    xe = jax.vmap(lambda hb, ib: hb[ib])(h, top_idx)
    hid = jax.nn.silu(jnp.einsum('becd,edf->becf', xe, w_gate)) * jnp.einsum('becd,edf->becf', xe, w_up)
    ye = jnp.einsum('becf,efd->becd', hid, w_down) * top_aff[..., None].astype(h.dtype)
    combine = lambda ib, yb: jnp.zeros((L, D), yb.dtype).at[ib.reshape(-1)].add(yb.reshape(-1, D))
    return jax.vmap(combine)(top_idx, ye)


def setup_inputs(seed: int = 0) -> dict:
    key = jax.random.key(seed)
    ks = jax.random.split(key, 21)
    nrm = lambda k, shape, scale: jax.random.normal(k, shape, jnp.float32) * scale
    D = D_MODEL
    dt = jnp.exp(jax.random.uniform(ks[11], (DEPTH, N_DIR, DN_HEADS), jnp.float32,
                                    minval=math.log(1e-3), maxval=math.log(1e-1)))
    return {
        'x': nrm(ks[0], (BATCH, SEQ, D), 1.0),
        'c': nrm(ks[1], (BATCH, D), 1.0),
        'ctx': nrm(ks[2], (BATCH, CTX_LEN, D), 1.0),
        'c_ctx': nrm(ks[3], (D,), 1.0),
        'w_mod': nrm(ks[4], (DEPTH, D, 6 * D), 0.5 * D ** -0.5),
        'b_mod': nrm(ks[5], (DEPTH, 6 * D), 0.01),
        'norm1': 1.0 + nrm(ks[6], (DEPTH, D), 0.02),
        'norm2': 1.0 + nrm(ks[7], (DEPTH, D), 0.02),
        'w_in': nrm(ks[8], (DEPTH, D, IN_COLS), D ** -0.5),
        'conv_w': nrm(ks[9], (DEPTH, CONV_K, QKV_COLS), CONV_K ** -0.5),
        'a_log': jnp.log(jax.random.uniform(ks[10], (DEPTH, N_DIR, DN_HEADS), jnp.float32, minval=1.0, maxval=16.0)),
        'dt_bias': dt + jnp.log(-jnp.expm1(-dt)),
        'dn_norm': 1.0 + nrm(ks[12], (DEPTH, DN_HEAD_DIM), 0.02),
        'pool_w': nrm(ks[13], (DEPTH, POOL_GROUPS, POOL_GROUP_DIM, POOL_GROUP_DIM), POOL_GROUP_DIM ** -0.5),
        'pool_scale': 1.0 + nrm(ks[14], (DEPTH, POOL_WIDTH), 0.1),
        'w_out': nrm(ks[15], (DEPTH, MIX_WIDTH, D), MIX_WIDTH ** -0.5),
        'w_router': nrm(ks[16], (DEPTH, D, N_EXPERTS), D ** -0.5),
        'w_gate': nrm(ks[17], (DEPTH, N_EXPERTS, D, EXPERT_FF), D ** -0.5),
        'w_up': nrm(ks[18], (DEPTH, N_EXPERTS, D, EXPERT_FF), D ** -0.5),
        'w_down': nrm(ks[19], (DEPTH, N_EXPERTS, EXPERT_FF, D), EXPERT_FF ** -0.5),
        'norm_f': 1.0 + nrm(ks[20], (D,), 0.02),
    }


def reference(x, c, ctx, c_ctx, w_mod, b_mod, norm1, norm2, w_in, conv_w, a_log, dt_bias, dn_norm,
              pool_w, pool_scale, w_out, w_router, w_gate, w_up, w_down, norm_f):
    rows = x.shape[1] // GRID_W
    zero = jnp.zeros((ctx.shape[0], DN_HEADS, DN_HEAD_DIM, DN_HEAD_DIM), jnp.float32)
    z = ctx
    for l in range(DEPTH):
        mix_w = (w_in[l], conv_w[l], a_log[l], dt_bias[l], dn_norm[l], pool_w[l], pool_scale[l], w_out[l])
        csh1, csc1, cg1, csh2, csc2, cg2 = adaln_params(c_ctx, w_mod[l], b_mod[l])
        sh1, sc1, g1, sh2, sc2, g2 = [t[:, None, :] for t in adaln_params(c, w_mod[l], b_mod[l])]
        hz = modulate(rmsnorm(z, norm1[l]), csh1, csc1)
        if l < DEPTH - 1:
            yz, ctx_st = token_mixer(hz, *mix_w, (zero, zero), None)
            z = z + cg1 * yz
            hz2 = modulate(rmsnorm(z, norm2[l]), csh2, csc2)
            z = z + cg2 * expert_choice_ffn(hz2, w_router[l], w_gate[l], w_up[l], w_down[l])
        else:
            ctx_st = context_states(hz, w_in[l], conv_w[l], a_log[l], dt_bias[l], (zero, zero))
        h = modulate(rmsnorm(x, norm1[l]), sh1, sc1)
        y, _ = token_mixer(h, *mix_w, ctx_st, rows)
        x = x + g1 * y
        h = modulate(rmsnorm(x, norm2[l]), sh2, sc2)
        x = x + g2 * expert_choice_ffn(h, w_router[l], w_gate[l], w_up[l], w_down[l])
    return rmsnorm(x, norm_f)
```

```cpp
#include <hip/hip_runtime.h>
#include <stdint.h>
#include <stdio.h>
#include <string.h>

#ifndef ONE_LAUNCH
#define ONE_LAUNCH 0
#endif
#ifndef REGSTAGE
#define REGSTAGE 0
#endif

#define LAS __attribute__((address_space(3)))
typedef unsigned short bf16_t;
typedef short bf16x8 __attribute__((ext_vector_type(8)));
typedef float f32x4 __attribute__((ext_vector_type(4)));
typedef float f32x2 __attribute__((ext_vector_type(2)));
typedef unsigned u32x2 __attribute__((ext_vector_type(2)));
typedef unsigned u32x4 __attribute__((ext_vector_type(4)));

constexpr int D = 1024, NB = 8, SEQ = 2048, DEPTH = 4, CTXL = 256;
constexpr int ROWS_LAT = NB * SEQ;
constexpr int ROWS_CTX = NB * CTXL;
constexpr int MT = ROWS_LAT + ROWS_CTX;
constexpr int INC = 2576;
constexpr int PN = 2560;
constexpr int NE = 16;
constexpr int NGROUPS = 144;
constexpr int NSLOTS = NGROUPS * 256;
constexpr int NTHREADS = 512;
constexpr float EPS = 1e-6f;

constexpr size_t al256(size_t x) { return (x + 255) & ~(size_t)255; }
constexpr size_t WS_BAR = 0;
constexpr size_t WS_MOD = 16384;
constexpr size_t WS_X = WS_MOD + al256((size_t)DEPTH * 9 * 6144 * 4);
constexpr size_t WS_H = WS_X + (size_t)MT * D * 4;
constexpr size_t WS_PROJ = WS_H + (size_t)MT * D * 2;
constexpr size_t WS_YE = WS_PROJ;
constexpr size_t WS_LOGA = WS_PROJ + (size_t)MT * PN * 2;
constexpr size_t WS_BETA = WS_LOGA + (size_t)MT * 8 * 4;
constexpr size_t WS_QKV = WS_BETA + (size_t)MT * 8 * 4;
constexpr size_t WS_HID = WS_QKV;
constexpr size_t WS_OF = WS_QKV + (size_t)MT * 1536 * 4;
constexpr size_t WS_OB = WS_OF + (size_t)MT * 512 * 4;
constexpr size_t WS_CAT = WS_OB + (size_t)MT * 512 * 4;
constexpr size_t WS_AFF = WS_CAT + (size_t)MT * D * 2;
constexpr size_t WS_SEL = WS_AFF + (size_t)MT * 16 * 4;
constexpr size_t WS_SELAFF = WS_SEL + (size_t)NSLOTS * 4;
constexpr size_t WS_SLOTOF = WS_SELAFF + (size_t)NSLOTS * 4;
constexpr size_t WS_WINT = WS_SLOTOF + (size_t)MT * 16 * 4;
constexpr size_t WS_WOUTT = WS_WINT + (size_t)DEPTH * PN * D * 2;
constexpr size_t WS_WGUT = WS_WOUTT + (size_t)DEPTH * D * D * 2;
constexpr size_t WS_WDT = WS_WGUT + (size_t)DEPTH * NE * 2048 * D * 2;
constexpr size_t WS_PWT = WS_WDT + (size_t)DEPTH * NE * D * D * 2;
constexpr size_t WS_END = WS_PWT + (size_t)DEPTH * 4 * 128 * 128 * 2;

constexpr int LDS_OFF = 1024;
constexpr int LDS_WORK = 98304;
constexpr int LDS_BYTES = LDS_OFF + LDS_WORK;

struct Params {
    const float *x, *c, *ctx, *c_ctx, *w_mod, *b_mod, *norm1, *norm2, *w_in, *conv_w, *a_log, *dt_bias, *dn_norm, *pool_w, *pool_scale, *w_out, *w_router, *w_gate, *w_up, *w_down, *norm_f;
    float* out;
    unsigned char* ws;
    int ph_lo, ph_hi;
};

#define XB_TMO      128
#define XB_XCNT(j)  (256  + 64 * (j))
#define XB_XSUB(j)  (1280 + 64 * (j))
#define XB_XGEN(j)  (2304 + 64 * (j))
#define XB_TOP      3328
#define XB_TOPGEN   3392
#define XCD_BAR_WORDS 3456
#define XB_SPIN_CAP (1u << 22)

__device__ __forceinline__ unsigned xb_ld(unsigned* p)              { return __hip_atomic_load(p, __ATOMIC_RELAXED, __HIP_MEMORY_SCOPE_AGENT); }
__device__ __forceinline__ unsigned xb_add(unsigned* p, unsigned v) { return __hip_atomic_fetch_add(p, v, __ATOMIC_RELAXED, __HIP_MEMORY_SCOPE_AGENT); }
__device__ __forceinline__ unsigned xb_xcc_id() { return (unsigned)__builtin_amdgcn_s_getreg((3 << 11) | 20) & 0xFu; }
#define XB_SPIN(cond, bar) do { unsigned _sp = 0; while (cond) { __builtin_amdgcn_s_sleep(1); \
    if ((++_sp & 255u) == 0u) { if (xb_ld(&(bar)[XB_TMO])) break; if (_sp > XB_SPIN_CAP) { atomicAdd(&(bar)[XB_TMO], 1u); break; } } } } while (0)

struct XcdBarrier { unsigned* bar; unsigned x; volatile LAS unsigned* st; };

__device__ __forceinline__ XcdBarrier xcd_barrier_post(unsigned* bar, volatile LAS unsigned* st) {
    XcdBarrier b; b.bar = bar; b.x = xb_xcc_id(); b.st = st;
    if (threadIdx.x == 0) (void)xb_add(&bar[XB_XCNT(b.x)], 1u);
    return b;
}
__device__ __forceinline__ void xcd_barrier_complete(unsigned* bar, unsigned x, unsigned& nloc, unsigned& nx) {
    const unsigned G = gridDim.x * gridDim.y * gridDim.z;
    unsigned sum, cnt, mine, sp = 0u;
    for (;;) {
        sum = 0u; cnt = 0u; mine = 0u;
#pragma unroll
        for (unsigned j = 0; j < 16; ++j) { const unsigned c = xb_ld(&bar[XB_XCNT(j)]); sum += c; cnt += (c > 0u) ? 1u : 0u; mine = (j == x) ? c : mine; }
        if (sum == G) break;
        __builtin_amdgcn_s_sleep(1);
        if ((++sp & 255u) == 0u) { if (xb_ld(&bar[XB_TMO])) break; if (sp > XB_SPIN_CAP) { atomicAdd(&bar[XB_TMO], 1u); break; } }
    }
    nloc = mine > 0u ? mine : 1u; nx = cnt > 0u ? cnt : 1u;
}
__device__ __forceinline__ void xcd_barrier(const XcdBarrier& b) {
    asm volatile("s_waitcnt vmcnt(0)" ::: "memory");
    __syncthreads();
    if (threadIdx.x == 0) {
        unsigned* bar = b.bar;
        __builtin_amdgcn_s_waitcnt(0);
        unsigned nloc = b.st[0], nx = b.st[1];
        if (nloc == 0u) { xcd_barrier_complete(bar, b.x, nloc, nx); b.st[0] = nloc; b.st[1] = nx; }
        const unsigned old = xb_add(&bar[XB_XSUB(b.x)], 1u);
        const unsigned gen = old / nloc;
        if (old + 1u == (gen + 1u) * nloc) {
            __builtin_amdgcn_fence(__ATOMIC_RELEASE, "agent");
            asm volatile("s_waitcnt vmcnt(0)" ::: "memory");
            const unsigned og = xb_add(&bar[XB_TOP], 1u);
            const unsigned tg = og / nx;
            if (og + 1u == (tg + 1u) * nx) xb_add(&bar[XB_TOPGEN], 1u);
            else XB_SPIN(xb_ld(&bar[XB_TOPGEN]) == tg, bar);
            __builtin_amdgcn_fence(__ATOMIC_ACQUIRE, "agent");
            xb_add(&bar[XB_XGEN(b.x)], 1u);
            asm volatile("s_waitcnt vmcnt(0)" ::: "memory");
        } else {
            XB_SPIN(xb_ld(&bar[XB_XGEN(b.x)]) == gen, bar);
            __builtin_amdgcn_fence(__ATOMIC_ACQUIRE, "agent");
            asm volatile("s_waitcnt vmcnt(0)" ::: "memory");
        }
    }
    __syncthreads();
}

typedef __bf16 bf16x2_t __attribute__((ext_vector_type(2)));
__device__ __forceinline__ unsigned pk_bf16(float lo, float hi) { const f32x2 v = {lo, hi}; const bf16x2_t b = __builtin_convertvector(v, bf16x2_t); return __builtin_bit_cast(unsigned, b); }
__device__ __forceinline__ float bf_lo(unsigned u) { return __uint_as_float(u << 16); }
__device__ __forceinline__ float bf_hi(unsigned u) { return __uint_as_float(u & 0xffff0000u); }
__device__ __forceinline__ float wave_sum(float v) {
#pragma unroll
    for (int o = 32; o > 0; o >>= 1) v += __shfl_xor(v, o);
    return v;
}
__device__ __forceinline__ int opaque_tid() { int t = threadIdx.x; asm volatile("" : "+v"(t)); return t; }
__device__ __forceinline__ int opaque_s(int v) { asm volatile("" : "+s"(v)); return v; }
__device__ __forceinline__ float silu_f(float v) { return v / (1.f + __expf(-v)); }

__device__ __forceinline__ int lds_byte(int r, int c) { const int st = (r >> 4) * 2 + (c >> 5), rr = r & 15, cc = c & 31, ob = rr * 64 + cc * 2; return st * 1024 + (ob ^ (((ob >> 9) & 1) << 5)); }
__device__ __forceinline__ void stage_rc(int b, int& R, int& C) { const int st = b >> 10, sb = b & 1023, swz = sb ^ (((sb >> 9) & 1) << 5); R = (st >> 1) * 16 + (swz >> 6); C = (st & 1) * 32 + ((swz & 63) >> 1); }

__device__ void phase_prologue(const Params& p, LAS unsigned char* lds) {
    const int tid = opaque_tid();
    {
        LAS float* sc = (LAS float*)lds;
        LAS float* red = sc + 9 * 1024;
        for (int idx = tid; idx < 9 * 1024; idx += NTHREADS) {
            const int r = idx >> 10, k = idx & 1023;
            const float v = r < 8 ? p.c[r * 1024 + k] : p.c_ctx[k];
            sc[idx] = silu_f(v);
        }
        __syncthreads();
        float* MOD = (float*)(p.ws + WS_MOD);
        for (int u = blockIdx.x; u < DEPTH * 96; u += gridDim.x) {
            const int l = u / 96, c0 = (u % 96) * 64, col = tid & 63, kg = tid >> 6;
            float acc[9];
#pragma unroll
            for (int r = 0; r < 9; ++r) acc[r] = 0.f;
            const float* W = p.w_mod + (size_t)l * 1024 * 6144 + c0 + col;
#pragma unroll 4
            for (int kk = 0; kk < 128; ++kk) {
                const int k = kg * 128 + kk;
                const float w = W[(size_t)k * 6144];
#pragma unroll
                for (int r = 0; r < 9; ++r) acc[r] += sc[r * 1024 + k] * w;
            }
#pragma unroll
            for (int r = 0; r < 9; ++r) red[(kg * 9 + r) * 64 + col] = acc[r];
            __syncthreads();
            for (int idx = tid; idx < 576; idx += NTHREADS) {
                const int r = idx >> 6, cc = idx & 63;
                float s = 0.f;
#pragma unroll
                for (int g = 0; g < 8; ++g) s += red[(g * 9 + r) * 64 + cc];
                MOD[((size_t)l * 9 + r) * 6144 + c0 + cc] = s + p.b_mod[l * 6144 + c0 + cc];
            }
            __syncthreads();
        }
    }
    {
        f32x4* X4 = (f32x4*)(p.ws + WS_X);
        const f32x4* x4 = (const f32x4*)p.x; const f32x4* c4 = (const f32x4*)p.ctx;
        const int nlat = ROWS_LAT * D / 4, ntot = MT * D / 4;
        for (int i = blockIdx.x * NTHREADS + tid; i < ntot; i += gridDim.x * NTHREADS) X4[i] = i < nlat ? x4[i] : c4[i - nlat];
    }
    {
        LAS float* tile = (LAS float*)lds;
        bf16_t* WINT = (bf16_t*)(p.ws + WS_WINT); bf16_t* WOUTT = (bf16_t*)(p.ws + WS_WOUTT); bf16_t* WGUT = (bf16_t*)(p.ws + WS_WGUT); bf16_t* WDT = (bf16_t*)(p.ws + WS_WDT);
        constexpr int T_IN = 10 * 16, T_OUT = 4 * 16, T_EXP = NE * 4 * 16, T_LAYER = T_IN + T_OUT + 3 * T_EXP;
        for (int t = blockIdx.x; t < DEPTH * T_LAYER; t += gridDim.x) {
            const int l = t / T_LAYER; int i = t % T_LAYER;
            const float* src; size_t sld; bf16_t* dst; int rs = 16;
            if (i < T_IN) { const int nt = i >> 4, kt = i & 15; const int n0 = nt < 6 ? nt * 256 : 1552 + (nt - 6) * 256;
                src = p.w_in + ((size_t)l * D + kt * 64) * INC + n0; sld = INC; dst = WINT + ((size_t)l * PN + nt * 256) * D + kt * 64; }
            else if (i < T_IN + T_OUT) { i -= T_IN; const int nt = i >> 4, kt = i & 15;
                src = p.w_out + ((size_t)l * D + kt * 64) * D + nt * 256; sld = D; dst = WOUTT + ((size_t)l * D + nt * 256) * D + kt * 64; }
            else { i -= T_IN + T_OUT; const int which = i / T_EXP; i %= T_EXP; const int e = i >> 6, nt = (i >> 4) & 3, kt = i & 15;
                const size_t mo = ((size_t)(l * NE + e) * D + kt * 64) * D + nt * 256;
                if (which == 2) { src = p.w_down + mo; dst = WDT + ((size_t)(l * NE + e) * D + nt * 256) * D + kt * 64; }
                else { src = (which == 0 ? p.w_gate : p.w_up) + mo; rs = 32; dst = WGUT + ((size_t)(l * NE + e) * 2048 + nt * 512 + which * 16) * D + kt * 64; }
                sld = D; }
#pragma unroll
            for (int j = 0; j < 8; ++j) {
                const int e = tid * 4 + j * 2048, k = e >> 8, n = e & 255;
                const f32x4 v = *(const f32x4*)(src + (size_t)k * sld + n);
                tile[k * 257 + n] = v[0]; tile[k * 257 + n + 1] = v[1]; tile[k * 257 + n + 2] = v[2]; tile[k * 257 + n + 3] = v[3];
            }
            __syncthreads();
#pragma unroll
            for (int ps = 0; ps < 4; ++ps) {
                const int n = ps * 64 + (tid >> 3), ks = (tid & 7) * 8;
                u32x4 o;
                o[0] = pk_bf16(tile[(ks + 0) * 257 + n], tile[(ks + 1) * 257 + n]); o[1] = pk_bf16(tile[(ks + 2) * 257 + n], tile[(ks + 3) * 257 + n]);
                o[2] = pk_bf16(tile[(ks + 4) * 257 + n], tile[(ks + 5) * 257 + n]); o[3] = pk_bf16(tile[(ks + 6) * 257 + n], tile[(ks + 7) * 257 + n]);
                *(u32x4*)(dst + (size_t)((n >> 4) * rs + (n & 15)) * D + ks) = o;
            }
            __syncthreads();
        }
        bf16_t* PWT = (bf16_t*)(p.ws + WS_PWT);
        for (int i = blockIdx.x * NTHREADS + tid; i < DEPTH * 4 * 128 * 128; i += gridDim.x * NTHREADS) {
            const int lg = i >> 14, d = (i >> 7) & 127, c = i & 127;
            PWT[i] = (bf16_t)(pk_bf16(p.pool_w[((size_t)lg * 128 + c) * 128 + d], 0.f) & 0xffffu);
        }
    }
}

template <int WHICH>
__device__ void phase_norm(const Params& p, const int l, LAS unsigned char* lds) {
    const int tid = opaque_tid(), wid = tid >> 6, lane = tid & 63;
    LAS float* wsm = (LAS float*)lds;
    if (WHICH != 3) {
        const float* src; int stride;
        if (WHICH == 1) { src = p.w_in + (size_t)l * D * INC + 1536; stride = INC; } else { src = p.w_router + (size_t)l * D * NE; stride = NE; }
        for (int idx = tid; idx < 16 * 1024; idx += NTHREADS) { const int k = idx >> 4, j = idx & 15; wsm[j * 1024 + k] = src[(size_t)k * stride + j]; }
        __syncthreads();
    }
    const float* nw = WHICH == 1 ? p.norm1 + l * D : (WHICH == 2 ? p.norm2 + l * D : p.norm_f);
    float* X = (float*)(p.ws + WS_X);
    const float* MOD = (const float*)(p.ws + WS_MOD);
    bf16_t* H = (bf16_t*)(p.ws + WS_H);
    const int nrows = (WHICH == 3) ? ROWS_LAT : MT;
    for (int row = blockIdx.x * 8 + wid; row < nrows; row += gridDim.x * 8) {
        const int bidx = row < ROWS_LAT ? (row >> 11) : 8;
        float* xr = X + (size_t)row * D;
        f32x4 xv[4];
#pragma unroll
        for (int i = 0; i < 4; ++i) xv[i] = *(const f32x4*)(xr + i * 256 + lane * 4);
        if ((WHICH == 1 && l > 0) || WHICH == 3) {
            const int lp = (WHICH == 3) ? DEPTH - 1 : l - 1;
            const float* g2 = MOD + ((size_t)lp * 9 + bidx) * 6144 + 5 * 1024;
            const int* so = (const int*)(p.ws + WS_SLOTOF) + (size_t)row * 16;
            const bf16_t* YE = (const bf16_t*)(p.ws + WS_YE);
            f32x4 a[4];
#pragma unroll
            for (int i = 0; i < 4; ++i) a[i] = (f32x4){0.f, 0.f, 0.f, 0.f};
            for (int e = 0; e < NE; ++e) {
                const int s = __builtin_amdgcn_readfirstlane(so[e]);
                if (s >= 0) {
                    const bf16_t* yr = YE + (size_t)s * D;
#pragma unroll
                    for (int i = 0; i < 4; ++i) { const u32x2 v = *(const u32x2*)(yr + i * 256 + lane * 4);
                        a[i][0] += bf_lo(v[0]); a[i][1] += bf_hi(v[0]); a[i][2] += bf_lo(v[1]); a[i][3] += bf_hi(v[1]); }
                }
            }
#pragma unroll
            for (int i = 0; i < 4; ++i) { const f32x4 g = *(const f32x4*)(g2 + i * 256 + lane * 4); xv[i] += g * a[i]; }
            if (WHICH == 1) {
#pragma unroll
                for (int i = 0; i < 4; ++i) *(f32x4*)(xr + i * 256 + lane * 4) = xv[i];
            }
        }
        float ss = 0.f;
#pragma unroll
        for (int i = 0; i < 4; ++i) ss += xv[i][0] * xv[i][0] + xv[i][1] * xv[i][1] + xv[i][2] * xv[i][2] + xv[i][3] * xv[i][3];
        ss = wave_sum(ss);
        const float rstd = rsqrtf(ss * (1.f / 1024.f) + EPS);
        if (WHICH == 3) {
#pragma unroll
            for (int i = 0; i < 4; ++i) { const f32x4 w = *(const f32x4*)(nw + i * 256 + lane * 4); *(f32x4*)(p.out + (size_t)row * D + i * 256 + lane * 4) = xv[i] * rstd * w; }
            continue;
        }
        const float* md = MOD + ((size_t)l * 9 + bidx) * 6144 + (WHICH == 1 ? 0 : 3072);
        f32x4 h[4];
#pragma unroll
        for (int i = 0; i < 4; ++i) {
            const int c = i * 256 + lane * 4;
            const f32x4 w = *(const f32x4*)(nw + c), sh = *(const f32x4*)(md + c), scl = *(const f32x4*)(md + 1024 + c);
            h[i] = (xv[i] * rstd * w) * (scl + 1.f) + sh;
            u32x2 o; o[0] = pk_bf16(h[i][0], h[i][1]); o[1] = pk_bf16(h[i][2], h[i][3]);
            *(u32x2*)(H + (size_t)row * D + c) = o;
        }
        float d[16];
#pragma unroll
        for (int jg = 0; jg < 4; ++jg) {
#pragma unroll
            for (int jj = 0; jj < 4; ++jj) {
                const int j = jg * 4 + jj;
                float s = 0.f;
#pragma unroll
                for (int i = 0; i < 4; ++i) { const f32x4 w = *(const LAS f32x4*)(wsm + j * 1024 + i * 256 + lane * 4); s += h[i][0] * w[0] + h[i][1] * w[1] + h[i][2] * w[2] + h[i][3] * w[3]; }
                d[j] = wave_sum(s);
            }
            __builtin_amdgcn_sched_barrier(0);
        }
        if (WHICH == 1) {
            float da = 0.f, db = 0.f;
#pragma unroll
            for (int j = 0; j < 8; ++j) { da = (lane == j) ? d[j] : da; db = (lane == j) ? d[8 + j] : db; }
            if (lane < 8) {
                const float xa = da + p.dt_bias[l * 8 + lane];
                const float sp = xa > 20.f ? xa : log1pf(__expf(xa));
                ((float*)(p.ws + WS_LOGA))[(size_t)row * 8 + lane] = -__expf(p.a_log[l * 8 + lane]) * sp;
                ((float*)(p.ws + WS_BETA))[(size_t)row * 8 + lane] = 1.f / (1.f + __expf(-db));
            }
        } else {
            float m = d[0];
#pragma unroll
            for (int j = 1; j < 16; ++j) m = fmaxf(m, d[j]);
            float sum = 0.f, mine = 0.f;
#pragma unroll
            for (int j = 0; j < 16; ++j) { const float e = __expf(d[j] - m); sum += e; mine = (lane == j) ? e : mine; }
            if (lane < 16) ((float*)(p.ws + WS_AFF))[(size_t)row * 16 + lane] = mine / sum;
        }
    }
}

__device__ __forceinline__ void gemm_core(const unsigned char* Ab, const unsigned (&aoff)[4], const unsigned char* Bb, const unsigned (&boff)[2], const int nt,
                                          LAS unsigned char* lds, f32x4 (&acc)[4][4], const int wid, const int lane) {
    const int wr = wid >> 1, wc = wid & 1, fr = lane & 15, fq = lane >> 4;
    const int ar = lds_byte(wr * 64 + fr, fq * 8), br = lds_byte(wc * 64 + fr, fq * 8);
    const unsigned ldsw = (unsigned)wid * 1024u;
#define G_STAGE(t, buf) do { const unsigned _ko = (unsigned)(t) * 128u; \
        _Pragma("unroll") for (int _i = 0; _i < 4; ++_i) __builtin_amdgcn_global_load_lds((const unsigned*)(Ab + aoff[_i] + _ko), (LAS unsigned*)(lds + (buf) * 49152 + ldsw + _i * 8192), 16, 0, 0); \
        _Pragma("unroll") for (int _i = 0; _i < 2; ++_i) __builtin_amdgcn_global_load_lds((const unsigned*)(Bb + boff[_i] + _ko), (LAS unsigned*)(lds + (buf) * 49152 + 32768 + ldsw + _i * 8192), 16, 0, 0); } while (0)
#pragma unroll
    for (int m = 0; m < 4; ++m)
#pragma unroll
        for (int n = 0; n < 4; ++n) acc[m][n] = (f32x4){0.f, 0.f, 0.f, 0.f};
#if REGSTAGE
    u32x4 ra[4], rb[2];
#pragma unroll
    for (int i = 0; i < 4; ++i) ra[i] = *(const u32x4*)(Ab + aoff[i]);
#pragma unroll
    for (int i = 0; i < 2; ++i) rb[i] = *(const u32x4*)(Bb + boff[i]);
    const unsigned tb = (unsigned)(wid * 64 + lane) * 16u;
    for (int t = 0; t < nt; ++t) {
        __syncthreads();
#pragma unroll
        for (int i = 0; i < 4; ++i) *(LAS u32x4*)(lds + tb + i * 8192) = ra[i];
#pragma unroll
        for (int i = 0; i < 2; ++i) *(LAS u32x4*)(lds + 32768 + tb + i * 8192) = rb[i];
        __syncthreads();
        if (t + 1 < nt) {
            const unsigned ko = (unsigned)(t + 1) * 128u;
#pragma unroll
            for (int i = 0; i < 4; ++i) ra[i] = *(const u32x4*)(Ab + aoff[i] + ko);
#pragma unroll
            for (int i = 0; i < 2; ++i) rb[i] = *(const u32x4*)(Bb + boff[i] + ko);
        }
        LAS unsigned char* bA = lds; LAS unsigned char* bB = bA + 32768;
        bf16x8 af[4][2], bfr[4][2];
#pragma unroll
        for (int m = 0; m < 4; ++m)
#pragma unroll
            for (int k = 0; k < 2; ++k) af[m][k] = *(const LAS bf16x8*)(bA + ar + m * 2048 + k * 1024);
#pragma unroll
        for (int n = 0; n < 4; ++n)
#pragma unroll
            for (int k = 0; k < 2; ++k) bfr[n][k] = *(const LAS bf16x8*)(bB + br + n * 2048 + k * 1024);
#pragma unroll
        for (int k = 0; k < 2; ++k)
#pragma unroll
            for (int m = 0; m < 4; ++m)
#pragma unroll
                for (int n = 0; n < 4; ++n) acc[m][n] = __builtin_amdgcn_mfma_f32_16x16x32_bf16(bfr[n][k], af[m][k], acc[m][n], 0, 0, 0);
    }
#else
    G_STAGE(0, 0);
    for (int t = 0; t < nt; ++t) {
        asm volatile("s_waitcnt vmcnt(0)" ::: "memory");
        __syncthreads();
        if (t + 1 < nt) { if ((t + 1) & 1) G_STAGE(t + 1, 1); else G_STAGE(t + 1, 0); }
        LAS unsigned char* bA = lds + (t & 1) * 49152; LAS unsigned char* bB = bA + 32768;
        bf16x8 af[4][2], bfr[4][2];
#pragma unroll
        for (int m = 0; m < 4; ++m)
#pragma unroll
            for (int k = 0; k < 2; ++k) af[m][k] = *(const LAS bf16x8*)(bA + ar + m * 2048 + k * 1024);
#pragma unroll
        for (int n = 0; n < 4; ++n)
#pragma unroll
            for (int k = 0; k < 2; ++k) bfr[n][k] = *(const LAS bf16x8*)(bB + br + n * 2048 + k * 1024);
#pragma unroll
        for (int k = 0; k < 2; ++k)
#pragma unroll
            for (int m = 0; m < 4; ++m)
#pragma unroll
                for (int n = 0; n < 4; ++n) acc[m][n] = __builtin_amdgcn_mfma_f32_16x16x32_bf16(bfr[n][k], af[m][k], acc[m][n], 0, 0, 0);
    }
#endif
    __syncthreads();
#undef G_STAGE
}

template <int MODE>
__device__ void phase_gemm(const Params& p, const int l, LAS unsigned char* lds) {
    const int tid = opaque_tid(), wid = __builtin_amdgcn_readfirstlane(tid >> 6), lane = tid & 63;
    const int wr = wid >> 1, wc = wid & 1, fr = lane & 15, fq = lane >> 4;
    int R0, C0; stage_rc(tid * 16, R0, C0);
    constexpr int nN = MODE == 0 ? 20 : (MODE == 1 ? 8 : (MODE == 2 ? 16 : 8));
    constexpr int nM = (MODE <= 1) ? MT / 256 : NGROUPS;
    const bf16_t* H = (const bf16_t*)(p.ws + WS_H);
    for (int u = blockIdx.x; u < nM * nN; u += gridDim.x) {
        const int pm = u / nN, pn = u % nN;
        const unsigned char* Ab; const unsigned char* Bb; unsigned aoff[4], boff[2];
#pragma unroll
        for (int i = 0; i < 2; ++i) boff[i] = (unsigned)((R0 + 64 * i) * D + C0) * 2u;
        int e = 0;
        if (MODE == 0) {
            Ab = (const unsigned char*)(H + (size_t)pm * 256 * D); Bb = (const unsigned char*)((const bf16_t*)(p.ws + WS_WINT) + ((size_t)l * PN + pn * 128) * D);
#pragma unroll
            for (int i = 0; i < 4; ++i) aoff[i] = (unsigned)((R0 + 64 * i) * D + C0) * 2u;
        } else if (MODE == 1) {
            Ab = (const unsigned char*)((const bf16_t*)(p.ws + WS_CAT) + (size_t)pm * 256 * D); Bb = (const unsigned char*)((const bf16_t*)(p.ws + WS_WOUTT) + ((size_t)l * D + pn * 128) * D);
#pragma unroll
            for (int i = 0; i < 4; ++i) aoff[i] = (unsigned)((R0 + 64 * i) * D + C0) * 2u;
        } else if (MODE == 2) {
            e = pm < 128 ? (pm >> 3) : (pm - 128);
            const int* SEL = (const int*)(p.ws + WS_SEL) + pm * 256;
            Ab = (const unsigned char*)H; Bb = (const unsigned char*)((const bf16_t*)(p.ws + WS_WGUT) + ((size_t)(l * NE + e) * 2048 + pn * 128) * D);
#pragma unroll
            for (int i = 0; i < 4; ++i) aoff[i] = (unsigned)(SEL[R0 + 64 * i] * D + C0) * 2u;
        } else {
            e = pm < 128 ? (pm >> 3) : (pm - 128);
            Ab = (const unsigned char*)((const bf16_t*)(p.ws + WS_HID) + (size_t)pm * 256 * D); Bb = (const unsigned char*)((const bf16_t*)(p.ws + WS_WDT) + ((size_t)(l * NE + e) * D + pn * 128) * D);
#pragma unroll
            for (int i = 0; i < 4; ++i) aoff[i] = (unsigned)((R0 + 64 * i) * D + C0) * 2u;
        }
        f32x4 acc[4][4];
        gemm_core(Ab, aoff, Bb, boff, D / 64, lds, acc, wid, lane);
        if (MODE == 0) {
            bf16_t* PROJ = (bf16_t*)(p.ws + WS_PROJ);
#pragma unroll
            for (int m = 0; m < 4; ++m) { const size_t row = (size_t)pm * 256 + wr * 64 + m * 16 + fr;
#pragma unroll
                for (int n = 0; n < 4; ++n) { u32x2 o; o[0] = pk_bf16(acc[m][n][0], acc[m][n][1]); o[1] = pk_bf16(acc[m][n][2], acc[m][n][3]);
                    *(u32x2*)(PROJ + row * PN + pn * 128 + wc * 64 + n * 16 + fq * 4) = o; } }
        } else if (MODE == 1) {
            float* X = (float*)(p.ws + WS_X);
            const int bidx = pm < 64 ? (pm >> 3) : 8;
            const float* g1 = (const float*)(p.ws + WS_MOD) + ((size_t)l * 9 + bidx) * 6144 + 2048;
#pragma unroll
            for (int n = 0; n < 4; ++n) { const int col = pn * 128 + wc * 64 + n * 16 + fq * 4; const f32x4 g = *(const f32x4*)(g1 + col);
#pragma unroll
                for (int m = 0; m < 4; ++m) { float* xp = X + ((size_t)pm * 256 + wr * 64 + m * 16 + fr) * D + col; *(f32x4*)xp = *(const f32x4*)xp + g * acc[m][n]; } }
        } else if (MODE == 2) {
            bf16_t* HID = (bf16_t*)(p.ws + WS_HID);
#pragma unroll
            for (int m = 0; m < 4; ++m) { const size_t slot = (size_t)pm * 256 + wr * 64 + m * 16 + fr;
#pragma unroll
                for (int q = 0; q < 2; ++q) { const f32x4 g = acc[m][2 * q], uu = acc[m][2 * q + 1];
                    u32x2 o; o[0] = pk_bf16(silu_f(g[0]) * uu[0], silu_f(g[1]) * uu[1]); o[1] = pk_bf16(silu_f(g[2]) * uu[2], silu_f(g[3]) * uu[3]);
                    *(u32x2*)(HID + slot * D + pn * 64 + wc * 32 + q * 16 + fq * 4) = o; } }
        } else {
            bf16_t* YE = (bf16_t*)(p.ws + WS_YE);
            const float* SELAFF = (const float*)(p.ws + WS_SELAFF);
#pragma unroll
            for (int m = 0; m < 4; ++m) { const size_t slot = (size_t)pm * 256 + wr * 64 + m * 16 + fr; const float a = SELAFF[slot];
#pragma unroll
                for (int n = 0; n < 4; ++n) { u32x2 o; o[0] = pk_bf16(acc[m][n][0] * a, acc[m][n][1] * a); o[1] = pk_bf16(acc[m][n][2] * a, acc[m][n][3] * a);
                    *(u32x2*)(YE + slot * D + pn * 128 + wc * 64 + n * 16 + fq * 4) = o; } }
        }
    }
}

__device__ void phase_conv_pool(const Params& p, const int l, LAS unsigned char* lds) {
    const int tid = opaque_tid(), wid = tid >> 6, lane = tid & 63;
    const bf16_t* PROJ = (const bf16_t*)(p.ws + WS_PROJ);
    {
        float* QKV = (float*)(p.ws + WS_QKV);
        const float* cw = p.conv_w + (size_t)l * 4 * 1536;
        for (int task = blockIdx.x * 8 + wid; task < MT * 12; task += gridDim.x * 8) {
            const int row = task / 12, part = task % 12;
            int s0, len;
            if (row < ROWS_LAT) { s0 = row & ~2047; len = 2048; } else { s0 = ROWS_LAT + ((row - ROWS_LAT) & ~255); len = 256; }
            const int c = part * 128 + lane * 2;
            float a0 = 0.f, a1 = 0.f;
#pragma unroll
            for (int j = 0; j < 4; ++j) {
                const int r2 = row + j - 2;
                if (r2 >= s0 && r2 < s0 + len) {
                    const unsigned v = *(const unsigned*)(PROJ + (size_t)r2 * PN + c);
                    const f32x2 w = *(const f32x2*)(cw + j * 1536 + c);
                    a0 += w[0] * bf_lo(v); a1 += w[1] * bf_hi(v);
                }
            }
            a0 = silu_f(a0); a1 = silu_f(a1);
            if (part < 8) {
                const float ss = wave_sum(a0 * a0 + a1 * a1);
                float sc = rsqrtf(ss + EPS);
                if (part < 4) sc *= 0.08838834764831845f;
                a0 *= sc; a1 *= sc;
            }
            *(f32x2*)(QKV + (size_t)row * 1536 + c) = (f32x2){a0, a1};
        }
    }
    {
        LAS float* V = (LAS float*)lds;
        LAS unsigned char* mt = lds + 40960;
        const bf16_t* PWT = (const bf16_t*)(p.ws + WS_PWT);
        bf16_t* CAT = (bf16_t*)(p.ws + WS_CAT);
        const int wr = wid >> 1, wc = wid & 1, fr = lane & 15, fq = lane >> 4;
        for (int u = blockIdx.x; u < 1152; u += gridDim.x) {
            int g, r, nrows, ncols, c0, rowbase;
            if (u < 1024) { const int b = u >> 7; g = (u >> 5) & 3; r = u & 31; nrows = 32; ncols = 64; c0 = 0; rowbase = b * 2048; }
            else { const int v = u - 1024; const int b = v >> 4; g = (v >> 2) & 3; r = 0; nrows = 1; ncols = 256; c0 = (v & 3) * 64; rowbase = ROWS_LAT + b * 256; }
            const int w = 2 << g, half = w >> 1;
            const int lo_r = max(r - half, 0), hi_r = min(r - half + w, nrows);
            const int cxlo = max(c0 - half, 0), cxhi = min(c0 + 64 + half, ncols);
            const bf16_t* ub = PROJ + 2048 + g * 128;
            for (int idx = tid; idx < (cxhi - cxlo) * 64; idx += NTHREADS) {
                const int cxi = idx >> 6, ch = (idx & 63) * 2;
                float s0 = 0.f, s1 = 0.f;
                for (int rr = lo_r; rr < hi_r; ++rr) { const unsigned v = *(const unsigned*)(ub + (size_t)(rowbase + rr * ncols + cxlo + cxi) * PN + ch); s0 += bf_lo(v); s1 += bf_hi(v); }
                V[cxi * 128 + ch] = s0; V[cxi * 128 + ch + 1] = s1;
            }
            __syncthreads();
            for (int idx = tid; idx < 64 * 64; idx += NTHREADS) {
                const int ci = idx >> 6, ch = (idx & 63) * 2, c = c0 + ci;
                const int lo_c = max(c - half, 0), hi_c = min(c - half + w, ncols);
                float s0 = 0.f, s1 = 0.f;
                for (int cx = lo_c; cx < hi_c; ++cx) { s0 += V[(cx - cxlo) * 128 + ch]; s1 += V[(cx - cxlo) * 128 + ch + 1]; }
                const float inv = 1.f / (float)((hi_r - lo_r) * (hi_c - lo_c));
                const unsigned v = *(const unsigned*)(ub + (size_t)(rowbase + r * ncols + c) * PN + ch);
                *(LAS unsigned*)(mt + ci * 272 + ch * 2) = pk_bf16(s0 * inv - bf_lo(v), s1 * inv - bf_hi(v));
            }
            __syncthreads();
            f32x4 acc[4];
#pragma unroll
            for (int n = 0; n < 4; ++n) acc[n] = (f32x4){0.f, 0.f, 0.f, 0.f};
            const bf16_t* pw = PWT + (size_t)(l * 4 + g) * 128 * 128;
#pragma unroll
            for (int kk = 0; kk < 4; ++kk) {
                const bf16x8 a = *(const LAS bf16x8*)(mt + (wr * 16 + fr) * 272 + (kk * 32 + fq * 8) * 2);
#pragma unroll
                for (int n = 0; n < 4; ++n) {
                    const bf16x8 b = *(const bf16x8*)(pw + (size_t)(wc * 64 + n * 16 + fr) * 128 + kk * 32 + fq * 8);
                    acc[n] = __builtin_amdgcn_mfma_f32_16x16x32_bf16(b, a, acc[n], 0, 0, 0);
                }
            }
            const size_t row = (size_t)rowbase + r * ncols + c0 + wr * 16 + fr;
#pragma unroll
            for (int n = 0; n < 4; ++n) {
                const int dcol = g * 128 + wc * 64 + n * 16 + fq * 4;
                const f32x4 s = *(const f32x4*)(p.pool_scale + l * 512 + dcol);
                u32x2 o; o[0] = pk_bf16(acc[n][0] * s[0], acc[n][1] * s[1]); o[1] = pk_bf16(acc[n][2] * s[2], acc[n][3] * s[3]);
                *(u32x2*)(CAT + row * D + 512 + dcol) = o;
            }
            __syncthreads();
        }
    }
}

__device__ void phase_scan_naive(const Params& p, const int l, LAS unsigned char* lds) {
    const int tid = opaque_tid();
    LAS float* ks = (LAS float*)lds;
    LAS float* qs = ks + 4096;
    LAS float* vs = qs + 4096;
    LAS float* as = vs + 4096;
    LAS float* bs = as + 32;
    LAS int* rws = (LAS int*)(bs + 32);
    const float* QKV = (const float*)(p.ws + WS_QKV);
    const float* LOGA = (const float*)(p.ws + WS_LOGA);
    const float* BETA = (const float*)(p.ws + WS_BETA);
    for (int u = blockIdx.x; u < 64; u += gridDim.x) {
        const int b = u >> 3, h = (u >> 1) & 3, d = u & 1;
        float* O = (float*)(p.ws + (d ? WS_OB : WS_OF));
        const int col = tid >> 2, part = tid & 3;
        float S[32];
#pragma unroll
        for (int i = 0; i < 32; ++i) S[i] = 0.f;
        for (int n0 = 0; n0 < CTXL + SEQ; n0 += 32) {
            __syncthreads();
            if (tid < 32) {
                const int n = n0 + tid; int row;
                if (n < CTXL) row = ROWS_LAT + b * CTXL + (d ? CTXL - 1 - n : n);
                else { const int m = n - CTXL; row = b * SEQ + (d ? SEQ - 1 - m : m); }
                rws[tid] = row;
                as[tid] = __expf(LOGA[(size_t)row * 8 + d * 4 + h]);
                bs[tid] = BETA[(size_t)row * 8 + d * 4 + h];
            }
            __syncthreads();
            for (int i = tid; i < 4096; i += NTHREADS) {
                const int tok = i >> 7, cc = i & 127; const size_t base = (size_t)rws[tok] * 1536 + h * 128 + cc;
                qs[i] = QKV[base]; ks[i] = QKV[base + 512]; vs[i] = QKV[base + 1024];
            }
            __syncthreads();
            for (int tok = 0; tok < 32; ++tok) {
                float kk[32];
#pragma unroll
                for (int i = 0; i < 8; ++i) { const f32x4 v = *(const LAS f32x4*)(ks + tok * 128 + part * 32 + i * 4); kk[i * 4] = v[0]; kk[i * 4 + 1] = v[1]; kk[i * 4 + 2] = v[2]; kk[i * 4 + 3] = v[3]; }
                float kp = 0.f;
#pragma unroll
                for (int i = 0; i < 32; ++i) kp += kk[i] * S[i];
                kp += __shfl_xor(kp, 1); kp += __shfl_xor(kp, 2);
                const float a = as[tok], bt = bs[tok];
                const float bv = bt * (vs[tok * 128 + col] - a * kp);
#pragma unroll
                for (int i = 0; i < 32; ++i) S[i] = a * S[i] + kk[i] * bv;
                float op = 0.f;
#pragma unroll
                for (int i = 0; i < 8; ++i) { const f32x4 v = *(const LAS f32x4*)(qs + tok * 128 + part * 32 + i * 4); op += v[0] * S[i * 4] + v[1] * S[i * 4 + 1] + v[2] * S[i * 4 + 2] + v[3] * S[i * 4 + 3]; }
                op += __shfl_xor(op, 1); op += __shfl_xor(op, 2);
                if (part == 0) O[(size_t)rws[tok] * 512 + h * 128 + col] = op;
            }
        }
        __syncthreads();
    }
}

__device__ void phase_onorm(const Params& p, const int l) {
    const int tid = opaque_tid(), wid = tid >> 6, lane = tid & 63;
    const float* OF = (const float*)(p.ws + WS_OF); const float* OB = (const float*)(p.ws + WS_OB);
    const bf16_t* PROJ = (const bf16_t*)(p.ws + WS_PROJ);
    bf16_t* CAT = (bf16_t*)(p.ws + WS_CAT);
    const int c = lane * 8;
    const f32x4 w0 = *(const f32x4*)(p.dn_norm + l * 128 + (c & 127)), w1 = *(const f32x4*)(p.dn_norm + l * 128 + (c & 127) + 4);
    for (int row = blockIdx.x * 8 + wid; row < MT; row += gridDim.x * 8) {
        const size_t o = (size_t)row * 512 + c;
        f32x4 v0 = *(const f32x4*)(OF + o) + *(const f32x4*)(OB + o), v1 = *(const f32x4*)(OF + o + 4) + *(const f32x4*)(OB + o + 4);
        float ss = v0[0] * v0[0] + v0[1] * v0[1] + v0[2] * v0[2] + v0[3] * v0[3] + v1[0] * v1[0] + v1[1] * v1[1] + v1[2] * v1[2] + v1[3] * v1[3];
        ss += __shfl_xor(ss, 1); ss += __shfl_xor(ss, 2); ss += __shfl_xor(ss, 4); ss += __shfl_xor(ss, 8);
        const float rs = rsqrtf(ss * (1.f / 128.f) + EPS);
        const u32x4 gv = *(const u32x4*)(PROJ + (size_t)row * PN + 1536 + c);
        u32x4 out;
        out[0] = pk_bf16(v0[0] * rs * w0[0] * silu_f(bf_lo(gv[0])), v0[1] * rs * w0[1] * silu_f(bf_hi(gv[0])));
        out[1] = pk_bf16(v0[2] * rs * w0[2] * silu_f(bf_lo(gv[1])), v0[3] * rs * w0[3] * silu_f(bf_hi(gv[1])));
        out[2] = pk_bf16(v1[0] * rs * w1[0] * silu_f(bf_lo(gv[2])), v1[1] * rs * w1[1] * silu_f(bf_hi(gv[2])));
        out[3] = pk_bf16(v1[2] * rs * w1[2] * silu_f(bf_lo(gv[3])), v1[3] * rs * w1[3] * silu_f(bf_hi(gv[3])));
        *(u32x4*)(CAT + (size_t)row * D + c) = out;
    }
}

__device__ void phase_topk(const Params& p, LAS unsigned char* lds) {
    const int tid = opaque_tid();
    LAS unsigned long long* ks = (LAS unsigned long long*)lds;
    const float* AFF = (const float*)(p.ws + WS_AFF);
    int* SEL = (int*)(p.ws + WS_SEL); float* SELAFF = (float*)(p.ws + WS_SELAFF); int* SLOTOF = (int*)(p.ws + WS_SLOTOF);
    for (int u = blockIdx.x; u < 256; u += gridDim.x) {
        int e, n, C, rowbase, slotbase;
        if (u < 128) { e = u >> 3; const int b = u & 7; n = SEQ; C = 256; rowbase = b * SEQ; slotbase = u * 256; }
        else { const int v = u - 128; e = v >> 3; const int b = v & 7; n = CTXL; C = 32; rowbase = ROWS_LAT + b * CTXL; slotbase = (128 + e) * 256 + b * 32; }
        for (int i = tid; i < n; i += NTHREADS) ks[i] = ((unsigned long long)__float_as_uint(AFF[(size_t)(rowbase + i) * 16 + e]) << 32) | (unsigned long long)(0xFFFFFFFFu - (unsigned)i);
        __syncthreads();
        for (int k = 2; k <= n; k <<= 1)
            for (int j = k >> 1; j > 0; j >>= 1) {
                for (int q = tid; q < (n >> 1); q += NTHREADS) {
                    const int i = ((q & ~(j - 1)) << 1) | (q & (j - 1)), i2 = i | j;
                    const unsigned long long a = ks[i], b2 = ks[i2];
                    const bool up = (i & k) == 0;
                    if (up ? (a < b2) : (a > b2)) { ks[i] = b2; ks[i2] = a; }
                }
                __syncthreads();
            }
        for (int i = tid; i < n; i += NTHREADS) {
            const unsigned long long key = ks[i];
            const int t = (int)(0xFFFFFFFFu - (unsigned)(key & 0xFFFFFFFFull));
            SLOTOF[(size_t)(rowbase + t) * 16 + e] = (i < C) ? slotbase + i : -1;
            if (i < C) { SEL[slotbase + i] = rowbase + t; SELAFF[slotbase + i] = __uint_as_float((unsigned)(key >> 32)); }
        }
        __syncthreads();
    }
}


#ifndef DUMP
#define DUMP 0
#endif
#if DUMP
__device__ void phase_dump(const Params& p, const size_t off, const int is_bf16, const size_t n_avail) {
    const int tid = opaque_tid();
    const size_t n = (size_t)ROWS_LAT * D;
    for (size_t i = (size_t)blockIdx.x * NTHREADS + tid; i < n; i += (size_t)gridDim.x * NTHREADS) {
        float v = 0.f;
        if (i < n_avail) v = is_bf16 ? __uint_as_float((unsigned)((const bf16_t*)(p.ws + off))[i] << 16) : ((const float*)(p.ws + off))[i];
        p.out[i] = v;
    }
}
#endif

__global__ void __launch_bounds__(NTHREADS, 2) fwd(const Params p) {
    extern __shared__ __attribute__((aligned(16))) unsigned char smem[];
    LAS unsigned char* lds = (LAS unsigned char*)smem + LDS_OFF;
    XcdBarrier bar; bar.bar = (unsigned*)(p.ws + WS_BAR); bar.x = 0; bar.st = nullptr;
    const bool multi = (p.ph_hi - p.ph_lo) > 1;
    if (multi) {
        if (threadIdx.x == 0) *(LAS u32x4*)((LAS unsigned char*)smem) = (u32x4){0u, 0u, 0u, 0u};
        __syncthreads();
        bar = xcd_barrier_post((unsigned*)(p.ws + WS_BAR), (volatile LAS unsigned*)((LAS unsigned char*)smem));
    }
#if DUMP
    if (p.ph_lo == 100) { phase_dump(p, (size_t)(DUMP_OFF), DUMP_BF16, (size_t)(DUMP_N)); return; }
#endif
    int ph = 0;
#define PHASE(body) do { if (ph >= p.ph_lo && ph < p.ph_hi) { const int l = opaque_s(lv); body; if (ph + 1 < p.ph_hi) xcd_barrier(bar); } ++ph; } while (0)
    int lv = 0;
    PHASE(phase_prologue(p, lds));
    for (lv = 0; lv < DEPTH; ++lv) {
        PHASE(phase_norm<1>(p, l, lds));
        PHASE(phase_gemm<0>(p, l, lds));
        PHASE(phase_conv_pool(p, l, lds));
        PHASE(phase_scan_naive(p, l, lds));
        PHASE(phase_onorm(p, l));
        PHASE(phase_gemm<1>(p, l, lds));
        PHASE(phase_norm<2>(p, l, lds));
        PHASE(phase_topk(p, lds));
        PHASE(phase_gemm<2>(p, l, lds));
        PHASE(phase_gemm<3>(p, l, lds));
    }
    lv = 0;
    PHASE(phase_norm<3>(p, l, lds));
#undef PHASE
}
constexpr int N_PHASES = 2 + DEPTH * 10;

extern "C" void kernel_launch(void* const* d_in, const int* in_sizes, int n_in, void* d_out, int out_size, void* d_ws, size_t ws_size, hipStream_t stream) {
    static int grid = 0;
    if (grid == 0) {
        if (n_in != 21 || out_size != ROWS_LAT * D || ws_size < WS_END) { fprintf(stderr, "kernel_launch: unexpected shapes (n_in %d out %d ws %zu need %zu)\n", n_in, out_size, ws_size, (size_t)WS_END); grid = -1; return; }
        int dev = 0, cus = 0, per_cu = 0;
        if (hipGetDevice(&dev) != hipSuccess || hipDeviceGetAttribute(&cus, hipDeviceAttributeMultiprocessorCount, dev) != hipSuccess) { grid = -1; return; }
        if (hipFuncSetAttribute((const void*)fwd, hipFuncAttributeMaxDynamicSharedMemorySize, LDS_BYTES) != hipSuccess) { fprintf(stderr, "kernel_launch: hipFuncSetAttribute failed\n"); grid = -1; return; }
        if (hipOccupancyMaxActiveBlocksPerMultiprocessor(&per_cu, (const void*)fwd, NTHREADS, LDS_BYTES) != hipSuccess || per_cu < 1) { fprintf(stderr, "kernel_launch: occupancy query says %d\n", per_cu); per_cu = 1; }
        (void)hipGetLastError();
        grid = cus;
    }
    if (grid < 0) return;
    (void)hipMemsetAsync((char*)d_ws + WS_BAR, 0, 16384, stream);
    Params p; memset(&p, 0, sizeof(p));
    const float** pp = (const float**)&p;
    for (int i = 0; i < 21; ++i) pp[i] = (const float*)d_in[i];
    p.out = (float*)d_out; p.ws = (unsigned char*)d_ws;
#if DUMP
    for (int ph = 0; ph <= DUMP_LAST; ++ph) { p.ph_lo = ph; p.ph_hi = ph + 1; hipLaunchKernelGGL(fwd, dim3(grid), dim3(NTHREADS), LDS_BYTES, stream, p); }
    p.ph_lo = 100; p.ph_hi = 101; hipLaunchKernelGGL(fwd, dim3(grid), dim3(NTHREADS), LDS_BYTES, stream, p);
#elif ONE_LAUNCH
    p.ph_lo = 0; p.ph_hi = N_PHASES;
    hipLaunchKernelGGL(fwd, dim3(grid), dim3(NTHREADS), LDS_BYTES, stream, p);
#else
    for (int ph = 0; ph < N_PHASES; ++ph) { p.ph_lo = ph; p.ph_hi = ph + 1; hipLaunchKernelGGL(fwd, dim3(grid), dim3(NTHREADS), LDS_BYTES, stream, p); }
#endif
}
```

```cpp
#include <hip/hip_runtime.h>
#include <stdint.h>
#include <stdio.h>
#include <string.h>

#ifndef ONE_LAUNCH
#define ONE_LAUNCH 1
#endif
#ifndef REGSTAGE
#define REGSTAGE 0
#endif

#define LAS __attribute__((address_space(3)))
typedef unsigned short bf16_t;
typedef short bf16x8 __attribute__((ext_vector_type(8)));
typedef float f32x4 __attribute__((ext_vector_type(4)));
typedef float f32x2 __attribute__((ext_vector_type(2)));
typedef unsigned u32x2 __attribute__((ext_vector_type(2)));
typedef unsigned u32x4 __attribute__((ext_vector_type(4)));

constexpr int D = 1024, NB = 8, SEQ = 2048, DEPTH = 4, CTXL = 256;
constexpr int ROWS_LAT = NB * SEQ;
constexpr int ROWS_CTX = NB * CTXL;
constexpr int MT = ROWS_LAT + ROWS_CTX;
constexpr int INC = 2576;
constexpr int PN = 2560;
constexpr int NE = 16;
constexpr int NGROUPS = 144;
constexpr int NSLOTS = NGROUPS * 256;
constexpr int NTHREADS = 512;
constexpr float EPS = 1e-6f;

constexpr size_t al256(size_t x) { return (x + 255) & ~(size_t)255; }
constexpr size_t WS_BAR = 0;
constexpr size_t WS_MOD = 16384;
constexpr size_t WS_X = WS_MOD + al256((size_t)DEPTH * 9 * 6144 * 4);
constexpr size_t WS_H = WS_X + (size_t)MT * D * 4;
constexpr size_t WS_PROJ = WS_H + (size_t)MT * D * 2;
constexpr size_t WS_YE = WS_PROJ;
constexpr size_t WS_LOGA = WS_PROJ + (size_t)MT * PN * 2;
constexpr size_t WS_BETA = WS_LOGA + (size_t)MT * 8 * 4;
constexpr size_t WS_QKV = WS_BETA + (size_t)MT * 8 * 4;
constexpr size_t WS_HID = WS_QKV;
constexpr size_t WS_OF = WS_QKV + (size_t)MT * 1536 * 4;
constexpr size_t WS_OB = WS_OF + (size_t)MT * 512 * 4;
constexpr size_t WS_CAT = WS_OB + (size_t)MT * 512 * 4;
constexpr size_t WS_AFF = WS_CAT + (size_t)MT * D * 2;
constexpr size_t WS_SEL = WS_AFF + (size_t)MT * 16 * 4;
constexpr size_t WS_SELAFF = WS_SEL + (size_t)NSLOTS * 4;
constexpr size_t WS_SLOTOF = WS_SELAFF + (size_t)NSLOTS * 4;
constexpr size_t WS_WINT = WS_SLOTOF + (size_t)MT * 16 * 4;
constexpr size_t WS_WOUTT = WS_WINT + (size_t)DEPTH * PN * D * 2;
constexpr size_t WS_WGUT = WS_WOUTT + (size_t)DEPTH * D * D * 2;
constexpr size_t WS_WDT = WS_WGUT + (size_t)DEPTH * NE * 2048 * D * 2;
constexpr size_t WS_PWT = WS_WDT + (size_t)DEPTH * NE * D * D * 2;
constexpr size_t WS_END = WS_PWT + (size_t)DEPTH * 4 * 128 * 128 * 2;

constexpr int LDS_OFF = 1024;
constexpr int LDS_WORK = 98304;
constexpr int LDS_BYTES = LDS_OFF + LDS_WORK;

struct Params {
    const float *x, *c, *ctx, *c_ctx, *w_mod, *b_mod, *norm1, *norm2, *w_in, *conv_w, *a_log, *dt_bias, *dn_norm, *pool_w, *pool_scale, *w_out, *w_router, *w_gate, *w_up, *w_down, *norm_f;
    float* out;
    unsigned char* ws;
    int ph_lo, ph_hi;
};

#define XB_TMO      128
#define XB_XCNT(j)  (256  + 64 * (j))
#define XB_XSUB(j)  (1280 + 64 * (j))
#define XB_XGEN(j)  (2304 + 64 * (j))
#define XB_TOP      3328
#define XB_TOPGEN   3392
#define XCD_BAR_WORDS 3456
#define XB_SPIN_CAP (1u << 22)

__device__ __forceinline__ unsigned xb_ld(unsigned* p)              { return __hip_atomic_load(p, __ATOMIC_RELAXED, __HIP_MEMORY_SCOPE_AGENT); }
__device__ __forceinline__ unsigned xb_add(unsigned* p, unsigned v) { return __hip_atomic_fetch_add(p, v, __ATOMIC_RELAXED, __HIP_MEMORY_SCOPE_AGENT); }
__device__ __forceinline__ unsigned xb_xcc_id() { return (unsigned)__builtin_amdgcn_s_getreg((3 << 11) | 20) & 0xFu; }
#define XB_SPIN(cond, bar) do { unsigned _sp = 0; while (cond) { __builtin_amdgcn_s_sleep(1); \
    if ((++_sp & 255u) == 0u) { if (xb_ld(&(bar)[XB_TMO])) break; if (_sp > XB_SPIN_CAP) { atomicAdd(&(bar)[XB_TMO], 1u); break; } } } } while (0)

struct XcdBarrier { unsigned* bar; unsigned x; volatile LAS unsigned* st; };

__device__ __forceinline__ XcdBarrier xcd_barrier_post(unsigned* bar, volatile LAS unsigned* st) {
    XcdBarrier b; b.bar = bar; b.x = xb_xcc_id(); b.st = st;
    if (threadIdx.x == 0) (void)xb_add(&bar[XB_XCNT(b.x)], 1u);
    return b;
}
__device__ __forceinline__ void xcd_barrier_complete(unsigned* bar, unsigned x, unsigned& nloc, unsigned& nx) {
    const unsigned G = gridDim.x * gridDim.y * gridDim.z;
    unsigned sum, cnt, mine, sp = 0u;
    for (;;) {
        sum = 0u; cnt = 0u; mine = 0u;
#pragma unroll
        for (unsigned j = 0; j < 16; ++j) { const unsigned c = xb_ld(&bar[XB_XCNT(j)]); sum += c; cnt += (c > 0u) ? 1u : 0u; mine = (j == x) ? c : mine; }
        if (sum == G) break;
        __builtin_amdgcn_s_sleep(1);
        if ((++sp & 255u) == 0u) { if (xb_ld(&bar[XB_TMO])) break; if (sp > XB_SPIN_CAP) { atomicAdd(&bar[XB_TMO], 1u); break; } }
    }
    nloc = mine > 0u ? mine : 1u; nx = cnt > 0u ? cnt : 1u;
}
__device__ __forceinline__ void xcd_barrier(const XcdBarrier& b) {
    asm volatile("s_waitcnt vmcnt(0)" ::: "memory");
    __syncthreads();
    if (threadIdx.x == 0) {
        unsigned* bar = b.bar;
        __builtin_amdgcn_s_waitcnt(0);
        unsigned nloc = b.st[0], nx = b.st[1];
        if (nloc == 0u) { xcd_barrier_complete(bar, b.x, nloc, nx); b.st[0] = nloc; b.st[1] = nx; }
        const unsigned old = xb_add(&bar[XB_XSUB(b.x)], 1u);
        const unsigned gen = old / nloc;
        if (old + 1u == (gen + 1u) * nloc) {
            __builtin_amdgcn_fence(__ATOMIC_RELEASE, "agent");
            asm volatile("s_waitcnt vmcnt(0)" ::: "memory");
            const unsigned og = xb_add(&bar[XB_TOP], 1u);
            const unsigned tg = og / nx;
            if (og + 1u == (tg + 1u) * nx) xb_add(&bar[XB_TOPGEN], 1u);
            else XB_SPIN(xb_ld(&bar[XB_TOPGEN]) == tg, bar);
            __builtin_amdgcn_fence(__ATOMIC_ACQUIRE, "agent");
            xb_add(&bar[XB_XGEN(b.x)], 1u);
            asm volatile("s_waitcnt vmcnt(0)" ::: "memory");
        } else {
            XB_SPIN(xb_ld(&bar[XB_XGEN(b.x)]) == gen, bar);
            __builtin_amdgcn_fence(__ATOMIC_ACQUIRE, "agent");
            asm volatile("s_waitcnt vmcnt(0)" ::: "memory");
        }
    }
    __syncthreads();
}

typedef __bf16 bf16x2_t __attribute__((ext_vector_type(2)));
__device__ __forceinline__ unsigned pk_bf16(float lo, float hi) { const f32x2 v = {lo, hi}; const bf16x2_t b = __builtin_convertvector(v, bf16x2_t); return __builtin_bit_cast(unsigned, b); }
__device__ __forceinline__ float bf_lo(unsigned u) { return __uint_as_float(u << 16); }
__device__ __forceinline__ float bf_hi(unsigned u) { return __uint_as_float(u & 0xffff0000u); }
__device__ __forceinline__ float wave_sum(float v) {
#pragma unroll
    for (int o = 32; o > 0; o >>= 1) v += __shfl_xor(v, o);
    return v;
}
__device__ __forceinline__ int opaque_tid() { int t = threadIdx.x; asm volatile("" : "+v"(t)); return t; }
__device__ __forceinline__ int opaque_s(int v) { asm volatile("" : "+s"(v)); return v; }
__device__ __forceinline__ float silu_f(float v) { return v / (1.f + __expf(-v)); }

__device__ __forceinline__ int lds_byte(int r, int c) { const int st = (r >> 4) * 2 + (c >> 5), rr = r & 15, cc = c & 31, ob = rr * 64 + cc * 2; return st * 1024 + (ob ^ (((ob >> 9) & 1) << 5)); }
__device__ __forceinline__ void stage_rc(int b, int& R, int& C) { const int st = b >> 10, sb = b & 1023, swz = sb ^ (((sb >> 9) & 1) << 5); R = (st >> 1) * 16 + (swz >> 6); C = (st & 1) * 32 + ((swz & 63) >> 1); }

__device__ void phase_prologue(const Params& p, LAS unsigned char* lds) {
    const int tid = opaque_tid();
    {
        LAS float* sc = (LAS float*)lds;
        LAS float* red = sc + 9 * 1024;
        for (int idx = tid; idx < 9 * 1024; idx += NTHREADS) {
            const int r = idx >> 10, k = idx & 1023;
            const float v = r < 8 ? p.c[r * 1024 + k] : p.c_ctx[k];
            sc[idx] = silu_f(v);
        }
        __syncthreads();
        float* MOD = (float*)(p.ws + WS_MOD);
        for (int u = blockIdx.x; u < DEPTH * 96; u += gridDim.x) {
            const int l = u / 96, c0 = (u % 96) * 64, col = tid & 63, kg = tid >> 6;
            float acc[9];
#pragma unroll
            for (int r = 0; r < 9; ++r) acc[r] = 0.f;
            const float* W = p.w_mod + (size_t)l * 1024 * 6144 + c0 + col;
#pragma unroll 4
            for (int kk = 0; kk < 128; ++kk) {
                const int k = kg * 128 + kk;
                const float w = W[(size_t)k * 6144];
#pragma unroll
                for (int r = 0; r < 9; ++r) acc[r] += sc[r * 1024 + k] * w;
            }
#pragma unroll
            for (int r = 0; r < 9; ++r) red[(kg * 9 + r) * 64 + col] = acc[r];
            __syncthreads();
            for (int idx = tid; idx < 576; idx += NTHREADS) {
                const int r = idx >> 6, cc = idx & 63;
                float s = 0.f;
#pragma unroll
                for (int g = 0; g < 8; ++g) s += red[(g * 9 + r) * 64 + cc];
                MOD[((size_t)l * 9 + r) * 6144 + c0 + cc] = s + p.b_mod[l * 6144 + c0 + cc];
            }
            __syncthreads();
        }
    }
    {
        f32x4* X4 = (f32x4*)(p.ws + WS_X);
        const f32x4* x4 = (const f32x4*)p.x; const f32x4* c4 = (const f32x4*)p.ctx;
        const int nlat = ROWS_LAT * D / 4, ntot = MT * D / 4;
        for (int i = blockIdx.x * NTHREADS + tid; i < ntot; i += gridDim.x * NTHREADS) X4[i] = i < nlat ? x4[i] : c4[i - nlat];
    }
    {
        LAS float* tile = (LAS float*)lds;
        bf16_t* WINT = (bf16_t*)(p.ws + WS_WINT); bf16_t* WOUTT = (bf16_t*)(p.ws + WS_WOUTT); bf16_t* WGUT = (bf16_t*)(p.ws + WS_WGUT); bf16_t* WDT = (bf16_t*)(p.ws + WS_WDT);
        constexpr int T_IN = 10 * 16, T_OUT = 4 * 16, T_EXP = NE * 4 * 16, T_LAYER = T_IN + T_OUT + 3 * T_EXP;
        for (int t = blockIdx.x; t < DEPTH * T_LAYER; t += gridDim.x) {
            const int l = t / T_LAYER; int i = t % T_LAYER;
            const float* src; size_t sld; bf16_t* dst; int rs = 16;
            if (i < T_IN) { const int nt = i >> 4, kt = i & 15; const int n0 = nt < 6 ? nt * 256 : 1552 + (nt - 6) * 256;
                src = p.w_in + ((size_t)l * D + kt * 64) * INC + n0; sld = INC; dst = WINT + ((size_t)l * PN + nt * 256) * D + kt * 64; }
            else if (i < T_IN + T_OUT) { i -= T_IN; const int nt = i >> 4, kt = i & 15;
                src = p.w_out + ((size_t)l * D + kt * 64) * D + nt * 256; sld = D; dst = WOUTT + ((size_t)l * D + nt * 256) * D + kt * 64; }
            else { i -= T_IN + T_OUT; const int which = i / T_EXP; i %= T_EXP; const int e = i >> 6, nt = (i >> 4) & 3, kt = i & 15;
                const size_t mo = ((size_t)(l * NE + e) * D + kt * 64) * D + nt * 256;
                if (which == 2) { src = p.w_down + mo; dst = WDT + ((size_t)(l * NE + e) * D + nt * 256) * D + kt * 64; }
                else { src = (which == 0 ? p.w_gate : p.w_up) + mo; rs = 32; dst = WGUT + ((size_t)(l * NE + e) * 2048 + nt * 512 + which * 16) * D + kt * 64; }
                sld = D; }
#pragma unroll
            for (int j = 0; j < 8; ++j) {
                const int e = tid * 4 + j * 2048, k = e >> 8, n = e & 255;
                const f32x4 v = *(const f32x4*)(src + (size_t)k * sld + n);
                tile[k * 257 + n] = v[0]; tile[k * 257 + n + 1] = v[1]; tile[k * 257 + n + 2] = v[2]; tile[k * 257 + n + 3] = v[3];
            }
            __syncthreads();
#pragma unroll
            for (int ps = 0; ps < 4; ++ps) {
                const int n = ps * 64 + (tid >> 3), ks = (tid & 7) * 8;
                u32x4 o;
                o[0] = pk_bf16(tile[(ks + 0) * 257 + n], tile[(ks + 1) * 257 + n]); o[1] = pk_bf16(tile[(ks + 2) * 257 + n], tile[(ks + 3) * 257 + n]);
                o[2] = pk_bf16(tile[(ks + 4) * 257 + n], tile[(ks + 5) * 257 + n]); o[3] = pk_bf16(tile[(ks + 6) * 257 + n], tile[(ks + 7) * 257 + n]);
                *(u32x4*)(dst + (size_t)((n >> 4) * rs + (n & 15)) * D + ks) = o;
            }
            __syncthreads();
        }
        bf16_t* PWT = (bf16_t*)(p.ws + WS_PWT);
        for (int i = blockIdx.x * NTHREADS + tid; i < DEPTH * 4 * 128 * 128; i += gridDim.x * NTHREADS) {
            const int lg = i >> 14, d = (i >> 7) & 127, c = i & 127;
            PWT[i] = (bf16_t)(pk_bf16(p.pool_w[((size_t)lg * 128 + c) * 128 + d], 0.f) & 0xffffu);
        }
    }
}

template <int WHICH>
__device__ void phase_norm(const Params& p, const int l, LAS unsigned char* lds) {
    const int tid = opaque_tid(), wid = tid >> 6, lane = tid & 63;
    LAS float* wsm = (LAS float*)lds;
    if (WHICH != 3) {
        const float* src; int stride;
        if (WHICH == 1) { src = p.w_in + (size_t)l * D * INC + 1536; stride = INC; } else { src = p.w_router + (size_t)l * D * NE; stride = NE; }
        for (int idx = tid; idx < 16 * 1024; idx += NTHREADS) { const int k = idx >> 4, j = idx & 15; wsm[j * 1024 + k] = src[(size_t)k * stride + j]; }
        __syncthreads();
    }
    const float* nw = WHICH == 1 ? p.norm1 + l * D : (WHICH == 2 ? p.norm2 + l * D : p.norm_f);
    float* X = (float*)(p.ws + WS_X);
    const float* MOD = (const float*)(p.ws + WS_MOD);
    bf16_t* H = (bf16_t*)(p.ws + WS_H);
    const int nrows = (WHICH == 3) ? ROWS_LAT : MT;
    for (int row = blockIdx.x * 8 + wid; row < nrows; row += gridDim.x * 8) {
        const int bidx = row < ROWS_LAT ? (row >> 11) : 8;
        float* xr = X + (size_t)row * D;
        f32x4 xv[4];
#pragma unroll
        for (int i = 0; i < 4; ++i) xv[i] = *(const f32x4*)(xr + i * 256 + lane * 4);
        if ((WHICH == 1 && l > 0) || WHICH == 3) {
            const int lp = (WHICH == 3) ? DEPTH - 1 : l - 1;
            const float* g2 = MOD + ((size_t)lp * 9 + bidx) * 6144 + 5 * 1024;
            const int* so = (const int*)(p.ws + WS_SLOTOF) + (size_t)row * 16;
            const bf16_t* YE = (const bf16_t*)(p.ws + WS_YE);
            f32x4 a[4];
#pragma unroll
            for (int i = 0; i < 4; ++i) a[i] = (f32x4){0.f, 0.f, 0.f, 0.f};
            for (int e = 0; e < NE; ++e) {
                const int s = __builtin_amdgcn_readfirstlane(so[e]);
                if (s >= 0) {
                    const bf16_t* yr = YE + (size_t)s * D;
#pragma unroll
                    for (int i = 0; i < 4; ++i) { const u32x2 v = *(const u32x2*)(yr + i * 256 + lane * 4);
                        a[i][0] += bf_lo(v[0]); a[i][1] += bf_hi(v[0]); a[i][2] += bf_lo(v[1]); a[i][3] += bf_hi(v[1]); }
                }
            }
#pragma unroll
            for (int i = 0; i < 4; ++i) { const f32x4 g = *(const f32x4*)(g2 + i * 256 + lane * 4); xv[i] += g * a[i]; }
            if (WHICH == 1) {
#pragma unroll
                for (int i = 0; i < 4; ++i) *(f32x4*)(xr + i * 256 + lane * 4) = xv[i];
            }
        }
        float ss = 0.f;
#pragma unroll
        for (int i = 0; i < 4; ++i) ss += xv[i][0] * xv[i][0] + xv[i][1] * xv[i][1] + xv[i][2] * xv[i][2] + xv[i][3] * xv[i][3];
        ss = wave_sum(ss);
        const float rstd = rsqrtf(ss * (1.f / 1024.f) + EPS);
        if (WHICH == 3) {
#pragma unroll
            for (int i = 0; i < 4; ++i) { const f32x4 w = *(const f32x4*)(nw + i * 256 + lane * 4); *(f32x4*)(p.out + (size_t)row * D + i * 256 + lane * 4) = xv[i] * rstd * w; }
            continue;
        }
        const float* md = MOD + ((size_t)l * 9 + bidx) * 6144 + (WHICH == 1 ? 0 : 3072);
        f32x4 h[4];
#pragma unroll
        for (int i = 0; i < 4; ++i) {
            const int c = i * 256 + lane * 4;
            const f32x4 w = *(const f32x4*)(nw + c), sh = *(const f32x4*)(md + c), scl = *(const f32x4*)(md + 1024 + c);
            h[i] = (xv[i] * rstd * w) * (scl + 1.f) + sh;
            u32x2 o; o[0] = pk_bf16(h[i][0], h[i][1]); o[1] = pk_bf16(h[i][2], h[i][3]);
            *(u32x2*)(H + (size_t)row * D + c) = o;
        }
        float d[16];
#pragma unroll
        for (int jg = 0; jg < 4; ++jg) {
#pragma unroll
            for (int jj = 0; jj < 4; ++jj) {
                const int j = jg * 4 + jj;
                float s = 0.f;
#pragma unroll
                for (int i = 0; i < 4; ++i) { const f32x4 w = *(const LAS f32x4*)(wsm + j * 1024 + i * 256 + lane * 4); s += h[i][0] * w[0] + h[i][1] * w[1] + h[i][2] * w[2] + h[i][3] * w[3]; }
                d[j] = wave_sum(s);
            }
            __builtin_amdgcn_sched_barrier(0);
        }
        if (WHICH == 1) {
            float da = 0.f, db = 0.f;
#pragma unroll
            for (int j = 0; j < 8; ++j) { da = (lane == j) ? d[j] : da; db = (lane == j) ? d[8 + j] : db; }
            if (lane < 8) {
                const float xa = da + p.dt_bias[l * 8 + lane];
                const float sp = xa > 20.f ? xa : log1pf(__expf(xa));
                ((float*)(p.ws + WS_LOGA))[(size_t)row * 8 + lane] = -__expf(p.a_log[l * 8 + lane]) * sp;
                ((float*)(p.ws + WS_BETA))[(size_t)row * 8 + lane] = 1.f / (1.f + __expf(-db));
            }
        } else {
            float m = d[0];
#pragma unroll
            for (int j = 1; j < 16; ++j) m = fmaxf(m, d[j]);
            float sum = 0.f, mine = 0.f;
#pragma unroll
            for (int j = 0; j < 16; ++j) { const float e = __expf(d[j] - m); sum += e; mine = (lane == j) ? e : mine; }
            if (lane < 16) ((float*)(p.ws + WS_AFF))[(size_t)row * 16 + lane] = mine / sum;
        }
    }
}

__device__ __forceinline__ void gemm_core(const unsigned char* Ab, const unsigned (&aoff)[4], const unsigned char* Bb, const unsigned (&boff)[2], const int nt,
                                          LAS unsigned char* lds, f32x4 (&acc)[4][4], const int wid, const int lane) {
    const int wr = wid >> 1, wc = wid & 1, fr = lane & 15, fq = lane >> 4;
    const int ar = lds_byte(wr * 64 + fr, fq * 8), br = lds_byte(wc * 64 + fr, fq * 8);
    const unsigned ldsw = (unsigned)wid * 1024u;
#define G_STAGE(t, buf) do { const unsigned _ko = (unsigned)(t) * 128u; \
        _Pragma("unroll") for (int _i = 0; _i < 4; ++_i) __builtin_amdgcn_global_load_lds((const unsigned*)(Ab + aoff[_i] + _ko), (LAS unsigned*)(lds + (buf) * 49152 + ldsw + _i * 8192), 16, 0, 0); \
        _Pragma("unroll") for (int _i = 0; _i < 2; ++_i) __builtin_amdgcn_global_load_lds((const unsigned*)(Bb + boff[_i] + _ko), (LAS unsigned*)(lds + (buf) * 49152 + 32768 + ldsw + _i * 8192), 16, 0, 0); } while (0)
#pragma unroll
    for (int m = 0; m < 4; ++m)
#pragma unroll
        for (int n = 0; n < 4; ++n) acc[m][n] = (f32x4){0.f, 0.f, 0.f, 0.f};
#if REGSTAGE
    u32x4 ra[4], rb[2];
#pragma unroll
    for (int i = 0; i < 4; ++i) ra[i] = *(const u32x4*)(Ab + aoff[i]);
#pragma unroll
    for (int i = 0; i < 2; ++i) rb[i] = *(const u32x4*)(Bb + boff[i]);
    const unsigned tb = (unsigned)(wid * 64 + lane) * 16u;
    for (int t = 0; t < nt; ++t) {
        __syncthreads();
#pragma unroll
        for (int i = 0; i < 4; ++i) *(LAS u32x4*)(lds + tb + i * 8192) = ra[i];
#pragma unroll
        for (int i = 0; i < 2; ++i) *(LAS u32x4*)(lds + 32768 + tb + i * 8192) = rb[i];
        __syncthreads();
        if (t + 1 < nt) {
            const unsigned ko = (unsigned)(t + 1) * 128u;
#pragma unroll
            for (int i = 0; i < 4; ++i) ra[i] = *(const u32x4*)(Ab + aoff[i] + ko);
#pragma unroll
            for (int i = 0; i < 2; ++i) rb[i] = *(const u32x4*)(Bb + boff[i] + ko);
        }
        LAS unsigned char* bA = lds; LAS unsigned char* bB = bA + 32768;
        bf16x8 af[4][2], bfr[4][2];
#pragma unroll
        for (int m = 0; m < 4; ++m)
#pragma unroll
            for (int k = 0; k < 2; ++k) af[m][k] = *(const LAS bf16x8*)(bA + ar + m * 2048 + k * 1024);
#pragma unroll
        for (int n = 0; n < 4; ++n)
#pragma unroll
            for (int k = 0; k < 2; ++k) bfr[n][k] = *(const LAS bf16x8*)(bB + br + n * 2048 + k * 1024);
#pragma unroll
        for (int k = 0; k < 2; ++k)
#pragma unroll
            for (int m = 0; m < 4; ++m)
#pragma unroll
                for (int n = 0; n < 4; ++n) acc[m][n] = __builtin_amdgcn_mfma_f32_16x16x32_bf16(bfr[n][k], af[m][k], acc[m][n], 0, 0, 0);
    }
#else
    G_STAGE(0, 0);
    for (int t = 0; t < nt; ++t) {
        asm volatile("s_waitcnt vmcnt(0)" ::: "memory");
        __syncthreads();
        if (t + 1 < nt) { if ((t + 1) & 1) G_STAGE(t + 1, 1); else G_STAGE(t + 1, 0); }
        LAS unsigned char* bA = lds + (t & 1) * 49152; LAS unsigned char* bB = bA + 32768;
        bf16x8 af[4][2], bfr[4][2];
#pragma unroll
        for (int m = 0; m < 4; ++m)
#pragma unroll
            for (int k = 0; k < 2; ++k) af[m][k] = *(const LAS bf16x8*)(bA + ar + m * 2048 + k * 1024);
#pragma unroll
        for (int n = 0; n < 4; ++n)
#pragma unroll
            for (int k = 0; k < 2; ++k) bfr[n][k] = *(const LAS bf16x8*)(bB + br + n * 2048 + k * 1024);
#pragma unroll
        for (int k = 0; k < 2; ++k)
#pragma unroll
            for (int m = 0; m < 4; ++m)
#pragma unroll
                for (int n = 0; n < 4; ++n) acc[m][n] = __builtin_amdgcn_mfma_f32_16x16x32_bf16(bfr[n][k], af[m][k], acc[m][n], 0, 0, 0);
    }
#endif
    __syncthreads();
#undef G_STAGE
}

template <int MODE>
__device__ void phase_gemm(const Params& p, const int l, LAS unsigned char* lds) {
    const int tid = opaque_tid(), wid = __builtin_amdgcn_readfirstlane(tid >> 6), lane = tid & 63;
    const int wr = wid >> 1, wc = wid & 1, fr = lane & 15, fq = lane >> 4;
    int R0, C0; stage_rc(tid * 16, R0, C0);
    constexpr int nN = MODE == 0 ? 20 : (MODE == 1 ? 8 : (MODE == 2 ? 16 : 8));
    constexpr int nM = (MODE <= 1) ? MT / 256 : NGROUPS;
    const bf16_t* H = (const bf16_t*)(p.ws + WS_H);
    for (int u = blockIdx.x; u < nM * nN; u += gridDim.x) {
        const int pm = u / nN, pn = u % nN;
        const unsigned char* Ab; const unsigned char* Bb; unsigned aoff[4], boff[2];
#pragma unroll
        for (int i = 0; i < 2; ++i) boff[i] = (unsigned)((R0 + 64 * i) * D + C0) * 2u;
        int e = 0;
        if (MODE == 0) {
            Ab = (const unsigned char*)(H + (size_t)pm * 256 * D); Bb = (const unsigned char*)((const bf16_t*)(p.ws + WS_WINT) + ((size_t)l * PN + pn * 128) * D);
#pragma unroll
            for (int i = 0; i < 4; ++i) aoff[i] = (unsigned)((R0 + 64 * i) * D + C0) * 2u;
        } else if (MODE == 1) {
            Ab = (const unsigned char*)((const bf16_t*)(p.ws + WS_CAT) + (size_t)pm * 256 * D); Bb = (const unsigned char*)((const bf16_t*)(p.ws + WS_WOUTT) + ((size_t)l * D + pn * 128) * D);
#pragma unroll
            for (int i = 0; i < 4; ++i) aoff[i] = (unsigned)((R0 + 64 * i) * D + C0) * 2u;
        } else if (MODE == 2) {
            e = pm < 128 ? (pm >> 3) : (pm - 128);
            const int* SEL = (const int*)(p.ws + WS_SEL) + pm * 256;
            Ab = (const unsigned char*)H; Bb = (const unsigned char*)((const bf16_t*)(p.ws + WS_WGUT) + ((size_t)(l * NE + e) * 2048 + pn * 128) * D);
#pragma unroll
            for (int i = 0; i < 4; ++i) aoff[i] = (unsigned)(SEL[R0 + 64 * i] * D + C0) * 2u;
        } else {
            e = pm < 128 ? (pm >> 3) : (pm - 128);
            Ab = (const unsigned char*)((const bf16_t*)(p.ws + WS_HID) + (size_t)pm * 256 * D); Bb = (const unsigned char*)((const bf16_t*)(p.ws + WS_WDT) + ((size_t)(l * NE + e) * D + pn * 128) * D);
#pragma unroll
            for (int i = 0; i < 4; ++i) aoff[i] = (unsigned)((R0 + 64 * i) * D + C0) * 2u;
        }
        f32x4 acc[4][4];
        gemm_core(Ab, aoff, Bb, boff, D / 64, lds, acc, wid, lane);
        if (MODE == 0) {
            bf16_t* PROJ = (bf16_t*)(p.ws + WS_PROJ);
#pragma unroll
            for (int m = 0; m < 4; ++m) { const size_t row = (size_t)pm * 256 + wr * 64 + m * 16 + fr;
#pragma unroll
                for (int n = 0; n < 4; ++n) { u32x2 o; o[0] = pk_bf16(acc[m][n][0], acc[m][n][1]); o[1] = pk_bf16(acc[m][n][2], acc[m][n][3]);
                    *(u32x2*)(PROJ + row * PN + pn * 128 + wc * 64 + n * 16 + fq * 4) = o; } }
        } else if (MODE == 1) {
            float* X = (float*)(p.ws + WS_X);
            const int bidx = pm < 64 ? (pm >> 3) : 8;
            const float* g1 = (const float*)(p.ws + WS_MOD) + ((size_t)l * 9 + bidx) * 6144 + 2048;
#pragma unroll
            for (int n = 0; n < 4; ++n) { const int col = pn * 128 + wc * 64 + n * 16 + fq * 4; const f32x4 g = *(const f32x4*)(g1 + col);
#pragma unroll
                for (int m = 0; m < 4; ++m) { float* xp = X + ((size_t)pm * 256 + wr * 64 + m * 16 + fr) * D + col; *(f32x4*)xp = *(const f32x4*)xp + g * acc[m][n]; } }
        } else if (MODE == 2) {
            bf16_t* HID = (bf16_t*)(p.ws + WS_HID);
#pragma unroll
            for (int m = 0; m < 4; ++m) { const size_t slot = (size_t)pm * 256 + wr * 64 + m * 16 + fr;
#pragma unroll
                for (int q = 0; q < 2; ++q) { const f32x4 g = acc[m][2 * q], uu = acc[m][2 * q + 1];
                    u32x2 o; o[0] = pk_bf16(silu_f(g[0]) * uu[0], silu_f(g[1]) * uu[1]); o[1] = pk_bf16(silu_f(g[2]) * uu[2], silu_f(g[3]) * uu[3]);
                    *(u32x2*)(HID + slot * D + pn * 64 + wc * 32 + q * 16 + fq * 4) = o; } }
        } else {
            bf16_t* YE = (bf16_t*)(p.ws + WS_YE);
            const float* SELAFF = (const float*)(p.ws + WS_SELAFF);
#pragma unroll
            for (int m = 0; m < 4; ++m) { const size_t slot = (size_t)pm * 256 + wr * 64 + m * 16 + fr; const float a = SELAFF[slot];
#pragma unroll
                for (int n = 0; n < 4; ++n) { u32x2 o; o[0] = pk_bf16(acc[m][n][0] * a, acc[m][n][1] * a); o[1] = pk_bf16(acc[m][n][2] * a, acc[m][n][3] * a);
                    *(u32x2*)(YE + slot * D + pn * 128 + wc * 64 + n * 16 + fq * 4) = o; } }
        }
    }
}

__device__ void phase_conv_pool(const Params& p, const int l, LAS unsigned char* lds) {
    const int tid = opaque_tid(), wid = tid >> 6, lane = tid & 63;
    const bf16_t* PROJ = (const bf16_t*)(p.ws + WS_PROJ);
    {
        float* QKV = (float*)(p.ws + WS_QKV);
        const float* cw = p.conv_w + (size_t)l * 4 * 1536;
        for (int task = blockIdx.x * 8 + wid; task < MT * 12; task += gridDim.x * 8) {
            const int row = task / 12, part = task % 12;
            int s0, len;
            if (row < ROWS_LAT) { s0 = row & ~2047; len = 2048; } else { s0 = ROWS_LAT + ((row - ROWS_LAT) & ~255); len = 256; }
            const int c = part * 128 + lane * 2;
            float a0 = 0.f, a1 = 0.f;
#pragma unroll
            for (int j = 0; j < 4; ++j) {
                const int r2 = row + j - 2;
                if (r2 >= s0 && r2 < s0 + len) {
                    const unsigned v = *(const unsigned*)(PROJ + (size_t)r2 * PN + c);
                    const f32x2 w = *(const f32x2*)(cw + j * 1536 + c);
                    a0 += w[0] * bf_lo(v); a1 += w[1] * bf_hi(v);
                }
            }
            a0 = silu_f(a0); a1 = silu_f(a1);
            if (part < 8) {
                const float ss = wave_sum(a0 * a0 + a1 * a1);
                float sc = rsqrtf(ss + EPS);
                if (part < 4) sc *= 0.08838834764831845f;
                a0 *= sc; a1 *= sc;
            }
            *(f32x2*)(QKV + (size_t)row * 1536 + c) = (f32x2){a0, a1};
        }
    }
    {
        LAS float* V = (LAS float*)lds;
        LAS unsigned char* mt = lds + 40960;
        const bf16_t* PWT = (const bf16_t*)(p.ws + WS_PWT);
        bf16_t* CAT = (bf16_t*)(p.ws + WS_CAT);
        const int wr = wid >> 1, wc = wid & 1, fr = lane & 15, fq = lane >> 4;
        for (int u = blockIdx.x; u < 1152; u += gridDim.x) {
            int g, r, nrows, ncols, c0, rowbase;
            if (u < 1024) { const int b = u >> 7; g = (u >> 5) & 3; r = u & 31; nrows = 32; ncols = 64; c0 = 0; rowbase = b * 2048; }
            else { const int v = u - 1024; const int b = v >> 4; g = (v >> 2) & 3; r = 0; nrows = 1; ncols = 256; c0 = (v & 3) * 64; rowbase = ROWS_LAT + b * 256; }
            const int w = 2 << g, half = w >> 1;
            const int lo_r = max(r - half, 0), hi_r = min(r - half + w, nrows);
            const int cxlo = max(c0 - half, 0), cxhi = min(c0 + 64 + half, ncols);
            const bf16_t* ub = PROJ + 2048 + g * 128;
            for (int idx = tid; idx < (cxhi - cxlo) * 64; idx += NTHREADS) {
                const int cxi = idx >> 6, ch = (idx & 63) * 2;
                float s0 = 0.f, s1 = 0.f;
                for (int rr = lo_r; rr < hi_r; ++rr) { const unsigned v = *(const unsigned*)(ub + (size_t)(rowbase + rr * ncols + cxlo + cxi) * PN + ch); s0 += bf_lo(v); s1 += bf_hi(v); }
                V[cxi * 128 + ch] = s0; V[cxi * 128 + ch + 1] = s1;
            }
            __syncthreads();
            for (int idx = tid; idx < 64 * 64; idx += NTHREADS) {
                const int ci = idx >> 6, ch = (idx & 63) * 2, c = c0 + ci;
                const int lo_c = max(c - half, 0), hi_c = min(c - half + w, ncols);
                float s0 = 0.f, s1 = 0.f;
                for (int cx = lo_c; cx < hi_c; ++cx) { s0 += V[(cx - cxlo) * 128 + ch]; s1 += V[(cx - cxlo) * 128 + ch + 1]; }
                const float inv = 1.f / (float)((hi_r - lo_r) * (hi_c - lo_c));
                const unsigned v = *(const unsigned*)(ub + (size_t)(rowbase + r * ncols + c) * PN + ch);
                *(LAS unsigned*)(mt + ci * 272 + ch * 2) = pk_bf16(s0 * inv - bf_lo(v), s1 * inv - bf_hi(v));
            }
            __syncthreads();
            f32x4 acc[4];
#pragma unroll
            for (int n = 0; n < 4; ++n) acc[n] = (f32x4){0.f, 0.f, 0.f, 0.f};
            const bf16_t* pw = PWT + (size_t)(l * 4 + g) * 128 * 128;
#pragma unroll
            for (int kk = 0; kk < 4; ++kk) {
                const bf16x8 a = *(const LAS bf16x8*)(mt + (wr * 16 + fr) * 272 + (kk * 32 + fq * 8) * 2);
#pragma unroll
                for (int n = 0; n < 4; ++n) {
                    const bf16x8 b = *(const bf16x8*)(pw + (size_t)(wc * 64 + n * 16 + fr) * 128 + kk * 32 + fq * 8);
                    acc[n] = __builtin_amdgcn_mfma_f32_16x16x32_bf16(b, a, acc[n], 0, 0, 0);
                }
            }
            const size_t row = (size_t)rowbase + r * ncols + c0 + wr * 16 + fr;
#pragma unroll
            for (int n = 0; n < 4; ++n) {
                const int dcol = g * 128 + wc * 64 + n * 16 + fq * 4;
                const f32x4 s = *(const f32x4*)(p.pool_scale + l * 512 + dcol);
                u32x2 o; o[0] = pk_bf16(acc[n][0] * s[0], acc[n][1] * s[1]); o[1] = pk_bf16(acc[n][2] * s[2], acc[n][3] * s[3]);
                *(u32x2*)(CAT + row * D + 512 + dcol) = o;
            }
            __syncthreads();
        }
    }
}

__device__ void phase_scan_naive(const Params& p, const int l, LAS unsigned char* lds) {
    const int tid = opaque_tid();
    LAS float* ks = (LAS float*)lds;
    LAS float* qs = ks + 4096;
    LAS float* vs = qs + 4096;
    LAS float* as = vs + 4096;
    LAS float* bs = as + 32;
    LAS int* rws = (LAS int*)(bs + 32);
    const float* QKV = (const float*)(p.ws + WS_QKV);
    const float* LOGA = (const float*)(p.ws + WS_LOGA);
    const float* BETA = (const float*)(p.ws + WS_BETA);
    for (int u = blockIdx.x; u < 64; u += gridDim.x) {
        const int b = u >> 3, h = (u >> 1) & 3, d = u & 1;
        float* O = (float*)(p.ws + (d ? WS_OB : WS_OF));
        const int col = tid >> 2, part = tid & 3;
        float S[32];
#pragma unroll
        for (int i = 0; i < 32; ++i) S[i] = 0.f;
        for (int n0 = 0; n0 < CTXL + SEQ; n0 += 32) {
            __syncthreads();
            if (tid < 32) {
                const int n = n0 + tid; int row;
                if (n < CTXL) row = ROWS_LAT + b * CTXL + (d ? CTXL - 1 - n : n);
                else { const int m = n - CTXL; row = b * SEQ + (d ? SEQ - 1 - m : m); }
                rws[tid] = row;
                as[tid] = __expf(LOGA[(size_t)row * 8 + d * 4 + h]);
                bs[tid] = BETA[(size_t)row * 8 + d * 4 + h];
            }
            __syncthreads();
            for (int i = tid; i < 4096; i += NTHREADS) {
                const int tok = i >> 7, cc = i & 127; const size_t base = (size_t)rws[tok] * 1536 + h * 128 + cc;
                qs[i] = QKV[base]; ks[i] = QKV[base + 512]; vs[i] = QKV[base + 1024];
            }
            __syncthreads();
            for (int tok = 0; tok < 32; ++tok) {
                float kk[32];
#pragma unroll
                for (int i = 0; i < 8; ++i) { const f32x4 v = *(const LAS f32x4*)(ks + tok * 128 + part * 32 + i * 4); kk[i * 4] = v[0]; kk[i * 4 + 1] = v[1]; kk[i * 4 + 2] = v[2]; kk[i * 4 + 3] = v[3]; }
                float kp = 0.f;
#pragma unroll
                for (int i = 0; i < 32; ++i) kp += kk[i] * S[i];
                kp += __shfl_xor(kp, 1); kp += __shfl_xor(kp, 2);
                const float a = as[tok], bt = bs[tok];
                const float bv = bt * (vs[tok * 128 + col] - a * kp);
#pragma unroll
                for (int i = 0; i < 32; ++i) S[i] = a * S[i] + kk[i] * bv;
                float op = 0.f;
#pragma unroll
                for (int i = 0; i < 8; ++i) { const f32x4 v = *(const LAS f32x4*)(qs + tok * 128 + part * 32 + i * 4); op += v[0] * S[i * 4] + v[1] * S[i * 4 + 1] + v[2] * S[i * 4 + 2] + v[3] * S[i * 4 + 3]; }
                op += __shfl_xor(op, 1); op += __shfl_xor(op, 2);
                if (part == 0) O[(size_t)rws[tok] * 512 + h * 128 + col] = op;
            }
        }
        __syncthreads();
    }
}

__device__ void phase_onorm(const Params& p, const int l) {
    const int tid = opaque_tid(), wid = tid >> 6, lane = tid & 63;
    const float* OF = (const float*)(p.ws + WS_OF); const float* OB = (const float*)(p.ws + WS_OB);
    const bf16_t* PROJ = (const bf16_t*)(p.ws + WS_PROJ);
    bf16_t* CAT = (bf16_t*)(p.ws + WS_CAT);
    const int c = lane * 8;
    const f32x4 w0 = *(const f32x4*)(p.dn_norm + l * 128 + (c & 127)), w1 = *(const f32x4*)(p.dn_norm + l * 128 + (c & 127) + 4);
    for (int row = blockIdx.x * 8 + wid; row < MT; row += gridDim.x * 8) {
        const size_t o = (size_t)row * 512 + c;
        f32x4 v0 = *(const f32x4*)(OF + o) + *(const f32x4*)(OB + o), v1 = *(const f32x4*)(OF + o + 4) + *(const f32x4*)(OB + o + 4);
        float ss = v0[0] * v0[0] + v0[1] * v0[1] + v0[2] * v0[2] + v0[3] * v0[3] + v1[0] * v1[0] + v1[1] * v1[1] + v1[2] * v1[2] + v1[3] * v1[3];
        ss += __shfl_xor(ss, 1); ss += __shfl_xor(ss, 2); ss += __shfl_xor(ss, 4); ss += __shfl_xor(ss, 8);
        const float rs = rsqrtf(ss * (1.f / 128.f) + EPS);
        const u32x4 gv = *(const u32x4*)(PROJ + (size_t)row * PN + 1536 + c);
        u32x4 out;
        out[0] = pk_bf16(v0[0] * rs * w0[0] * silu_f(bf_lo(gv[0])), v0[1] * rs * w0[1] * silu_f(bf_hi(gv[0])));
        out[1] = pk_bf16(v0[2] * rs * w0[2] * silu_f(bf_lo(gv[1])), v0[3] * rs * w0[3] * silu_f(bf_hi(gv[1])));
        out[2] = pk_bf16(v1[0] * rs * w1[0] * silu_f(bf_lo(gv[2])), v1[1] * rs * w1[1] * silu_f(bf_hi(gv[2])));
        out[3] = pk_bf16(v1[2] * rs * w1[2] * silu_f(bf_lo(gv[3])), v1[3] * rs * w1[3] * silu_f(bf_hi(gv[3])));
        *(u32x4*)(CAT + (size_t)row * D + c) = out;
    }
}

__device__ void phase_topk(const Params& p, LAS unsigned char* lds) {
    const int tid = opaque_tid();
    LAS unsigned long long* ks = (LAS unsigned long long*)lds;
    const float* AFF = (const float*)(p.ws + WS_AFF);
    int* SEL = (int*)(p.ws + WS_SEL); float* SELAFF = (float*)(p.ws + WS_SELAFF); int* SLOTOF = (int*)(p.ws + WS_SLOTOF);
    for (int u = blockIdx.x; u < 256; u += gridDim.x) {
        int e, n, C, rowbase, slotbase;
        if (u < 128) { e = u >> 3; const int b = u & 7; n = SEQ; C = 256; rowbase = b * SEQ; slotbase = u * 256; }
        else { const int v = u - 128; e = v >> 3; const int b = v & 7; n = CTXL; C = 32; rowbase = ROWS_LAT + b * CTXL; slotbase = (128 + e) * 256 + b * 32; }
        for (int i = tid; i < n; i += NTHREADS) ks[i] = ((unsigned long long)__float_as_uint(AFF[(size_t)(rowbase + i) * 16 + e]) << 32) | (unsigned long long)(0xFFFFFFFFu - (unsigned)i);
        __syncthreads();
        for (int k = 2; k <= n; k <<= 1)
            for (int j = k >> 1; j > 0; j >>= 1) {
                for (int q = tid; q < (n >> 1); q += NTHREADS) {
                    const int i = ((q & ~(j - 1)) << 1) | (q & (j - 1)), i2 = i | j;
                    const unsigned long long a = ks[i], b2 = ks[i2];
                    const bool up = (i & k) == 0;
                    if (up ? (a < b2) : (a > b2)) { ks[i] = b2; ks[i2] = a; }
                }
                __syncthreads();
            }
        for (int i = tid; i < n; i += NTHREADS) {
            const unsigned long long key = ks[i];
            const int t = (int)(0xFFFFFFFFu - (unsigned)(key & 0xFFFFFFFFull));
            SLOTOF[(size_t)(rowbase + t) * 16 + e] = (i < C) ? slotbase + i : -1;
            if (i < C) { SEL[slotbase + i] = rowbase + t; SELAFF[slotbase + i] = __uint_as_float((unsigned)(key >> 32)); }
        }
        __syncthreads();
    }
}


#ifndef DUMP
#define DUMP 0
#endif
#if DUMP
__device__ void phase_dump(const Params& p, const size_t off, const int is_bf16, const size_t n_avail) {
    const int tid = opaque_tid();
    const size_t n = (size_t)ROWS_LAT * D;
    for (size_t i = (size_t)blockIdx.x * NTHREADS + tid; i < n; i += (size_t)gridDim.x * NTHREADS) {
        float v = 0.f;
        if (i < n_avail) v = is_bf16 ? __uint_as_float((unsigned)((const bf16_t*)(p.ws + off))[i] << 16) : ((const float*)(p.ws + off))[i];
        p.out[i] = v;
    }
}
#endif

__global__ void __launch_bounds__(NTHREADS, 2) fwd(const Params p) {
    extern __shared__ __attribute__((aligned(16))) unsigned char smem[];
    LAS unsigned char* lds = (LAS unsigned char*)smem + LDS_OFF;
    XcdBarrier bar; bar.bar = (unsigned*)(p.ws + WS_BAR); bar.x = 0; bar.st = nullptr;
    const bool multi = (p.ph_hi - p.ph_lo) > 1;
    if (multi) {
        if (threadIdx.x == 0) *(LAS u32x4*)((LAS unsigned char*)smem) = (u32x4){0u, 0u, 0u, 0u};
        __syncthreads();
        bar = xcd_barrier_post((unsigned*)(p.ws + WS_BAR), (volatile LAS unsigned*)((LAS unsigned char*)smem));
    }
#if DUMP
    if (p.ph_lo == 100) { phase_dump(p, (size_t)(DUMP_OFF), DUMP_BF16, (size_t)(DUMP_N)); return; }
#endif
    int ph = 0;
#define PHASE(body) do { if (ph >= p.ph_lo && ph < p.ph_hi) { const int l = opaque_s(lv); body; if (ph + 1 < p.ph_hi) xcd_barrier(bar); } ++ph; } while (0)
    int lv = 0;
    PHASE(phase_prologue(p, lds));
    for (lv = 0; lv < DEPTH; ++lv) {
        PHASE(phase_norm<1>(p, l, lds));
        PHASE(phase_gemm<0>(p, l, lds));
        PHASE(phase_conv_pool(p, l, lds));
        PHASE(phase_scan_naive(p, l, lds));
        PHASE(phase_onorm(p, l));
        PHASE(phase_gemm<1>(p, l, lds));
        PHASE(phase_norm<2>(p, l, lds));
        PHASE(phase_topk(p, lds));
        PHASE(phase_gemm<2>(p, l, lds));
        PHASE(phase_gemm<3>(p, l, lds));
    }
    lv = 0;
    PHASE(phase_norm<3>(p, l, lds));
#undef PHASE
}
constexpr int N_PHASES = 2 + DEPTH * 10;

extern "C" void kernel_launch(void* const* d_in, const int* in_sizes, int n_in, void* d_out, int out_size, void* d_ws, size_t ws_size, hipStream_t stream) {
    static int grid = 0;
    if (grid == 0) {
        if (n_in != 21 || out_size != ROWS_LAT * D || ws_size < WS_END) { fprintf(stderr, "kernel_launch: unexpected shapes (n_in %d out %d ws %zu need %zu)\n", n_in, out_size, ws_size, (size_t)WS_END); grid = -1; return; }
        int dev = 0, cus = 0, per_cu = 0;
        if (hipGetDevice(&dev) != hipSuccess || hipDeviceGetAttribute(&cus, hipDeviceAttributeMultiprocessorCount, dev) != hipSuccess) { grid = -1; return; }
        if (hipFuncSetAttribute((const void*)fwd, hipFuncAttributeMaxDynamicSharedMemorySize, LDS_BYTES) != hipSuccess) { fprintf(stderr, "kernel_launch: hipFuncSetAttribute failed\n"); grid = -1; return; }
        if (hipOccupancyMaxActiveBlocksPerMultiprocessor(&per_cu, (const void*)fwd, NTHREADS, LDS_BYTES) != hipSuccess || per_cu < 1) { fprintf(stderr, "kernel_launch: occupancy query says %d\n", per_cu); per_cu = 1; }
        (void)hipGetLastError();
        grid = cus;
    }
    if (grid < 0) return;
    (void)hipMemsetAsync((char*)d_ws + WS_BAR, 0, 16384, stream);
    Params p; memset(&p, 0, sizeof(p));
    const float** pp = (const float**)&p;
    for (int i = 0; i < 21; ++i) pp[i] = (const float*)d_in[i];
    p.out = (float*)d_out; p.ws = (unsigned char*)d_ws;
#if DUMP
    for (int ph = 0; ph <= DUMP_LAST; ++ph) { p.ph_lo = ph; p.ph_hi = ph + 1; hipLaunchKernelGGL(fwd, dim3(grid), dim3(NTHREADS), LDS_BYTES, stream, p); }
    p.ph_lo = 100; p.ph_hi = 101; hipLaunchKernelGGL(fwd, dim3(grid), dim3(NTHREADS), LDS_BYTES, stream, p);
#elif ONE_LAUNCH
    p.ph_lo = 0; p.ph_hi = N_PHASES;
    hipLaunchKernelGGL(fwd, dim3(grid), dim3(NTHREADS), LDS_BYTES, stream, p);
#else
    for (int ph = 0; ph < N_PHASES; ++ph) { p.ph_lo = ph; p.ph_hi = ph + 1; hipLaunchKernelGGL(fwd, dim3(grid), dim3(NTHREADS), LDS_BYTES, stream, p); }
#endif
}
```

```cpp
#include <hip/hip_runtime.h>
#include <stdint.h>
#include <stdio.h>
#include <string.h>

#ifndef ONE_LAUNCH
#define ONE_LAUNCH 1
#endif
#ifndef NAIVE_SCAN
#define NAIVE_SCAN 0
#endif
#ifndef REGSTAGE
#define REGSTAGE 0
#endif

#define LAS __attribute__((address_space(3)))
typedef unsigned short bf16_t;
typedef short bf16x8 __attribute__((ext_vector_type(8)));
typedef float f32x4 __attribute__((ext_vector_type(4)));
typedef float f32x2 __attribute__((ext_vector_type(2)));
typedef unsigned u32x2 __attribute__((ext_vector_type(2)));
typedef unsigned u32x4 __attribute__((ext_vector_type(4)));

constexpr int D = 1024, NB = 8, SEQ = 2048, DEPTH = 4, CTXL = 256;
constexpr int ROWS_LAT = NB * SEQ;
constexpr int ROWS_CTX = NB * CTXL;
constexpr int MT = ROWS_LAT + ROWS_CTX;
constexpr int INC = 2576;
constexpr int PN = 2560;
constexpr int NE = 16;
constexpr int NGROUPS = 144;
constexpr int NSLOTS = NGROUPS * 256;
constexpr int NTHREADS = 512;
constexpr float EPS = 1e-6f;

constexpr size_t al256(size_t x) { return (x + 255) & ~(size_t)255; }
constexpr size_t WS_BAR = 0;
constexpr size_t WS_MOD = 16384;
constexpr size_t WS_X = WS_MOD + al256((size_t)DEPTH * 9 * 6144 * 4);
constexpr size_t WS_H = WS_X + (size_t)MT * D * 4;
constexpr size_t WS_PROJ = WS_H + (size_t)MT * D * 2;
constexpr size_t WS_YE = WS_PROJ;
constexpr size_t WS_LOGA = WS_PROJ + (size_t)MT * PN * 2;
constexpr size_t WS_BETA = WS_LOGA + (size_t)MT * 8 * 4;
constexpr size_t WS_QKV = WS_BETA + (size_t)MT * 8 * 4;
constexpr size_t WS_HID = WS_QKV;
constexpr size_t WS_OF = WS_QKV + (NAIVE_SCAN ? (size_t)MT * 1536 * 4 : (size_t)NSLOTS * D * 2);
constexpr size_t WS_OB = WS_OF + (size_t)MT * 512 * 4;
constexpr size_t WS_CAT = WS_OB + (size_t)MT * 512 * 4;
constexpr size_t WS_AFF = WS_CAT + (size_t)MT * D * 2;
constexpr size_t WS_SEL = WS_AFF + (size_t)MT * 16 * 4;
constexpr size_t WS_SELAFF = WS_SEL + (size_t)NSLOTS * 4;
constexpr size_t WS_SLOTOF = WS_SELAFF + (size_t)NSLOTS * 4;
constexpr size_t WS_WINT = WS_SLOTOF + (size_t)MT * 16 * 4;
constexpr size_t WS_WOUTT = WS_WINT + (size_t)DEPTH * PN * D * 2;
constexpr size_t WS_WGUT = WS_WOUTT + (size_t)DEPTH * D * D * 2;
constexpr size_t WS_WDT = WS_WGUT + (size_t)DEPTH * NE * 2048 * D * 2;
constexpr size_t WS_PWT = WS_WDT + (size_t)DEPTH * NE * D * D * 2;
constexpr size_t WS_SCN = WS_PWT + (size_t)DEPTH * 4 * 128 * 128 * 2;
constexpr int REC_W = 0, REC_KT = 16384, REC_QD = 32768, REC_QK = 49152, REC_UT = 57344, REC_MISC = 73728, REC_BYTES = 73984;
constexpr int NCHUNK = 36;
constexpr size_t WS_END = WS_SCN + (size_t)NB * 4 * 2 * NCHUNK * REC_BYTES + 4096;

constexpr int LDS_OFF = 1024;
constexpr int LDS_WORK = 152576;
constexpr int LDS_BYTES = LDS_OFF + LDS_WORK;

struct Params {
    const float *x, *c, *ctx, *c_ctx, *w_mod, *b_mod, *norm1, *norm2, *w_in, *conv_w, *a_log, *dt_bias, *dn_norm, *pool_w, *pool_scale, *w_out, *w_router, *w_gate, *w_up, *w_down, *norm_f;
    float* out;
    unsigned char* ws;
    int ph_lo, ph_hi;
};

#define XB_TMO      128
#define XB_XCNT(j)  (256  + 64 * (j))
#define XB_XSUB(j)  (1280 + 64 * (j))
#define XB_XGEN(j)  (2304 + 64 * (j))
#define XB_TOP      3328
#define XB_TOPGEN   3392
#define XCD_BAR_WORDS 3456
#define XB_SPIN_CAP (1u << 22)

__device__ __forceinline__ unsigned xb_ld(unsigned* p)              { return __hip_atomic_load(p, __ATOMIC_RELAXED, __HIP_MEMORY_SCOPE_AGENT); }
__device__ __forceinline__ unsigned xb_add(unsigned* p, unsigned v) { return __hip_atomic_fetch_add(p, v, __ATOMIC_RELAXED, __HIP_MEMORY_SCOPE_AGENT); }
__device__ __forceinline__ unsigned xb_xcc_id() { return (unsigned)__builtin_amdgcn_s_getreg((3 << 11) | 20) & 0xFu; }
#define XB_SPIN(cond, bar) do { unsigned _sp = 0; while (cond) { __builtin_amdgcn_s_sleep(1); \
    if ((++_sp & 255u) == 0u) { if (xb_ld(&(bar)[XB_TMO])) break; if (_sp > XB_SPIN_CAP) { atomicAdd(&(bar)[XB_TMO], 1u); break; } } } } while (0)

struct XcdBarrier { unsigned* bar; unsigned x; volatile LAS unsigned* st; };

__device__ __forceinline__ XcdBarrier xcd_barrier_post(unsigned* bar, volatile LAS unsigned* st) {
    XcdBarrier b; b.bar = bar; b.x = xb_xcc_id(); b.st = st;
    if (threadIdx.x == 0) (void)xb_add(&bar[XB_XCNT(b.x)], 1u);
    return b;
}
__device__ __forceinline__ void xcd_barrier_complete(unsigned* bar, unsigned x, unsigned& nloc, unsigned& nx) {
    const unsigned G = gridDim.x * gridDim.y * gridDim.z;
    unsigned sum, cnt, mine, sp = 0u;
    for (;;) {
        sum = 0u; cnt = 0u; mine = 0u;
#pragma unroll
        for (unsigned j = 0; j < 16; ++j) { const unsigned c = xb_ld(&bar[XB_XCNT(j)]); sum += c; cnt += (c > 0u) ? 1u : 0u; mine = (j == x) ? c : mine; }
        if (sum == G) break;
        __builtin_amdgcn_s_sleep(1);
        if ((++sp & 255u) == 0u) { if (xb_ld(&bar[XB_TMO])) break; if (sp > XB_SPIN_CAP) { atomicAdd(&bar[XB_TMO], 1u); break; } }
    }
    nloc = mine > 0u ? mine : 1u; nx = cnt > 0u ? cnt : 1u;
}
__device__ __forceinline__ void xcd_barrier(const XcdBarrier& b) {
    asm volatile("s_waitcnt vmcnt(0)" ::: "memory");
    __syncthreads();
    if (threadIdx.x == 0) {
        unsigned* bar = b.bar;
        __builtin_amdgcn_s_waitcnt(0);
        unsigned nloc = b.st[0], nx = b.st[1];
        if (nloc == 0u) { xcd_barrier_complete(bar, b.x, nloc, nx); b.st[0] = nloc; b.st[1] = nx; }
        const unsigned old = xb_add(&bar[XB_XSUB(b.x)], 1u);
        const unsigned gen = old / nloc;
        if (old + 1u == (gen + 1u) * nloc) {
            __builtin_amdgcn_fence(__ATOMIC_RELEASE, "agent");
            asm volatile("s_waitcnt vmcnt(0)" ::: "memory");
            const unsigned og = xb_add(&bar[XB_TOP], 1u);
            const unsigned tg = og / nx;
            if (og + 1u == (tg + 1u) * nx) xb_add(&bar[XB_TOPGEN], 1u);
            else XB_SPIN(xb_ld(&bar[XB_TOPGEN]) == tg, bar);
            __builtin_amdgcn_fence(__ATOMIC_ACQUIRE, "agent");
            xb_add(&bar[XB_XGEN(b.x)], 1u);
            asm volatile("s_waitcnt vmcnt(0)" ::: "memory");
        } else {
            XB_SPIN(xb_ld(&bar[XB_XGEN(b.x)]) == gen, bar);
            __builtin_amdgcn_fence(__ATOMIC_ACQUIRE, "agent");
            asm volatile("s_waitcnt vmcnt(0)" ::: "memory");
        }
    }
    __syncthreads();
}

typedef __bf16 bf16x2_t __attribute__((ext_vector_type(2)));
__device__ __forceinline__ unsigned pk_bf16(float lo, float hi) { const f32x2 v = {lo, hi}; const bf16x2_t b = __builtin_convertvector(v, bf16x2_t); return __builtin_bit_cast(unsigned, b); }
__device__ __forceinline__ float bf_lo(unsigned u) { return __uint_as_float(u << 16); }
__device__ __forceinline__ float bf_hi(unsigned u) { return __uint_as_float(u & 0xffff0000u); }
__device__ __forceinline__ float wave_sum(float v) {
#pragma unroll
    for (int o = 32; o > 0; o >>= 1) v += __shfl_xor(v, o);
    return v;
}
__device__ __forceinline__ int opaque_tid() { int t = threadIdx.x; asm volatile("" : "+v"(t)); return t; }
__device__ __forceinline__ int opaque_s(int v) { asm volatile("" : "+s"(v)); return v; }
__device__ __forceinline__ float silu_f(float v) { return v / (1.f + __expf(-v)); }

__device__ __forceinline__ int lds_byte(int r, int c) { const int st = (r >> 4) * 2 + (c >> 5), rr = r & 15, cc = c & 31, ob = rr * 64 + cc * 2; return st * 1024 + (ob ^ (((ob >> 9) & 1) << 5)); }
__device__ __forceinline__ void stage_rc(int b, int& R, int& C) { const int st = b >> 10, sb = b & 1023, swz = sb ^ (((sb >> 9) & 1) << 5); R = (st >> 1) * 16 + (swz >> 6); C = (st & 1) * 32 + ((swz & 63) >> 1); }

__device__ void phase_prologue(const Params& p, LAS unsigned char* lds) {
    const int tid = opaque_tid();
    {
        LAS float* sc = (LAS float*)lds;
        LAS float* red = sc + 9 * 1024;
        for (int idx = tid; idx < 9 * 1024; idx += NTHREADS) {
            const int r = idx >> 10, k = idx & 1023;
            const float v = r < 8 ? p.c[r * 1024 + k] : p.c_ctx[k];
            sc[idx] = silu_f(v);
        }
        __syncthreads();
        float* MOD = (float*)(p.ws + WS_MOD);
        for (int u = blockIdx.x; u < DEPTH * 96; u += gridDim.x) {
            const int l = u / 96, c0 = (u % 96) * 64, col = tid & 63, kg = tid >> 6;
            float acc[9];
#pragma unroll
            for (int r = 0; r < 9; ++r) acc[r] = 0.f;
            const float* W = p.w_mod + (size_t)l * 1024 * 6144 + c0 + col;
#pragma unroll 4
            for (int kk = 0; kk < 128; ++kk) {
                const int k = kg * 128 + kk;
                const float w = W[(size_t)k * 6144];
#pragma unroll
                for (int r = 0; r < 9; ++r) acc[r] += sc[r * 1024 + k] * w;
            }
#pragma unroll
            for (int r = 0; r < 9; ++r) red[(kg * 9 + r) * 64 + col] = acc[r];
            __syncthreads();
            for (int idx = tid; idx < 576; idx += NTHREADS) {
                const int r = idx >> 6, cc = idx & 63;
                float s = 0.f;
#pragma unroll
                for (int g = 0; g < 8; ++g) s += red[(g * 9 + r) * 64 + cc];
                MOD[((size_t)l * 9 + r) * 6144 + c0 + cc] = s + p.b_mod[l * 6144 + c0 + cc];
            }
            __syncthreads();
        }
    }
    {
        f32x4* X4 = (f32x4*)(p.ws + WS_X);
        const f32x4* x4 = (const f32x4*)p.x; const f32x4* c4 = (const f32x4*)p.ctx;
        const int nlat = ROWS_LAT * D / 4, ntot = MT * D / 4;
        for (int i = blockIdx.x * NTHREADS + tid; i < ntot; i += gridDim.x * NTHREADS) X4[i] = i < nlat ? x4[i] : c4[i - nlat];
    }
    {
        LAS float* tile = (LAS float*)lds;
        bf16_t* WINT = (bf16_t*)(p.ws + WS_WINT); bf16_t* WOUTT = (bf16_t*)(p.ws + WS_WOUTT); bf16_t* WGUT = (bf16_t*)(p.ws + WS_WGUT); bf16_t* WDT = (bf16_t*)(p.ws + WS_WDT);
        constexpr int T_IN = 10 * 16, T_OUT = 4 * 16, T_EXP = NE * 4 * 16, T_LAYER = T_IN + T_OUT + 3 * T_EXP;
        for (int t = blockIdx.x; t < DEPTH * T_LAYER; t += gridDim.x) {
            const int l = t / T_LAYER; int i = t % T_LAYER;
            const float* src; size_t sld; bf16_t* dst; int rs = 16;
            if (i < T_IN) { const int nt = i >> 4, kt = i & 15; const int n0 = nt < 6 ? nt * 256 : 1552 + (nt - 6) * 256;
                src = p.w_in + ((size_t)l * D + kt * 64) * INC + n0; sld = INC; dst = WINT + ((size_t)l * PN + nt * 256) * D + kt * 64; }
            else if (i < T_IN + T_OUT) { i -= T_IN; const int nt = i >> 4, kt = i & 15;
                src = p.w_out + ((size_t)l * D + kt * 64) * D + nt * 256; sld = D; dst = WOUTT + ((size_t)l * D + nt * 256) * D + kt * 64; }
            else { i -= T_IN + T_OUT; const int which = i / T_EXP; i %= T_EXP; const int e = i >> 6, nt = (i >> 4) & 3, kt = i & 15;
                const size_t mo = ((size_t)(l * NE + e) * D + kt * 64) * D + nt * 256;
                if (which == 2) { src = p.w_down + mo; dst = WDT + ((size_t)(l * NE + e) * D + nt * 256) * D + kt * 64; }
                else { src = (which == 0 ? p.w_gate : p.w_up) + mo; rs = 32; dst = WGUT + ((size_t)(l * NE + e) * 2048 + nt * 512 + which * 16) * D + kt * 64; }
                sld = D; }
#pragma unroll
            for (int j = 0; j < 8; ++j) {
                const int e = tid * 4 + j * 2048, k = e >> 8, n = e & 255;
                const f32x4 v = *(const f32x4*)(src + (size_t)k * sld + n);
                tile[k * 257 + n] = v[0]; tile[k * 257 + n + 1] = v[1]; tile[k * 257 + n + 2] = v[2]; tile[k * 257 + n + 3] = v[3];
            }
            __syncthreads();
#pragma unroll
            for (int ps = 0; ps < 4; ++ps) {
                const int n = ps * 64 + (tid >> 3), ks = (tid & 7) * 8;
                u32x4 o;
                o[0] = pk_bf16(tile[(ks + 0) * 257 + n], tile[(ks + 1) * 257 + n]); o[1] = pk_bf16(tile[(ks + 2) * 257 + n], tile[(ks + 3) * 257 + n]);
                o[2] = pk_bf16(tile[(ks + 4) * 257 + n], tile[(ks + 5) * 257 + n]); o[3] = pk_bf16(tile[(ks + 6) * 257 + n], tile[(ks + 7) * 257 + n]);
                *(u32x4*)(dst + (size_t)((n >> 4) * rs + (n & 15)) * D + ks) = o;
            }
            __syncthreads();
        }
        bf16_t* PWT = (bf16_t*)(p.ws + WS_PWT);
        for (int i = blockIdx.x * NTHREADS + tid; i < DEPTH * 4 * 128 * 128; i += gridDim.x * NTHREADS) {
            const int lg = i >> 14, d = (i >> 7) & 127, c = i & 127;
            PWT[i] = (bf16_t)(pk_bf16(p.pool_w[((size_t)lg * 128 + c) * 128 + d], 0.f) & 0xffffu);
        }
    }
}

template <int WHICH>
__device__ void phase_norm(const Params& p, const int l, LAS unsigned char* lds) {
    const int tid = opaque_tid(), wid = tid >> 6, lane = tid & 63;
    LAS float* wsm = (LAS float*)lds;
    if (WHICH != 3) {
        const float* src; int stride;
        if (WHICH == 1) { src = p.w_in + (size_t)l * D * INC + 1536; stride = INC; } else { src = p.w_router + (size_t)l * D * NE; stride = NE; }
        for (int idx = tid; idx < 16 * 1024; idx += NTHREADS) { const int k = idx >> 4, j = idx & 15; wsm[j * 1024 + k] = src[(size_t)k * stride + j]; }
        __syncthreads();
    }
    const float* nw = WHICH == 1 ? p.norm1 + l * D : (WHICH == 2 ? p.norm2 + l * D : p.norm_f);
    float* X = (float*)(p.ws + WS_X);
    const float* MOD = (const float*)(p.ws + WS_MOD);
    bf16_t* H = (bf16_t*)(p.ws + WS_H);
    const int nrows = (WHICH == 3) ? ROWS_LAT : MT;
    for (int row = blockIdx.x * 8 + wid; row < nrows; row += gridDim.x * 8) {
        const int bidx = row < ROWS_LAT ? (row >> 11) : 8;
        float* xr = X + (size_t)row * D;
        f32x4 xv[4];
#pragma unroll
        for (int i = 0; i < 4; ++i) xv[i] = *(const f32x4*)(xr + i * 256 + lane * 4);
        if ((WHICH == 1 && l > 0) || WHICH == 3) {
            const int lp = (WHICH == 3) ? DEPTH - 1 : l - 1;
            const float* g2 = MOD + ((size_t)lp * 9 + bidx) * 6144 + 5 * 1024;
            const int* so = (const int*)(p.ws + WS_SLOTOF) + (size_t)row * 16;
            const bf16_t* YE = (const bf16_t*)(p.ws + WS_YE);
            f32x4 a[4];
#pragma unroll
            for (int i = 0; i < 4; ++i) a[i] = (f32x4){0.f, 0.f, 0.f, 0.f};
            for (int e = 0; e < NE; ++e) {
                const int s = __builtin_amdgcn_readfirstlane(so[e]);
                if (s >= 0) {
                    const bf16_t* yr = YE + (size_t)s * D;
#pragma unroll
                    for (int i = 0; i < 4; ++i) { const u32x2 v = *(const u32x2*)(yr + i * 256 + lane * 4);
                        a[i][0] += bf_lo(v[0]); a[i][1] += bf_hi(v[0]); a[i][2] += bf_lo(v[1]); a[i][3] += bf_hi(v[1]); }
                }
            }
#pragma unroll
            for (int i = 0; i < 4; ++i) { const f32x4 g = *(const f32x4*)(g2 + i * 256 + lane * 4); xv[i] += g * a[i]; }
            if (WHICH == 1) {
#pragma unroll
                for (int i = 0; i < 4; ++i) *(f32x4*)(xr + i * 256 + lane * 4) = xv[i];
            }
        }
        float ss = 0.f;
#pragma unroll
        for (int i = 0; i < 4; ++i) ss += xv[i][0] * xv[i][0] + xv[i][1] * xv[i][1] + xv[i][2] * xv[i][2] + xv[i][3] * xv[i][3];
        ss = wave_sum(ss);
        const float rstd = rsqrtf(ss * (1.f / 1024.f) + EPS);
        if (WHICH == 3) {
#pragma unroll
            for (int i = 0; i < 4; ++i) { const f32x4 w = *(const f32x4*)(nw + i * 256 + lane * 4); *(f32x4*)(p.out + (size_t)row * D + i * 256 + lane * 4) = xv[i] * rstd * w; }
            continue;
        }
        const float* md = MOD + ((size_t)l * 9 + bidx) * 6144 + (WHICH == 1 ? 0 : 3072);
        f32x4 h[4];
#pragma unroll
        for (int i = 0; i < 4; ++i) {
            const int c = i * 256 + lane * 4;
            const f32x4 w = *(const f32x4*)(nw + c), sh = *(const f32x4*)(md + c), scl = *(const f32x4*)(md + 1024 + c);
            h[i] = (xv[i] * rstd * w) * (scl + 1.f) + sh;
            u32x2 o; o[0] = pk_bf16(h[i][0], h[i][1]); o[1] = pk_bf16(h[i][2], h[i][3]);
            *(u32x2*)(H + (size_t)row * D + c) = o;
        }
        float d[16];
#pragma unroll
        for (int jg = 0; jg < 4; ++jg) {
#pragma unroll
            for (int jj = 0; jj < 4; ++jj) {
                const int j = jg * 4 + jj;
                float s = 0.f;
#pragma unroll
                for (int i = 0; i < 4; ++i) { const f32x4 w = *(const LAS f32x4*)(wsm + j * 1024 + i * 256 + lane * 4); s += h[i][0] * w[0] + h[i][1] * w[1] + h[i][2] * w[2] + h[i][3] * w[3]; }
                d[j] = wave_sum(s);
            }
            __builtin_amdgcn_sched_barrier(0);
        }
        if (WHICH == 1) {
            float da = 0.f, db = 0.f;
#pragma unroll
            for (int j = 0; j < 8; ++j) { da = (lane == j) ? d[j] : da; db = (lane == j) ? d[8 + j] : db; }
            if (lane < 8) {
                const float xa = da + p.dt_bias[l * 8 + lane];
                const float sp = xa > 20.f ? xa : log1pf(__expf(xa));
                ((float*)(p.ws + WS_LOGA))[(size_t)row * 8 + lane] = -__expf(p.a_log[l * 8 + lane]) * sp;
                ((float*)(p.ws + WS_BETA))[(size_t)row * 8 + lane] = 1.f / (1.f + __expf(-db));
            }
        } else {
            float m = d[0];
#pragma unroll
            for (int j = 1; j < 16; ++j) m = fmaxf(m, d[j]);
            float sum = 0.f, mine = 0.f;
#pragma unroll
            for (int j = 0; j < 16; ++j) { const float e = __expf(d[j] - m); sum += e; mine = (lane == j) ? e : mine; }
            if (lane < 16) ((float*)(p.ws + WS_AFF))[(size_t)row * 16 + lane] = mine / sum;
        }
    }
}

__device__ __forceinline__ void gemm_core(const unsigned char* Ab, const unsigned (&aoff)[4], const unsigned char* Bb, const unsigned (&boff)[2], const int nt,
                                          LAS unsigned char* lds, f32x4 (&acc)[4][4], const int wid, const int lane) {
    const int wr = wid >> 1, wc = wid & 1, fr = lane & 15, fq = lane >> 4;
    const int ar = lds_byte(wr * 64 + fr, fq * 8), br = lds_byte(wc * 64 + fr, fq * 8);
    const unsigned ldsw = (unsigned)wid * 1024u;
#define G_STAGE(t, buf) do { const unsigned _ko = (unsigned)(t) * 128u; \
        _Pragma("unroll") for (int _i = 0; _i < 4; ++_i) __builtin_amdgcn_global_load_lds((const unsigned*)(Ab + aoff[_i] + _ko), (LAS unsigned*)(lds + (buf) * 49152 + ldsw + _i * 8192), 16, 0, 0); \
        _Pragma("unroll") for (int _i = 0; _i < 2; ++_i) __builtin_amdgcn_global_load_lds((const unsigned*)(Bb + boff[_i] + _ko), (LAS unsigned*)(lds + (buf) * 49152 + 32768 + ldsw + _i * 8192), 16, 0, 0); } while (0)
#pragma unroll
    for (int m = 0; m < 4; ++m)
#pragma unroll
        for (int n = 0; n < 4; ++n) acc[m][n] = (f32x4){0.f, 0.f, 0.f, 0.f};
#if REGSTAGE
    u32x4 ra[4], rb[2];
#pragma unroll
    for (int i = 0; i < 4; ++i) ra[i] = *(const u32x4*)(Ab + aoff[i]);
#pragma unroll
    for (int i = 0; i < 2; ++i) rb[i] = *(const u32x4*)(Bb + boff[i]);
    const unsigned tb = (unsigned)(wid * 64 + lane) * 16u;
    for (int t = 0; t < nt; ++t) {
        __syncthreads();
#pragma unroll
        for (int i = 0; i < 4; ++i) *(LAS u32x4*)(lds + tb + i * 8192) = ra[i];
#pragma unroll
        for (int i = 0; i < 2; ++i) *(LAS u32x4*)(lds + 32768 + tb + i * 8192) = rb[i];
        __syncthreads();
        if (t + 1 < nt) {
            const unsigned ko = (unsigned)(t + 1) * 128u;
#pragma unroll
            for (int i = 0; i < 4; ++i) ra[i] = *(const u32x4*)(Ab + aoff[i] + ko);
#pragma unroll
            for (int i = 0; i < 2; ++i) rb[i] = *(const u32x4*)(Bb + boff[i] + ko);
        }
        LAS unsigned char* bA = lds; LAS unsigned char* bB = bA + 32768;
        bf16x8 af[4][2], bfr[4][2];
#pragma unroll
        for (int m = 0; m < 4; ++m)
#pragma unroll
            for (int k = 0; k < 2; ++k) af[m][k] = *(const LAS bf16x8*)(bA + ar + m * 2048 + k * 1024);
#pragma unroll
        for (int n = 0; n < 4; ++n)
#pragma unroll
            for (int k = 0; k < 2; ++k) bfr[n][k] = *(const LAS bf16x8*)(bB + br + n * 2048 + k * 1024);
#pragma unroll
        for (int k = 0; k < 2; ++k)
#pragma unroll
            for (int m = 0; m < 4; ++m)
#pragma unroll
                for (int n = 0; n < 4; ++n) acc[m][n] = __builtin_amdgcn_mfma_f32_16x16x32_bf16(bfr[n][k], af[m][k], acc[m][n], 0, 0, 0);
    }
#else
    G_STAGE(0, 0);
    for (int t = 0; t < nt; ++t) {
        asm volatile("s_waitcnt vmcnt(0)" ::: "memory");
        __syncthreads();
        if (t + 1 < nt) { if ((t + 1) & 1) G_STAGE(t + 1, 1); else G_STAGE(t + 1, 0); }
        LAS unsigned char* bA = lds + (t & 1) * 49152; LAS unsigned char* bB = bA + 32768;
        bf16x8 af[4][2], bfr[4][2];
#pragma unroll
        for (int m = 0; m < 4; ++m)
#pragma unroll
            for (int k = 0; k < 2; ++k) af[m][k] = *(const LAS bf16x8*)(bA + ar + m * 2048 + k * 1024);
#pragma unroll
        for (int n = 0; n < 4; ++n)
#pragma unroll
            for (int k = 0; k < 2; ++k) bfr[n][k] = *(const LAS bf16x8*)(bB + br + n * 2048 + k * 1024);
#pragma unroll
        for (int k = 0; k < 2; ++k)
#pragma unroll
            for (int m = 0; m < 4; ++m)
#pragma unroll
                for (int n = 0; n < 4; ++n) acc[m][n] = __builtin_amdgcn_mfma_f32_16x16x32_bf16(bfr[n][k], af[m][k], acc[m][n], 0, 0, 0);
    }
#endif
    __syncthreads();
#undef G_STAGE
}

template <int MODE>
__device__ void phase_gemm(const Params& p, const int l, LAS unsigned char* lds) {
    const int tid = opaque_tid(), wid = __builtin_amdgcn_readfirstlane(tid >> 6), lane = tid & 63;
    const int wr = wid >> 1, wc = wid & 1, fr = lane & 15, fq = lane >> 4;
    int R0, C0; stage_rc(tid * 16, R0, C0);
    constexpr int nN = MODE == 0 ? 20 : (MODE == 1 ? 8 : (MODE == 2 ? 16 : 8));
    constexpr int nM = (MODE <= 1) ? MT / 256 : NGROUPS;
    const bf16_t* H = (const bf16_t*)(p.ws + WS_H);
    for (int u = blockIdx.x; u < nM * nN; u += gridDim.x) {
        const int pm = u / nN, pn = u % nN;
        const unsigned char* Ab; const unsigned char* Bb; unsigned aoff[4], boff[2];
#pragma unroll
        for (int i = 0; i < 2; ++i) boff[i] = (unsigned)((R0 + 64 * i) * D + C0) * 2u;
        int e = 0;
        if (MODE == 0) {
            Ab = (const unsigned char*)(H + (size_t)pm * 256 * D); Bb = (const unsigned char*)((const bf16_t*)(p.ws + WS_WINT) + ((size_t)l * PN + pn * 128) * D);
#pragma unroll
            for (int i = 0; i < 4; ++i) aoff[i] = (unsigned)((R0 + 64 * i) * D + C0) * 2u;
        } else if (MODE == 1) {
            Ab = (const unsigned char*)((const bf16_t*)(p.ws + WS_CAT) + (size_t)pm * 256 * D); Bb = (const unsigned char*)((const bf16_t*)(p.ws + WS_WOUTT) + ((size_t)l * D + pn * 128) * D);
#pragma unroll
            for (int i = 0; i < 4; ++i) aoff[i] = (unsigned)((R0 + 64 * i) * D + C0) * 2u;
        } else if (MODE == 2) {
            e = pm < 128 ? (pm >> 3) : (pm - 128);
            const int* SEL = (const int*)(p.ws + WS_SEL) + pm * 256;
            Ab = (const unsigned char*)H; Bb = (const unsigned char*)((const bf16_t*)(p.ws + WS_WGUT) + ((size_t)(l * NE + e) * 2048 + pn * 128) * D);
#pragma unroll
            for (int i = 0; i < 4; ++i) aoff[i] = (unsigned)(SEL[R0 + 64 * i] * D + C0) * 2u;
        } else {
            e = pm < 128 ? (pm >> 3) : (pm - 128);
            Ab = (const unsigned char*)((const bf16_t*)(p.ws + WS_HID) + (size_t)pm * 256 * D); Bb = (const unsigned char*)((const bf16_t*)(p.ws + WS_WDT) + ((size_t)(l * NE + e) * D + pn * 128) * D);
#pragma unroll
            for (int i = 0; i < 4; ++i) aoff[i] = (unsigned)((R0 + 64 * i) * D + C0) * 2u;
        }
        f32x4 acc[4][4];
        gemm_core(Ab, aoff, Bb, boff, D / 64, lds, acc, wid, lane);
        if (MODE == 0) {
            bf16_t* PROJ = (bf16_t*)(p.ws + WS_PROJ);
#pragma unroll
            for (int m = 0; m < 4; ++m) { const size_t row = (size_t)pm * 256 + wr * 64 + m * 16 + fr;
#pragma unroll
                for (int n = 0; n < 4; ++n) { u32x2 o; o[0] = pk_bf16(acc[m][n][0], acc[m][n][1]); o[1] = pk_bf16(acc[m][n][2], acc[m][n][3]);
                    *(u32x2*)(PROJ + row * PN + pn * 128 + wc * 64 + n * 16 + fq * 4) = o; } }
        } else if (MODE == 1) {
            float* X = (float*)(p.ws + WS_X);
            const int bidx = pm < 64 ? (pm >> 3) : 8;
            const float* g1 = (const float*)(p.ws + WS_MOD) + ((size_t)l * 9 + bidx) * 6144 + 2048;
#pragma unroll
            for (int n = 0; n < 4; ++n) { const int col = pn * 128 + wc * 64 + n * 16 + fq * 4; const f32x4 g = *(const f32x4*)(g1 + col);
#pragma unroll
                for (int m = 0; m < 4; ++m) { float* xp = X + ((size_t)pm * 256 + wr * 64 + m * 16 + fr) * D + col; *(f32x4*)xp = *(const f32x4*)xp + g * acc[m][n]; } }
        } else if (MODE == 2) {
            bf16_t* HID = (bf16_t*)(p.ws + WS_HID);
#pragma unroll
            for (int m = 0; m < 4; ++m) { const size_t slot = (size_t)pm * 256 + wr * 64 + m * 16 + fr;
#pragma unroll
                for (int q = 0; q < 2; ++q) { const f32x4 g = acc[m][2 * q], uu = acc[m][2 * q + 1];
                    u32x2 o; o[0] = pk_bf16(silu_f(g[0]) * uu[0], silu_f(g[1]) * uu[1]); o[1] = pk_bf16(silu_f(g[2]) * uu[2], silu_f(g[3]) * uu[3]);
                    *(u32x2*)(HID + slot * D + pn * 64 + wc * 32 + q * 16 + fq * 4) = o; } }
        } else {
            bf16_t* YE = (bf16_t*)(p.ws + WS_YE);
            const float* SELAFF = (const float*)(p.ws + WS_SELAFF);
#pragma unroll
            for (int m = 0; m < 4; ++m) { const size_t slot = (size_t)pm * 256 + wr * 64 + m * 16 + fr; const float a = SELAFF[slot];
#pragma unroll
                for (int n = 0; n < 4; ++n) { u32x2 o; o[0] = pk_bf16(acc[m][n][0] * a, acc[m][n][1] * a); o[1] = pk_bf16(acc[m][n][2] * a, acc[m][n][3] * a);
                    *(u32x2*)(YE + slot * D + pn * 128 + wc * 64 + n * 16 + fq * 4) = o; } }
        }
    }
}

__device__ void phase_conv_pool(const Params& p, const int l, LAS unsigned char* lds) {
    const int tid = opaque_tid(), wid = tid >> 6, lane = tid & 63;
    const bf16_t* PROJ = (const bf16_t*)(p.ws + WS_PROJ);
    if (NAIVE_SCAN) {
        float* QKV = (float*)(p.ws + WS_QKV);
        const float* cw = p.conv_w + (size_t)l * 4 * 1536;
        for (int task = blockIdx.x * 8 + wid; task < MT * 12; task += gridDim.x * 8) {
            const int row = task / 12, part = task % 12;
            int s0, len;
            if (row < ROWS_LAT) { s0 = row & ~2047; len = 2048; } else { s0 = ROWS_LAT + ((row - ROWS_LAT) & ~255); len = 256; }
            const int c = part * 128 + lane * 2;
            float a0 = 0.f, a1 = 0.f;
#pragma unroll
            for (int j = 0; j < 4; ++j) {
                const int r2 = row + j - 2;
                if (r2 >= s0 && r2 < s0 + len) {
                    const unsigned v = *(const unsigned*)(PROJ + (size_t)r2 * PN + c);
                    const f32x2 w = *(const f32x2*)(cw + j * 1536 + c);
                    a0 += w[0] * bf_lo(v); a1 += w[1] * bf_hi(v);
                }
            }
            a0 = silu_f(a0); a1 = silu_f(a1);
            if (part < 8) {
                const float ss = wave_sum(a0 * a0 + a1 * a1);
                float sc = rsqrtf(ss + EPS);
                if (part < 4) sc *= 0.08838834764831845f;
                a0 *= sc; a1 *= sc;
            }
            *(f32x2*)(QKV + (size_t)row * 1536 + c) = (f32x2){a0, a1};
        }
    }
    {
        LAS float* V = (LAS float*)lds;
        LAS unsigned char* mt = lds + 40960;
        const bf16_t* PWT = (const bf16_t*)(p.ws + WS_PWT);
        bf16_t* CAT = (bf16_t*)(p.ws + WS_CAT);
        const int wr = wid >> 1, wc = wid & 1, fr = lane & 15, fq = lane >> 4;
        for (int u = blockIdx.x; u < 1152; u += gridDim.x) {
            int g, r, nrows, ncols, c0, rowbase;
            if (u < 1024) { const int b = u >> 7; g = (u >> 5) & 3; r = u & 31; nrows = 32; ncols = 64; c0 = 0; rowbase = b * 2048; }
            else { const int v = u - 1024; const int b = v >> 4; g = (v >> 2) & 3; r = 0; nrows = 1; ncols = 256; c0 = (v & 3) * 64; rowbase = ROWS_LAT + b * 256; }
            const int w = 2 << g, half = w >> 1;
            const int lo_r = max(r - half, 0), hi_r = min(r - half + w, nrows);
            const int cxlo = max(c0 - half, 0), cxhi = min(c0 + 64 + half, ncols);
            const bf16_t* ub = PROJ + 2048 + g * 128;
            for (int idx = tid; idx < (cxhi - cxlo) * 64; idx += NTHREADS) {
                const int cxi = idx >> 6, ch = (idx & 63) * 2;
                float s0 = 0.f, s1 = 0.f;
                for (int rr = lo_r; rr < hi_r; ++rr) { const unsigned v = *(const unsigned*)(ub + (size_t)(rowbase + rr * ncols + cxlo + cxi) * PN + ch); s0 += bf_lo(v); s1 += bf_hi(v); }
                V[cxi * 128 + ch] = s0; V[cxi * 128 + ch + 1] = s1;
            }
            __syncthreads();
            for (int idx = tid; idx < 64 * 64; idx += NTHREADS) {
                const int ci = idx >> 6, ch = (idx & 63) * 2, c = c0 + ci;
                const int lo_c = max(c - half, 0), hi_c = min(c - half + w, ncols);
                float s0 = 0.f, s1 = 0.f;
                for (int cx = lo_c; cx < hi_c; ++cx) { s0 += V[(cx - cxlo) * 128 + ch]; s1 += V[(cx - cxlo) * 128 + ch + 1]; }
                const float inv = 1.f / (float)((hi_r - lo_r) * (hi_c - lo_c));
                const unsigned v = *(const unsigned*)(ub + (size_t)(rowbase + r * ncols + c) * PN + ch);
                *(LAS unsigned*)(mt + ci * 272 + ch * 2) = pk_bf16(s0 * inv - bf_lo(v), s1 * inv - bf_hi(v));
            }
            __syncthreads();
            f32x4 acc[4];
#pragma unroll
            for (int n = 0; n < 4; ++n) acc[n] = (f32x4){0.f, 0.f, 0.f, 0.f};
            const bf16_t* pw = PWT + (size_t)(l * 4 + g) * 128 * 128;
#pragma unroll
            for (int kk = 0; kk < 4; ++kk) {
                const bf16x8 a = *(const LAS bf16x8*)(mt + (wr * 16 + fr) * 272 + (kk * 32 + fq * 8) * 2);
#pragma unroll
                for (int n = 0; n < 4; ++n) {
                    const bf16x8 b = *(const bf16x8*)(pw + (size_t)(wc * 64 + n * 16 + fr) * 128 + kk * 32 + fq * 8);
                    acc[n] = __builtin_amdgcn_mfma_f32_16x16x32_bf16(b, a, acc[n], 0, 0, 0);
                }
            }
            const size_t row = (size_t)rowbase + r * ncols + c0 + wr * 16 + fr;
#pragma unroll
            for (int n = 0; n < 4; ++n) {
                const int dcol = g * 128 + wc * 64 + n * 16 + fq * 4;
                const f32x4 s = *(const f32x4*)(p.pool_scale + l * 512 + dcol);
                u32x2 o; o[0] = pk_bf16(acc[n][0] * s[0], acc[n][1] * s[1]); o[1] = pk_bf16(acc[n][2] * s[2], acc[n][3] * s[3]);
                *(u32x2*)(CAT + row * D + 512 + dcol) = o;
            }
            __syncthreads();
        }
    }
}


__device__ __forceinline__ int img256(int row, int col) { return row * 256 + ((((col >> 3) ^ row) & 15) << 4) + (col & 7) * 2; }
__device__ __forceinline__ int img128(int row, int col) { return (row >> 1) * 256 + (row & 1) * 128 + ((((col >> 3) ^ (row >> 1)) & 7) << 4) + (col & 7) * 2; }

__device__ void phase_prep(const Params& p, const int l, LAS unsigned char* lds) {
    const int tid = opaque_tid(), wid = __builtin_amdgcn_readfirstlane(tid >> 6), lane = tid & 63, fr = lane & 15, fq = lane >> 4;
    constexpr int R_KK = 0, R_QK = 16640, R_TB = 33280, R_QN = 53248, R_KN = 70656, R_KNT = 88064, R_VT = 106496, R_TW = 124928, R_TU = 134144, R_MB = R_TW, R_G = 143360;
    LAS float* KK = (LAS float*)(lds + R_KK); LAS float* QK = (LAS float*)(lds + R_QK); LAS float* TB = (LAS float*)(lds + R_TB); LAS float* MB = (LAS float*)(lds + R_MB);
    LAS float* G_LA = (LAS float*)(lds + R_G);
    LAS float* G_BT = G_LA + 128;
    LAS float* G_GC = G_BT + 128;
    LAS float* G_TOT = G_GC + 128;
    LAS float* XS = G_TOT + 16;
    const bf16_t* PROJ = (const bf16_t*)(p.ws + WS_PROJ);
    const float* LOGA = (const float*)(p.ws + WS_LOGA); const float* BETA = (const float*)(p.ws + WS_BETA);
    for (int u = blockIdx.x; u < NB * 4 * NCHUNK; u += gridDim.x) {
        const int b = u / 144, rem = u % 144, h = rem / 36, cc = rem % 36;
        int rowbase, seqlen, cpos;
        if (cc < 32) { rowbase = b * SEQ; seqlen = SEQ; cpos = cc; } else { rowbase = ROWS_LAT + b * CTXL; seqlen = CTXL; cpos = cc - 32; }
        const int t0 = cpos * 64;
        for (int idx = tid; idx < 67 * 48; idx += NTHREADS) {
            const int rr = idx / 48, pc = idx % 48, seg = pc >> 4, po = pc & 15, tok = t0 - 2 + rr;
            u32x4 v = (u32x4){0u, 0u, 0u, 0u};
            if (tok >= 0 && tok < seqlen) v = *(const u32x4*)(PROJ + (size_t)(rowbase + tok) * PN + seg * 512 + h * 128 + po * 8);
            *(LAS u32x4*)(lds + rr * 784 + seg * 256 + po * 16) = v;
        }
        if (tid < 128) { const int d = tid >> 6; const size_t gi = (size_t)(rowbase + t0 + lane) * 8 + d * 4 + h; G_LA[tid] = LOGA[gi]; G_BT[tid] = BETA[gi]; }
        __syncthreads();
        if (wid < 2) {
            const int d = wid, pos = d ? 63 - lane : lane;
            float v = G_LA[d * 64 + pos];
#pragma unroll
            for (int o = 1; o < 64; o <<= 1) { const float t = __shfl_up(v, o); if (lane >= o) v += t; }
            G_GC[d * 64 + pos] = v;
            if (lane == 63) G_TOT[d] = v;
        }
        {
            const int r = tid >> 3, cs = tid & 7;
            const float* cw = p.conv_w + (size_t)l * 4 * 1536 + h * 128 + cs * 16;
#pragma unroll
            for (int seg = 0; seg < 3; ++seg) {
                float a[16];
#pragma unroll
                for (int e = 0; e < 16; ++e) a[e] = 0.f;
#pragma unroll
                for (int j = 0; j < 4; ++j) {
                    const u32x4 x0 = *(const LAS u32x4*)(lds + (r + j) * 784 + seg * 256 + cs * 32), x1 = *(const LAS u32x4*)(lds + (r + j) * 784 + seg * 256 + cs * 32 + 16);
                    const float* wj = cw + j * 1536 + seg * 512;
                    const f32x4 w0 = *(const f32x4*)(wj), w1 = *(const f32x4*)(wj + 4), w2 = *(const f32x4*)(wj + 8), w3 = *(const f32x4*)(wj + 12);
                    a[0] += w0[0] * bf_lo(x0[0]); a[1] += w0[1] * bf_hi(x0[0]); a[2] += w0[2] * bf_lo(x0[1]); a[3] += w0[3] * bf_hi(x0[1]);
                    a[4] += w1[0] * bf_lo(x0[2]); a[5] += w1[1] * bf_hi(x0[2]); a[6] += w1[2] * bf_lo(x0[3]); a[7] += w1[3] * bf_hi(x0[3]);
                    a[8] += w2[0] * bf_lo(x1[0]); a[9] += w2[1] * bf_hi(x1[0]); a[10] += w2[2] * bf_lo(x1[1]); a[11] += w2[3] * bf_hi(x1[1]);
                    a[12] += w3[0] * bf_lo(x1[2]); a[13] += w3[1] * bf_hi(x1[2]); a[14] += w3[2] * bf_lo(x1[3]); a[15] += w3[3] * bf_hi(x1[3]);
                }
                float ss = 0.f;
#pragma unroll
                for (int e = 0; e < 16; ++e) { a[e] = silu_f(a[e]); ss += a[e] * a[e]; }
                if (seg < 2) {
                    ss += __shfl_xor(ss, 1); ss += __shfl_xor(ss, 2); ss += __shfl_xor(ss, 4);
                    float sc = rsqrtf(ss + EPS); if (seg == 0) sc *= 0.08838834764831845f;
#pragma unroll
                    for (int e = 0; e < 16; ++e) a[e] *= sc;
                }
                unsigned pk[8];
#pragma unroll
                for (int e = 0; e < 8; ++e) pk[e] = pk_bf16(a[2 * e], a[2 * e + 1]);
                if (seg < 2) {
                    LAS unsigned char* dst = lds + (seg == 0 ? R_QN : R_KN) + r * 272 + cs * 32;
                    *(LAS u32x4*)dst = (u32x4){pk[0], pk[1], pk[2], pk[3]}; *(LAS u32x4*)(dst + 16) = (u32x4){pk[4], pk[5], pk[6], pk[7]};
                }
                if (seg >= 1) {
                    LAS unsigned char* dt = lds + (seg == 1 ? R_KNT : R_VT) + (cs * 16) * 144 + r * 2;
#pragma unroll
                    for (int e = 0; e < 8; ++e) { *(LAS unsigned short*)(dt + (2 * e) * 144) = (unsigned short)(pk[e] & 0xffffu); *(LAS unsigned short*)(dt + (2 * e + 1) * 144) = (unsigned short)(pk[e] >> 16); }
                }
            }
        }
        __syncthreads();
        {
            const int ib = wid & 3, pr = wid >> 2;
            LAS unsigned char* Ab = lds + (pr ? R_QN : R_KN) + (ib * 16 + fr) * 272 + fq * 16;
            bf16x8 a[4];
#pragma unroll
            for (int kk = 0; kk < 4; ++kk) a[kk] = *(const LAS bf16x8*)(Ab + kk * 64);
            LAS float* dstf = pr ? QK : KK;
#pragma unroll
            for (int jb = 0; jb < 4; ++jb) {
                f32x4 acc = (f32x4){0.f, 0.f, 0.f, 0.f};
#pragma unroll
                for (int kk = 0; kk < 4; ++kk) { const bf16x8 bb = *(const LAS bf16x8*)(lds + R_KN + (jb * 16 + fr) * 272 + fq * 16 + kk * 64); acc = __builtin_amdgcn_mfma_f32_16x16x32_bf16(a[kk], bb, acc, 0, 0, 0); }
#pragma unroll
                for (int r = 0; r < 4; ++r) dstf[(ib * 16 + fq * 4 + r) * 65 + jb * 16 + fr] = acc[r];
            }
        }
        __syncthreads();
        for (int d = 0; d < 2; ++d) {
            const LAS float* gc = G_GC + d * 64; const LAS float* bt = G_BT + d * 64;
            for (int idx = tid; idx < 4096; idx += NTHREADS) {
                const int i2 = idx >> 6, j2 = idx & 63, pi = d ? 63 - i2 : i2, pj = d ? 63 - j2 : j2;
                float v = 0.f;
                if (j2 < i2) v = bt[pi] * KK[pi * 65 + pj] * __expf(gc[pi] - gc[pj]);
                MB[i2 * 65 + j2] = v; TB[i2 * 65 + j2] = (i2 == j2) ? 1.f : 0.f;
            }
            __syncthreads();
            if (wid < 4 && lane < 16) {
                const int bb = wid; float tc[16];
#pragma unroll
                for (int a = 0; a < 16; ++a) {
                    float sv = (a == lane) ? 1.f : 0.f;
#pragma unroll
                    for (int b2 = 0; b2 < a; ++b2) sv -= MB[(bb * 16 + a) * 65 + bb * 16 + b2] * tc[b2];
                    tc[a] = sv;
                }
#pragma unroll
                for (int a = 0; a < 16; ++a) TB[(bb * 16 + a) * 65 + bb * 16 + lane] = tc[a];
            }
            __syncthreads();
            if (wid < 2) {
                const int rb = 2 * wid + 1, cb = 2 * wid; LAS float* xs = XS + wid * 272;
                f32x4 acc = (f32x4){0.f, 0.f, 0.f, 0.f};
#pragma unroll
                for (int ks = 0; ks < 4; ++ks) acc = __builtin_amdgcn_mfma_f32_16x16x4f32(MB[(rb * 16 + fr) * 65 + cb * 16 + ks * 4 + fq], TB[(cb * 16 + ks * 4 + fq) * 65 + cb * 16 + fr], acc, 0, 0, 0);
#pragma unroll
                for (int r = 0; r < 4; ++r) xs[(fq * 4 + r) * 17 + fr] = acc[r];
                f32x4 acc2 = (f32x4){0.f, 0.f, 0.f, 0.f};
#pragma unroll
                for (int ks = 0; ks < 4; ++ks) acc2 = __builtin_amdgcn_mfma_f32_16x16x4f32(TB[(rb * 16 + fr) * 65 + rb * 16 + ks * 4 + fq], xs[(ks * 4 + fq) * 17 + fr], acc2, 0, 0, 0);
#pragma unroll
                for (int r = 0; r < 4; ++r) TB[(rb * 16 + fq * 4 + r) * 65 + cb * 16 + fr] = -acc2[r];
            }
            __syncthreads();
            if (wid < 4) {
                const int ti = wid >> 1, tj = wid & 1;
                f32x4 acc = (f32x4){0.f, 0.f, 0.f, 0.f};
#pragma unroll
                for (int ks = 0; ks < 8; ++ks) acc = __builtin_amdgcn_mfma_f32_16x16x4f32(MB[(32 + ti * 16 + fr) * 65 + ks * 4 + fq], TB[(ks * 4 + fq) * 65 + tj * 16 + fr], acc, 0, 0, 0);
#pragma unroll
                for (int r = 0; r < 4; ++r) XS[(ti * 16 + fq * 4 + r) * 33 + tj * 16 + fr] = acc[r];
            }
            __syncthreads();
            if (wid < 4) {
                const int ti = wid >> 1, tj = wid & 1;
                f32x4 acc = (f32x4){0.f, 0.f, 0.f, 0.f};
#pragma unroll
                for (int ks = 0; ks < 8; ++ks) acc = __builtin_amdgcn_mfma_f32_16x16x4f32(TB[(32 + ti * 16 + fr) * 65 + 32 + ks * 4 + fq], XS[(ks * 4 + fq) * 33 + tj * 16 + fr], acc, 0, 0, 0);
#pragma unroll
                for (int r = 0; r < 4; ++r) TB[(32 + ti * 16 + fq * 4 + r) * 65 + tj * 16 + fr] = -acc[r];
            }
            __syncthreads();
            for (int idx = tid; idx < 2048; idx += NTHREADS) {
                const int i = idx >> 5, j = (idx & 31) * 2, i2 = d ? 63 - i : i, j2 = d ? 63 - j : j, j3 = d ? j2 - 1 : j2 + 1;
                const float t0v = TB[i2 * 65 + j2], t1v = TB[i2 * 65 + j3];
                const float c0 = bt[j], c1 = bt[j + 1];
                *(LAS unsigned*)(lds + R_TU + i * 144 + j * 2) = pk_bf16(t0v * c0, t1v * c1);
                *(LAS unsigned*)(lds + R_TW + i * 144 + j * 2) = pk_bf16(t0v * c0 * __expf(gc[j]), t1v * c1 * __expf(gc[j + 1]));
            }
            __syncthreads();
            const int cposn = (cc < 32) ? 4 + (d ? 31 - cpos : cpos) : (d ? 3 - cpos : cpos);
            unsigned char* rec = p.ws + WS_SCN + ((size_t)((b * 4 + h) * 2 + d) * NCHUNK + cposn) * REC_BYTES;
            {
                bf16x8 ak[2], av[2];
#pragma unroll
                for (int kk = 0; kk < 2; ++kk) { ak[kk] = *(const LAS bf16x8*)(lds + R_KNT + (wid * 16 + fr) * 144 + kk * 64 + fq * 16); av[kk] = *(const LAS bf16x8*)(lds + R_VT + (wid * 16 + fr) * 144 + kk * 64 + fq * 16); }
#pragma unroll
                for (int ib = 0; ib < 4; ++ib) {
                    f32x4 aw = (f32x4){0.f, 0.f, 0.f, 0.f}, au = (f32x4){0.f, 0.f, 0.f, 0.f};
#pragma unroll
                    for (int kk = 0; kk < 2; ++kk) {
                        const bf16x8 tw = *(const LAS bf16x8*)(lds + R_TW + (ib * 16 + fr) * 144 + kk * 64 + fq * 16), tu = *(const LAS bf16x8*)(lds + R_TU + (ib * 16 + fr) * 144 + kk * 64 + fq * 16);
                        aw = __builtin_amdgcn_mfma_f32_16x16x32_bf16(ak[kk], tw, aw, 0, 0, 0);
                        au = __builtin_amdgcn_mfma_f32_16x16x32_bf16(tu, av[kk], au, 0, 0, 0);
                    }
                    u32x2 ow; ow[0] = pk_bf16(aw[0], aw[1]); ow[1] = pk_bf16(aw[2], aw[3]);
                    *(u32x2*)(rec + REC_W + img256(ib * 16 + fr, wid * 16 + fq * 4)) = ow;
                    u32x2 ou; ou[0] = pk_bf16(au[0], au[1]); ou[1] = pk_bf16(au[2], au[3]);
                    *(u32x2*)(rec + REC_UT + (wid * 16 + fr) * 128 + (ib * 16 + fq * 4) * 2) = ou;
                }
            }
            const float gtot = G_TOT[d];
            for (int idx = tid; idx < 1024; idx += NTHREADS) {
                const int dk = idx >> 3, i8 = (idx & 7) * 8;
                const u32x4 kv = *(const LAS u32x4*)(lds + R_KNT + dk * 144 + i8 * 2);
                u32x4 o;
#pragma unroll
                for (int e = 0; e < 4; ++e) o[e] = pk_bf16(bf_lo(kv[e]) * __expf(gtot - gc[i8 + 2 * e]), bf_hi(kv[e]) * __expf(gtot - gc[i8 + 2 * e + 1]));
                *(u32x4*)(rec + REC_KT + img128(dk, i8)) = o;
            }
            for (int idx = tid; idx < 1024; idx += NTHREADS) {
                const int i = idx >> 4, k8 = (idx & 15) * 8;
                const u32x4 qv = *(const LAS u32x4*)(lds + R_QN + i * 272 + k8 * 2);
                const float eg = __expf(gc[i]);
                u32x4 o;
#pragma unroll
                for (int e = 0; e < 4; ++e) o[e] = pk_bf16(bf_lo(qv[e]) * eg, bf_hi(qv[e]) * eg);
                *(u32x4*)(rec + REC_QD + img256(i, k8)) = o;
            }
            {
                const int i = tid >> 3, j8 = (tid & 7) * 8;
                float v[8];
#pragma unroll
                for (int e = 0; e < 8; ++e) { const int j = j8 + e; const bool ok = d ? (j >= i) : (j <= i); v[e] = ok ? QK[i * 65 + j] * __expf(gc[i] - gc[j]) : 0.f; }
                u32x4 o; o[0] = pk_bf16(v[0], v[1]); o[1] = pk_bf16(v[2], v[3]); o[2] = pk_bf16(v[4], v[5]); o[3] = pk_bf16(v[6], v[7]);
                *(u32x4*)(rec + REC_QK + img128(i, j8)) = o;
            }
            if (tid == 0) { *(float*)(rec + REC_MISC) = __expf(gtot); *(int*)(rec + REC_MISC + 4) = rowbase + t0; }
            __syncthreads();
        }
    }
}

__device__ void phase_scan(const Params& p, const int l, LAS unsigned char* lds) {
    const int tid = opaque_tid(), wid = __builtin_amdgcn_readfirstlane(tid >> 6), lane = tid & 63, fr = lane & 15, fq = lane >> 4;
    constexpr int BUFB = 62464, R_ST = 2 * BUFB, R_UTL = R_ST + 32 * 272;
    for (int id = blockIdx.x; id < 256; id += gridDim.x) {
        const int bhd = (id & 7) * 8 + (id >> 5), sl = (id >> 3) & 3, h = (bhd >> 1) & 3, d = bhd & 1;
        float* O = (float*)(p.ws + (d ? WS_OB : WS_OF));
        const unsigned char* rec0 = p.ws + WS_SCN + (size_t)bhd * NCHUNK * REC_BYTES;
        __syncthreads();
        for (int i = tid; i < 32 * 272 / 4; i += NTHREADS) ((LAS unsigned*)(lds + R_ST))[i] = 0u;
        f32x4 sacc[2];
        sacc[0] = (f32x4){0.f, 0.f, 0.f, 0.f}; sacc[1] = (f32x4){0.f, 0.f, 0.f, 0.f};
#define S_ISSUE(n, bufo) do { const unsigned char* _r = rec0 + (size_t)(n) * REC_BYTES + lane * 16; \
        _Pragma("unroll") for (int _q = 0; _q < 7; ++_q) __builtin_amdgcn_global_load_lds((const unsigned*)(_r + (wid + 8 * _q) * 1024), (LAS unsigned*)(lds + (bufo) + (wid + 8 * _q) * 1024), 16, 0, 0); \
        if (wid < 4) __builtin_amdgcn_global_load_lds((const unsigned*)(_r + REC_UT + sl * 4096 + wid * 1024), (LAS unsigned*)(lds + (bufo) + 57344 + wid * 1024), 16, 0, 0); \
        if (wid == 4) __builtin_amdgcn_global_load_lds((const unsigned*)(_r + REC_MISC), (LAS unsigned*)(lds + (bufo) + 61440), 16, 0, 0); } while (0)
        S_ISSUE(0, 0);
        const int ib = wid >> 1, nb = wid & 1;
        for (int n = 0; n < NCHUNK; ++n) {
            asm volatile("s_waitcnt vmcnt(0)" ::: "memory");
            __syncthreads();
            if (n + 1 < NCHUNK) { if ((n + 1) & 1) S_ISSUE(n + 1, BUFB); else S_ISSUE(n + 1, 0); }
            LAS unsigned char* buf = lds + (n & 1) * BUFB;
            f32x4 accP = (f32x4){0.f, 0.f, 0.f, 0.f}, accQ = (f32x4){0.f, 0.f, 0.f, 0.f};
#pragma unroll
            for (int kk = 0; kk < 4; ++kk) {
                const bf16x8 sb = *(const LAS bf16x8*)(lds + R_ST + (nb * 16 + fr) * 272 + kk * 64 + fq * 16);
                const bf16x8 aw = *(const LAS bf16x8*)(buf + REC_W + img256(ib * 16 + fr, kk * 32 + fq * 8));
                const bf16x8 aq = *(const LAS bf16x8*)(buf + REC_QD + img256(ib * 16 + fr, kk * 32 + fq * 8));
                accP = __builtin_amdgcn_mfma_f32_16x16x32_bf16(aw, sb, accP, 0, 0, 0);
                accQ = __builtin_amdgcn_mfma_f32_16x16x32_bf16(aq, sb, accQ, 0, 0, 0);
            }
            {
                const u32x2 uv = *(const LAS u32x2*)(buf + REC_UT + (nb * 16 + fr) * 128 + (ib * 16 + fq * 4) * 2);
                u32x2 o; o[0] = pk_bf16(bf_lo(uv[0]) - accP[0], bf_hi(uv[0]) - accP[1]); o[1] = pk_bf16(bf_lo(uv[1]) - accP[2], bf_hi(uv[1]) - accP[3]);
                *(LAS u32x2*)(lds + R_UTL + (nb * 16 + fr) * 144 + (ib * 16 + fq * 4) * 2) = o;
            }
            __syncthreads();
            const float sd = *(const LAS float*)(buf + 61440); const int rowstart = *(const LAS int*)(buf + 61444);
            bf16x8 ub[2][2];
#pragma unroll
            for (int n2 = 0; n2 < 2; ++n2)
#pragma unroll
                for (int kk = 0; kk < 2; ++kk) ub[n2][kk] = *(const LAS bf16x8*)(lds + R_UTL + (n2 * 16 + fr) * 144 + kk * 64 + fq * 16);
#pragma unroll
            for (int kk = 0; kk < 2; ++kk) {
                const bf16x8 a = *(const LAS bf16x8*)(buf + REC_QK + img128(ib * 16 + fr, kk * 32 + fq * 8));
                const bf16x8 un = *(const LAS bf16x8*)(lds + R_UTL + (nb * 16 + fr) * 144 + kk * 64 + fq * 16);
                accQ = __builtin_amdgcn_mfma_f32_16x16x32_bf16(a, un, accQ, 0, 0, 0);
            }
#pragma unroll
            for (int r = 0; r < 4; ++r) O[(size_t)(rowstart + ib * 16 + fq * 4 + r) * 512 + h * 128 + sl * 32 + nb * 16 + fr] = accQ[r];
#pragma unroll
            for (int n2 = 0; n2 < 2; ++n2) {
                sacc[n2] *= sd;
#pragma unroll
                for (int kk = 0; kk < 2; ++kk) {
                    const bf16x8 a = *(const LAS bf16x8*)(buf + REC_KT + img128(wid * 16 + fr, kk * 32 + fq * 8));
                    sacc[n2] = __builtin_amdgcn_mfma_f32_16x16x32_bf16(a, ub[n2][kk], sacc[n2], 0, 0, 0);
                }
                u32x2 o; o[0] = pk_bf16(sacc[n2][0], sacc[n2][1]); o[1] = pk_bf16(sacc[n2][2], sacc[n2][3]);
                *(LAS u32x2*)(lds + R_ST + (n2 * 16 + fr) * 272 + (wid * 16 + fq * 4) * 2) = o;
            }
        }
#undef S_ISSUE
        __syncthreads();
    }
}

__device__ void phase_scan_naive(const Params& p, const int l, LAS unsigned char* lds) {
    const int tid = opaque_tid();
    LAS float* ks = (LAS float*)lds;
    LAS float* qs = ks + 4096;
    LAS float* vs = qs + 4096;
    LAS float* as = vs + 4096;
    LAS float* bs = as + 32;
    LAS int* rws = (LAS int*)(bs + 32);
    const float* QKV = (const float*)(p.ws + WS_QKV);
    const float* LOGA = (const float*)(p.ws + WS_LOGA);
    const float* BETA = (const float*)(p.ws + WS_BETA);
    for (int u = blockIdx.x; u < 64; u += gridDim.x) {
        const int b = u >> 3, h = (u >> 1) & 3, d = u & 1;
        float* O = (float*)(p.ws + (d ? WS_OB : WS_OF));
        const int col = tid >> 2, part = tid & 3;
        float S[32];
#pragma unroll
        for (int i = 0; i < 32; ++i) S[i] = 0.f;
        for (int n0 = 0; n0 < CTXL + SEQ; n0 += 32) {
            __syncthreads();
            if (tid < 32) {
                const int n = n0 + tid; int row;
                if (n < CTXL) row = ROWS_LAT + b * CTXL + (d ? CTXL - 1 - n : n);
                else { const int m = n - CTXL; row = b * SEQ + (d ? SEQ - 1 - m : m); }
                rws[tid] = row;
                as[tid] = __expf(LOGA[(size_t)row * 8 + d * 4 + h]);
                bs[tid] = BETA[(size_t)row * 8 + d * 4 + h];
            }
            __syncthreads();
            for (int i = tid; i < 4096; i += NTHREADS) {
                const int tok = i >> 7, cc = i & 127; const size_t base = (size_t)rws[tok] * 1536 + h * 128 + cc;
                qs[i] = QKV[base]; ks[i] = QKV[base + 512]; vs[i] = QKV[base + 1024];
            }
            __syncthreads();
            for (int tok = 0; tok < 32; ++tok) {
                float kk[32];
#pragma unroll
                for (int i = 0; i < 8; ++i) { const f32x4 v = *(const LAS f32x4*)(ks + tok * 128 + part * 32 + i * 4); kk[i * 4] = v[0]; kk[i * 4 + 1] = v[1]; kk[i * 4 + 2] = v[2]; kk[i * 4 + 3] = v[3]; }
                float kp = 0.f;
#pragma unroll
                for (int i = 0; i < 32; ++i) kp += kk[i] * S[i];
                kp += __shfl_xor(kp, 1); kp += __shfl_xor(kp, 2);
                const float a = as[tok], bt = bs[tok];
                const float bv = bt * (vs[tok * 128 + col] - a * kp);
#pragma unroll
                for (int i = 0; i < 32; ++i) S[i] = a * S[i] + kk[i] * bv;
                float op = 0.f;
#pragma unroll
                for (int i = 0; i < 8; ++i) { const f32x4 v = *(const LAS f32x4*)(qs + tok * 128 + part * 32 + i * 4); op += v[0] * S[i * 4] + v[1] * S[i * 4 + 1] + v[2] * S[i * 4 + 2] + v[3] * S[i * 4 + 3]; }
                op += __shfl_xor(op, 1); op += __shfl_xor(op, 2);
                if (part == 0) O[(size_t)rws[tok] * 512 + h * 128 + col] = op;
            }
        }
        __syncthreads();
    }
}

__device__ void phase_onorm(const Params& p, const int l) {
    const int tid = opaque_tid(), wid = tid >> 6, lane = tid & 63;
    const float* OF = (const float*)(p.ws + WS_OF); const float* OB = (const float*)(p.ws + WS_OB);
    const bf16_t* PROJ = (const bf16_t*)(p.ws + WS_PROJ);
    bf16_t* CAT = (bf16_t*)(p.ws + WS_CAT);
    const int c = lane * 8;
    const f32x4 w0 = *(const f32x4*)(p.dn_norm + l * 128 + (c & 127)), w1 = *(const f32x4*)(p.dn_norm + l * 128 + (c & 127) + 4);
    for (int row = blockIdx.x * 8 + wid; row < MT; row += gridDim.x * 8) {
        const size_t o = (size_t)row * 512 + c;
        f32x4 v0 = *(const f32x4*)(OF + o) + *(const f32x4*)(OB + o), v1 = *(const f32x4*)(OF + o + 4) + *(const f32x4*)(OB + o + 4);
        float ss = v0[0] * v0[0] + v0[1] * v0[1] + v0[2] * v0[2] + v0[3] * v0[3] + v1[0] * v1[0] + v1[1] * v1[1] + v1[2] * v1[2] + v1[3] * v1[3];
        ss += __shfl_xor(ss, 1); ss += __shfl_xor(ss, 2); ss += __shfl_xor(ss, 4); ss += __shfl_xor(ss, 8);
        const float rs = rsqrtf(ss * (1.f / 128.f) + EPS);
        const u32x4 gv = *(const u32x4*)(PROJ + (size_t)row * PN + 1536 + c);
        u32x4 out;
        out[0] = pk_bf16(v0[0] * rs * w0[0] * silu_f(bf_lo(gv[0])), v0[1] * rs * w0[1] * silu_f(bf_hi(gv[0])));
        out[1] = pk_bf16(v0[2] * rs * w0[2] * silu_f(bf_lo(gv[1])), v0[3] * rs * w0[3] * silu_f(bf_hi(gv[1])));
        out[2] = pk_bf16(v1[0] * rs * w1[0] * silu_f(bf_lo(gv[2])), v1[1] * rs * w1[1] * silu_f(bf_hi(gv[2])));
        out[3] = pk_bf16(v1[2] * rs * w1[2] * silu_f(bf_lo(gv[3])), v1[3] * rs * w1[3] * silu_f(bf_hi(gv[3])));
        *(u32x4*)(CAT + (size_t)row * D + c) = out;
    }
}

__device__ void phase_topk(const Params& p, LAS unsigned char* lds) {
    const int tid = opaque_tid();
    LAS unsigned long long* ks = (LAS unsigned long long*)lds;
    const float* AFF = (const float*)(p.ws + WS_AFF);
    int* SEL = (int*)(p.ws + WS_SEL); float* SELAFF = (float*)(p.ws + WS_SELAFF); int* SLOTOF = (int*)(p.ws + WS_SLOTOF);
    for (int u = blockIdx.x; u < 256; u += gridDim.x) {
        int e, n, C, rowbase, slotbase;
        if (u < 128) { e = u >> 3; const int b = u & 7; n = SEQ; C = 256; rowbase = b * SEQ; slotbase = u * 256; }
        else { const int v = u - 128; e = v >> 3; const int b = v & 7; n = CTXL; C = 32; rowbase = ROWS_LAT + b * CTXL; slotbase = (128 + e) * 256 + b * 32; }
        for (int i = tid; i < n; i += NTHREADS) ks[i] = ((unsigned long long)__float_as_uint(AFF[(size_t)(rowbase + i) * 16 + e]) << 32) | (unsigned long long)(0xFFFFFFFFu - (unsigned)i);
        __syncthreads();
        for (int k = 2; k <= n; k <<= 1)
            for (int j = k >> 1; j > 0; j >>= 1) {
                for (int q = tid; q < (n >> 1); q += NTHREADS) {
                    const int i = ((q & ~(j - 1)) << 1) | (q & (j - 1)), i2 = i | j;
                    const unsigned long long a = ks[i], b2 = ks[i2];
                    const bool up = (i & k) == 0;
                    if (up ? (a < b2) : (a > b2)) { ks[i] = b2; ks[i2] = a; }
                }
                __syncthreads();
            }
        for (int i = tid; i < n; i += NTHREADS) {
            const unsigned long long key = ks[i];
            const int t = (int)(0xFFFFFFFFu - (unsigned)(key & 0xFFFFFFFFull));
            SLOTOF[(size_t)(rowbase + t) * 16 + e] = (i < C) ? slotbase + i : -1;
            if (i < C) { SEL[slotbase + i] = rowbase + t; SELAFF[slotbase + i] = __uint_as_float((unsigned)(key >> 32)); }
        }
        __syncthreads();
    }
}


#ifndef DUMP
#define DUMP 0
#endif
#if DUMP
__device__ void phase_dump(const Params& p, const size_t off, const int is_bf16, const size_t n_avail) {
    const int tid = opaque_tid();
    const size_t n = (size_t)ROWS_LAT * D;
    for (size_t i = (size_t)blockIdx.x * NTHREADS + tid; i < n; i += (size_t)gridDim.x * NTHREADS) {
        float v = 0.f;
        if (i < n_avail) v = is_bf16 ? __uint_as_float((unsigned)((const bf16_t*)(p.ws + off))[i] << 16) : ((const float*)(p.ws + off))[i];
        p.out[i] = v;
    }
}
#endif

__global__ void __launch_bounds__(NTHREADS, 2) fwd(const Params p) {
    extern __shared__ __attribute__((aligned(16))) unsigned char smem[];
    LAS unsigned char* lds = (LAS unsigned char*)smem + LDS_OFF;
    XcdBarrier bar; bar.bar = (unsigned*)(p.ws + WS_BAR); bar.x = 0; bar.st = nullptr;
    const bool multi = (p.ph_hi - p.ph_lo) > 1;
    if (multi) {
        if (threadIdx.x == 0) *(LAS u32x4*)((LAS unsigned char*)smem) = (u32x4){0u, 0u, 0u, 0u};
        __syncthreads();
        bar = xcd_barrier_post((unsigned*)(p.ws + WS_BAR), (volatile LAS unsigned*)((LAS unsigned char*)smem));
    }
#if DUMP
    if (p.ph_lo == 100) { phase_dump(p, (size_t)(DUMP_OFF), DUMP_BF16, (size_t)(DUMP_N)); return; }
#endif
    int ph = 0;
#define PHASE(body) do { if (ph >= p.ph_lo && ph < p.ph_hi) { const int l = opaque_s(lv); body; if (ph + 1 < p.ph_hi) xcd_barrier(bar); } ++ph; } while (0)
    int lv = 0;
    PHASE(phase_prologue(p, lds));
    for (lv = 0; lv < DEPTH; ++lv) {
        PHASE(phase_norm<1>(p, l, lds));
        PHASE(phase_gemm<0>(p, l, lds));
#if NAIVE_SCAN
        PHASE(phase_conv_pool(p, l, lds));
        PHASE(phase_scan_naive(p, l, lds));
#else
        PHASE(phase_prep(p, l, lds); phase_conv_pool(p, l, lds));
        PHASE(phase_scan(p, l, lds));
#endif
        PHASE(phase_onorm(p, l));
        PHASE(phase_gemm<1>(p, l, lds));
        PHASE(phase_norm<2>(p, l, lds));
        PHASE(phase_topk(p, lds));
        PHASE(phase_gemm<2>(p, l, lds));
        PHASE(phase_gemm<3>(p, l, lds));
    }
    lv = 0;
    PHASE(phase_norm<3>(p, l, lds));
#undef PHASE
}
constexpr int N_PHASES = 2 + DEPTH * 10;

extern "C" void kernel_launch(void* const* d_in, const int* in_sizes, int n_in, void* d_out, int out_size, void* d_ws, size_t ws_size, hipStream_t stream) {
    static int grid = 0;
    if (grid == 0) {
        if (n_in != 21 || out_size != ROWS_LAT * D || ws_size < WS_END) { fprintf(stderr, "kernel_launch: unexpected shapes (n_in %d out %d ws %zu need %zu)\n", n_in, out_size, ws_size, (size_t)WS_END); grid = -1; return; }
        int dev = 0, cus = 0, per_cu = 0;
        if (hipGetDevice(&dev) != hipSuccess || hipDeviceGetAttribute(&cus, hipDeviceAttributeMultiprocessorCount, dev) != hipSuccess) { grid = -1; return; }
        if (hipFuncSetAttribute((const void*)fwd, hipFuncAttributeMaxDynamicSharedMemorySize, LDS_BYTES) != hipSuccess) { fprintf(stderr, "kernel_launch: hipFuncSetAttribute failed\n"); grid = -1; return; }
        if (hipOccupancyMaxActiveBlocksPerMultiprocessor(&per_cu, (const void*)fwd, NTHREADS, LDS_BYTES) != hipSuccess || per_cu < 1) { fprintf(stderr, "kernel_launch: occupancy query says %d\n", per_cu); per_cu = 1; }
        (void)hipGetLastError();
        grid = cus;
    }
    if (grid < 0) return;
    (void)hipMemsetAsync((char*)d_ws + WS_BAR, 0, 16384, stream);
    Params p; memset(&p, 0, sizeof(p));
    const float** pp = (const float**)&p;
    for (int i = 0; i < 21; ++i) pp[i] = (const float*)d_in[i];
    p.out = (float*)d_out; p.ws = (unsigned char*)d_ws;
#if DUMP
    for (int ph = 0; ph <= DUMP_LAST; ++ph) { p.ph_lo = ph; p.ph_hi = ph + 1; hipLaunchKernelGGL(fwd, dim3(grid), dim3(NTHREADS), LDS_BYTES, stream, p); }
    p.ph_lo = 100; p.ph_hi = 101; hipLaunchKernelGGL(fwd, dim3(grid), dim3(NTHREADS), LDS_BYTES, stream, p);
#elif ONE_LAUNCH
    p.ph_lo = 0; p.ph_hi = N_PHASES;
    hipLaunchKernelGGL(fwd, dim3(grid), dim3(NTHREADS), LDS_BYTES, stream, p);
#else
    for (int ph = 0; ph < N_PHASES; ++ph) { p.ph_lo = ph; p.ph_hi = ph + 1; hipLaunchKernelGGL(fwd, dim3(grid), dim3(NTHREADS), LDS_BYTES, stream, p); }
#endif
}
```

```cpp
#include <hip/hip_runtime.h>
#include <stdint.h>
#include <stdio.h>
#include <string.h>

#ifndef ONE_LAUNCH
#define ONE_LAUNCH 1
#endif
#ifndef NAIVE_SCAN
#define NAIVE_SCAN 0
#endif
#ifndef REGSTAGE
#define REGSTAGE 0
#endif

#define LAS __attribute__((address_space(3)))
typedef unsigned short bf16_t;
typedef short bf16x8 __attribute__((ext_vector_type(8)));
typedef float f32x4 __attribute__((ext_vector_type(4)));
typedef float f32x2 __attribute__((ext_vector_type(2)));
typedef unsigned u32x2 __attribute__((ext_vector_type(2)));
typedef unsigned u32x4 __attribute__((ext_vector_type(4)));

constexpr int D = 1024, NB = 8, SEQ = 2048, DEPTH = 4, CTXL = 256;
constexpr int ROWS_LAT = NB * SEQ;
constexpr int ROWS_CTX = NB * CTXL;
constexpr int MT = ROWS_LAT + ROWS_CTX;
constexpr int INC = 2576;
constexpr int PN = 2560;
constexpr int NE = 16;
constexpr int NGROUPS = 144;
constexpr int NSLOTS = NGROUPS * 256;
constexpr int NTHREADS = 512;
constexpr float EPS = 1e-6f;

constexpr size_t al256(size_t x) { return (x + 255) & ~(size_t)255; }
constexpr size_t WS_BAR = 0;
constexpr size_t WS_MOD = 16384;
constexpr size_t WS_X = WS_MOD + al256((size_t)DEPTH * 9 * 6144 * 4);
constexpr size_t WS_H = WS_X + (size_t)MT * D * 4;
constexpr size_t WS_PROJ = WS_H + (size_t)MT * D * 2;
constexpr size_t WS_YE = WS_PROJ;
constexpr size_t WS_LOGA = WS_PROJ + (size_t)MT * PN * 2;
constexpr size_t WS_BETA = WS_LOGA + (size_t)MT * 8 * 4;
constexpr size_t WS_QKV = WS_BETA + (size_t)MT * 8 * 4;
constexpr size_t WS_HID = WS_QKV;
constexpr size_t WS_OF = WS_QKV + (NAIVE_SCAN ? (size_t)MT * 1536 * 4 : (size_t)NSLOTS * D * 2);
constexpr size_t WS_OB = WS_OF + (size_t)MT * 512 * 4;
constexpr size_t WS_CAT = WS_OB + (size_t)MT * 512 * 4;
constexpr size_t WS_AFF = WS_CAT + (size_t)MT * D * 2;
constexpr size_t WS_SEL = WS_AFF + (size_t)MT * 16 * 4;
constexpr size_t WS_SELAFF = WS_SEL + (size_t)NSLOTS * 4;
constexpr size_t WS_SLOTOF = WS_SELAFF + (size_t)NSLOTS * 4;
constexpr size_t WS_WINT = WS_SLOTOF + (size_t)MT * 16 * 4;
constexpr size_t WS_WOUTT = WS_WINT + (size_t)DEPTH * PN * D * 2;
constexpr size_t WS_WGUT = WS_WOUTT + (size_t)DEPTH * D * D * 2;
constexpr size_t WS_WDT = WS_WGUT + (size_t)DEPTH * NE * 2048 * D * 2;
constexpr size_t WS_PWT = WS_WDT + (size_t)DEPTH * NE * D * D * 2;
constexpr size_t WS_SCN = WS_PWT + (size_t)DEPTH * 4 * 128 * 128 * 2;
constexpr int REC_W = 0, REC_KT = 16384, REC_QD = 32768, REC_QK = 49152, REC_UT = 57344, REC_MISC = 73728, REC_BYTES = 73984;
constexpr int NCHUNK = 36;
constexpr size_t WS_END = WS_SCN + (size_t)NB * 4 * 2 * NCHUNK * REC_BYTES + 4096;

constexpr int LDS_OFF = 1024;
constexpr int LDS_WORK = 157696;
constexpr int LDS_BYTES = LDS_OFF + LDS_WORK;

struct Params {
    const float *x, *c, *ctx, *c_ctx, *w_mod, *b_mod, *norm1, *norm2, *w_in, *conv_w, *a_log, *dt_bias, *dn_norm, *pool_w, *pool_scale, *w_out, *w_router, *w_gate, *w_up, *w_down, *norm_f;
    float* out;
    unsigned char* ws;
    int ph_lo, ph_hi;
};

#define XB_TMO      128
#define XB_XCNT(j)  (256  + 64 * (j))
#define XB_XSUB(j)  (1280 + 64 * (j))
#define XB_XGEN(j)  (2304 + 64 * (j))
#define XB_TOP      3328
#define XB_TOPGEN   3392
#define XCD_BAR_WORDS 3456
#define XB_SPIN_CAP (1u << 22)

__device__ __forceinline__ unsigned xb_ld(unsigned* p)              { return __hip_atomic_load(p, __ATOMIC_RELAXED, __HIP_MEMORY_SCOPE_AGENT); }
__device__ __forceinline__ unsigned xb_add(unsigned* p, unsigned v) { return __hip_atomic_fetch_add(p, v, __ATOMIC_RELAXED, __HIP_MEMORY_SCOPE_AGENT); }
__device__ __forceinline__ unsigned xb_xcc_id() { return (unsigned)__builtin_amdgcn_s_getreg((3 << 11) | 20) & 0xFu; }
#define XB_SPIN(cond, bar) do { unsigned _sp = 0; while (cond) { __builtin_amdgcn_s_sleep(1); \
    if ((++_sp & 255u) == 0u) { if (xb_ld(&(bar)[XB_TMO])) break; if (_sp > XB_SPIN_CAP) { atomicAdd(&(bar)[XB_TMO], 1u); break; } } } } while (0)

struct XcdBarrier { unsigned* bar; unsigned x; volatile LAS unsigned* st; };

__device__ __forceinline__ XcdBarrier xcd_barrier_post(unsigned* bar, volatile LAS unsigned* st) {
    XcdBarrier b; b.bar = bar; b.x = xb_xcc_id(); b.st = st;
    if (threadIdx.x == 0) (void)xb_add(&bar[XB_XCNT(b.x)], 1u);
    return b;
}
__device__ __forceinline__ void xcd_barrier_complete(unsigned* bar, unsigned x, unsigned& nloc, unsigned& nx) {
    const unsigned G = gridDim.x * gridDim.y * gridDim.z;
    unsigned sum, cnt, mine, sp = 0u;
    for (;;) {
        sum = 0u; cnt = 0u; mine = 0u;
#pragma unroll
        for (unsigned j = 0; j < 16; ++j) { const unsigned c = xb_ld(&bar[XB_XCNT(j)]); sum += c; cnt += (c > 0u) ? 1u : 0u; mine = (j == x) ? c : mine; }
        if (sum == G) break;
        __builtin_amdgcn_s_sleep(1);
        if ((++sp & 255u) == 0u) { if (xb_ld(&bar[XB_TMO])) break; if (sp > XB_SPIN_CAP) { atomicAdd(&bar[XB_TMO], 1u); break; } }
    }
    nloc = mine > 0u ? mine : 1u; nx = cnt > 0u ? cnt : 1u;
}
__device__ __forceinline__ void xcd_barrier(const XcdBarrier& b) {
    asm volatile("s_waitcnt vmcnt(0)" ::: "memory");
    __syncthreads();
    if (threadIdx.x == 0) {
        unsigned* bar = b.bar;
        __builtin_amdgcn_s_waitcnt(0);
        unsigned nloc = b.st[0], nx = b.st[1];
        if (nloc == 0u) { xcd_barrier_complete(bar, b.x, nloc, nx); b.st[0] = nloc; b.st[1] = nx; }
        const unsigned old = xb_add(&bar[XB_XSUB(b.x)], 1u);
        const unsigned gen = old / nloc;
        if (old + 1u == (gen + 1u) * nloc) {
            __builtin_amdgcn_fence(__ATOMIC_RELEASE, "agent");
            asm volatile("s_waitcnt vmcnt(0)" ::: "memory");
            const unsigned og = xb_add(&bar[XB_TOP], 1u);
            const unsigned tg = og / nx;
            if (og + 1u == (tg + 1u) * nx) xb_add(&bar[XB_TOPGEN], 1u);
            else XB_SPIN(xb_ld(&bar[XB_TOPGEN]) == tg, bar);
            __builtin_amdgcn_fence(__ATOMIC_ACQUIRE, "agent");
            xb_add(&bar[XB_XGEN(b.x)], 1u);
            asm volatile("s_waitcnt vmcnt(0)" ::: "memory");
        } else {
            XB_SPIN(xb_ld(&bar[XB_XGEN(b.x)]) == gen, bar);
            __builtin_amdgcn_fence(__ATOMIC_ACQUIRE, "agent");
            asm volatile("s_waitcnt vmcnt(0)" ::: "memory");
        }
    }
    __syncthreads();
}

typedef __bf16 bf16x2_t __attribute__((ext_vector_type(2)));
__device__ __forceinline__ unsigned pk_bf16(float lo, float hi) { const f32x2 v = {lo, hi}; const bf16x2_t b = __builtin_convertvector(v, bf16x2_t); return __builtin_bit_cast(unsigned, b); }
__device__ __forceinline__ float bf_lo(unsigned u) { return __uint_as_float(u << 16); }
__device__ __forceinline__ float bf_hi(unsigned u) { return __uint_as_float(u & 0xffff0000u); }
__device__ __forceinline__ float shx(float v, int mask, int lane) { return __int_as_float(__builtin_amdgcn_ds_bpermute((lane ^ mask) << 2, __float_as_int(v))); }
__device__ __forceinline__ float shup(float v, int o, int lane) { return __int_as_float(__builtin_amdgcn_ds_bpermute(((lane - o) & 63) << 2, __float_as_int(v))); }
__device__ __forceinline__ float wave_sum(float v, int lane) {
#pragma unroll
    for (int o = 32; o > 0; o >>= 1) v += shx(v, o, lane);
    return v;
}
__device__ __forceinline__ int opaque_tid() { int t = threadIdx.x; asm volatile("" : "+v"(t)); return t; }
__device__ __forceinline__ int opaque_s(int v) { asm volatile("" : "+s"(v)); return v; }
__device__ __forceinline__ float silu_f(float v) { return v / (1.f + __expf(-v)); }

__device__ __forceinline__ int lds_byte(int r, int c) { const int st = (r >> 4) * 2 + (c >> 5), rr = r & 15, cc = c & 31, ob = rr * 64 + cc * 2; return st * 1024 + (ob ^ (((ob >> 9) & 1) << 5)); }
__device__ __forceinline__ void stage_rc(int b, int& R, int& C) { const int st = b >> 10, sb = b & 1023, swz = sb ^ (((sb >> 9) & 1) << 5); R = (st >> 1) * 16 + (swz >> 6); C = (st & 1) * 32 + ((swz & 63) >> 1); }

__device__ void phase_prologue(const Params& p, LAS unsigned char* lds) {
    const int tid = opaque_tid();
    {
        LAS float* sc = (LAS float*)lds;
        LAS float* red = sc + 9 * 1024;
        for (int idx = tid; idx < 9 * 1024; idx += NTHREADS) {
            const int r = idx >> 10, k = idx & 1023;
            const float v = r < 8 ? p.c[r * 1024 + k] : p.c_ctx[k];
            sc[idx] = silu_f(v);
        }
        __syncthreads();
        float* MOD = (float*)(p.ws + WS_MOD);
        for (int u = blockIdx.x; u < DEPTH * 96; u += gridDim.x) {
            const int l = u / 96, c0 = (u % 96) * 64, col = tid & 63, kg = tid >> 6;
            float acc[9];
#pragma unroll
            for (int r = 0; r < 9; ++r) acc[r] = 0.f;
            const float* W = p.w_mod + (size_t)l * 1024 * 6144 + c0 + col;
#pragma unroll 4
            for (int kk = 0; kk < 128; ++kk) {
                const int k = kg * 128 + kk;
                const float w = W[(size_t)k * 6144];
#pragma unroll
                for (int r = 0; r < 9; ++r) acc[r] += sc[r * 1024 + k] * w;
            }
#pragma unroll
            for (int r = 0; r < 9; ++r) red[(kg * 9 + r) * 64 + col] = acc[r];
            __syncthreads();
            for (int idx = tid; idx < 576; idx += NTHREADS) {
                const int r = idx >> 6, cc = idx & 63;
                float s = 0.f;
#pragma unroll
                for (int g = 0; g < 8; ++g) s += red[(g * 9 + r) * 64 + cc];
                MOD[((size_t)l * 9 + r) * 6144 + c0 + cc] = s + p.b_mod[l * 6144 + c0 + cc];
            }
            __syncthreads();
        }
    }
    {
        f32x4* X4 = (f32x4*)(p.ws + WS_X);
        const f32x4* x4 = (const f32x4*)p.x; const f32x4* c4 = (const f32x4*)p.ctx;
        const int nlat = ROWS_LAT * D / 4, ntot = MT * D / 4;
        for (int i = blockIdx.x * NTHREADS + tid; i < ntot; i += gridDim.x * NTHREADS) X4[i] = i < nlat ? x4[i] : c4[i - nlat];
    }
    {
        LAS float* tile = (LAS float*)lds;
        bf16_t* WINT = (bf16_t*)(p.ws + WS_WINT); bf16_t* WOUTT = (bf16_t*)(p.ws + WS_WOUTT); bf16_t* WGUT = (bf16_t*)(p.ws + WS_WGUT); bf16_t* WDT = (bf16_t*)(p.ws + WS_WDT);
        constexpr int T_IN = 10 * 16, T_OUT = 4 * 16, T_EXP = NE * 4 * 16, T_LAYER = T_IN + T_OUT + 3 * T_EXP;
        for (int t = blockIdx.x; t < DEPTH * T_LAYER; t += gridDim.x) {
            const int l = t / T_LAYER; int i = t % T_LAYER;
            const float* src; size_t sld; bf16_t* dst; int rs = 16;
            if (i < T_IN) { const int nt = i >> 4, kt = i & 15; const int n0 = nt < 6 ? nt * 256 : 1552 + (nt - 6) * 256;
                src = p.w_in + ((size_t)l * D + kt * 64) * INC + n0; sld = INC; dst = WINT + ((size_t)l * PN + nt * 256) * D + kt * 64; }
            else if (i < T_IN + T_OUT) { i -= T_IN; const int nt = i >> 4, kt = i & 15;
                src = p.w_out + ((size_t)l * D + kt * 64) * D + nt * 256; sld = D; dst = WOUTT + ((size_t)l * D + nt * 256) * D + kt * 64; }
            else { i -= T_IN + T_OUT; const int which = i / T_EXP; i %= T_EXP; const int e = i >> 6, nt = (i >> 4) & 3, kt = i & 15;
                const size_t mo = ((size_t)(l * NE + e) * D + kt * 64) * D + nt * 256;
                if (which == 2) { src = p.w_down + mo; dst = WDT + ((size_t)(l * NE + e) * D + nt * 256) * D + kt * 64; }
                else { src = (which == 0 ? p.w_gate : p.w_up) + mo; rs = 32; dst = WGUT + ((size_t)(l * NE + e) * 2048 + nt * 512 + which * 16) * D + kt * 64; }
                sld = D; }
#pragma unroll
            for (int j = 0; j < 8; ++j) {
                const int e = tid * 4 + j * 2048, k = e >> 8, n = e & 255;
                const f32x4 v = *(const f32x4*)(src + (size_t)k * sld + n);
                tile[k * 257 + n] = v[0]; tile[k * 257 + n + 1] = v[1]; tile[k * 257 + n + 2] = v[2]; tile[k * 257 + n + 3] = v[3];
            }
            __syncthreads();
#pragma unroll
            for (int ps = 0; ps < 4; ++ps) {
                const int n = ps * 64 + (tid >> 3), ks = (tid & 7) * 8;
                u32x4 o;
                o[0] = pk_bf16(tile[(ks + 0) * 257 + n], tile[(ks + 1) * 257 + n]); o[1] = pk_bf16(tile[(ks + 2) * 257 + n], tile[(ks + 3) * 257 + n]);
                o[2] = pk_bf16(tile[(ks + 4) * 257 + n], tile[(ks + 5) * 257 + n]); o[3] = pk_bf16(tile[(ks + 6) * 257 + n], tile[(ks + 7) * 257 + n]);
                *(u32x4*)(dst + (size_t)((n >> 4) * rs + (n & 15)) * D + ks) = o;
            }
            __syncthreads();
        }
        bf16_t* PWT = (bf16_t*)(p.ws + WS_PWT);
        for (int i = blockIdx.x * NTHREADS + tid; i < DEPTH * 4 * 128 * 128; i += gridDim.x * NTHREADS) {
            const int lg = i >> 14, d = (i >> 7) & 127, c = i & 127;
            PWT[i] = (bf16_t)(pk_bf16(p.pool_w[((size_t)lg * 128 + c) * 128 + d], 0.f) & 0xffffu);
        }
    }
}

__device__ __forceinline__ float reduce4(const float v0, const float v1, const float v2, const float v3, const int lane) {
    const bool b5 = lane & 32, b4 = lane & 16;
    const float a0 = (b5 ? v2 : v0) + shx(b5 ? v0 : v2, 32, lane), a1 = (b5 ? v3 : v1) + shx(b5 ? v1 : v3, 32, lane);
    float c = (b4 ? a1 : a0) + shx(b4 ? a0 : a1, 16, lane);
    c += shx(c, 8, lane); c += shx(c, 4, lane); c += shx(c, 2, lane); c += shx(c, 1, lane);
    return c;
}

template <int WHICH>
__device__ void phase_norm(const Params& p, const int l, LAS unsigned char* lds) {
    const int tid = opaque_tid(), wid = tid >> 6, lane = tid & 63;
    LAS float* wsm = (LAS float*)lds;
    if (WHICH != 3) {
        const float* src; int stride;
        if (WHICH == 1) { src = p.w_in + (size_t)l * D * INC + 1536; stride = INC; } else { src = p.w_router + (size_t)l * D * NE; stride = NE; }
        for (int idx = tid; idx < 16 * 1024; idx += NTHREADS) { const int k = idx >> 4, j = idx & 15; wsm[j * 1024 + k] = src[(size_t)k * stride + j]; }
        __syncthreads();
    }
    const float* nw = WHICH == 1 ? p.norm1 + l * D : (WHICH == 2 ? p.norm2 + l * D : p.norm_f);
    float* X = (float*)(p.ws + WS_X);
    const float* MOD = (const float*)(p.ws + WS_MOD);
    bf16_t* H = (bf16_t*)(p.ws + WS_H);
    const int nrows = (WHICH == 3) ? ROWS_LAT : MT;
    constexpr int R = 3;
    const int rstride = gridDim.x * 8;
    const bool comb = (WHICH == 1 && l > 0) || WHICH == 3;
    for (int base = blockIdx.x * 8 + wid; base < nrows; base += rstride * R) {
        f32x4 xv[R][4]; int sv[R]; bool ok[R];
#pragma unroll
        for (int k = 0; k < R; ++k) {
            const int row = base + k * rstride; ok[k] = row < nrows; sv[k] = -1;
            if (ok[k]) {
                const float* xr = X + (size_t)row * D;
#pragma unroll
                for (int i = 0; i < 4; ++i) xv[k][i] = *(const f32x4*)(xr + i * 256 + lane * 4);
                if (comb && lane < 16) sv[k] = ((const int*)(p.ws + WS_SLOTOF))[(size_t)row * 16 + lane];
            } else {
#pragma unroll
                for (int i = 0; i < 4; ++i) xv[k][i] = (f32x4){0.f, 0.f, 0.f, 0.f};
            }
        }
        if (comb) {
            const int lp = (WHICH == 3) ? DEPTH - 1 : l - 1;
            const bf16_t* YE = (const bf16_t*)(p.ws + WS_YE);
            f32x4 a[R][4]; unsigned long long msk[R];
#pragma unroll
            for (int k = 0; k < R; ++k) { msk[k] = __ballot(sv[k] >= 0);
#pragma unroll
                for (int i = 0; i < 4; ++i) a[k][i] = (f32x4){0.f, 0.f, 0.f, 0.f}; }
            while (msk[0] | msk[1] | msk[2]) {
                u32x2 t[R][4]; bool has[R];
#pragma unroll
                for (int k = 0; k < R; ++k) {
                    has[k] = msk[k] != 0ull;
                    if (has[k]) {
                        const int e = __builtin_ctzll(msk[k]); msk[k] &= msk[k] - 1ull;
                        const int sl = __builtin_amdgcn_readlane(sv[k], e);
                        const bf16_t* yr = YE + (size_t)sl * D;
#pragma unroll
                        for (int i = 0; i < 4; ++i) t[k][i] = *(const u32x2*)(yr + i * 256 + lane * 4);
                    }
                }
#pragma unroll
                for (int k = 0; k < R; ++k) if (has[k]) {
#pragma unroll
                    for (int i = 0; i < 4; ++i) { a[k][i][0] += bf_lo(t[k][i][0]); a[k][i][1] += bf_hi(t[k][i][0]); a[k][i][2] += bf_lo(t[k][i][1]); a[k][i][3] += bf_hi(t[k][i][1]); }
                }
            }
#pragma unroll
            for (int k = 0; k < R; ++k) if (ok[k]) {
                const int row = base + k * rstride, bidx = row < ROWS_LAT ? (row >> 11) : 8;
                const float* g2 = MOD + ((size_t)lp * 9 + bidx) * 6144 + 5 * 1024;
#pragma unroll
                for (int i = 0; i < 4; ++i) { const f32x4 g = *(const f32x4*)(g2 + i * 256 + lane * 4); xv[k][i] += g * a[k][i];
                    if (WHICH == 1) *(f32x4*)(X + (size_t)row * D + i * 256 + lane * 4) = xv[k][i]; }
            }
        }
        float rstd[R];
#pragma unroll
        for (int k = 0; k < R; ++k) {
            float ss = 0.f;
#pragma unroll
            for (int i = 0; i < 4; ++i) ss += xv[k][i][0] * xv[k][i][0] + xv[k][i][1] * xv[k][i][1] + xv[k][i][2] * xv[k][i][2] + xv[k][i][3] * xv[k][i][3];
            rstd[k] = rsqrtf(wave_sum(ss, lane) * (1.f / 1024.f) + EPS);
        }
        if (WHICH == 3) {
#pragma unroll
            for (int k = 0; k < R; ++k) if (ok[k]) {
                const int row = base + k * rstride;
#pragma unroll
                for (int i = 0; i < 4; ++i) { const f32x4 w = *(const f32x4*)(nw + i * 256 + lane * 4); *(f32x4*)(p.out + (size_t)row * D + i * 256 + lane * 4) = xv[k][i] * rstd[k] * w; }
            }
            continue;
        }
#pragma unroll
        for (int k = 0; k < R; ++k) {
            const int row = base + k * rstride, bidx = row < ROWS_LAT ? (row >> 11) : 8;
            const float* md = MOD + ((size_t)l * 9 + bidx) * 6144 + (WHICH == 1 ? 0 : 3072);
#pragma unroll
            for (int i = 0; i < 4; ++i) {
                const int c = i * 256 + lane * 4;
                const f32x4 w = *(const f32x4*)(nw + c), sh = *(const f32x4*)(md + c), scl = *(const f32x4*)(md + 1024 + c);
                xv[k][i] = (xv[k][i] * rstd[k] * w) * (scl + 1.f) + sh;
                if (ok[k]) { u32x2 o; o[0] = pk_bf16(xv[k][i][0], xv[k][i][1]); o[1] = pk_bf16(xv[k][i][2], xv[k][i][3]); *(u32x2*)(H + (size_t)row * D + c) = o; }
            }
        }
        float dj[R][4];
#pragma unroll
        for (int jg = 0; jg < 4; ++jg) {
            float sp[R][4];
#pragma unroll
            for (int jj = 0; jj < 4; ++jj) {
                const int j = jg * 4 + jj;
                float s0 = 0.f, s1 = 0.f, s2 = 0.f;
#pragma unroll
                for (int i = 0; i < 4; ++i) { const f32x4 w = *(const LAS f32x4*)(wsm + j * 1024 + i * 256 + lane * 4);
                    s0 += xv[0][i][0] * w[0] + xv[0][i][1] * w[1] + xv[0][i][2] * w[2] + xv[0][i][3] * w[3];
                    s1 += xv[1][i][0] * w[0] + xv[1][i][1] * w[1] + xv[1][i][2] * w[2] + xv[1][i][3] * w[3];
                    s2 += xv[2][i][0] * w[0] + xv[2][i][1] * w[1] + xv[2][i][2] * w[2] + xv[2][i][3] * w[3]; }
                sp[0][jj] = s0; sp[1][jj] = s1; sp[2][jj] = s2;
            }
#pragma unroll
            for (int k = 0; k < R; ++k) dj[k][jg] = reduce4(sp[k][0], sp[k][1], sp[k][2], sp[k][3], lane);
            __builtin_amdgcn_sched_barrier(0);
        }
        const int q = lane >> 4;
#pragma unroll
        for (int k = 0; k < R; ++k) {
            const int row = base + k * rstride;
            if (WHICH == 1) {
                if (ok[k] && (lane & 15) == 0) {
#pragma unroll
                    for (int jg = 0; jg < 4; ++jg) {
                        const int j = jg * 4 + q; const float v = dj[k][jg];
                        if (jg < 2) { const float xa = v + p.dt_bias[l * 8 + j]; const float sp2 = xa > 20.f ? xa : log1pf(__expf(xa));
                            ((float*)(p.ws + WS_LOGA))[(size_t)row * 8 + j] = -__expf(p.a_log[l * 8 + j]) * sp2; }
                        else ((float*)(p.ws + WS_BETA))[(size_t)row * 8 + (j - 8)] = 1.f / (1.f + __expf(-v));
                    }
                }
            } else {
                float m = fmaxf(fmaxf(dj[k][0], dj[k][1]), fmaxf(dj[k][2], dj[k][3]));
                m = fmaxf(m, shx(m, 16, lane)); m = fmaxf(m, shx(m, 32, lane));
                float e[4], sum = 0.f;
#pragma unroll
                for (int jg = 0; jg < 4; ++jg) { e[jg] = __expf(dj[k][jg] - m); sum += e[jg]; }
                sum += shx(sum, 16, lane); sum += shx(sum, 32, lane);
                const float inv = 1.f / sum;
                if (ok[k] && (lane & 15) == 0) {
#pragma unroll
                    for (int jg = 0; jg < 4; ++jg) ((float*)(p.ws + WS_AFF))[(size_t)row * 16 + jg * 4 + q] = e[jg] * inv;
                }
            }
        }
    }
}

__device__ __forceinline__ void gemm_core(const unsigned char* Ab, const unsigned (&aoff)[4], const unsigned char* Bb, const unsigned (&boff)[2], const int nt,
                                          LAS unsigned char* lds, f32x4 (&acc)[4][4], const int wid, const int lane) {
    const int wr = wid >> 1, wc = wid & 1, fr = lane & 15, fq = lane >> 4;
    const int ar = lds_byte(wr * 64 + fr, fq * 8), br = lds_byte(wc * 64 + fr, fq * 8);
    const unsigned ldsw = (unsigned)wid * 1024u;
#define G_STAGE(t, buf) do { const unsigned _ko = (unsigned)(t) * 128u; \
        _Pragma("unroll") for (int _i = 0; _i < 4; ++_i) __builtin_amdgcn_global_load_lds((const unsigned*)(Ab + aoff[_i] + _ko), (LAS unsigned*)(lds + (buf) * 49152 + ldsw + _i * 8192), 16, 0, 0); \
        _Pragma("unroll") for (int _i = 0; _i < 2; ++_i) __builtin_amdgcn_global_load_lds((const unsigned*)(Bb + boff[_i] + _ko), (LAS unsigned*)(lds + (buf) * 49152 + 32768 + ldsw + _i * 8192), 16, 0, 0); } while (0)
#pragma unroll
    for (int m = 0; m < 4; ++m)
#pragma unroll
        for (int n = 0; n < 4; ++n) acc[m][n] = (f32x4){0.f, 0.f, 0.f, 0.f};
#if REGSTAGE
    u32x4 ra[4], rb[2];
#pragma unroll
    for (int i = 0; i < 4; ++i) ra[i] = *(const u32x4*)(Ab + aoff[i]);
#pragma unroll
    for (int i = 0; i < 2; ++i) rb[i] = *(const u32x4*)(Bb + boff[i]);
    const unsigned tb = (unsigned)(wid * 64 + lane) * 16u;
    for (int t = 0; t < nt; ++t) {
        __syncthreads();
#pragma unroll
        for (int i = 0; i < 4; ++i) *(LAS u32x4*)(lds + tb + i * 8192) = ra[i];
#pragma unroll
        for (int i = 0; i < 2; ++i) *(LAS u32x4*)(lds + 32768 + tb + i * 8192) = rb[i];
        __syncthreads();
        if (t + 1 < nt) {
            const unsigned ko = (unsigned)(t + 1) * 128u;
#pragma unroll
            for (int i = 0; i < 4; ++i) ra[i] = *(const u32x4*)(Ab + aoff[i] + ko);
#pragma unroll
            for (int i = 0; i < 2; ++i) rb[i] = *(const u32x4*)(Bb + boff[i] + ko);
        }
        LAS unsigned char* bA = lds; LAS unsigned char* bB = bA + 32768;
        bf16x8 af[4][2], bfr[4][2];
#pragma unroll
        for (int m = 0; m < 4; ++m)
#pragma unroll
            for (int k = 0; k < 2; ++k) af[m][k] = *(const LAS bf16x8*)(bA + ar + m * 2048 + k * 1024);
#pragma unroll
        for (int n = 0; n < 4; ++n)
#pragma unroll
            for (int k = 0; k < 2; ++k) bfr[n][k] = *(const LAS bf16x8*)(bB + br + n * 2048 + k * 1024);
#pragma unroll
        for (int k = 0; k < 2; ++k)
#pragma unroll
            for (int m = 0; m < 4; ++m)
#pragma unroll
                for (int n = 0; n < 4; ++n) acc[m][n] = __builtin_amdgcn_mfma_f32_16x16x32_bf16(bfr[n][k], af[m][k], acc[m][n], 0, 0, 0);
    }
#else
    G_STAGE(0, 0);
    for (int t = 0; t < nt; ++t) {
        asm volatile("s_waitcnt vmcnt(0)" ::: "memory");
        __syncthreads();
        if (t + 1 < nt) { if ((t + 1) & 1) G_STAGE(t + 1, 1); else G_STAGE(t + 1, 0); }
        LAS unsigned char* bA = lds + (t & 1) * 49152; LAS unsigned char* bB = bA + 32768;
        bf16x8 af[4][2], bfr[4][2];
#pragma unroll
        for (int m = 0; m < 4; ++m)
#pragma unroll
            for (int k = 0; k < 2; ++k) af[m][k] = *(const LAS bf16x8*)(bA + ar + m * 2048 + k * 1024);
#pragma unroll
        for (int n = 0; n < 4; ++n)
#pragma unroll
            for (int k = 0; k < 2; ++k) bfr[n][k] = *(const LAS bf16x8*)(bB + br + n * 2048 + k * 1024);
#pragma unroll
        for (int k = 0; k < 2; ++k)
#pragma unroll
            for (int m = 0; m < 4; ++m)
#pragma unroll
                for (int n = 0; n < 4; ++n) acc[m][n] = __builtin_amdgcn_mfma_f32_16x16x32_bf16(bfr[n][k], af[m][k], acc[m][n], 0, 0, 0);
    }
#endif
    __syncthreads();
#undef G_STAGE
}

template <int MODE>
__device__ void phase_gemm(const Params& p, const int l, LAS unsigned char* lds) {
    const int tid = opaque_tid(), wid = __builtin_amdgcn_readfirstlane(tid >> 6), lane = tid & 63;
    const int wr = wid >> 1, wc = wid & 1, fr = lane & 15, fq = lane >> 4;
    int R0, C0; stage_rc(tid * 16, R0, C0);
    constexpr int nN = MODE == 0 ? 20 : (MODE == 1 ? 8 : (MODE == 2 ? 16 : 8));
    constexpr int nM = (MODE <= 1) ? MT / 256 : NGROUPS;
    const bf16_t* H = (const bf16_t*)(p.ws + WS_H);
    for (int u = blockIdx.x; u < nM * nN; u += gridDim.x) {
        const int pm = u / nN, pn = u % nN;
        const unsigned char* Ab; const unsigned char* Bb; unsigned aoff[4], boff[2];
#pragma unroll
        for (int i = 0; i < 2; ++i) boff[i] = (unsigned)((R0 + 64 * i) * D + C0) * 2u;
        int e = 0;
        if (MODE == 0) {
            Ab = (const unsigned char*)(H + (size_t)pm * 256 * D); Bb = (const unsigned char*)((const bf16_t*)(p.ws + WS_WINT) + ((size_t)l * PN + pn * 128) * D);
#pragma unroll
            for (int i = 0; i < 4; ++i) aoff[i] = (unsigned)((R0 + 64 * i) * D + C0) * 2u;
        } else if (MODE == 1) {
            Ab = (const unsigned char*)((const bf16_t*)(p.ws + WS_CAT) + (size_t)pm * 256 * D); Bb = (const unsigned char*)((const bf16_t*)(p.ws + WS_WOUTT) + ((size_t)l * D + pn * 128) * D);
#pragma unroll
            for (int i = 0; i < 4; ++i) aoff[i] = (unsigned)((R0 + 64 * i) * D + C0) * 2u;
        } else if (MODE == 2) {
            e = pm < 128 ? (pm >> 3) : (pm - 128);
            const int* SEL = (const int*)(p.ws + WS_SEL) + pm * 256;
            Ab = (const unsigned char*)H; Bb = (const unsigned char*)((const bf16_t*)(p.ws + WS_WGUT) + ((size_t)(l * NE + e) * 2048 + pn * 128) * D);
#pragma unroll
            for (int i = 0; i < 4; ++i) aoff[i] = (unsigned)(SEL[R0 + 64 * i] * D + C0) * 2u;
        } else {
            e = pm < 128 ? (pm >> 3) : (pm - 128);
            Ab = (const unsigned char*)((const bf16_t*)(p.ws + WS_HID) + (size_t)pm * 256 * D); Bb = (const unsigned char*)((const bf16_t*)(p.ws + WS_WDT) + ((size_t)(l * NE + e) * D + pn * 128) * D);
#pragma unroll
            for (int i = 0; i < 4; ++i) aoff[i] = (unsigned)((R0 + 64 * i) * D + C0) * 2u;
        }
        f32x4 acc[4][4];
        gemm_core(Ab, aoff, Bb, boff, D / 64, lds, acc, wid, lane);
        if (MODE == 0) {
            bf16_t* PROJ = (bf16_t*)(p.ws + WS_PROJ);
#pragma unroll
            for (int m = 0; m < 4; ++m) { const size_t row = (size_t)pm * 256 + wr * 64 + m * 16 + fr;
#pragma unroll
                for (int n = 0; n < 4; ++n) { u32x2 o; o[0] = pk_bf16(acc[m][n][0], acc[m][n][1]); o[1] = pk_bf16(acc[m][n][2], acc[m][n][3]);
                    *(u32x2*)(PROJ + row * PN + pn * 128 + wc * 64 + n * 16 + fq * 4) = o; } }
        } else if (MODE == 1) {
            float* X = (float*)(p.ws + WS_X);
            const int bidx = pm < 64 ? (pm >> 3) : 8;
            const float* g1 = (const float*)(p.ws + WS_MOD) + ((size_t)l * 9 + bidx) * 6144 + 2048;
#pragma unroll
            for (int n = 0; n < 4; ++n) { const int col = pn * 128 + wc * 64 + n * 16 + fq * 4; const f32x4 g = *(const f32x4*)(g1 + col);
#pragma unroll
                for (int m = 0; m < 4; ++m) { float* xp = X + ((size_t)pm * 256 + wr * 64 + m * 16 + fr) * D + col; *(f32x4*)xp = *(const f32x4*)xp + g * acc[m][n]; } }
        } else if (MODE == 2) {
            bf16_t* HID = (bf16_t*)(p.ws + WS_HID);
#pragma unroll
            for (int m = 0; m < 4; ++m) { const size_t slot = (size_t)pm * 256 + wr * 64 + m * 16 + fr;
#pragma unroll
                for (int q = 0; q < 2; ++q) { const f32x4 g = acc[m][2 * q], uu = acc[m][2 * q + 1];
                    u32x2 o; o[0] = pk_bf16(silu_f(g[0]) * uu[0], silu_f(g[1]) * uu[1]); o[1] = pk_bf16(silu_f(g[2]) * uu[2], silu_f(g[3]) * uu[3]);
                    *(u32x2*)(HID + slot * D + pn * 64 + wc * 32 + q * 16 + fq * 4) = o; } }
        } else {
            bf16_t* YE = (bf16_t*)(p.ws + WS_YE);
            const float* SELAFF = (const float*)(p.ws + WS_SELAFF);
#pragma unroll
            for (int m = 0; m < 4; ++m) { const size_t slot = (size_t)pm * 256 + wr * 64 + m * 16 + fr; const float a = SELAFF[slot];
#pragma unroll
                for (int n = 0; n < 4; ++n) { u32x2 o; o[0] = pk_bf16(acc[m][n][0] * a, acc[m][n][1] * a); o[1] = pk_bf16(acc[m][n][2] * a, acc[m][n][3] * a);
                    *(u32x2*)(YE + slot * D + pn * 128 + wc * 64 + n * 16 + fq * 4) = o; } }
        }
    }
}

__device__ void phase_conv_pool(const Params& p, const int l, LAS unsigned char* lds) {
    const int tid = opaque_tid(), wid = tid >> 6, lane = tid & 63;
    const bf16_t* PROJ = (const bf16_t*)(p.ws + WS_PROJ);
    if (NAIVE_SCAN) {
        float* QKV = (float*)(p.ws + WS_QKV);
        const float* cw = p.conv_w + (size_t)l * 4 * 1536;
        for (int task = blockIdx.x * 8 + wid; task < MT * 12; task += gridDim.x * 8) {
            const int row = task / 12, part = task % 12;
            int s0, len;
            if (row < ROWS_LAT) { s0 = row & ~2047; len = 2048; } else { s0 = ROWS_LAT + ((row - ROWS_LAT) & ~255); len = 256; }
            const int c = part * 128 + lane * 2;
            float a0 = 0.f, a1 = 0.f;
#pragma unroll
            for (int j = 0; j < 4; ++j) {
                const int r2 = row + j - 2;
                if (r2 >= s0 && r2 < s0 + len) {
                    const unsigned v = *(const unsigned*)(PROJ + (size_t)r2 * PN + c);
                    const f32x2 w = *(const f32x2*)(cw + j * 1536 + c);
                    a0 += w[0] * bf_lo(v); a1 += w[1] * bf_hi(v);
                }
            }
            a0 = silu_f(a0); a1 = silu_f(a1);
            if (part < 8) {
                const float ss = wave_sum(a0 * a0 + a1 * a1, lane);
                float sc = rsqrtf(ss + EPS);
                if (part < 4) sc *= 0.08838834764831845f;
                a0 *= sc; a1 *= sc;
            }
            *(f32x2*)(QKV + (size_t)row * 1536 + c) = (f32x2){a0, a1};
        }
    }
    {
        LAS float* V = (LAS float*)lds;
        LAS unsigned char* mt = lds + 40960;
        const bf16_t* PWT = (const bf16_t*)(p.ws + WS_PWT);
        bf16_t* CAT = (bf16_t*)(p.ws + WS_CAT);
        const int wr = wid >> 1, wc = wid & 1, fr = lane & 15, fq = lane >> 4;
        for (int u = blockIdx.x; u < 1152; u += gridDim.x) {
            int g, r, nrows, ncols, c0, rowbase;
            if (u < 1024) { const int b = u >> 7; g = (u >> 5) & 3; r = u & 31; nrows = 32; ncols = 64; c0 = 0; rowbase = b * 2048; }
            else { const int v = u - 1024; const int b = v >> 4; g = (v >> 2) & 3; r = 0; nrows = 1; ncols = 256; c0 = (v & 3) * 64; rowbase = ROWS_LAT + b * 256; }
            const int w = 2 << g, half = w >> 1;
            const int lo_r = max(r - half, 0), hi_r = min(r - half + w, nrows);
            const int cxlo = max(c0 - half, 0), cxhi = min(c0 + 64 + half, ncols);
            const bf16_t* ub = PROJ + 2048 + g * 128;
            for (int pi = tid; pi < (cxhi - cxlo) * 16; pi += NTHREADS) {
                const int cxi = pi >> 4, c8 = (pi & 15) * 8;
                float av[8];
#pragma unroll
                for (int e = 0; e < 8; ++e) av[e] = 0.f;
                const bf16_t* src = ub + (size_t)(rowbase + cxlo + cxi) * PN + c8;
                for (int r0 = lo_r; r0 < hi_r; r0 += 8) {
                    u32x4 v[8];
#pragma unroll
                    for (int k = 0; k < 8; ++k) { const int rr = min(r0 + k, hi_r - 1); v[k] = *(const u32x4*)(src + (size_t)rr * ncols * PN); }
#pragma unroll
                    for (int k = 0; k < 8; ++k) if (r0 + k < hi_r) {
#pragma unroll
                        for (int e = 0; e < 4; ++e) { av[2 * e] += bf_lo(v[k][e]); av[2 * e + 1] += bf_hi(v[k][e]); }
                    }
                }
                *(LAS f32x4*)(V + cxi * 128 + c8) = (f32x4){av[0], av[1], av[2], av[3]};
                *(LAS f32x4*)(V + cxi * 128 + c8 + 4) = (f32x4){av[4], av[5], av[6], av[7]};
            }
            __syncthreads();
            for (int idx = tid; idx < 64 * 64; idx += NTHREADS) {
                const int ci = idx >> 6, ch = (idx & 63) * 2, c = c0 + ci;
                const int lo_c = max(c - half, 0), hi_c = min(c - half + w, ncols);
                float s0 = 0.f, s1 = 0.f;
                for (int cx = lo_c; cx < hi_c; ++cx) { s0 += V[(cx - cxlo) * 128 + ch]; s1 += V[(cx - cxlo) * 128 + ch + 1]; }
                const float inv = 1.f / (float)((hi_r - lo_r) * (hi_c - lo_c));
                const unsigned v = *(const unsigned*)(ub + (size_t)(rowbase + r * ncols + c) * PN + ch);
                *(LAS unsigned*)(mt + ci * 272 + ch * 2) = pk_bf16(s0 * inv - bf_lo(v), s1 * inv - bf_hi(v));
            }
            __syncthreads();
            f32x4 acc[4];
#pragma unroll
            for (int n = 0; n < 4; ++n) acc[n] = (f32x4){0.f, 0.f, 0.f, 0.f};
            const bf16_t* pw = PWT + (size_t)(l * 4 + g) * 128 * 128;
#pragma unroll
            for (int kk = 0; kk < 4; ++kk) {
                const bf16x8 a = *(const LAS bf16x8*)(mt + (wr * 16 + fr) * 272 + (kk * 32 + fq * 8) * 2);
#pragma unroll
                for (int n = 0; n < 4; ++n) {
                    const bf16x8 b = *(const bf16x8*)(pw + (size_t)(wc * 64 + n * 16 + fr) * 128 + kk * 32 + fq * 8);
                    acc[n] = __builtin_amdgcn_mfma_f32_16x16x32_bf16(b, a, acc[n], 0, 0, 0);
                }
            }
            const size_t row = (size_t)rowbase + r * ncols + c0 + wr * 16 + fr;
#pragma unroll
            for (int n = 0; n < 4; ++n) {
                const int dcol = g * 128 + wc * 64 + n * 16 + fq * 4;
                const f32x4 s = *(const f32x4*)(p.pool_scale + l * 512 + dcol);
                u32x2 o; o[0] = pk_bf16(acc[n][0] * s[0], acc[n][1] * s[1]); o[1] = pk_bf16(acc[n][2] * s[2], acc[n][3] * s[3]);
                *(u32x2*)(CAT + row * D + 512 + dcol) = o;
            }
            __syncthreads();
        }
    }
}


__device__ __forceinline__ int img256(int row, int col) { return row * 256 + ((((col >> 3) ^ row) & 15) << 4) + (col & 7) * 2; }
__device__ __forceinline__ int img128(int row, int col) { return (row >> 1) * 256 + (row & 1) * 128 + ((((col >> 3) ^ (row >> 1)) & 7) << 4) + (col & 7) * 2; }

__device__ void phase_prep(const Params& p, const int l, LAS unsigned char* lds) {
    int tid = opaque_tid(), wid = __builtin_amdgcn_readfirstlane(tid >> 6), lane = tid & 63, fr = lane & 15, fq = lane >> 4;
#define RELAUNDER() do { asm volatile("" : "+v"(tid)); wid = __builtin_amdgcn_readfirstlane(tid >> 6); lane = tid & 63; fr = lane & 15; fq = lane >> 4; } while (0)
    constexpr int R_KK = 0, R_QK = 16640, R_TB = 33280, R_QN = 53248, R_KN = 70656, R_KNT = 88064, R_VT = 106496, R_TW = 124928, R_TU = 134144, R_MB = R_TW, R_G = 143360;
    LAS float* KK = (LAS float*)(lds + R_KK); LAS float* QK = (LAS float*)(lds + R_QK); LAS float* TB = (LAS float*)(lds + R_TB); LAS float* MB = (LAS float*)(lds + R_MB);
    LAS float* G_LA = (LAS float*)(lds + R_G);
    LAS float* G_BT = G_LA + 128;
    LAS float* G_GC = G_BT + 128;
    LAS float* G_TOT = G_GC + 128;
    LAS float* XS = G_TOT + 16;
    LAS float* CW = (LAS float*)(lds + 149504);
    const bf16_t* PROJ = (const bf16_t*)(p.ws + WS_PROJ);
    const float* LOGA = (const float*)(p.ws + WS_LOGA); const float* BETA = (const float*)(p.ws + WS_BETA);
    int cur_h = -1;
    for (int u = blockIdx.x; u < NB * 4 * NCHUNK; u += gridDim.x) {
        const int h = u & 3, b = (u >> 2) / 36, cc = (u >> 2) % 36;
        if (h != cur_h) {
            __syncthreads();
            for (int idx = tid; idx < 1536; idx += NTHREADS) { const int j = idx / 384, rm = idx % 384, seg = rm >> 7, c = rm & 127; CW[idx] = p.conv_w[(size_t)(l * 4 + j) * 1536 + seg * 512 + h * 128 + c]; }
            cur_h = h;
        }
        int rowbase, seqlen, cpos;
        if (cc < 32) { rowbase = b * SEQ; seqlen = SEQ; cpos = cc; } else { rowbase = ROWS_LAT + b * CTXL; seqlen = CTXL; cpos = cc - 32; }
        const int t0 = cpos * 64;
        RELAUNDER();
        {
            u32x4 rv[7];
#pragma unroll
            for (int it = 0; it < 7; ++it) {
                const int idx = tid + it * NTHREADS, rr = idx / 48, pc = idx % 48, seg = pc >> 4, po = pc & 15, tok = t0 - 2 + rr;
                rv[it] = (u32x4){0u, 0u, 0u, 0u};
                if (idx < 67 * 48 && tok >= 0 && tok < seqlen) rv[it] = *(const u32x4*)(PROJ + (size_t)(rowbase + tok) * PN + seg * 512 + h * 128 + po * 8);
            }
#pragma unroll
            for (int it = 0; it < 7; ++it) {
                const int idx = tid + it * NTHREADS, rr = idx / 48, pc = idx % 48, seg = pc >> 4, po = pc & 15;
                if (idx < 67 * 48) *(LAS u32x4*)(lds + rr * 784 + seg * 256 + po * 16) = rv[it];
            }
        }
        if (tid < 128) { const int d = tid >> 6; const size_t gi = (size_t)(rowbase + t0 + lane) * 8 + d * 4 + h; G_LA[tid] = LOGA[gi]; G_BT[tid] = BETA[gi]; }
        __syncthreads();
        RELAUNDER();
        if (wid < 2) {
            const int d = wid, pos = d ? 63 - lane : lane;
            float v = G_LA[d * 64 + pos];
#pragma unroll
            for (int o = 1; o < 64; o <<= 1) { const float t = shup(v, o, lane); if (lane >= o) v += t; }
            G_GC[d * 64 + pos] = v;
            if (lane == 63) G_TOT[d] = v;
        }
        RELAUNDER();
        {
            const int r = tid >> 3, cs = tid & 7;
            const LAS float* cw = CW + cs * 16;
#pragma unroll
            for (int seg = 0; seg < 3; ++seg) {
                float a[16];
#pragma unroll
                for (int e = 0; e < 16; ++e) a[e] = 0.f;
#pragma unroll
                for (int j = 0; j < 4; ++j) {
                    const u32x4 x0 = *(const LAS u32x4*)(lds + (r + j) * 784 + seg * 256 + cs * 32), x1 = *(const LAS u32x4*)(lds + (r + j) * 784 + seg * 256 + cs * 32 + 16);
                    const LAS float* wj = cw + j * 384 + seg * 128;
                    const f32x4 w0 = *(const LAS f32x4*)(wj), w1 = *(const LAS f32x4*)(wj + 4), w2 = *(const LAS f32x4*)(wj + 8), w3 = *(const LAS f32x4*)(wj + 12);
                    a[0] += w0[0] * bf_lo(x0[0]); a[1] += w0[1] * bf_hi(x0[0]); a[2] += w0[2] * bf_lo(x0[1]); a[3] += w0[3] * bf_hi(x0[1]);
                    a[4] += w1[0] * bf_lo(x0[2]); a[5] += w1[1] * bf_hi(x0[2]); a[6] += w1[2] * bf_lo(x0[3]); a[7] += w1[3] * bf_hi(x0[3]);
                    a[8] += w2[0] * bf_lo(x1[0]); a[9] += w2[1] * bf_hi(x1[0]); a[10] += w2[2] * bf_lo(x1[1]); a[11] += w2[3] * bf_hi(x1[1]);
                    a[12] += w3[0] * bf_lo(x1[2]); a[13] += w3[1] * bf_hi(x1[2]); a[14] += w3[2] * bf_lo(x1[3]); a[15] += w3[3] * bf_hi(x1[3]);
                    if (j & 1) __builtin_amdgcn_sched_barrier(0);
                }
                float ss = 0.f;
#pragma unroll
                for (int e = 0; e < 16; ++e) { a[e] = silu_f(a[e]); ss += a[e] * a[e]; }
                if (seg < 2) {
                    ss += shx(ss, 1, lane); ss += shx(ss, 2, lane); ss += shx(ss, 4, lane);
                    float sc = rsqrtf(ss + EPS); if (seg == 0) sc *= 0.08838834764831845f;
#pragma unroll
                    for (int e = 0; e < 16; ++e) a[e] *= sc;
                }
                unsigned pk[8];
#pragma unroll
                for (int e = 0; e < 8; ++e) pk[e] = pk_bf16(a[2 * e], a[2 * e + 1]);
                if (seg < 2) {
                    LAS unsigned char* dst = lds + (seg == 0 ? R_QN : R_KN) + r * 272 + cs * 32;
                    *(LAS u32x4*)dst = (u32x4){pk[0], pk[1], pk[2], pk[3]}; *(LAS u32x4*)(dst + 16) = (u32x4){pk[4], pk[5], pk[6], pk[7]};
                }
                if (seg >= 1) {
                    LAS unsigned char* dt = lds + (seg == 1 ? R_KNT : R_VT) + (cs * 16) * 144 + r * 2;
#pragma unroll
                    for (int e = 0; e < 8; ++e) { *(LAS unsigned short*)(dt + (2 * e) * 144) = (unsigned short)(pk[e] & 0xffffu); *(LAS unsigned short*)(dt + (2 * e + 1) * 144) = (unsigned short)(pk[e] >> 16); }
                }
            }
        }
        __syncthreads();
        RELAUNDER();
        {
            const int ib = wid & 3, pr = wid >> 2;
            LAS unsigned char* Ab = lds + (pr ? R_QN : R_KN) + (ib * 16 + fr) * 272 + fq * 16;
            bf16x8 a[4];
#pragma unroll
            for (int kk = 0; kk < 4; ++kk) a[kk] = *(const LAS bf16x8*)(Ab + kk * 64);
            LAS float* dstf = pr ? QK : KK;
#pragma unroll
            for (int jb = 0; jb < 4; ++jb) {
                f32x4 acc = (f32x4){0.f, 0.f, 0.f, 0.f};
#pragma unroll
                for (int kk = 0; kk < 4; ++kk) { const bf16x8 bb = *(const LAS bf16x8*)(lds + R_KN + (jb * 16 + fr) * 272 + fq * 16 + kk * 64); acc = __builtin_amdgcn_mfma_f32_16x16x32_bf16(a[kk], bb, acc, 0, 0, 0); }
#pragma unroll
                for (int r = 0; r < 4; ++r) dstf[(ib * 16 + fq * 4 + r) * 65 + jb * 16 + fr] = acc[r];
            }
        }
        __syncthreads();
        for (int d = 0; d < 2; ++d) {
            const LAS float* gc = G_GC + d * 64; const LAS float* bt = G_BT + d * 64;
            RELAUNDER();
            for (int idx = tid; idx < 4096; idx += NTHREADS) {
                const int i2 = idx >> 6, j2 = idx & 63, pi = d ? 63 - i2 : i2, pj = d ? 63 - j2 : j2;
                float v = 0.f;
                if (j2 < i2) v = bt[pi] * KK[pi * 65 + pj] * __expf(gc[pi] - gc[pj]);
                MB[i2 * 65 + j2] = v; TB[i2 * 65 + j2] = (i2 == j2) ? 1.f : 0.f;
            }
            __syncthreads();
            RELAUNDER();
            if (wid < 4 && lane < 16) {
                const int bb = wid; float tc[16], mrow[16];
#pragma unroll
                for (int b2 = 0; b2 < 16; ++b2) mrow[b2] = MB[(bb * 16 + lane) * 65 + bb * 16 + b2];
#pragma unroll
                for (int a = 0; a < 16; ++a) {
                    float sv = (a == lane) ? 1.f : 0.f;
#pragma unroll
                    for (int b2 = 0; b2 < a; ++b2) sv -= __int_as_float(__builtin_amdgcn_readlane(__float_as_int(mrow[b2]), a)) * tc[b2];
                    tc[a] = sv;
                }
#pragma unroll
                for (int a = 0; a < 16; ++a) TB[(bb * 16 + a) * 65 + bb * 16 + lane] = tc[a];
            }
            __syncthreads();
            RELAUNDER();
            if (wid < 2) {
                const int rb = 2 * wid + 1, cb = 2 * wid; LAS float* xs = XS + wid * 272;
                f32x4 acc = (f32x4){0.f, 0.f, 0.f, 0.f};
#pragma unroll
                for (int ks = 0; ks < 4; ++ks) acc = __builtin_amdgcn_mfma_f32_16x16x4f32(MB[(rb * 16 + fr) * 65 + cb * 16 + ks * 4 + fq], TB[(cb * 16 + ks * 4 + fq) * 65 + cb * 16 + fr], acc, 0, 0, 0);
#pragma unroll
                for (int r = 0; r < 4; ++r) xs[(fq * 4 + r) * 17 + fr] = acc[r];
                f32x4 acc2 = (f32x4){0.f, 0.f, 0.f, 0.f};
#pragma unroll
                for (int ks = 0; ks < 4; ++ks) acc2 = __builtin_amdgcn_mfma_f32_16x16x4f32(TB[(rb * 16 + fr) * 65 + rb * 16 + ks * 4 + fq], xs[(ks * 4 + fq) * 17 + fr], acc2, 0, 0, 0);
#pragma unroll
                for (int r = 0; r < 4; ++r) TB[(rb * 16 + fq * 4 + r) * 65 + cb * 16 + fr] = -acc2[r];
            }
            __syncthreads();
            RELAUNDER();
            if (wid < 4) {
                const int ti = wid >> 1, tj = wid & 1;
                f32x4 acc = (f32x4){0.f, 0.f, 0.f, 0.f};
#pragma unroll
                for (int ks = 0; ks < 8; ++ks) acc = __builtin_amdgcn_mfma_f32_16x16x4f32(MB[(32 + ti * 16 + fr) * 65 + ks * 4 + fq], TB[(ks * 4 + fq) * 65 + tj * 16 + fr], acc, 0, 0, 0);
#pragma unroll
                for (int r = 0; r < 4; ++r) XS[(ti * 16 + fq * 4 + r) * 33 + tj * 16 + fr] = acc[r];
            }
            __syncthreads();
            if (wid < 4) {
                const int ti = wid >> 1, tj = wid & 1;
                f32x4 acc = (f32x4){0.f, 0.f, 0.f, 0.f};
#pragma unroll
                for (int ks = 0; ks < 8; ++ks) acc = __builtin_amdgcn_mfma_f32_16x16x4f32(TB[(32 + ti * 16 + fr) * 65 + 32 + ks * 4 + fq], XS[(ks * 4 + fq) * 33 + tj * 16 + fr], acc, 0, 0, 0);
#pragma unroll
                for (int r = 0; r < 4; ++r) TB[(32 + ti * 16 + fq * 4 + r) * 65 + tj * 16 + fr] = -acc[r];
            }
            __syncthreads();
            RELAUNDER();
            for (int idx = tid; idx < 2048; idx += NTHREADS) {
                const int i = idx >> 5, j = (idx & 31) * 2, i2 = d ? 63 - i : i, j2 = d ? 63 - j : j, j3 = d ? j2 - 1 : j2 + 1;
                const float t0v = TB[i2 * 65 + j2], t1v = TB[i2 * 65 + j3];
                const float c0 = bt[j], c1 = bt[j + 1];
                *(LAS unsigned*)(lds + R_TU + i * 144 + j * 2) = pk_bf16(t0v * c0, t1v * c1);
                *(LAS unsigned*)(lds + R_TW + i * 144 + j * 2) = pk_bf16(t0v * c0 * __expf(gc[j]), t1v * c1 * __expf(gc[j + 1]));
            }
            __syncthreads();
            RELAUNDER();
            const int cposn = (cc < 32) ? 4 + (d ? 31 - cpos : cpos) : (d ? 3 - cpos : cpos);
            unsigned char* rec = p.ws + WS_SCN + ((size_t)((b * 4 + h) * 2 + d) * NCHUNK + cposn) * REC_BYTES;
            {
                bf16x8 ak[2], av[2];
#pragma unroll
                for (int kk = 0; kk < 2; ++kk) { ak[kk] = *(const LAS bf16x8*)(lds + R_KNT + (wid * 16 + fr) * 144 + kk * 64 + fq * 16); av[kk] = *(const LAS bf16x8*)(lds + R_VT + (wid * 16 + fr) * 144 + kk * 64 + fq * 16); }
#pragma unroll
                for (int ib = 0; ib < 4; ++ib) {
                    f32x4 aw = (f32x4){0.f, 0.f, 0.f, 0.f}, au = (f32x4){0.f, 0.f, 0.f, 0.f};
#pragma unroll
                    for (int kk = 0; kk < 2; ++kk) {
                        const bf16x8 tw = *(const LAS bf16x8*)(lds + R_TW + (ib * 16 + fr) * 144 + kk * 64 + fq * 16), tu = *(const LAS bf16x8*)(lds + R_TU + (ib * 16 + fr) * 144 + kk * 64 + fq * 16);
                        aw = __builtin_amdgcn_mfma_f32_16x16x32_bf16(ak[kk], tw, aw, 0, 0, 0);
                        au = __builtin_amdgcn_mfma_f32_16x16x32_bf16(tu, av[kk], au, 0, 0, 0);
                    }
                    u32x2 ow; ow[0] = pk_bf16(aw[0], aw[1]); ow[1] = pk_bf16(aw[2], aw[3]);
                    *(u32x2*)(rec + REC_W + img256(ib * 16 + fr, wid * 16 + fq * 4)) = ow;
                    u32x2 ou; ou[0] = pk_bf16(au[0], au[1]); ou[1] = pk_bf16(au[2], au[3]);
                    *(u32x2*)(rec + REC_UT + (wid * 16 + fr) * 128 + (ib * 16 + fq * 4) * 2) = ou;
                }
            }
            RELAUNDER();
            const float gtot = G_TOT[d];
            for (int idx = tid; idx < 1024; idx += NTHREADS) {
                const int dk = idx >> 3, i8 = (idx & 7) * 8;
                const u32x4 kv = *(const LAS u32x4*)(lds + R_KNT + dk * 144 + i8 * 2);
                u32x4 o;
#pragma unroll
                for (int e = 0; e < 4; ++e) o[e] = pk_bf16(bf_lo(kv[e]) * __expf(gtot - gc[i8 + 2 * e]), bf_hi(kv[e]) * __expf(gtot - gc[i8 + 2 * e + 1]));
                *(u32x4*)(rec + REC_KT + img128(dk, i8)) = o;
            }
            for (int idx = tid; idx < 1024; idx += NTHREADS) {
                const int i = idx >> 4, k8 = (idx & 15) * 8;
                const u32x4 qv = *(const LAS u32x4*)(lds + R_QN + i * 272 + k8 * 2);
                const float eg = __expf(gc[i]);
                u32x4 o;
#pragma unroll
                for (int e = 0; e < 4; ++e) o[e] = pk_bf16(bf_lo(qv[e]) * eg, bf_hi(qv[e]) * eg);
                *(u32x4*)(rec + REC_QD + img256(i, k8)) = o;
            }
            {
                const int i = tid >> 3, j8 = (tid & 7) * 8;
                float v[8];
#pragma unroll
                for (int e = 0; e < 8; ++e) { const int j = j8 + e; const bool ok = d ? (j >= i) : (j <= i); v[e] = ok ? QK[i * 65 + j] * __expf(gc[i] - gc[j]) : 0.f; }
                u32x4 o; o[0] = pk_bf16(v[0], v[1]); o[1] = pk_bf16(v[2], v[3]); o[2] = pk_bf16(v[4], v[5]); o[3] = pk_bf16(v[6], v[7]);
                *(u32x4*)(rec + REC_QK + img128(i, j8)) = o;
            }
            if (tid == 0) { *(float*)(rec + REC_MISC) = __expf(gtot); *(int*)(rec + REC_MISC + 4) = rowbase + t0; }
            __syncthreads();
        }
    }
}
#undef RELAUNDER

__device__ void phase_scan(const Params& p, const int l, LAS unsigned char* lds) {
    const int tid = opaque_tid(), wid = __builtin_amdgcn_readfirstlane(tid >> 6), lane = tid & 63, fr = lane & 15, fq = lane >> 4;
    constexpr int BUFB = 62464, R_ST = 2 * BUFB, R_UTL = R_ST + 32 * 272;
    for (int id = blockIdx.x; id < 256; id += gridDim.x) {
        const int bhd = (id & 7) * 8 + (id >> 5), sl = (id >> 3) & 3, h = (bhd >> 1) & 3, d = bhd & 1;
        float* O = (float*)(p.ws + (d ? WS_OB : WS_OF));
        const unsigned char* rec0 = p.ws + WS_SCN + (size_t)bhd * NCHUNK * REC_BYTES;
        __syncthreads();
        for (int i = tid; i < 32 * 272 / 4; i += NTHREADS) ((LAS unsigned*)(lds + R_ST))[i] = 0u;
        f32x4 sacc[2];
        sacc[0] = (f32x4){0.f, 0.f, 0.f, 0.f}; sacc[1] = (f32x4){0.f, 0.f, 0.f, 0.f};
#define S_ISSUE(n, bufo) do { const unsigned char* _r = rec0 + (size_t)(n) * REC_BYTES + lane * 16; \
        _Pragma("unroll") for (int _q = 0; _q < 7; ++_q) __builtin_amdgcn_global_load_lds((const unsigned*)(_r + (wid + 8 * _q) * 1024), (LAS unsigned*)(lds + (bufo) + (wid + 8 * _q) * 1024), 16, 0, 0); \
        if (wid < 4) __builtin_amdgcn_global_load_lds((const unsigned*)(_r + REC_UT + sl * 4096 + wid * 1024), (LAS unsigned*)(lds + (bufo) + 57344 + wid * 1024), 16, 0, 0); \
        if (wid == 4) __builtin_amdgcn_global_load_lds((const unsigned*)(_r + REC_MISC), (LAS unsigned*)(lds + (bufo) + 61440), 16, 0, 0); } while (0)
        S_ISSUE(0, 0);
        const int ib = wid >> 1, nb = wid & 1;
        for (int n = 0; n < NCHUNK; ++n) {
            asm volatile("s_waitcnt vmcnt(0)" ::: "memory");
            __syncthreads();
            if (n + 1 < NCHUNK) { if ((n + 1) & 1) S_ISSUE(n + 1, BUFB); else S_ISSUE(n + 1, 0); }
            LAS unsigned char* buf = lds + (n & 1) * BUFB;
            f32x4 accP = (f32x4){0.f, 0.f, 0.f, 0.f}, accQ = (f32x4){0.f, 0.f, 0.f, 0.f};
#pragma unroll
            for (int kk = 0; kk < 4; ++kk) {
                const bf16x8 sb = *(const LAS bf16x8*)(lds + R_ST + (nb * 16 + fr) * 272 + kk * 64 + fq * 16);
                const bf16x8 aw = *(const LAS bf16x8*)(buf + REC_W + img256(ib * 16 + fr, kk * 32 + fq * 8));
                const bf16x8 aq = *(const LAS bf16x8*)(buf + REC_QD + img256(ib * 16 + fr, kk * 32 + fq * 8));
                accP = __builtin_amdgcn_mfma_f32_16x16x32_bf16(aw, sb, accP, 0, 0, 0);
                accQ = __builtin_amdgcn_mfma_f32_16x16x32_bf16(aq, sb, accQ, 0, 0, 0);
            }
            {
                const u32x2 uv = *(const LAS u32x2*)(buf + REC_UT + (nb * 16 + fr) * 128 + (ib * 16 + fq * 4) * 2);
                u32x2 o; o[0] = pk_bf16(bf_lo(uv[0]) - accP[0], bf_hi(uv[0]) - accP[1]); o[1] = pk_bf16(bf_lo(uv[1]) - accP[2], bf_hi(uv[1]) - accP[3]);
                *(LAS u32x2*)(lds + R_UTL + (nb * 16 + fr) * 144 + (ib * 16 + fq * 4) * 2) = o;
            }
            __syncthreads();
            const float sd = *(const LAS float*)(buf + 61440); const int rowstart = *(const LAS int*)(buf + 61444);
            bf16x8 ub[2][2];
#pragma unroll
            for (int n2 = 0; n2 < 2; ++n2)
#pragma unroll
                for (int kk = 0; kk < 2; ++kk) ub[n2][kk] = *(const LAS bf16x8*)(lds + R_UTL + (n2 * 16 + fr) * 144 + kk * 64 + fq * 16);
#pragma unroll
            for (int kk = 0; kk < 2; ++kk) {
                const bf16x8 a = *(const LAS bf16x8*)(buf + REC_QK + img128(ib * 16 + fr, kk * 32 + fq * 8));
                const bf16x8 un = *(const LAS bf16x8*)(lds + R_UTL + (nb * 16 + fr) * 144 + kk * 64 + fq * 16);
                accQ = __builtin_amdgcn_mfma_f32_16x16x32_bf16(a, un, accQ, 0, 0, 0);
            }
#pragma unroll
            for (int r = 0; r < 4; ++r) O[(size_t)(rowstart + ib * 16 + fq * 4 + r) * 512 + h * 128 + sl * 32 + nb * 16 + fr] = accQ[r];
#pragma unroll
            for (int n2 = 0; n2 < 2; ++n2) {
                sacc[n2] *= sd;
#pragma unroll
                for (int kk = 0; kk < 2; ++kk) {
                    const bf16x8 a = *(const LAS bf16x8*)(buf + REC_KT + img128(wid * 16 + fr, kk * 32 + fq * 8));
                    sacc[n2] = __builtin_amdgcn_mfma_f32_16x16x32_bf16(a, ub[n2][kk], sacc[n2], 0, 0, 0);
                }
                u32x2 o; o[0] = pk_bf16(sacc[n2][0], sacc[n2][1]); o[1] = pk_bf16(sacc[n2][2], sacc[n2][3]);
                *(LAS u32x2*)(lds + R_ST + (n2 * 16 + fr) * 272 + (wid * 16 + fq * 4) * 2) = o;
            }
        }
#undef S_ISSUE
        __syncthreads();
    }
}

__device__ void phase_scan_naive(const Params& p, const int l, LAS unsigned char* lds) {
    const int tid = opaque_tid();
    const int lane = tid & 63;
    LAS float* ks = (LAS float*)lds;
    LAS float* qs = ks + 4096;
    LAS float* vs = qs + 4096;
    LAS float* as = vs + 4096;
    LAS float* bs = as + 32;
    LAS int* rws = (LAS int*)(bs + 32);
    const float* QKV = (const float*)(p.ws + WS_QKV);
    const float* LOGA = (const float*)(p.ws + WS_LOGA);
    const float* BETA = (const float*)(p.ws + WS_BETA);
    for (int u = blockIdx.x; u < 64; u += gridDim.x) {
        const int b = u >> 3, h = (u >> 1) & 3, d = u & 1;
        float* O = (float*)(p.ws + (d ? WS_OB : WS_OF));
        const int col = tid >> 2, part = tid & 3;
        float S[32];
#pragma unroll
        for (int i = 0; i < 32; ++i) S[i] = 0.f;
        for (int n0 = 0; n0 < CTXL + SEQ; n0 += 32) {
            __syncthreads();
            if (tid < 32) {
                const int n = n0 + tid; int row;
                if (n < CTXL) row = ROWS_LAT + b * CTXL + (d ? CTXL - 1 - n : n);
                else { const int m = n - CTXL; row = b * SEQ + (d ? SEQ - 1 - m : m); }
                rws[tid] = row;
                as[tid] = __expf(LOGA[(size_t)row * 8 + d * 4 + h]);
                bs[tid] = BETA[(size_t)row * 8 + d * 4 + h];
            }
            __syncthreads();
            for (int i = tid; i < 4096; i += NTHREADS) {
                const int tok = i >> 7, cc = i & 127; const size_t base = (size_t)rws[tok] * 1536 + h * 128 + cc;
                qs[i] = QKV[base]; ks[i] = QKV[base + 512]; vs[i] = QKV[base + 1024];
            }
            __syncthreads();
            for (int tok = 0; tok < 32; ++tok) {
                float kk[32];
#pragma unroll
                for (int i = 0; i < 8; ++i) { const f32x4 v = *(const LAS f32x4*)(ks + tok * 128 + part * 32 + i * 4); kk[i * 4] = v[0]; kk[i * 4 + 1] = v[1]; kk[i * 4 + 2] = v[2]; kk[i * 4 + 3] = v[3]; }
                float kp = 0.f;
#pragma unroll
                for (int i = 0; i < 32; ++i) kp += kk[i] * S[i];
                kp += shx(kp, 1, lane); kp += shx(kp, 2, lane);
                const float a = as[tok], bt = bs[tok];
                const float bv = bt * (vs[tok * 128 + col] - a * kp);
#pragma unroll
                for (int i = 0; i < 32; ++i) S[i] = a * S[i] + kk[i] * bv;
                float op = 0.f;
#pragma unroll
                for (int i = 0; i < 8; ++i) { const f32x4 v = *(const LAS f32x4*)(qs + tok * 128 + part * 32 + i * 4); op += v[0] * S[i * 4] + v[1] * S[i * 4 + 1] + v[2] * S[i * 4 + 2] + v[3] * S[i * 4 + 3]; }
                op += shx(op, 1, lane); op += shx(op, 2, lane);
                if (part == 0) O[(size_t)rws[tok] * 512 + h * 128 + col] = op;
            }
        }
        __syncthreads();
    }
}

__device__ void phase_onorm(const Params& p, const int l) {
    const int tid = opaque_tid(), wid = tid >> 6, lane = tid & 63;
    const float* OF = (const float*)(p.ws + WS_OF); const float* OB = (const float*)(p.ws + WS_OB);
    const bf16_t* PROJ = (const bf16_t*)(p.ws + WS_PROJ);
    bf16_t* CAT = (bf16_t*)(p.ws + WS_CAT);
    const int c = lane * 8;
    const f32x4 w0 = *(const f32x4*)(p.dn_norm + l * 128 + (c & 127)), w1 = *(const f32x4*)(p.dn_norm + l * 128 + (c & 127) + 4);
    for (int row = blockIdx.x * 8 + wid; row < MT; row += gridDim.x * 8) {
        const size_t o = (size_t)row * 512 + c;
        f32x4 v0 = *(const f32x4*)(OF + o) + *(const f32x4*)(OB + o), v1 = *(const f32x4*)(OF + o + 4) + *(const f32x4*)(OB + o + 4);
        float ss = v0[0] * v0[0] + v0[1] * v0[1] + v0[2] * v0[2] + v0[3] * v0[3] + v1[0] * v1[0] + v1[1] * v1[1] + v1[2] * v1[2] + v1[3] * v1[3];
        ss += shx(ss, 1, lane); ss += shx(ss, 2, lane); ss += shx(ss, 4, lane); ss += shx(ss, 8, lane);
        const float rs = rsqrtf(ss * (1.f / 128.f) + EPS);
        const u32x4 gv = *(const u32x4*)(PROJ + (size_t)row * PN + 1536 + c);
        u32x4 out;
        out[0] = pk_bf16(v0[0] * rs * w0[0] * silu_f(bf_lo(gv[0])), v0[1] * rs * w0[1] * silu_f(bf_hi(gv[0])));
        out[1] = pk_bf16(v0[2] * rs * w0[2] * silu_f(bf_lo(gv[1])), v0[3] * rs * w0[3] * silu_f(bf_hi(gv[1])));
        out[2] = pk_bf16(v1[0] * rs * w1[0] * silu_f(bf_lo(gv[2])), v1[1] * rs * w1[1] * silu_f(bf_hi(gv[2])));
        out[3] = pk_bf16(v1[2] * rs * w1[2] * silu_f(bf_lo(gv[3])), v1[3] * rs * w1[3] * silu_f(bf_hi(gv[3])));
        *(u32x4*)(CAT + (size_t)row * D + c) = out;
    }
}

__device__ void phase_topk(const Params& p, LAS unsigned char* lds) {
    const int tid = opaque_tid();
    LAS unsigned long long* ks = (LAS unsigned long long*)lds;
    const float* AFF = (const float*)(p.ws + WS_AFF);
    int* SEL = (int*)(p.ws + WS_SEL); float* SELAFF = (float*)(p.ws + WS_SELAFF); int* SLOTOF = (int*)(p.ws + WS_SLOTOF);
    for (int u = blockIdx.x; u < 256; u += gridDim.x) {
        int e, n, C, rowbase, slotbase;
        if (u < 128) { e = u >> 3; const int b = u & 7; n = SEQ; C = 256; rowbase = b * SEQ; slotbase = u * 256; }
        else { const int v = u - 128; e = v >> 3; const int b = v & 7; n = CTXL; C = 32; rowbase = ROWS_LAT + b * CTXL; slotbase = (128 + e) * 256 + b * 32; }
        for (int i = tid; i < n; i += NTHREADS) ks[i] = ((unsigned long long)__float_as_uint(AFF[(size_t)(rowbase + i) * 16 + e]) << 32) | (unsigned long long)(0xFFFFFFFFu - (unsigned)i);
        __syncthreads();
        for (int k = 2; k <= n; k <<= 1)
            for (int j = k >> 1; j > 0; j >>= 1) {
                for (int q = tid; q < (n >> 1); q += NTHREADS) {
                    const int i = ((q & ~(j - 1)) << 1) | (q & (j - 1)), i2 = i | j;
                    const unsigned long long a = ks[i], b2 = ks[i2];
                    const bool up = (i & k) == 0;
                    if (up ? (a < b2) : (a > b2)) { ks[i] = b2; ks[i2] = a; }
                }
                __syncthreads();
            }
        for (int i = tid; i < n; i += NTHREADS) {
            const unsigned long long key = ks[i];
            const int t = (int)(0xFFFFFFFFu - (unsigned)(key & 0xFFFFFFFFull));
            SLOTOF[(size_t)(rowbase + t) * 16 + e] = (i < C) ? slotbase + i : -1;
            if (i < C) { SEL[slotbase + i] = rowbase + t; SELAFF[slotbase + i] = __uint_as_float((unsigned)(key >> 32)); }
        }
        __syncthreads();
    }
}


#ifndef DUMP
#define DUMP 0
#endif
#if DUMP
__device__ void phase_dump(const Params& p, const size_t off, const int is_bf16, const size_t n_avail) {
    const int tid = opaque_tid();
    const size_t n = (size_t)ROWS_LAT * D;
    for (size_t i = (size_t)blockIdx.x * NTHREADS + tid; i < n; i += (size_t)gridDim.x * NTHREADS) {
        float v = 0.f;
        if (i < n_avail) v = is_bf16 ? __uint_as_float((unsigned)((const bf16_t*)(p.ws + off))[i] << 16) : ((const float*)(p.ws + off))[i];
        p.out[i] = v;
    }
}
#endif

__global__ void __launch_bounds__(NTHREADS, 2) fwd(const Params p) {
    extern __shared__ __attribute__((aligned(16))) unsigned char smem[];
    LAS unsigned char* lds = (LAS unsigned char*)smem + LDS_OFF;
    XcdBarrier bar; bar.bar = (unsigned*)(p.ws + WS_BAR); bar.x = 0; bar.st = nullptr;
    const bool multi = (p.ph_hi - p.ph_lo) > 1;
    if (multi) {
        if (threadIdx.x == 0) *(LAS u32x4*)((LAS unsigned char*)smem) = (u32x4){0u, 0u, 0u, 0u};
        __syncthreads();
        bar = xcd_barrier_post((unsigned*)(p.ws + WS_BAR), (volatile LAS unsigned*)((LAS unsigned char*)smem));
    }
#if DUMP
    if (p.ph_lo == 100) { phase_dump(p, (size_t)(DUMP_OFF), DUMP_BF16, (size_t)(DUMP_N)); return; }
#endif
    int ph = 0;
#define PHASE(body) do { if (ph >= p.ph_lo && ph < p.ph_hi) { const int l = opaque_s(lv); body; if (ph + 1 < p.ph_hi) xcd_barrier(bar); } ++ph; } while (0)
    int lv = 0;
    PHASE(phase_prologue(p, lds));
    for (lv = 0; lv < DEPTH; ++lv) {
        PHASE(phase_norm<1>(p, l, lds));
        PHASE(phase_gemm<0>(p, l, lds));
#if NAIVE_SCAN
        PHASE(phase_conv_pool(p, l, lds));
        PHASE(phase_scan_naive(p, l, lds));
#else
        PHASE(phase_prep(p, l, lds); phase_conv_pool(p, l, lds));
        PHASE(phase_scan(p, l, lds));
#endif
        PHASE(phase_onorm(p, l));
        PHASE(phase_gemm<1>(p, l, lds));
        PHASE(phase_norm<2>(p, l, lds));
        PHASE(phase_topk(p, lds));
        PHASE(phase_gemm<2>(p, l, lds));
        PHASE(phase_gemm<3>(p, l, lds));
    }
    lv = 0;
    PHASE(phase_norm<3>(p, l, lds));
#undef PHASE
}
constexpr int N_PHASES = 2 + DEPTH * 10;

extern "C" void kernel_launch(void* const* d_in, const int* in_sizes, int n_in, void* d_out, int out_size, void* d_ws, size_t ws_size, hipStream_t stream) {
    static int grid = 0;
    if (grid == 0) {
        if (n_in != 21 || out_size != ROWS_LAT * D || ws_size < WS_END) { fprintf(stderr, "kernel_launch: unexpected shapes (n_in %d out %d ws %zu need %zu)\n", n_in, out_size, ws_size, (size_t)WS_END); grid = -1; return; }
        int dev = 0, cus = 0, per_cu = 0;
        if (hipGetDevice(&dev) != hipSuccess || hipDeviceGetAttribute(&cus, hipDeviceAttributeMultiprocessorCount, dev) != hipSuccess) { grid = -1; return; }
        if (hipFuncSetAttribute((const void*)fwd, hipFuncAttributeMaxDynamicSharedMemorySize, LDS_BYTES) != hipSuccess) { fprintf(stderr, "kernel_launch: hipFuncSetAttribute failed\n"); grid = -1; return; }
        if (hipOccupancyMaxActiveBlocksPerMultiprocessor(&per_cu, (const void*)fwd, NTHREADS, LDS_BYTES) != hipSuccess || per_cu < 1) { fprintf(stderr, "kernel_launch: occupancy query says %d\n", per_cu); per_cu = 1; }
        (void)hipGetLastError();
        grid = cus;
    }
    if (grid < 0) return;
    (void)hipMemsetAsync((char*)d_ws + WS_BAR, 0, 16384, stream);
    Params p; memset(&p, 0, sizeof(p));
    const float** pp = (const float**)&p;
    for (int i = 0; i < 21; ++i) pp[i] = (const float*)d_in[i];
    p.out = (float*)d_out; p.ws = (unsigned char*)d_ws;
#if DUMP
    for (int ph = 0; ph <= DUMP_LAST; ++ph) { p.ph_lo = ph; p.ph_hi = ph + 1; hipLaunchKernelGGL(fwd, dim3(grid), dim3(NTHREADS), LDS_BYTES, stream, p); }
    p.ph_lo = 100; p.ph_hi = 101; hipLaunchKernelGGL(fwd, dim3(grid), dim3(NTHREADS), LDS_BYTES, stream, p);
#elif ONE_LAUNCH
    p.ph_lo = 0; p.ph_hi = N_PHASES;
    hipLaunchKernelGGL(fwd, dim3(grid), dim3(NTHREADS), LDS_BYTES, stream, p);
#else
    for (int ph = 0; ph < N_PHASES; ++ph) { p.ph_lo = ph; p.ph_hi = ph + 1; hipLaunchKernelGGL(fwd, dim3(grid), dim3(NTHREADS), LDS_BYTES, stream, p); }
#endif
}
```

```cpp
#include <hip/hip_runtime.h>
#include <stdint.h>
#include <stdio.h>
#include <string.h>

#ifndef ONE_LAUNCH
#define ONE_LAUNCH 1
#endif
#ifndef NAIVE_SCAN
#define NAIVE_SCAN 0
#endif
#ifndef GEMM8
#define GEMM8 1
#endif
#ifndef REGSTAGE
#define REGSTAGE 0
#endif

#define LAS __attribute__((address_space(3)))
typedef unsigned short bf16_t;
typedef short bf16x8 __attribute__((ext_vector_type(8)));
typedef float f32x4 __attribute__((ext_vector_type(4)));
typedef float f32x2 __attribute__((ext_vector_type(2)));
typedef unsigned u32x2 __attribute__((ext_vector_type(2)));
typedef unsigned u32x4 __attribute__((ext_vector_type(4)));

constexpr int D = 1024, NB = 8, SEQ = 2048, DEPTH = 4, CTXL = 256;
constexpr int ROWS_LAT = NB * SEQ;
constexpr int ROWS_CTX = NB * CTXL;
constexpr int MT = ROWS_LAT + ROWS_CTX;
constexpr int INC = 2576;
constexpr int PN = 2560;
constexpr int NE = 16;
constexpr int NGROUPS = 144;
constexpr int NSLOTS = NGROUPS * 256;
constexpr int NTHREADS = 512;
constexpr float EPS = 1e-6f;

constexpr size_t al256(size_t x) { return (x + 255) & ~(size_t)255; }
constexpr size_t WS_BAR = 0;
constexpr size_t WS_MOD = 16384;
constexpr size_t WS_X = WS_MOD + al256((size_t)DEPTH * 9 * 6144 * 4);
constexpr size_t WS_H = WS_X + (size_t)MT * D * 4;
constexpr size_t WS_PROJ = WS_H + (size_t)MT * D * 2;
constexpr size_t WS_YE = WS_PROJ;
constexpr size_t WS_LOGA = WS_PROJ + (size_t)MT * PN * 2;
constexpr size_t WS_BETA = WS_LOGA + (size_t)MT * 8 * 4;
constexpr size_t WS_QKV = WS_BETA + (size_t)MT * 8 * 4;
constexpr size_t WS_HID = WS_QKV;
constexpr size_t WS_OF = WS_QKV + (NAIVE_SCAN ? (size_t)MT * 1536 * 4 : (size_t)NSLOTS * D * 2);
constexpr size_t WS_OB = WS_OF + (size_t)MT * 512 * 4;
constexpr size_t WS_CAT = WS_OB + (size_t)MT * 512 * 4;
constexpr size_t WS_AFF = WS_CAT + (size_t)MT * D * 2;
constexpr size_t WS_SEL = WS_AFF + (size_t)MT * 16 * 4;
constexpr size_t WS_SELAFF = WS_SEL + (size_t)NSLOTS * 4;
constexpr size_t WS_SLOTOF = WS_SELAFF + (size_t)NSLOTS * 4;
constexpr size_t WS_WINT = WS_SLOTOF + (size_t)MT * 16 * 4;
constexpr size_t WS_WOUTT = WS_WINT + (size_t)DEPTH * PN * D * 2;
constexpr size_t WS_WGUT = WS_WOUTT + (size_t)DEPTH * D * D * 2;
constexpr size_t WS_WDT = WS_WGUT + (size_t)DEPTH * NE * 2048 * D * 2;
constexpr size_t WS_PWT = WS_WDT + (size_t)DEPTH * NE * D * D * 2;
constexpr size_t WS_SCN = WS_PWT + (size_t)DEPTH * 4 * 128 * 128 * 2;
constexpr int REC_W = 0, REC_KT = 16384, REC_QD = 32768, REC_QK = 49152, REC_UT = 57344, REC_MISC = 73728, REC_BYTES = 73984;
constexpr int NCHUNK = 36;
constexpr size_t WS_END = WS_SCN + (size_t)NB * 4 * 2 * NCHUNK * REC_BYTES + 4096;

constexpr int LDS_OFF = 1024;
constexpr int LDS_WORK = 157696;
constexpr int LDS_BYTES = LDS_OFF + LDS_WORK;

struct Params {
    const float *x, *c, *ctx, *c_ctx, *w_mod, *b_mod, *norm1, *norm2, *w_in, *conv_w, *a_log, *dt_bias, *dn_norm, *pool_w, *pool_scale, *w_out, *w_router, *w_gate, *w_up, *w_down, *norm_f;
    float* out;
    unsigned char* ws;
    int ph_lo, ph_hi;
};

#define XB_TMO      128
#define XB_XCNT(j)  (256  + 64 * (j))
#define XB_XSUB(j)  (1280 + 64 * (j))
#define XB_XGEN(j)  (2304 + 64 * (j))
#define XB_TOP      3328
#define XB_TOPGEN   3392
#define XCD_BAR_WORDS 3456
#define XB_SPIN_CAP (1u << 22)

__device__ __forceinline__ unsigned xb_ld(unsigned* p)              { return __hip_atomic_load(p, __ATOMIC_RELAXED, __HIP_MEMORY_SCOPE_AGENT); }
__device__ __forceinline__ unsigned xb_add(unsigned* p, unsigned v) { return __hip_atomic_fetch_add(p, v, __ATOMIC_RELAXED, __HIP_MEMORY_SCOPE_AGENT); }
__device__ __forceinline__ unsigned xb_xcc_id() { return (unsigned)__builtin_amdgcn_s_getreg((3 << 11) | 20) & 0xFu; }
#define XB_SPIN(cond, bar) do { unsigned _sp = 0; while (cond) { __builtin_amdgcn_s_sleep(1); \
    if ((++_sp & 255u) == 0u) { if (xb_ld(&(bar)[XB_TMO])) break; if (_sp > XB_SPIN_CAP) { atomicAdd(&(bar)[XB_TMO], 1u); break; } } } } while (0)

struct XcdBarrier { unsigned* bar; unsigned x; volatile LAS unsigned* st; };

__device__ __forceinline__ XcdBarrier xcd_barrier_post(unsigned* bar, volatile LAS unsigned* st) {
    XcdBarrier b; b.bar = bar; b.x = xb_xcc_id(); b.st = st;
    if (threadIdx.x == 0) (void)xb_add(&bar[XB_XCNT(b.x)], 1u);
    return b;
}
__device__ __forceinline__ void xcd_barrier_complete(unsigned* bar, unsigned x, unsigned& nloc, unsigned& nx) {
    const unsigned G = gridDim.x * gridDim.y * gridDim.z;
    unsigned sum, cnt, mine, sp = 0u;
    for (;;) {
        sum = 0u; cnt = 0u; mine = 0u;
#pragma unroll
        for (unsigned j = 0; j < 16; ++j) { const unsigned c = xb_ld(&bar[XB_XCNT(j)]); sum += c; cnt += (c > 0u) ? 1u : 0u; mine = (j == x) ? c : mine; }
        if (sum == G) break;
        __builtin_amdgcn_s_sleep(1);
        if ((++sp & 255u) == 0u) { if (xb_ld(&bar[XB_TMO])) break; if (sp > XB_SPIN_CAP) { atomicAdd(&bar[XB_TMO], 1u); break; } }
    }
    nloc = mine > 0u ? mine : 1u; nx = cnt > 0u ? cnt : 1u;
}
__device__ __forceinline__ void xcd_barrier(const XcdBarrier& b) {
    asm volatile("s_waitcnt vmcnt(0)" ::: "memory");
    __syncthreads();
    if (threadIdx.x == 0) {
        unsigned* bar = b.bar;
        __builtin_amdgcn_s_waitcnt(0);
        unsigned nloc = b.st[0], nx = b.st[1];
        if (nloc == 0u) { xcd_barrier_complete(bar, b.x, nloc, nx); b.st[0] = nloc; b.st[1] = nx; }
        const unsigned old = xb_add(&bar[XB_XSUB(b.x)], 1u);
        const unsigned gen = old / nloc;
        if (old + 1u == (gen + 1u) * nloc) {
            __builtin_amdgcn_fence(__ATOMIC_RELEASE, "agent");
            asm volatile("s_waitcnt vmcnt(0)" ::: "memory");
            const unsigned og = xb_add(&bar[XB_TOP], 1u);
            const unsigned tg = og / nx;
            if (og + 1u == (tg + 1u) * nx) xb_add(&bar[XB_TOPGEN], 1u);
            else XB_SPIN(xb_ld(&bar[XB_TOPGEN]) == tg, bar);
            __builtin_amdgcn_fence(__ATOMIC_ACQUIRE, "agent");
            xb_add(&bar[XB_XGEN(b.x)], 1u);
            asm volatile("s_waitcnt vmcnt(0)" ::: "memory");
        } else {
            XB_SPIN(xb_ld(&bar[XB_XGEN(b.x)]) == gen, bar);
            __builtin_amdgcn_fence(__ATOMIC_ACQUIRE, "agent");
            asm volatile("s_waitcnt vmcnt(0)" ::: "memory");
        }
    }
    __syncthreads();
}

typedef __bf16 bf16x2_t __attribute__((ext_vector_type(2)));
__device__ __forceinline__ unsigned pk_bf16(float lo, float hi) { const f32x2 v = {lo, hi}; const bf16x2_t b = __builtin_convertvector(v, bf16x2_t); return __builtin_bit_cast(unsigned, b); }
__device__ __forceinline__ float bf_lo(unsigned u) { return __uint_as_float(u << 16); }
__device__ __forceinline__ float bf_hi(unsigned u) { return __uint_as_float(u & 0xffff0000u); }
__device__ __forceinline__ float shx(float v, int mask, int lane) { return __int_as_float(__builtin_amdgcn_ds_bpermute((lane ^ mask) << 2, __float_as_int(v))); }
__device__ __forceinline__ float shup(float v, int o, int lane) { return __int_as_float(__builtin_amdgcn_ds_bpermute(((lane - o) & 63) << 2, __float_as_int(v))); }
__device__ __forceinline__ float wave_sum(float v, int lane) {
#pragma unroll
    for (int o = 32; o > 0; o >>= 1) v += shx(v, o, lane);
    return v;
}
__device__ __forceinline__ int opaque_tid() { int t = threadIdx.x; asm volatile("" : "+v"(t)); return t; }
__device__ __forceinline__ int opaque_s(int v) { asm volatile("" : "+s"(v)); return v; }
__device__ __forceinline__ float silu_f(float v) { return v / (1.f + __expf(-v)); }

__device__ __forceinline__ int lds_byte(int r, int c) { const int st = (r >> 4) * 2 + (c >> 5), rr = r & 15, cc = c & 31, ob = rr * 64 + cc * 2; return st * 1024 + (ob ^ (((ob >> 9) & 1) << 5)); }
__device__ __forceinline__ void stage_rc(int b, int& R, int& C) { const int st = b >> 10, sb = b & 1023, swz = sb ^ (((sb >> 9) & 1) << 5); R = (st >> 1) * 16 + (swz >> 6); C = (st & 1) * 32 + ((swz & 63) >> 1); }

__device__ void phase_prologue(const Params& p, LAS unsigned char* lds) {
    const int tid = opaque_tid();
    {
        LAS float* sc = (LAS float*)lds;
        LAS float* red = sc + 9 * 1024;
        for (int idx = tid; idx < 9 * 1024; idx += NTHREADS) {
            const int r = idx >> 10, k = idx & 1023;
            const float v = r < 8 ? p.c[r * 1024 + k] : p.c_ctx[k];
            sc[idx] = silu_f(v);
        }
        __syncthreads();
        float* MOD = (float*)(p.ws + WS_MOD);
        for (int u = blockIdx.x; u < DEPTH * 96; u += gridDim.x) {
            const int l = u / 96, c0 = (u % 96) * 64, col = tid & 63, kg = tid >> 6;
            float acc[9];
#pragma unroll
            for (int r = 0; r < 9; ++r) acc[r] = 0.f;
            const float* W = p.w_mod + (size_t)l * 1024 * 6144 + c0 + col;
#pragma unroll 4
            for (int kk = 0; kk < 128; ++kk) {
                const int k = kg * 128 + kk;
                const float w = W[(size_t)k * 6144];
#pragma unroll
                for (int r = 0; r < 9; ++r) acc[r] += sc[r * 1024 + k] * w;
            }
#pragma unroll
            for (int r = 0; r < 9; ++r) red[(kg * 9 + r) * 64 + col] = acc[r];
            __syncthreads();
            for (int idx = tid; idx < 576; idx += NTHREADS) {
                const int r = idx >> 6, cc = idx & 63;
                float s = 0.f;
#pragma unroll
                for (int g = 0; g < 8; ++g) s += red[(g * 9 + r) * 64 + cc];
                MOD[((size_t)l * 9 + r) * 6144 + c0 + cc] = s + p.b_mod[l * 6144 + c0 + cc];
            }
            __syncthreads();
        }
    }
    {
        f32x4* X4 = (f32x4*)(p.ws + WS_X);
        const f32x4* x4 = (const f32x4*)p.x; const f32x4* c4 = (const f32x4*)p.ctx;
        const int nlat = ROWS_LAT * D / 4, ntot = MT * D / 4;
        for (int i = blockIdx.x * NTHREADS + tid; i < ntot; i += gridDim.x * NTHREADS) X4[i] = i < nlat ? x4[i] : c4[i - nlat];
    }
    {
        LAS float* tile = (LAS float*)lds;
        bf16_t* WINT = (bf16_t*)(p.ws + WS_WINT); bf16_t* WOUTT = (bf16_t*)(p.ws + WS_WOUTT); bf16_t* WGUT = (bf16_t*)(p.ws + WS_WGUT); bf16_t* WDT = (bf16_t*)(p.ws + WS_WDT);
        constexpr int T_IN = 10 * 16, T_OUT = 4 * 16, T_EXP = NE * 4 * 16, T_LAYER = T_IN + T_OUT + 3 * T_EXP;
        for (int t = blockIdx.x; t < DEPTH * T_LAYER; t += gridDim.x) {
            const int l = t / T_LAYER; int i = t % T_LAYER;
            const float* src; size_t sld; bf16_t* dst; int rs = 16;
            if (i < T_IN) { const int nt = i >> 4, kt = i & 15; const int n0 = nt < 6 ? nt * 256 : 1552 + (nt - 6) * 256;
                src = p.w_in + ((size_t)l * D + kt * 64) * INC + n0; sld = INC; dst = WINT + ((size_t)l * PN + nt * 256) * D + kt * 64; }
            else if (i < T_IN + T_OUT) { i -= T_IN; const int nt = i >> 4, kt = i & 15;
                src = p.w_out + ((size_t)l * D + kt * 64) * D + nt * 256; sld = D; dst = WOUTT + ((size_t)l * D + nt * 256) * D + kt * 64; }
            else { i -= T_IN + T_OUT; const int which = i / T_EXP; i %= T_EXP; const int e = i >> 6, nt = (i >> 4) & 3, kt = i & 15;
                const size_t mo = ((size_t)(l * NE + e) * D + kt * 64) * D + nt * 256;
                if (which == 2) { src = p.w_down + mo; dst = WDT + ((size_t)(l * NE + e) * D + nt * 256) * D + kt * 64; }
                else { src = (which == 0 ? p.w_gate : p.w_up) + mo; rs = 32; dst = WGUT + ((size_t)(l * NE + e) * 2048 + nt * 512 + which * 16) * D + kt * 64; }
                sld = D; }
#pragma unroll
            for (int j = 0; j < 8; ++j) {
                const int e = tid * 4 + j * 2048, k = e >> 8, n = e & 255;
                const f32x4 v = *(const f32x4*)(src + (size_t)k * sld + n);
                tile[k * 257 + n] = v[0]; tile[k * 257 + n + 1] = v[1]; tile[k * 257 + n + 2] = v[2]; tile[k * 257 + n + 3] = v[3];
            }
            __syncthreads();
#pragma unroll
            for (int ps = 0; ps < 4; ++ps) {
                const int n = ps * 64 + (tid >> 3), ks = (tid & 7) * 8;
                u32x4 o;
                o[0] = pk_bf16(tile[(ks + 0) * 257 + n], tile[(ks + 1) * 257 + n]); o[1] = pk_bf16(tile[(ks + 2) * 257 + n], tile[(ks + 3) * 257 + n]);
                o[2] = pk_bf16(tile[(ks + 4) * 257 + n], tile[(ks + 5) * 257 + n]); o[3] = pk_bf16(tile[(ks + 6) * 257 + n], tile[(ks + 7) * 257 + n]);
                *(u32x4*)(dst + (size_t)((n >> 4) * rs + (n & 15)) * D + ks) = o;
            }
            __syncthreads();
        }
        bf16_t* PWT = (bf16_t*)(p.ws + WS_PWT);
        for (int i = blockIdx.x * NTHREADS + tid; i < DEPTH * 4 * 128 * 128; i += gridDim.x * NTHREADS) {
            const int lg = i >> 14, d = (i >> 7) & 127, c = i & 127;
            PWT[i] = (bf16_t)(pk_bf16(p.pool_w[((size_t)lg * 128 + c) * 128 + d], 0.f) & 0xffffu);
        }
    }
}

__device__ __forceinline__ float reduce4(const float v0, const float v1, const float v2, const float v3, const int lane) {
    const bool b5 = lane & 32, b4 = lane & 16;
    const float a0 = (b5 ? v2 : v0) + shx(b5 ? v0 : v2, 32, lane), a1 = (b5 ? v3 : v1) + shx(b5 ? v1 : v3, 32, lane);
    float c = (b4 ? a1 : a0) + shx(b4 ? a0 : a1, 16, lane);
    c += shx(c, 8, lane); c += shx(c, 4, lane); c += shx(c, 2, lane); c += shx(c, 1, lane);
    return c;
}

template <int WHICH>
__device__ void phase_norm(const Params& p, const int l, LAS unsigned char* lds) {
    const int tid = opaque_tid(), wid = tid >> 6, lane = tid & 63;
    LAS float* wsm = (LAS float*)lds;
    if (WHICH != 3) {
        const float* src; int stride;
        if (WHICH == 1) { src = p.w_in + (size_t)l * D * INC + 1536; stride = INC; } else { src = p.w_router + (size_t)l * D * NE; stride = NE; }
        for (int idx = tid; idx < 16 * 1024; idx += NTHREADS) { const int k = idx >> 4, j = idx & 15; wsm[j * 1024 + k] = src[(size_t)k * stride + j]; }
        __syncthreads();
    }
    const float* nw = WHICH == 1 ? p.norm1 + l * D : (WHICH == 2 ? p.norm2 + l * D : p.norm_f);
    float* X = (float*)(p.ws + WS_X);
    const float* MOD = (const float*)(p.ws + WS_MOD);
    bf16_t* H = (bf16_t*)(p.ws + WS_H);
    const int nrows = (WHICH == 3) ? ROWS_LAT : MT;
    constexpr int R = 3;
    const int rstride = gridDim.x * 8;
    const bool comb = (WHICH == 1 && l > 0) || WHICH == 3;
    for (int base = blockIdx.x * 8 + wid; base < nrows; base += rstride * R) {
        f32x4 xv[R][4]; int sv[R]; bool ok[R];
#pragma unroll
        for (int k = 0; k < R; ++k) {
            const int row = base + k * rstride; ok[k] = row < nrows; sv[k] = -1;
            if (ok[k]) {
                const float* xr = X + (size_t)row * D;
#pragma unroll
                for (int i = 0; i < 4; ++i) xv[k][i] = *(const f32x4*)(xr + i * 256 + lane * 4);
                if (comb && lane < 16) sv[k] = ((const int*)(p.ws + WS_SLOTOF))[(size_t)row * 16 + lane];
            } else {
#pragma unroll
                for (int i = 0; i < 4; ++i) xv[k][i] = (f32x4){0.f, 0.f, 0.f, 0.f};
            }
        }
        if (comb) {
            const int lp = (WHICH == 3) ? DEPTH - 1 : l - 1;
            const bf16_t* YE = (const bf16_t*)(p.ws + WS_YE);
            f32x4 a[R][4]; unsigned long long msk[R];
#pragma unroll
            for (int k = 0; k < R; ++k) { msk[k] = __ballot(sv[k] >= 0);
#pragma unroll
                for (int i = 0; i < 4; ++i) a[k][i] = (f32x4){0.f, 0.f, 0.f, 0.f}; }
            while (msk[0] | msk[1] | msk[2]) {
                u32x2 t[R][4]; bool has[R];
#pragma unroll
                for (int k = 0; k < R; ++k) {
                    has[k] = msk[k] != 0ull;
                    if (has[k]) {
                        const int e = __builtin_ctzll(msk[k]); msk[k] &= msk[k] - 1ull;
                        const int sl = __builtin_amdgcn_readlane(sv[k], e);
                        const bf16_t* yr = YE + (size_t)sl * D;
#pragma unroll
                        for (int i = 0; i < 4; ++i) t[k][i] = *(const u32x2*)(yr + i * 256 + lane * 4);
                    }
                }
#pragma unroll
                for (int k = 0; k < R; ++k) if (has[k]) {
#pragma unroll
                    for (int i = 0; i < 4; ++i) { a[k][i][0] += bf_lo(t[k][i][0]); a[k][i][1] += bf_hi(t[k][i][0]); a[k][i][2] += bf_lo(t[k][i][1]); a[k][i][3] += bf_hi(t[k][i][1]); }
                }
            }
#pragma unroll
            for (int k = 0; k < R; ++k) if (ok[k]) {
                const int row = base + k * rstride, bidx = row < ROWS_LAT ? (row >> 11) : 8;
                const float* g2 = MOD + ((size_t)lp * 9 + bidx) * 6144 + 5 * 1024;
#pragma unroll
                for (int i = 0; i < 4; ++i) { const f32x4 g = *(const f32x4*)(g2 + i * 256 + lane * 4); xv[k][i] += g * a[k][i];
                    if (WHICH == 1) *(f32x4*)(X + (size_t)row * D + i * 256 + lane * 4) = xv[k][i]; }
            }
        }
        float rstd[R];
#pragma unroll
        for (int k = 0; k < R; ++k) {
            float ss = 0.f;
#pragma unroll
            for (int i = 0; i < 4; ++i) ss += xv[k][i][0] * xv[k][i][0] + xv[k][i][1] * xv[k][i][1] + xv[k][i][2] * xv[k][i][2] + xv[k][i][3] * xv[k][i][3];
            rstd[k] = rsqrtf(wave_sum(ss, lane) * (1.f / 1024.f) + EPS);
        }
        if (WHICH == 3) {
#pragma unroll
            for (int k = 0; k < R; ++k) if (ok[k]) {
                const int row = base + k * rstride;
#pragma unroll
                for (int i = 0; i < 4; ++i) { const f32x4 w = *(const f32x4*)(nw + i * 256 + lane * 4); *(f32x4*)(p.out + (size_t)row * D + i * 256 + lane * 4) = xv[k][i] * rstd[k] * w; }
            }
            continue;
        }
#pragma unroll
        for (int k = 0; k < R; ++k) {
            const int row = base + k * rstride, bidx = row < ROWS_LAT ? (row >> 11) : 8;
            const float* md = MOD + ((size_t)l * 9 + bidx) * 6144 + (WHICH == 1 ? 0 : 3072);
#pragma unroll
            for (int i = 0; i < 4; ++i) {
                const int c = i * 256 + lane * 4;
                const f32x4 w = *(const f32x4*)(nw + c), sh = *(const f32x4*)(md + c), scl = *(const f32x4*)(md + 1024 + c);
                xv[k][i] = (xv[k][i] * rstd[k] * w) * (scl + 1.f) + sh;
                if (ok[k]) { u32x2 o; o[0] = pk_bf16(xv[k][i][0], xv[k][i][1]); o[1] = pk_bf16(xv[k][i][2], xv[k][i][3]); *(u32x2*)(H + (size_t)row * D + c) = o; }
            }
        }
        float dj[R][4];
#pragma unroll
        for (int jg = 0; jg < 4; ++jg) {
            float sp[R][4];
#pragma unroll
            for (int jj = 0; jj < 4; ++jj) {
                const int j = jg * 4 + jj;
                float s0 = 0.f, s1 = 0.f, s2 = 0.f;
#pragma unroll
                for (int i = 0; i < 4; ++i) { const f32x4 w = *(const LAS f32x4*)(wsm + j * 1024 + i * 256 + lane * 4);
                    s0 += xv[0][i][0] * w[0] + xv[0][i][1] * w[1] + xv[0][i][2] * w[2] + xv[0][i][3] * w[3];
                    s1 += xv[1][i][0] * w[0] + xv[1][i][1] * w[1] + xv[1][i][2] * w[2] + xv[1][i][3] * w[3];
                    s2 += xv[2][i][0] * w[0] + xv[2][i][1] * w[1] + xv[2][i][2] * w[2] + xv[2][i][3] * w[3]; }
                sp[0][jj] = s0; sp[1][jj] = s1; sp[2][jj] = s2;
            }
#pragma unroll
            for (int k = 0; k < R; ++k) dj[k][jg] = reduce4(sp[k][0], sp[k][1], sp[k][2], sp[k][3], lane);
            __builtin_amdgcn_sched_barrier(0);
        }
        const int q = lane >> 4;
#pragma unroll
        for (int k = 0; k < R; ++k) {
            const int row = base + k * rstride;
            if (WHICH == 1) {
                if (ok[k] && (lane & 15) == 0) {
#pragma unroll
                    for (int jg = 0; jg < 4; ++jg) {
                        const int j = jg * 4 + q; const float v = dj[k][jg];
                        if (jg < 2) { const float xa = v + p.dt_bias[l * 8 + j]; const float sp2 = xa > 20.f ? xa : log1pf(__expf(xa));
                            ((float*)(p.ws + WS_LOGA))[(size_t)row * 8 + j] = -__expf(p.a_log[l * 8 + j]) * sp2; }
                        else ((float*)(p.ws + WS_BETA))[(size_t)row * 8 + (j - 8)] = 1.f / (1.f + __expf(-v));
                    }
                }
            } else {
                float m = fmaxf(fmaxf(dj[k][0], dj[k][1]), fmaxf(dj[k][2], dj[k][3]));
                m = fmaxf(m, shx(m, 16, lane)); m = fmaxf(m, shx(m, 32, lane));
                float e[4], sum = 0.f;
#pragma unroll
                for (int jg = 0; jg < 4; ++jg) { e[jg] = __expf(dj[k][jg] - m); sum += e[jg]; }
                sum += shx(sum, 16, lane); sum += shx(sum, 32, lane);
                const float inv = 1.f / sum;
                if (ok[k] && (lane & 15) == 0) {
#pragma unroll
                    for (int jg = 0; jg < 4; ++jg) ((float*)(p.ws + WS_AFF))[(size_t)row * 16 + jg * 4 + q] = e[jg] * inv;
                }
            }
        }
    }
}

__device__ __forceinline__ void gemm_core(const unsigned char* Ab, const unsigned (&aoff)[4], const unsigned char* Bb, const unsigned (&boff)[2], const int nt,
                                          LAS unsigned char* lds, f32x4 (&acc)[4][4], const int wid, const int lane) {
    const int wr = wid >> 1, wc = wid & 1, fr = lane & 15, fq = lane >> 4;
    const int ar = lds_byte(wr * 64 + fr, fq * 8), br = lds_byte(wc * 64 + fr, fq * 8);
    const unsigned ldsw = (unsigned)wid * 1024u;
#define G_STAGE(t, buf) do { const unsigned _ko = (unsigned)(t) * 128u; \
        _Pragma("unroll") for (int _i = 0; _i < 4; ++_i) __builtin_amdgcn_global_load_lds((const unsigned*)(Ab + aoff[_i] + _ko), (LAS unsigned*)(lds + (buf) * 49152 + ldsw + _i * 8192), 16, 0, 0); \
        _Pragma("unroll") for (int _i = 0; _i < 2; ++_i) __builtin_amdgcn_global_load_lds((const unsigned*)(Bb + boff[_i] + _ko), (LAS unsigned*)(lds + (buf) * 49152 + 32768 + ldsw + _i * 8192), 16, 0, 0); } while (0)
#pragma unroll
    for (int m = 0; m < 4; ++m)
#pragma unroll
        for (int n = 0; n < 4; ++n) acc[m][n] = (f32x4){0.f, 0.f, 0.f, 0.f};
#if REGSTAGE
    u32x4 ra[4], rb[2];
#pragma unroll
    for (int i = 0; i < 4; ++i) ra[i] = *(const u32x4*)(Ab + aoff[i]);
#pragma unroll
    for (int i = 0; i < 2; ++i) rb[i] = *(const u32x4*)(Bb + boff[i]);
    const unsigned tb = (unsigned)(wid * 64 + lane) * 16u;
    for (int t = 0; t < nt; ++t) {
        __syncthreads();
#pragma unroll
        for (int i = 0; i < 4; ++i) *(LAS u32x4*)(lds + tb + i * 8192) = ra[i];
#pragma unroll
        for (int i = 0; i < 2; ++i) *(LAS u32x4*)(lds + 32768 + tb + i * 8192) = rb[i];
        __syncthreads();
        if (t + 1 < nt) {
            const unsigned ko = (unsigned)(t + 1) * 128u;
#pragma unroll
            for (int i = 0; i < 4; ++i) ra[i] = *(const u32x4*)(Ab + aoff[i] + ko);
#pragma unroll
            for (int i = 0; i < 2; ++i) rb[i] = *(const u32x4*)(Bb + boff[i] + ko);
        }
        LAS unsigned char* bA = lds; LAS unsigned char* bB = bA + 32768;
        bf16x8 af[4][2], bfr[4][2];
#pragma unroll
        for (int m = 0; m < 4; ++m)
#pragma unroll
            for (int k = 0; k < 2; ++k) af[m][k] = *(const LAS bf16x8*)(bA + ar + m * 2048 + k * 1024);
#pragma unroll
        for (int n = 0; n < 4; ++n)
#pragma unroll
            for (int k = 0; k < 2; ++k) bfr[n][k] = *(const LAS bf16x8*)(bB + br + n * 2048 + k * 1024);
#pragma unroll
        for (int k = 0; k < 2; ++k)
#pragma unroll
            for (int m = 0; m < 4; ++m)
#pragma unroll
                for (int n = 0; n < 4; ++n) acc[m][n] = __builtin_amdgcn_mfma_f32_16x16x32_bf16(bfr[n][k], af[m][k], acc[m][n], 0, 0, 0);
    }
#else
    G_STAGE(0, 0);
    for (int t = 0; t < nt; ++t) {
        asm volatile("s_waitcnt vmcnt(0)" ::: "memory");
        __syncthreads();
        if (t + 1 < nt) { if ((t + 1) & 1) G_STAGE(t + 1, 1); else G_STAGE(t + 1, 0); }
        LAS unsigned char* bA = lds + (t & 1) * 49152; LAS unsigned char* bB = bA + 32768;
        bf16x8 af[4][2], bfr[4][2];
#pragma unroll
        for (int m = 0; m < 4; ++m)
#pragma unroll
            for (int k = 0; k < 2; ++k) af[m][k] = *(const LAS bf16x8*)(bA + ar + m * 2048 + k * 1024);
#pragma unroll
        for (int n = 0; n < 4; ++n)
#pragma unroll
            for (int k = 0; k < 2; ++k) bfr[n][k] = *(const LAS bf16x8*)(bB + br + n * 2048 + k * 1024);
#pragma unroll
        for (int k = 0; k < 2; ++k)
#pragma unroll
            for (int m = 0; m < 4; ++m)
#pragma unroll
                for (int n = 0; n < 4; ++n) acc[m][n] = __builtin_amdgcn_mfma_f32_16x16x32_bf16(bfr[n][k], af[m][k], acc[m][n], 0, 0, 0);
    }
#endif
    __syncthreads();
#undef G_STAGE
}

template <int MODE>
__device__ void phase_gemm(const Params& p, const int l, LAS unsigned char* lds) {
    const int tid = opaque_tid(), wid = __builtin_amdgcn_readfirstlane(tid >> 6), lane = tid & 63;
    const int wr = wid >> 1, wc = wid & 1, fr = lane & 15, fq = lane >> 4;
    int R0, C0; stage_rc(tid * 16, R0, C0);
    constexpr int nN = MODE == 0 ? 20 : (MODE == 1 ? 8 : (MODE == 2 ? 16 : 8));
    constexpr int nM = (MODE <= 1) ? MT / 256 : NGROUPS;
    const bf16_t* H = (const bf16_t*)(p.ws + WS_H);
    for (int u = blockIdx.x; u < nM * nN; u += gridDim.x) {
        const int pm = u / nN, pn = u % nN;
        const unsigned char* Ab; const unsigned char* Bb; unsigned aoff[4], boff[2];
#pragma unroll
        for (int i = 0; i < 2; ++i) boff[i] = (unsigned)((R0 + 64 * i) * D + C0) * 2u;
        int e = 0;
        if (MODE == 0) {
            Ab = (const unsigned char*)(H + (size_t)pm * 256 * D); Bb = (const unsigned char*)((const bf16_t*)(p.ws + WS_WINT) + ((size_t)l * PN + pn * 128) * D);
#pragma unroll
            for (int i = 0; i < 4; ++i) aoff[i] = (unsigned)((R0 + 64 * i) * D + C0) * 2u;
        } else if (MODE == 1) {
            Ab = (const unsigned char*)((const bf16_t*)(p.ws + WS_CAT) + (size_t)pm * 256 * D); Bb = (const unsigned char*)((const bf16_t*)(p.ws + WS_WOUTT) + ((size_t)l * D + pn * 128) * D);
#pragma unroll
            for (int i = 0; i < 4; ++i) aoff[i] = (unsigned)((R0 + 64 * i) * D + C0) * 2u;
        } else if (MODE == 2) {
            e = pm < 128 ? (pm >> 3) : (pm - 128);
            const int* SEL = (const int*)(p.ws + WS_SEL) + pm * 256;
            Ab = (const unsigned char*)H; Bb = (const unsigned char*)((const bf16_t*)(p.ws + WS_WGUT) + ((size_t)(l * NE + e) * 2048 + pn * 128) * D);
#pragma unroll
            for (int i = 0; i < 4; ++i) aoff[i] = (unsigned)(SEL[R0 + 64 * i] * D + C0) * 2u;
        } else {
            e = pm < 128 ? (pm >> 3) : (pm - 128);
            Ab = (const unsigned char*)((const bf16_t*)(p.ws + WS_HID) + (size_t)pm * 256 * D); Bb = (const unsigned char*)((const bf16_t*)(p.ws + WS_WDT) + ((size_t)(l * NE + e) * D + pn * 128) * D);
#pragma unroll
            for (int i = 0; i < 4; ++i) aoff[i] = (unsigned)((R0 + 64 * i) * D + C0) * 2u;
        }
        f32x4 acc[4][4];
        gemm_core(Ab, aoff, Bb, boff, D / 64, lds, acc, wid, lane);
        if (MODE == 0) {
            bf16_t* PROJ = (bf16_t*)(p.ws + WS_PROJ);
#pragma unroll
            for (int m = 0; m < 4; ++m) { const size_t row = (size_t)pm * 256 + wr * 64 + m * 16 + fr;
#pragma unroll
                for (int n = 0; n < 4; ++n) { u32x2 o; o[0] = pk_bf16(acc[m][n][0], acc[m][n][1]); o[1] = pk_bf16(acc[m][n][2], acc[m][n][3]);
                    *(u32x2*)(PROJ + row * PN + pn * 128 + wc * 64 + n * 16 + fq * 4) = o; } }
        } else if (MODE == 1) {
            float* X = (float*)(p.ws + WS_X);
            const int bidx = pm < 64 ? (pm >> 3) : 8;
            const float* g1 = (const float*)(p.ws + WS_MOD) + ((size_t)l * 9 + bidx) * 6144 + 2048;
#pragma unroll
            for (int n = 0; n < 4; ++n) { const int col = pn * 128 + wc * 64 + n * 16 + fq * 4; const f32x4 g = *(const f32x4*)(g1 + col);
#pragma unroll
                for (int m = 0; m < 4; ++m) { float* xp = X + ((size_t)pm * 256 + wr * 64 + m * 16 + fr) * D + col; *(f32x4*)xp = *(const f32x4*)xp + g * acc[m][n]; } }
        } else if (MODE == 2) {
            bf16_t* HID = (bf16_t*)(p.ws + WS_HID);
#pragma unroll
            for (int m = 0; m < 4; ++m) { const size_t slot = (size_t)pm * 256 + wr * 64 + m * 16 + fr;
#pragma unroll
                for (int q = 0; q < 2; ++q) { const f32x4 g = acc[m][2 * q], uu = acc[m][2 * q + 1];
                    u32x2 o; o[0] = pk_bf16(silu_f(g[0]) * uu[0], silu_f(g[1]) * uu[1]); o[1] = pk_bf16(silu_f(g[2]) * uu[2], silu_f(g[3]) * uu[3]);
                    *(u32x2*)(HID + slot * D + pn * 64 + wc * 32 + q * 16 + fq * 4) = o; } }
        } else {
            bf16_t* YE = (bf16_t*)(p.ws + WS_YE);
            const float* SELAFF = (const float*)(p.ws + WS_SELAFF);
#pragma unroll
            for (int m = 0; m < 4; ++m) { const size_t slot = (size_t)pm * 256 + wr * 64 + m * 16 + fr; const float a = SELAFF[slot];
#pragma unroll
                for (int n = 0; n < 4; ++n) { u32x2 o; o[0] = pk_bf16(acc[m][n][0] * a, acc[m][n][1] * a); o[1] = pk_bf16(acc[m][n][2] * a, acc[m][n][3] * a);
                    *(u32x2*)(YE + slot * D + pn * 128 + wc * 64 + n * 16 + fq * 4) = o; } }
        }
    }
}

struct UnitOps { const unsigned char* A; const unsigned char* B; unsigned va[2][2]; int pm, pn; };

template <int MODE>
__device__ __forceinline__ bool gemm_unit(const Params& p, const int l, const int i, const int R0, const int C0, UnitOps& u) {
    constexpr int nN = MODE == 0 ? 10 : (MODE == 1 ? 4 : (MODE == 2 ? 8 : 4));
    constexpr int nM = (MODE <= 1) ? MT / 256 : NGROUPS;
    const int idx = blockIdx.x + i * gridDim.x;
    if (idx >= nM * nN) return false;
    const int pm = idx / nN, pn = idx % nN;
    u.pm = pm; u.pn = pn;
    if (MODE == 2) {
        const int e = pm < 128 ? (pm >> 3) : (pm - 128);
        const int* SEL = (const int*)(p.ws + WS_SEL) + pm * 256;
        u.A = p.ws + WS_H; u.B = p.ws + WS_WGUT + ((size_t)(l * NE + e) * 2048 + pn * 256) * D * 2;
#pragma unroll
        for (int h = 0; h < 2; ++h)
#pragma unroll
            for (int k = 0; k < 2; ++k) u.va[h][k] = (unsigned)(SEL[h * 128 + R0 + 64 * k] * D + C0) * 2u;
    } else {
        if (MODE == 0) { u.A = p.ws + WS_H + (size_t)pm * 256 * D * 2; u.B = p.ws + WS_WINT + ((size_t)l * PN + pn * 256) * D * 2; }
        else if (MODE == 1) { u.A = p.ws + WS_CAT + (size_t)pm * 256 * D * 2; u.B = p.ws + WS_WOUTT + ((size_t)l * D + pn * 256) * D * 2; }
        else { const int e = pm < 128 ? (pm >> 3) : (pm - 128); u.A = p.ws + WS_HID + (size_t)pm * 256 * D * 2; u.B = p.ws + WS_WDT + ((size_t)(l * NE + e) * D + pn * 256) * D * 2; }
#pragma unroll
        for (int h = 0; h < 2; ++h)
#pragma unroll
            for (int k = 0; k < 2; ++k) u.va[h][k] = (unsigned)((h * 128 + R0 + 64 * k) * D + C0) * 2u;
    }
    return true;
}

template <int MODE>
__device__ __forceinline__ void gemm_epilogue(const Params& p, const int l, const f32x4 (&acc)[2][2][4][2], const UnitOps& u, const int wr, const int wc, const int fr, const int fq) {
    const int row0 = u.pm * 256 + wr * 64 + fr, col0 = u.pn * 256 + wc * 32 + 4 * fq;
    if (MODE == 0) {
        bf16_t* PROJ = (bf16_t*)(p.ws + WS_PROJ);
#pragma unroll
        for (int ai = 0; ai < 2; ++ai)
#pragma unroll
            for (int m = 0; m < 4; ++m) { bf16_t* rp = PROJ + (size_t)(row0 + ai * 128 + m * 16) * PN + col0;
#pragma unroll
                for (int bj = 0; bj < 2; ++bj)
#pragma unroll
                    for (int n = 0; n < 2; ++n) { const f32x4 v = acc[ai][bj][m][n]; u32x2 o; o[0] = pk_bf16(v[0], v[1]); o[1] = pk_bf16(v[2], v[3]); *(u32x2*)(rp + bj * 128 + n * 16) = o; } }
    } else if (MODE == 1) {
        float* X = (float*)(p.ws + WS_X);
        const int bidx = u.pm < 64 ? (u.pm >> 3) : 8;
        const float* g1 = (const float*)(p.ws + WS_MOD) + ((size_t)l * 9 + bidx) * 6144 + 2048 + col0;
        f32x4 gv[2][2];
#pragma unroll
        for (int bj = 0; bj < 2; ++bj)
#pragma unroll
            for (int n = 0; n < 2; ++n) gv[bj][n] = *(const f32x4*)(g1 + bj * 128 + n * 16);
#pragma unroll
        for (int ai = 0; ai < 2; ++ai)
#pragma unroll
            for (int m = 0; m < 4; ++m) { float* rp = X + (size_t)(row0 + ai * 128 + m * 16) * D + col0;
#pragma unroll
                for (int bj = 0; bj < 2; ++bj)
#pragma unroll
                    for (int n = 0; n < 2; ++n) { float* xp = rp + bj * 128 + n * 16; *(f32x4*)xp = *(const f32x4*)xp + gv[bj][n] * acc[ai][bj][m][n]; } }
    } else if (MODE == 2) {
        bf16_t* HID = (bf16_t*)(p.ws + WS_HID);
        const int f0 = u.pn * 128 + wc * 16 + 4 * fq;
#pragma unroll
        for (int ai = 0; ai < 2; ++ai)
#pragma unroll
            for (int m = 0; m < 4; ++m) { bf16_t* rp = HID + (size_t)(row0 + ai * 128 + m * 16) * D + f0;
#pragma unroll
                for (int bj = 0; bj < 2; ++bj) { const f32x4 g = acc[ai][bj][m][0], uu = acc[ai][bj][m][1];
                    u32x2 o; o[0] = pk_bf16(silu_f(g[0]) * uu[0], silu_f(g[1]) * uu[1]); o[1] = pk_bf16(silu_f(g[2]) * uu[2], silu_f(g[3]) * uu[3]);
                    *(u32x2*)(rp + bj * 64) = o; } }
    } else {
        bf16_t* YE = (bf16_t*)(p.ws + WS_YE);
        const float* SELAFF = (const float*)(p.ws + WS_SELAFF);
#pragma unroll
        for (int ai = 0; ai < 2; ++ai)
#pragma unroll
            for (int m = 0; m < 4; ++m) { const size_t slot = (size_t)(row0 + ai * 128 + m * 16); const float a = SELAFF[slot]; bf16_t* rp = YE + slot * D + col0;
#pragma unroll
                for (int bj = 0; bj < 2; ++bj)
#pragma unroll
                    for (int n = 0; n < 2; ++n) { const f32x4 v = acc[ai][bj][m][n]; u32x2 o; o[0] = pk_bf16(v[0] * a, v[1] * a); o[1] = pk_bf16(v[2] * a, v[3] * a); *(u32x2*)(rp + bj * 128 + n * 16) = o; } }
    }
}

template <int MODE>
__device__ void phase_gemm8(const Params& p, const int l, LAS unsigned char* lds) {
    const int tid = opaque_tid(), wid = __builtin_amdgcn_readfirstlane(tid >> 6), lane = tid & 63, wr = wid >> 2, wc = wid & 3, fr = lane & 15, fq = lane >> 4;
    constexpr int HTB = 16384;
    constexpr int nt = D / 64;
    constexpr unsigned kstep = 128u, hstepB = 128u * D * 2u;
    int R0, C0; stage_rc(tid * 16, R0, C0);
    unsigned vb[2];
#pragma unroll
    for (int k = 0; k < 2; ++k) vb[k] = (unsigned)((R0 + 64 * k) * D + C0) * 2u;
    const unsigned ldsw = (unsigned)wid * 1024u;
    const int aoff = lds_byte(wr * 64 + fr, fq * 8), boff = lds_byte(wc * 32 + fr, fq * 8);
#define G8_SA(b, h) (((b) * 2 + (h)) * HTB)
#define G8_SB(b, h) ((4 + (b) * 2 + (h)) * HTB)
#define G8_STAGE_A(bufoff, U, h, ko) do { _Pragma("unroll") for (int _i = 0; _i < 2; ++_i) \
        __builtin_amdgcn_global_load_lds((const unsigned*)((U).A + (U).va[h][_i] + (ko)), (LAS unsigned*)(lds + (bufoff) + ldsw + _i * 8192), 16, 0, 0); } while (0)
#define G8_STAGE_B(bufoff, U, h, ko) do { _Pragma("unroll") for (int _i = 0; _i < 2; ++_i) \
        __builtin_amdgcn_global_load_lds((const unsigned*)((U).B + vb[_i] + (h) * hstepB + (ko)), (LAS unsigned*)(lds + (bufoff) + ldsw + _i * 8192), 16, 0, 0); } while (0)
#define G8_LDA(dst, b, h) do { _Pragma("unroll") for (int m = 0; m < 4; ++m) _Pragma("unroll") for (int k = 0; k < 2; ++k) dst[m][k] = *(const LAS bf16x8*)(lds + G8_SA(b, h) + aoff + m * 2048 + k * 1024); } while (0)
#define G8_LDB(dst, b, h) do { _Pragma("unroll") for (int n = 0; n < 2; ++n) _Pragma("unroll") for (int k = 0; k < 2; ++k) dst[n][k] = *(const LAS bf16x8*)(lds + G8_SB(b, h) + boff + n * 2048 + k * 1024); } while (0)
#define G8_MMA(ai, bj, At, Bt) do { __builtin_amdgcn_s_setprio(1); _Pragma("unroll") for (int m = 0; m < 4; ++m) _Pragma("unroll") for (int n = 0; n < 2; ++n) _Pragma("unroll") for (int k = 0; k < 2; ++k) \
        acc[ai][bj][m][n] = __builtin_amdgcn_mfma_f32_16x16x32_bf16(Bt[n][k], At[m][k], acc[ai][bj][m][n], 0, 0, 0); __builtin_amdgcn_s_setprio(0); } while (0)
#define G8_WAIT_V(n) asm volatile("s_waitcnt vmcnt(" #n ")" ::: "memory")
#define G8_WAIT_L(n) asm volatile("s_waitcnt lgkmcnt(" #n ")" ::: "memory")
#define G8_BAR __builtin_amdgcn_s_barrier()
#define G8_SCHED __builtin_amdgcn_sched_barrier(0)
    UnitOps cur, nxt; int ui = 0;
    if (!gemm_unit<MODE>(p, l, 0, R0, C0, cur)) return;
    f32x4 acc[2][2][4][2];
#pragma unroll
    for (int a = 0; a < 2; ++a)
#pragma unroll
        for (int b = 0; b < 2; ++b)
#pragma unroll
            for (int m = 0; m < 4; ++m)
#pragma unroll
                for (int n = 0; n < 2; ++n) acc[a][b][m][n] = (f32x4){0.f, 0.f, 0.f, 0.f};
    bf16x8 At[4][2], B0[2][2], B1[2][2];
    bool has_next = gemm_unit<MODE>(p, l, 1, R0, C0, nxt);
    if (!has_next) nxt = cur;
    G8_STAGE_B(G8_SB(0, 0), cur, 0, 0u); G8_STAGE_A(G8_SA(0, 0), cur, 0, 0u); G8_STAGE_B(G8_SB(0, 1), cur, 1, 0u); G8_STAGE_A(G8_SA(0, 1), cur, 1, 0u);
    if (wr == 1) G8_BAR;
    G8_WAIT_V(4); G8_BAR;
    G8_STAGE_B(G8_SB(1, 0), cur, 0, kstep); G8_STAGE_A(G8_SA(1, 0), cur, 0, kstep); G8_STAGE_B(G8_SB(1, 1), cur, 1, kstep);
    G8_WAIT_V(6); G8_BAR;
    for (;;) {
#pragma unroll 1
        for (int t = 0; t < nt; t += 2) {
            const bool last = (t == nt - 2);
            const unsigned k1 = (unsigned)(t + 1) * kstep, k2 = last ? 0u : (unsigned)(t + 2) * kstep, k3 = k2 + kstep;
            UnitOps& U2 = last ? nxt : cur;
            G8_LDB(B0, 0, 0); G8_SCHED; G8_LDA(At, 0, 0); G8_STAGE_A(G8_SA(1, 1), cur, 1, k1);
            G8_WAIT_L(8); G8_BAR; G8_WAIT_L(0); G8_MMA(0, 0, At, B0); G8_BAR; G8_SCHED;
            G8_LDB(B1, 0, 1); G8_STAGE_B(G8_SB(0, 0), U2, 0, k2);
            G8_BAR; G8_WAIT_L(0); G8_MMA(0, 1, At, B1); G8_BAR;
            G8_LDA(At, 0, 1); G8_STAGE_A(G8_SA(0, 0), U2, 0, k2);
            G8_BAR; G8_WAIT_L(0); G8_MMA(1, 0, At, B0); G8_BAR; G8_SCHED;
            G8_STAGE_B(G8_SB(0, 1), U2, 1, k2);
            G8_WAIT_V(6); G8_BAR; G8_MMA(1, 1, At, B1); G8_BAR;
            G8_LDB(B0, 1, 0); G8_SCHED; G8_LDA(At, 1, 0); G8_STAGE_A(G8_SA(0, 1), U2, 1, k2);
            G8_WAIT_L(8); G8_BAR; G8_WAIT_L(0); G8_MMA(0, 0, At, B0); G8_BAR; G8_SCHED;
            G8_LDB(B1, 1, 1); G8_STAGE_B(G8_SB(1, 0), U2, 0, k3);
            G8_BAR; G8_WAIT_L(0); G8_MMA(0, 1, At, B1); G8_BAR;
            G8_LDA(At, 1, 1); G8_STAGE_A(G8_SA(1, 0), U2, 0, k3);
            G8_BAR; G8_WAIT_L(0); G8_MMA(1, 0, At, B0); G8_BAR; G8_SCHED;
            G8_STAGE_B(G8_SB(1, 1), U2, 1, k3);
            G8_WAIT_V(6); G8_BAR; G8_MMA(1, 1, At, B1); G8_BAR;
        }
        gemm_epilogue<MODE>(p, l, acc, cur, wr, wc, fr, fq);
        if (!has_next) break;
#pragma unroll
        for (int a = 0; a < 2; ++a)
#pragma unroll
            for (int b = 0; b < 2; ++b)
#pragma unroll
                for (int m = 0; m < 4; ++m)
#pragma unroll
                    for (int n = 0; n < 2; ++n) acc[a][b][m][n] = (f32x4){0.f, 0.f, 0.f, 0.f};
        cur = nxt; ++ui;
        has_next = gemm_unit<MODE>(p, l, ui + 1, R0, C0, nxt);
        if (!has_next) nxt = cur;
    }
    G8_WAIT_V(0);
    if (wr == 0) G8_BAR;
    G8_BAR;
#undef G8_SA
#undef G8_SB
#undef G8_STAGE_A
#undef G8_STAGE_B
#undef G8_LDA
#undef G8_LDB
#undef G8_MMA
#undef G8_WAIT_V
#undef G8_WAIT_L
#undef G8_BAR
#undef G8_SCHED
}

__device__ void phase_conv_pool(const Params& p, const int l, LAS unsigned char* lds) {
    const int tid = opaque_tid(), wid = tid >> 6, lane = tid & 63;
    const bf16_t* PROJ = (const bf16_t*)(p.ws + WS_PROJ);
    if (NAIVE_SCAN) {
        float* QKV = (float*)(p.ws + WS_QKV);
        const float* cw = p.conv_w + (size_t)l * 4 * 1536;
        for (int task = blockIdx.x * 8 + wid; task < MT * 12; task += gridDim.x * 8) {
            const int row = task / 12, part = task % 12;
            int s0, len;
            if (row < ROWS_LAT) { s0 = row & ~2047; len = 2048; } else { s0 = ROWS_LAT + ((row - ROWS_LAT) & ~255); len = 256; }
            const int c = part * 128 + lane * 2;
            float a0 = 0.f, a1 = 0.f;
#pragma unroll
            for (int j = 0; j < 4; ++j) {
                const int r2 = row + j - 2;
                if (r2 >= s0 && r2 < s0 + len) {
                    const unsigned v = *(const unsigned*)(PROJ + (size_t)r2 * PN + c);
                    const f32x2 w = *(const f32x2*)(cw + j * 1536 + c);
                    a0 += w[0] * bf_lo(v); a1 += w[1] * bf_hi(v);
                }
            }
            a0 = silu_f(a0); a1 = silu_f(a1);
            if (part < 8) {
                const float ss = wave_sum(a0 * a0 + a1 * a1, lane);
                float sc = rsqrtf(ss + EPS);
                if (part < 4) sc *= 0.08838834764831845f;
                a0 *= sc; a1 *= sc;
            }
            *(f32x2*)(QKV + (size_t)row * 1536 + c) = (f32x2){a0, a1};
        }
    }
    {
        LAS float* V = (LAS float*)lds;
        LAS unsigned char* mt = lds + 40960;
        const bf16_t* PWT = (const bf16_t*)(p.ws + WS_PWT);
        bf16_t* CAT = (bf16_t*)(p.ws + WS_CAT);
        const int wr = wid >> 1, wc = wid & 1, fr = lane & 15, fq = lane >> 4;
        for (int u = blockIdx.x; u < 1152; u += gridDim.x) {
            int g, r, nrows, ncols, c0, rowbase;
            if (u < 1024) { const int b = u >> 7; g = (u >> 5) & 3; r = u & 31; nrows = 32; ncols = 64; c0 = 0; rowbase = b * 2048; }
            else { const int v = u - 1024; const int b = v >> 4; g = (v >> 2) & 3; r = 0; nrows = 1; ncols = 256; c0 = (v & 3) * 64; rowbase = ROWS_LAT + b * 256; }
            const int w = 2 << g, half = w >> 1;
            const int lo_r = max(r - half, 0), hi_r = min(r - half + w, nrows);
            const int cxlo = max(c0 - half, 0), cxhi = min(c0 + 64 + half, ncols);
            const bf16_t* ub = PROJ + 2048 + g * 128;
            for (int pi = tid; pi < (cxhi - cxlo) * 16; pi += NTHREADS) {
                const int cxi = pi >> 4, c8 = (pi & 15) * 8;
                float av[8];
#pragma unroll
                for (int e = 0; e < 8; ++e) av[e] = 0.f;
                const bf16_t* src = ub + (size_t)(rowbase + cxlo + cxi) * PN + c8;
                for (int r0 = lo_r; r0 < hi_r; r0 += 8) {
                    u32x4 v[8];
#pragma unroll
                    for (int k = 0; k < 8; ++k) { const int rr = min(r0 + k, hi_r - 1); v[k] = *(const u32x4*)(src + (size_t)rr * ncols * PN); }
#pragma unroll
                    for (int k = 0; k < 8; ++k) if (r0 + k < hi_r) {
#pragma unroll
                        for (int e = 0; e < 4; ++e) { av[2 * e] += bf_lo(v[k][e]); av[2 * e + 1] += bf_hi(v[k][e]); }
                    }
                }
                *(LAS f32x4*)(V + cxi * 128 + c8) = (f32x4){av[0], av[1], av[2], av[3]};
                *(LAS f32x4*)(V + cxi * 128 + c8 + 4) = (f32x4){av[4], av[5], av[6], av[7]};
            }
            __syncthreads();
            for (int idx = tid; idx < 64 * 64; idx += NTHREADS) {
                const int ci = idx >> 6, ch = (idx & 63) * 2, c = c0 + ci;
                const int lo_c = max(c - half, 0), hi_c = min(c - half + w, ncols);
                float s0 = 0.f, s1 = 0.f;
                for (int cx = lo_c; cx < hi_c; ++cx) { s0 += V[(cx - cxlo) * 128 + ch]; s1 += V[(cx - cxlo) * 128 + ch + 1]; }
                const float inv = 1.f / (float)((hi_r - lo_r) * (hi_c - lo_c));
                const unsigned v = *(const unsigned*)(ub + (size_t)(rowbase + r * ncols + c) * PN + ch);
                *(LAS unsigned*)(mt + ci * 272 + ch * 2) = pk_bf16(s0 * inv - bf_lo(v), s1 * inv - bf_hi(v));
            }
            __syncthreads();
            f32x4 acc[4];
#pragma unroll
            for (int n = 0; n < 4; ++n) acc[n] = (f32x4){0.f, 0.f, 0.f, 0.f};
            const bf16_t* pw = PWT + (size_t)(l * 4 + g) * 128 * 128;
#pragma unroll
            for (int kk = 0; kk < 4; ++kk) {
                const bf16x8 a = *(const LAS bf16x8*)(mt + (wr * 16 + fr) * 272 + (kk * 32 + fq * 8) * 2);
#pragma unroll
                for (int n = 0; n < 4; ++n) {
                    const bf16x8 b = *(const bf16x8*)(pw + (size_t)(wc * 64 + n * 16 + fr) * 128 + kk * 32 + fq * 8);
                    acc[n] = __builtin_amdgcn_mfma_f32_16x16x32_bf16(b, a, acc[n], 0, 0, 0);
                }
            }
            const size_t row = (size_t)rowbase + r * ncols + c0 + wr * 16 + fr;
#pragma unroll
            for (int n = 0; n < 4; ++n) {
                const int dcol = g * 128 + wc * 64 + n * 16 + fq * 4;
                const f32x4 s = *(const f32x4*)(p.pool_scale + l * 512 + dcol);
                u32x2 o; o[0] = pk_bf16(acc[n][0] * s[0], acc[n][1] * s[1]); o[1] = pk_bf16(acc[n][2] * s[2], acc[n][3] * s[3]);
                *(u32x2*)(CAT + row * D + 512 + dcol) = o;
            }
            __syncthreads();
        }
    }
}


__device__ __forceinline__ int img256(int row, int col) { return row * 256 + ((((col >> 3) ^ row) & 15) << 4) + (col & 7) * 2; }
__device__ __forceinline__ int img128(int row, int col) { return (row >> 1) * 256 + (row & 1) * 128 + ((((col >> 3) ^ (row >> 1)) & 7) << 4) + (col & 7) * 2; }

__device__ void phase_prep(const Params& p, const int l, LAS unsigned char* lds) {
    int tid = opaque_tid(), wid = __builtin_amdgcn_readfirstlane(tid >> 6), lane = tid & 63, fr = lane & 15, fq = lane >> 4;
#define RELAUNDER() do { asm volatile("" : "+v"(tid)); wid = __builtin_amdgcn_readfirstlane(tid >> 6); lane = tid & 63; fr = lane & 15; fq = lane >> 4; } while (0)
    constexpr int R_KK = 0, R_QK = 16640, R_TB = 33280, R_QN = 53248, R_KN = 70656, R_KNT = 88064, R_VT = 106496, R_TW = 124928, R_TU = 134144, R_MB = R_TW, R_G = 143360;
    LAS float* KK = (LAS float*)(lds + R_KK); LAS float* QK = (LAS float*)(lds + R_QK); LAS float* TB = (LAS float*)(lds + R_TB); LAS float* MB = (LAS float*)(lds + R_MB);
    LAS float* G_LA = (LAS float*)(lds + R_G);
    LAS float* G_BT = G_LA + 128;
    LAS float* G_GC = G_BT + 128;
    LAS float* G_TOT = G_GC + 128;
    LAS float* XS = G_TOT + 16;
    LAS float* CW = (LAS float*)(lds + 149504);
    const bf16_t* PROJ = (const bf16_t*)(p.ws + WS_PROJ);
    const float* LOGA = (const float*)(p.ws + WS_LOGA); const float* BETA = (const float*)(p.ws + WS_BETA);
    int cur_h = -1;
    for (int u = blockIdx.x; u < NB * 4 * NCHUNK; u += gridDim.x) {
        const int h = u & 3, b = (u >> 2) / 36, cc = (u >> 2) % 36;
        if (h != cur_h) {
            __syncthreads();
            for (int idx = tid; idx < 1536; idx += NTHREADS) { const int j = idx / 384, rm = idx % 384, seg = rm >> 7, c = rm & 127; CW[idx] = p.conv_w[(size_t)(l * 4 + j) * 1536 + seg * 512 + h * 128 + c]; }
            cur_h = h;
        }
        int rowbase, seqlen, cpos;
        if (cc < 32) { rowbase = b * SEQ; seqlen = SEQ; cpos = cc; } else { rowbase = ROWS_LAT + b * CTXL; seqlen = CTXL; cpos = cc - 32; }
        const int t0 = cpos * 64;
        RELAUNDER();
        {
            u32x4 rv[7];
#pragma unroll
            for (int it = 0; it < 7; ++it) {
                const int idx = tid + it * NTHREADS, rr = idx / 48, pc = idx % 48, seg = pc >> 4, po = pc & 15, tok = t0 - 2 + rr;
                rv[it] = (u32x4){0u, 0u, 0u, 0u};
                if (idx < 67 * 48 && tok >= 0 && tok < seqlen) rv[it] = *(const u32x4*)(PROJ + (size_t)(rowbase + tok) * PN + seg * 512 + h * 128 + po * 8);
            }
#pragma unroll
            for (int it = 0; it < 7; ++it) {
                const int idx = tid + it * NTHREADS, rr = idx / 48, pc = idx % 48, seg = pc >> 4, po = pc & 15;
                if (idx < 67 * 48) *(LAS u32x4*)(lds + rr * 784 + seg * 256 + po * 16) = rv[it];
            }
        }
        if (tid < 128) { const int d = tid >> 6; const size_t gi = (size_t)(rowbase + t0 + lane) * 8 + d * 4 + h; G_LA[tid] = LOGA[gi]; G_BT[tid] = BETA[gi]; }
        __syncthreads();
        RELAUNDER();
        if (wid < 2) {
            const int d = wid, pos = d ? 63 - lane : lane;
            float v = G_LA[d * 64 + pos];
#pragma unroll
            for (int o = 1; o < 64; o <<= 1) { const float t = shup(v, o, lane); if (lane >= o) v += t; }
            G_GC[d * 64 + pos] = v;
            if (lane == 63) G_TOT[d] = v;
        }
        RELAUNDER();
        {
            const int r = tid >> 3, cs = tid & 7;
            const LAS float* cw = CW + cs * 16;
#pragma unroll
            for (int seg = 0; seg < 3; ++seg) {
                float a[16];
#pragma unroll
                for (int e = 0; e < 16; ++e) a[e] = 0.f;
#pragma unroll
                for (int j = 0; j < 4; ++j) {
                    const u32x4 x0 = *(const LAS u32x4*)(lds + (r + j) * 784 + seg * 256 + cs * 32), x1 = *(const LAS u32x4*)(lds + (r + j) * 784 + seg * 256 + cs * 32 + 16);
                    const LAS float* wj = cw + j * 384 + seg * 128;
                    const f32x4 w0 = *(const LAS f32x4*)(wj), w1 = *(const LAS f32x4*)(wj + 4), w2 = *(const LAS f32x4*)(wj + 8), w3 = *(const LAS f32x4*)(wj + 12);
                    a[0] += w0[0] * bf_lo(x0[0]); a[1] += w0[1] * bf_hi(x0[0]); a[2] += w0[2] * bf_lo(x0[1]); a[3] += w0[3] * bf_hi(x0[1]);
                    a[4] += w1[0] * bf_lo(x0[2]); a[5] += w1[1] * bf_hi(x0[2]); a[6] += w1[2] * bf_lo(x0[3]); a[7] += w1[3] * bf_hi(x0[3]);
                    a[8] += w2[0] * bf_lo(x1[0]); a[9] += w2[1] * bf_hi(x1[0]); a[10] += w2[2] * bf_lo(x1[1]); a[11] += w2[3] * bf_hi(x1[1]);
                    a[12] += w3[0] * bf_lo(x1[2]); a[13] += w3[1] * bf_hi(x1[2]); a[14] += w3[2] * bf_lo(x1[3]); a[15] += w3[3] * bf_hi(x1[3]);
                    if (j & 1) __builtin_amdgcn_sched_barrier(0);
                }
                float ss = 0.f;
#pragma unroll
                for (int e = 0; e < 16; ++e) { a[e] = silu_f(a[e]); ss += a[e] * a[e]; }
                if (seg < 2) {
                    ss += shx(ss, 1, lane); ss += shx(ss, 2, lane); ss += shx(ss, 4, lane);
                    float sc = rsqrtf(ss + EPS); if (seg == 0) sc *= 0.08838834764831845f;
#pragma unroll
                    for (int e = 0; e < 16; ++e) a[e] *= sc;
                }
                unsigned pk[8];
#pragma unroll
                for (int e = 0; e < 8; ++e) pk[e] = pk_bf16(a[2 * e], a[2 * e + 1]);
                if (seg < 2) {
                    LAS unsigned char* dst = lds + (seg == 0 ? R_QN : R_KN) + r * 272 + cs * 32;
                    *(LAS u32x4*)dst = (u32x4){pk[0], pk[1], pk[2], pk[3]}; *(LAS u32x4*)(dst + 16) = (u32x4){pk[4], pk[5], pk[6], pk[7]};
                }
                if (seg >= 1) {
                    LAS unsigned char* dt = lds + (seg == 1 ? R_KNT : R_VT) + (cs * 16) * 144 + r * 2;
#pragma unroll
                    for (int e = 0; e < 8; ++e) { *(LAS unsigned short*)(dt + (2 * e) * 144) = (unsigned short)(pk[e] & 0xffffu); *(LAS unsigned short*)(dt + (2 * e + 1) * 144) = (unsigned short)(pk[e] >> 16); }
                }
            }
        }
        __syncthreads();
        RELAUNDER();
        {
            const int ib = wid & 3, pr = wid >> 2;
            LAS unsigned char* Ab = lds + (pr ? R_QN : R_KN) + (ib * 16 + fr) * 272 + fq * 16;
            bf16x8 a[4];
#pragma unroll
            for (int kk = 0; kk < 4; ++kk) a[kk] = *(const LAS bf16x8*)(Ab + kk * 64);
            LAS float* dstf = pr ? QK : KK;
#pragma unroll
            for (int jb = 0; jb < 4; ++jb) {
                f32x4 acc = (f32x4){0.f, 0.f, 0.f, 0.f};
#pragma unroll
                for (int kk = 0; kk < 4; ++kk) { const bf16x8 bb = *(const LAS bf16x8*)(lds + R_KN + (jb * 16 + fr) * 272 + fq * 16 + kk * 64); acc = __builtin_amdgcn_mfma_f32_16x16x32_bf16(a[kk], bb, acc, 0, 0, 0); }
#pragma unroll
                for (int r = 0; r < 4; ++r) dstf[(ib * 16 + fq * 4 + r) * 65 + jb * 16 + fr] = acc[r];
            }
        }
        __syncthreads();
        for (int d = 0; d < 2; ++d) {
            const LAS float* gc = G_GC + d * 64; const LAS float* bt = G_BT + d * 64;
            RELAUNDER();
            for (int idx = tid; idx < 4096; idx += NTHREADS) {
                const int i2 = idx >> 6, j2 = idx & 63, pi = d ? 63 - i2 : i2, pj = d ? 63 - j2 : j2;
                float v = 0.f;
                if (j2 < i2) v = bt[pi] * KK[pi * 65 + pj] * __expf(gc[pi] - gc[pj]);
                MB[i2 * 65 + j2] = v; TB[i2 * 65 + j2] = (i2 == j2) ? 1.f : 0.f;
            }
            __syncthreads();
            RELAUNDER();
            if (wid < 4 && lane < 16) {
                const int bb = wid; float tc[16], mrow[16];
#pragma unroll
                for (int b2 = 0; b2 < 16; ++b2) mrow[b2] = MB[(bb * 16 + lane) * 65 + bb * 16 + b2];
#pragma unroll
                for (int a = 0; a < 16; ++a) {
                    float sv = (a == lane) ? 1.f : 0.f;
#pragma unroll
                    for (int b2 = 0; b2 < a; ++b2) sv -= __int_as_float(__builtin_amdgcn_readlane(__float_as_int(mrow[b2]), a)) * tc[b2];
                    tc[a] = sv;
                }
#pragma unroll
                for (int a = 0; a < 16; ++a) TB[(bb * 16 + a) * 65 + bb * 16 + lane] = tc[a];
            }
            __syncthreads();
            RELAUNDER();
            if (wid < 2) {
                const int rb = 2 * wid + 1, cb = 2 * wid; LAS float* xs = XS + wid * 272;
                f32x4 acc = (f32x4){0.f, 0.f, 0.f, 0.f};
#pragma unroll
                for (int ks = 0; ks < 4; ++ks) acc = __builtin_amdgcn_mfma_f32_16x16x4f32(MB[(rb * 16 + fr) * 65 + cb * 16 + ks * 4 + fq], TB[(cb * 16 + ks * 4 + fq) * 65 + cb * 16 + fr], acc, 0, 0, 0);
#pragma unroll
                for (int r = 0; r < 4; ++r) xs[(fq * 4 + r) * 17 + fr] = acc[r];
                f32x4 acc2 = (f32x4){0.f, 0.f, 0.f, 0.f};
#pragma unroll
                for (int ks = 0; ks < 4; ++ks) acc2 = __builtin_amdgcn_mfma_f32_16x16x4f32(TB[(rb * 16 + fr) * 65 + rb * 16 + ks * 4 + fq], xs[(ks * 4 + fq) * 17 + fr], acc2, 0, 0, 0);
#pragma unroll
                for (int r = 0; r < 4; ++r) TB[(rb * 16 + fq * 4 + r) * 65 + cb * 16 + fr] = -acc2[r];
            }
            __syncthreads();
            RELAUNDER();
            if (wid < 4) {
                const int ti = wid >> 1, tj = wid & 1;
                f32x4 acc = (f32x4){0.f, 0.f, 0.f, 0.f};
#pragma unroll
                for (int ks = 0; ks < 8; ++ks) acc = __builtin_amdgcn_mfma_f32_16x16x4f32(MB[(32 + ti * 16 + fr) * 65 + ks * 4 + fq], TB[(ks * 4 + fq) * 65 + tj * 16 + fr], acc, 0, 0, 0);
#pragma unroll
                for (int r = 0; r < 4; ++r) XS[(ti * 16 + fq * 4 + r) * 33 + tj * 16 + fr] = acc[r];
            }
            __syncthreads();
            if (wid < 4) {
                const int ti = wid >> 1, tj = wid & 1;
                f32x4 acc = (f32x4){0.f, 0.f, 0.f, 0.f};
#pragma unroll
                for (int ks = 0; ks < 8; ++ks) acc = __builtin_amdgcn_mfma_f32_16x16x4f32(TB[(32 + ti * 16 + fr) * 65 + 32 + ks * 4 + fq], XS[(ks * 4 + fq) * 33 + tj * 16 + fr], acc, 0, 0, 0);
#pragma unroll
                for (int r = 0; r < 4; ++r) TB[(32 + ti * 16 + fq * 4 + r) * 65 + tj * 16 + fr] = -acc[r];
            }
            __syncthreads();
            RELAUNDER();
            for (int idx = tid; idx < 2048; idx += NTHREADS) {
                const int i = idx >> 5, j = (idx & 31) * 2, i2 = d ? 63 - i : i, j2 = d ? 63 - j : j, j3 = d ? j2 - 1 : j2 + 1;
                const float t0v = TB[i2 * 65 + j2], t1v = TB[i2 * 65 + j3];
                const float c0 = bt[j], c1 = bt[j + 1];
                *(LAS unsigned*)(lds + R_TU + i * 144 + j * 2) = pk_bf16(t0v * c0, t1v * c1);
                *(LAS unsigned*)(lds + R_TW + i * 144 + j * 2) = pk_bf16(t0v * c0 * __expf(gc[j]), t1v * c1 * __expf(gc[j + 1]));
            }
            __syncthreads();
            RELAUNDER();
            const int cposn = (cc < 32) ? 4 + (d ? 31 - cpos : cpos) : (d ? 3 - cpos : cpos);
            unsigned char* rec = p.ws + WS_SCN + ((size_t)((b * 4 + h) * 2 + d) * NCHUNK + cposn) * REC_BYTES;
            {
                bf16x8 ak[2], av[2];
#pragma unroll
                for (int kk = 0; kk < 2; ++kk) { ak[kk] = *(const LAS bf16x8*)(lds + R_KNT + (wid * 16 + fr) * 144 + kk * 64 + fq * 16); av[kk] = *(const LAS bf16x8*)(lds + R_VT + (wid * 16 + fr) * 144 + kk * 64 + fq * 16); }
#pragma unroll
                for (int ib = 0; ib < 4; ++ib) {
                    f32x4 aw = (f32x4){0.f, 0.f, 0.f, 0.f}, au = (f32x4){0.f, 0.f, 0.f, 0.f};
#pragma unroll
                    for (int kk = 0; kk < 2; ++kk) {
                        const bf16x8 tw = *(const LAS bf16x8*)(lds + R_TW + (ib * 16 + fr) * 144 + kk * 64 + fq * 16), tu = *(const LAS bf16x8*)(lds + R_TU + (ib * 16 + fr) * 144 + kk * 64 + fq * 16);
                        aw = __builtin_amdgcn_mfma_f32_16x16x32_bf16(ak[kk], tw, aw, 0, 0, 0);
                        au = __builtin_amdgcn_mfma_f32_16x16x32_bf16(tu, av[kk], au, 0, 0, 0);
                    }
                    u32x2 ow; ow[0] = pk_bf16(aw[0], aw[1]); ow[1] = pk_bf16(aw[2], aw[3]);
                    *(u32x2*)(rec + REC_W + img256(ib * 16 + fr, wid * 16 + fq * 4)) = ow;
                    u32x2 ou; ou[0] = pk_bf16(au[0], au[1]); ou[1] = pk_bf16(au[2], au[3]);
                    *(u32x2*)(rec + REC_UT + (wid * 16 + fr) * 128 + (ib * 16 + fq * 4) * 2) = ou;
                }
            }
            RELAUNDER();
            const float gtot = G_TOT[d];
            for (int idx = tid; idx < 1024; idx += NTHREADS) {
                const int dk = idx >> 3, i8 = (idx & 7) * 8;
                const u32x4 kv = *(const LAS u32x4*)(lds + R_KNT + dk * 144 + i8 * 2);
                u32x4 o;
#pragma unroll
                for (int e = 0; e < 4; ++e) o[e] = pk_bf16(bf_lo(kv[e]) * __expf(gtot - gc[i8 + 2 * e]), bf_hi(kv[e]) * __expf(gtot - gc[i8 + 2 * e + 1]));
                *(u32x4*)(rec + REC_KT + img128(dk, i8)) = o;
            }
            for (int idx = tid; idx < 1024; idx += NTHREADS) {
                const int i = idx >> 4, k8 = (idx & 15) * 8;
                const u32x4 qv = *(const LAS u32x4*)(lds + R_QN + i * 272 + k8 * 2);
                const float eg = __expf(gc[i]);
                u32x4 o;
#pragma unroll
                for (int e = 0; e < 4; ++e) o[e] = pk_bf16(bf_lo(qv[e]) * eg, bf_hi(qv[e]) * eg);
                *(u32x4*)(rec + REC_QD + img256(i, k8)) = o;
            }
            {
                const int i = tid >> 3, j8 = (tid & 7) * 8;
                float v[8];
#pragma unroll
                for (int e = 0; e < 8; ++e) { const int j = j8 + e; const bool ok = d ? (j >= i) : (j <= i); v[e] = ok ? QK[i * 65 + j] * __expf(gc[i] - gc[j]) : 0.f; }
                u32x4 o; o[0] = pk_bf16(v[0], v[1]); o[1] = pk_bf16(v[2], v[3]); o[2] = pk_bf16(v[4], v[5]); o[3] = pk_bf16(v[6], v[7]);
                *(u32x4*)(rec + REC_QK + img128(i, j8)) = o;
            }
            if (tid == 0) { *(float*)(rec + REC_MISC) = __expf(gtot); *(int*)(rec + REC_MISC + 4) = rowbase + t0; }
            __syncthreads();
        }
    }
}
#undef RELAUNDER

__device__ void phase_scan(const Params& p, const int l, LAS unsigned char* lds) {
    const int tid = opaque_tid(), wid = __builtin_amdgcn_readfirstlane(tid >> 6), lane = tid & 63, fr = lane & 15, fq = lane >> 4;
    constexpr int BUFB = 62464, R_ST = 2 * BUFB, R_UTL = R_ST + 32 * 272;
    for (int id = blockIdx.x; id < 256; id += gridDim.x) {
        const int bhd = (id & 7) * 8 + (id >> 5), sl = (id >> 3) & 3, h = (bhd >> 1) & 3, d = bhd & 1;
        float* O = (float*)(p.ws + (d ? WS_OB : WS_OF));
        const unsigned char* rec0 = p.ws + WS_SCN + (size_t)bhd * NCHUNK * REC_BYTES;
        __syncthreads();
        for (int i = tid; i < 32 * 272 / 4; i += NTHREADS) ((LAS unsigned*)(lds + R_ST))[i] = 0u;
        f32x4 sacc[2];
        sacc[0] = (f32x4){0.f, 0.f, 0.f, 0.f}; sacc[1] = (f32x4){0.f, 0.f, 0.f, 0.f};
#define S_ISSUE(n, bufo) do { const unsigned char* _r = rec0 + (size_t)(n) * REC_BYTES + lane * 16; \
        _Pragma("unroll") for (int _q = 0; _q < 7; ++_q) __builtin_amdgcn_global_load_lds((const unsigned*)(_r + (wid + 8 * _q) * 1024), (LAS unsigned*)(lds + (bufo) + (wid + 8 * _q) * 1024), 16, 0, 0); \
        if (wid < 4) __builtin_amdgcn_global_load_lds((const unsigned*)(_r + REC_UT + sl * 4096 + wid * 1024), (LAS unsigned*)(lds + (bufo) + 57344 + wid * 1024), 16, 0, 0); \
        if (wid == 4) __builtin_amdgcn_global_load_lds((const unsigned*)(_r + REC_MISC), (LAS unsigned*)(lds + (bufo) + 61440), 16, 0, 0); } while (0)
        S_ISSUE(0, 0);
        const int ib = wid >> 1, nb = wid & 1;
        for (int n = 0; n < NCHUNK; ++n) {
            asm volatile("s_waitcnt vmcnt(0)" ::: "memory");
            __syncthreads();
            if (n + 1 < NCHUNK) { if ((n + 1) & 1) S_ISSUE(n + 1, BUFB); else S_ISSUE(n + 1, 0); }
            LAS unsigned char* buf = lds + (n & 1) * BUFB;
            f32x4 accP = (f32x4){0.f, 0.f, 0.f, 0.f}, accQ = (f32x4){0.f, 0.f, 0.f, 0.f};
#pragma unroll
            for (int kk = 0; kk < 4; ++kk) {
                const bf16x8 sb = *(const LAS bf16x8*)(lds + R_ST + (nb * 16 + fr) * 272 + kk * 64 + fq * 16);
                const bf16x8 aw = *(const LAS bf16x8*)(buf + REC_W + img256(ib * 16 + fr, kk * 32 + fq * 8));
                const bf16x8 aq = *(const LAS bf16x8*)(buf + REC_QD + img256(ib * 16 + fr, kk * 32 + fq * 8));
                accP = __builtin_amdgcn_mfma_f32_16x16x32_bf16(aw, sb, accP, 0, 0, 0);
                accQ = __builtin_amdgcn_mfma_f32_16x16x32_bf16(aq, sb, accQ, 0, 0, 0);
            }
            {
                const u32x2 uv = *(const LAS u32x2*)(buf + REC_UT + (nb * 16 + fr) * 128 + (ib * 16 + fq * 4) * 2);
                u32x2 o; o[0] = pk_bf16(bf_lo(uv[0]) - accP[0], bf_hi(uv[0]) - accP[1]); o[1] = pk_bf16(bf_lo(uv[1]) - accP[2], bf_hi(uv[1]) - accP[3]);
                *(LAS u32x2*)(lds + R_UTL + (nb * 16 + fr) * 144 + (ib * 16 + fq * 4) * 2) = o;
            }
            __syncthreads();
            const float sd = *(const LAS float*)(buf + 61440); const int rowstart = *(const LAS int*)(buf + 61444);
            bf16x8 ub[2][2];
#pragma unroll
            for (int n2 = 0; n2 < 2; ++n2)
#pragma unroll
                for (int kk = 0; kk < 2; ++kk) ub[n2][kk] = *(const LAS bf16x8*)(lds + R_UTL + (n2 * 16 + fr) * 144 + kk * 64 + fq * 16);
#pragma unroll
            for (int kk = 0; kk < 2; ++kk) {
                const bf16x8 a = *(const LAS bf16x8*)(buf + REC_QK + img128(ib * 16 + fr, kk * 32 + fq * 8));
                const bf16x8 un = *(const LAS bf16x8*)(lds + R_UTL + (nb * 16 + fr) * 144 + kk * 64 + fq * 16);
                accQ = __builtin_amdgcn_mfma_f32_16x16x32_bf16(a, un, accQ, 0, 0, 0);
            }
#pragma unroll
            for (int r = 0; r < 4; ++r) O[(size_t)(rowstart + ib * 16 + fq * 4 + r) * 512 + h * 128 + sl * 32 + nb * 16 + fr] = accQ[r];
#pragma unroll
            for (int n2 = 0; n2 < 2; ++n2) {
                sacc[n2] *= sd;
#pragma unroll
                for (int kk = 0; kk < 2; ++kk) {
                    const bf16x8 a = *(const LAS bf16x8*)(buf + REC_KT + img128(wid * 16 + fr, kk * 32 + fq * 8));
                    sacc[n2] = __builtin_amdgcn_mfma_f32_16x16x32_bf16(a, ub[n2][kk], sacc[n2], 0, 0, 0);
                }
                u32x2 o; o[0] = pk_bf16(sacc[n2][0], sacc[n2][1]); o[1] = pk_bf16(sacc[n2][2], sacc[n2][3]);
                *(LAS u32x2*)(lds + R_ST + (n2 * 16 + fr) * 272 + (wid * 16 + fq * 4) * 2) = o;
            }
        }
#undef S_ISSUE
        __syncthreads();
    }
}

__device__ void phase_scan_naive(const Params& p, const int l, LAS unsigned char* lds) {
    const int tid = opaque_tid();
    const int lane = tid & 63;
    LAS float* ks = (LAS float*)lds;
    LAS float* qs = ks + 4096;
    LAS float* vs = qs + 4096;
    LAS float* as = vs + 4096;
    LAS float* bs = as + 32;
    LAS int* rws = (LAS int*)(bs + 32);
    const float* QKV = (const float*)(p.ws + WS_QKV);
    const float* LOGA = (const float*)(p.ws + WS_LOGA);
    const float* BETA = (const float*)(p.ws + WS_BETA);
    for (int u = blockIdx.x; u < 64; u += gridDim.x) {
        const int b = u >> 3, h = (u >> 1) & 3, d = u & 1;
        float* O = (float*)(p.ws + (d ? WS_OB : WS_OF));
        const int col = tid >> 2, part = tid & 3;
        float S[32];
#pragma unroll
        for (int i = 0; i < 32; ++i) S[i] = 0.f;
        for (int n0 = 0; n0 < CTXL + SEQ; n0 += 32) {
            __syncthreads();
            if (tid < 32) {
                const int n = n0 + tid; int row;
                if (n < CTXL) row = ROWS_LAT + b * CTXL + (d ? CTXL - 1 - n : n);
                else { const int m = n - CTXL; row = b * SEQ + (d ? SEQ - 1 - m : m); }
                rws[tid] = row;
                as[tid] = __expf(LOGA[(size_t)row * 8 + d * 4 + h]);
                bs[tid] = BETA[(size_t)row * 8 + d * 4 + h];
            }
            __syncthreads();
            for (int i = tid; i < 4096; i += NTHREADS) {
                const int tok = i >> 7, cc = i & 127; const size_t base = (size_t)rws[tok] * 1536 + h * 128 + cc;
                qs[i] = QKV[base]; ks[i] = QKV[base + 512]; vs[i] = QKV[base + 1024];
            }
            __syncthreads();
            for (int tok = 0; tok < 32; ++tok) {
                float kk[32];
#pragma unroll
                for (int i = 0; i < 8; ++i) { const f32x4 v = *(const LAS f32x4*)(ks + tok * 128 + part * 32 + i * 4); kk[i * 4] = v[0]; kk[i * 4 + 1] = v[1]; kk[i * 4 + 2] = v[2]; kk[i * 4 + 3] = v[3]; }
                float kp = 0.f;
#pragma unroll
                for (int i = 0; i < 32; ++i) kp += kk[i] * S[i];
                kp += shx(kp, 1, lane); kp += shx(kp, 2, lane);
                const float a = as[tok], bt = bs[tok];
                const float bv = bt * (vs[tok * 128 + col] - a * kp);
#pragma unroll
                for (int i = 0; i < 32; ++i) S[i] = a * S[i] + kk[i] * bv;
                float op = 0.f;
#pragma unroll
                for (int i = 0; i < 8; ++i) { const f32x4 v = *(const LAS f32x4*)(qs + tok * 128 + part * 32 + i * 4); op += v[0] * S[i * 4] + v[1] * S[i * 4 + 1] + v[2] * S[i * 4 + 2] + v[3] * S[i * 4 + 3]; }
                op += shx(op, 1, lane); op += shx(op, 2, lane);
                if (part == 0) O[(size_t)rws[tok] * 512 + h * 128 + col] = op;
            }
        }
        __syncthreads();
    }
}

__device__ void phase_onorm(const Params& p, const int l) {
    const int tid = opaque_tid(), wid = tid >> 6, lane = tid & 63;
    const float* OF = (const float*)(p.ws + WS_OF); const float* OB = (const float*)(p.ws + WS_OB);
    const bf16_t* PROJ = (const bf16_t*)(p.ws + WS_PROJ);
    bf16_t* CAT = (bf16_t*)(p.ws + WS_CAT);
    const int c = lane * 8;
    const f32x4 w0 = *(const f32x4*)(p.dn_norm + l * 128 + (c & 127)), w1 = *(const f32x4*)(p.dn_norm + l * 128 + (c & 127) + 4);
    for (int row = blockIdx.x * 8 + wid; row < MT; row += gridDim.x * 8) {
        const size_t o = (size_t)row * 512 + c;
        f32x4 v0 = *(const f32x4*)(OF + o) + *(const f32x4*)(OB + o), v1 = *(const f32x4*)(OF + o + 4) + *(const f32x4*)(OB + o + 4);
        float ss = v0[0] * v0[0] + v0[1] * v0[1] + v0[2] * v0[2] + v0[3] * v0[3] + v1[0] * v1[0] + v1[1] * v1[1] + v1[2] * v1[2] + v1[3] * v1[3];
        ss += shx(ss, 1, lane); ss += shx(ss, 2, lane); ss += shx(ss, 4, lane); ss += shx(ss, 8, lane);
        const float rs = rsqrtf(ss * (1.f / 128.f) + EPS);
        const u32x4 gv = *(const u32x4*)(PROJ + (size_t)row * PN + 1536 + c);
        u32x4 out;
        out[0] = pk_bf16(v0[0] * rs * w0[0] * silu_f(bf_lo(gv[0])), v0[1] * rs * w0[1] * silu_f(bf_hi(gv[0])));
        out[1] = pk_bf16(v0[2] * rs * w0[2] * silu_f(bf_lo(gv[1])), v0[3] * rs * w0[3] * silu_f(bf_hi(gv[1])));
        out[2] = pk_bf16(v1[0] * rs * w1[0] * silu_f(bf_lo(gv[2])), v1[1] * rs * w1[1] * silu_f(bf_hi(gv[2])));
        out[3] = pk_bf16(v1[2] * rs * w1[2] * silu_f(bf_lo(gv[3])), v1[3] * rs * w1[3] * silu_f(bf_hi(gv[3])));
        *(u32x4*)(CAT + (size_t)row * D + c) = out;
    }
}

__device__ void phase_topk(const Params& p, LAS unsigned char* lds) {
    const int tid = opaque_tid();
    LAS unsigned long long* ks = (LAS unsigned long long*)lds;
    const float* AFF = (const float*)(p.ws + WS_AFF);
    int* SEL = (int*)(p.ws + WS_SEL); float* SELAFF = (float*)(p.ws + WS_SELAFF); int* SLOTOF = (int*)(p.ws + WS_SLOTOF);
    for (int u = blockIdx.x; u < 256; u += gridDim.x) {
        int e, n, C, rowbase, slotbase;
        if (u < 128) { e = u >> 3; const int b = u & 7; n = SEQ; C = 256; rowbase = b * SEQ; slotbase = u * 256; }
        else { const int v = u - 128; e = v >> 3; const int b = v & 7; n = CTXL; C = 32; rowbase = ROWS_LAT + b * CTXL; slotbase = (128 + e) * 256 + b * 32; }
        for (int i = tid; i < n; i += NTHREADS) ks[i] = ((unsigned long long)__float_as_uint(AFF[(size_t)(rowbase + i) * 16 + e]) << 32) | (unsigned long long)(0xFFFFFFFFu - (unsigned)i);
        __syncthreads();
        for (int k = 2; k <= n; k <<= 1)
            for (int j = k >> 1; j > 0; j >>= 1) {
                for (int q = tid; q < (n >> 1); q += NTHREADS) {
                    const int i = ((q & ~(j - 1)) << 1) | (q & (j - 1)), i2 = i | j;
                    const unsigned long long a = ks[i], b2 = ks[i2];
                    const bool up = (i & k) == 0;
                    if (up ? (a < b2) : (a > b2)) { ks[i] = b2; ks[i2] = a; }
                }
                __syncthreads();
            }
        for (int i = tid; i < n; i += NTHREADS) {
            const unsigned long long key = ks[i];
            const int t = (int)(0xFFFFFFFFu - (unsigned)(key & 0xFFFFFFFFull));
            SLOTOF[(size_t)(rowbase + t) * 16 + e] = (i < C) ? slotbase + i : -1;
            if (i < C) { SEL[slotbase + i] = rowbase + t; SELAFF[slotbase + i] = __uint_as_float((unsigned)(key >> 32)); }
        }
        __syncthreads();
    }
}


#ifndef DUMP
#define DUMP 0
#endif
#if DUMP
__device__ void phase_dump(const Params& p, const size_t off, const int is_bf16, const size_t n_avail) {
    const int tid = opaque_tid();
    const size_t n = (size_t)ROWS_LAT * D;
    for (size_t i = (size_t)blockIdx.x * NTHREADS + tid; i < n; i += (size_t)gridDim.x * NTHREADS) {
        float v = 0.f;
        if (i < n_avail) v = is_bf16 ? __uint_as_float((unsigned)((const bf16_t*)(p.ws + off))[i] << 16) : ((const float*)(p.ws + off))[i];
        p.out[i] = v;
    }
}
#endif

__global__ void __launch_bounds__(NTHREADS, 2) fwd(const Params p) {
    extern __shared__ __attribute__((aligned(16))) unsigned char smem[];
    LAS unsigned char* lds = (LAS unsigned char*)smem + LDS_OFF;
    XcdBarrier bar; bar.bar = (unsigned*)(p.ws + WS_BAR); bar.x = 0; bar.st = nullptr;
    const bool multi = (p.ph_hi - p.ph_lo) > 1;
    if (multi) {
        if (threadIdx.x == 0) *(LAS u32x4*)((LAS unsigned char*)smem) = (u32x4){0u, 0u, 0u, 0u};
        __syncthreads();
        bar = xcd_barrier_post((unsigned*)(p.ws + WS_BAR), (volatile LAS unsigned*)((LAS unsigned char*)smem));
    }
#if DUMP
    if (p.ph_lo == 100) { phase_dump(p, (size_t)(DUMP_OFF), DUMP_BF16, (size_t)(DUMP_N)); return; }
#endif
    int ph = 0;
#define PHASE(body) do { if (ph >= p.ph_lo && ph < p.ph_hi) { const int l = opaque_s(lv); body; if (ph + 1 < p.ph_hi) xcd_barrier(bar); } ++ph; } while (0)
    int lv = 0;
    PHASE(phase_prologue(p, lds));
    for (lv = 0; lv < DEPTH; ++lv) {
        PHASE(phase_norm<1>(p, l, lds));
        PHASE(GEMM8 ? phase_gemm8<0>(p, l, lds) : phase_gemm<0>(p, l, lds));
#if NAIVE_SCAN
        PHASE(phase_conv_pool(p, l, lds));
        PHASE(phase_scan_naive(p, l, lds));
#else
        PHASE(phase_prep(p, l, lds); phase_conv_pool(p, l, lds));
        PHASE(phase_scan(p, l, lds));
#endif
        PHASE(phase_onorm(p, l));
        PHASE(GEMM8 ? phase_gemm8<1>(p, l, lds) : phase_gemm<1>(p, l, lds));
        PHASE(phase_norm<2>(p, l, lds));
        PHASE(phase_topk(p, lds));
        PHASE(GEMM8 ? phase_gemm8<2>(p, l, lds) : phase_gemm<2>(p, l, lds));
        PHASE(GEMM8 ? phase_gemm8<3>(p, l, lds) : phase_gemm<3>(p, l, lds));
    }
    lv = 0;
    PHASE(phase_norm<3>(p, l, lds));
#undef PHASE
}
constexpr int N_PHASES = 2 + DEPTH * 10;

extern "C" void kernel_launch(void* const* d_in, const int* in_sizes, int n_in, void* d_out, int out_size, void* d_ws, size_t ws_size, hipStream_t stream) {
    static int grid = 0;
    if (grid == 0) {
        if (n_in != 21 || out_size != ROWS_LAT * D || ws_size < WS_END) { fprintf(stderr, "kernel_launch: unexpected shapes (n_in %d out %d ws %zu need %zu)\n", n_in, out_size, ws_size, (size_t)WS_END); grid = -1; return; }
        int dev = 0, cus = 0, per_cu = 0;
        if (hipGetDevice(&dev) != hipSuccess || hipDeviceGetAttribute(&cus, hipDeviceAttributeMultiprocessorCount, dev) != hipSuccess) { grid = -1; return; }
        if (hipFuncSetAttribute((const void*)fwd, hipFuncAttributeMaxDynamicSharedMemorySize, LDS_BYTES) != hipSuccess) { fprintf(stderr, "kernel_launch: hipFuncSetAttribute failed\n"); grid = -1; return; }
        if (hipOccupancyMaxActiveBlocksPerMultiprocessor(&per_cu, (const void*)fwd, NTHREADS, LDS_BYTES) != hipSuccess || per_cu < 1) { fprintf(stderr, "kernel_launch: occupancy query says %d\n", per_cu); per_cu = 1; }
        (void)hipGetLastError();
        grid = cus;
    }
    if (grid < 0) return;
    (void)hipMemsetAsync((char*)d_ws + WS_BAR, 0, 16384, stream);
    Params p; memset(&p, 0, sizeof(p));
    const float** pp = (const float**)&p;
    for (int i = 0; i < 21; ++i) pp[i] = (const float*)d_in[i];
    p.out = (float*)d_out; p.ws = (unsigned char*)d_ws;
#if DUMP
    for (int ph = 0; ph <= DUMP_LAST; ++ph) { p.ph_lo = ph; p.ph_hi = ph + 1; hipLaunchKernelGGL(fwd, dim3(grid), dim3(NTHREADS), LDS_BYTES, stream, p); }
    p.ph_lo = 100; p.ph_hi = 101; hipLaunchKernelGGL(fwd, dim3(grid), dim3(NTHREADS), LDS_BYTES, stream, p);
#elif ONE_LAUNCH
    p.ph_lo = 0; p.ph_hi = N_PHASES;
    hipLaunchKernelGGL(fwd, dim3(grid), dim3(NTHREADS), LDS_BYTES, stream, p);
#else
    for (int ph = 0; ph < N_PHASES; ++ph) { p.ph_lo = ph; p.ph_hi = ph + 1; hipLaunchKernelGGL(fwd, dim3(grid), dim3(NTHREADS), LDS_BYTES, stream, p); }
#endif
}
```

```cpp
#include <hip/hip_runtime.h>
#include <stdint.h>
#include <stdio.h>
#include <string.h>

#ifndef ONE_LAUNCH
#define ONE_LAUNCH 1
#endif
#ifndef NAIVE_SCAN
#define NAIVE_SCAN 0
#endif
#ifndef GEMM8
#define GEMM8 1
#endif
#ifndef REGSTAGE
#define REGSTAGE 0
#endif

#define LAS __attribute__((address_space(3)))
typedef unsigned short bf16_t;
typedef short bf16x8 __attribute__((ext_vector_type(8)));
typedef float f32x4 __attribute__((ext_vector_type(4)));
typedef float f32x2 __attribute__((ext_vector_type(2)));
typedef unsigned u32x2 __attribute__((ext_vector_type(2)));
typedef unsigned u32x4 __attribute__((ext_vector_type(4)));

constexpr int D = 1024, NB = 8, SEQ = 2048, DEPTH = 4, CTXL = 256;
constexpr int ROWS_LAT = NB * SEQ;
constexpr int ROWS_CTX = NB * CTXL;
constexpr int MT = ROWS_LAT + ROWS_CTX;
constexpr int INC = 2576;
constexpr int PN = 2560;
constexpr int NE = 16;
constexpr int NGROUPS = 144;
constexpr int NSLOTS = NGROUPS * 256;
constexpr int NTHREADS = 512;
constexpr float EPS = 1e-6f;

constexpr size_t al256(size_t x) { return (x + 255) & ~(size_t)255; }
constexpr size_t WS_BAR = 0;
constexpr size_t WS_MOD = 16384;
constexpr size_t WS_X = WS_MOD + al256((size_t)DEPTH * 9 * 6144 * 4);
constexpr size_t WS_H = WS_X + (size_t)MT * D * 4;
constexpr size_t WS_PROJ = WS_H + (size_t)MT * D * 2;
constexpr size_t WS_YE = WS_PROJ;
constexpr size_t WS_LOGA = WS_PROJ + (size_t)MT * PN * 2;
constexpr size_t WS_BETA = WS_LOGA + (size_t)MT * 8 * 4;
constexpr size_t WS_QKV = WS_BETA + (size_t)MT * 8 * 4;
constexpr size_t WS_HID = WS_QKV;
constexpr size_t WS_OF = WS_QKV + (NAIVE_SCAN ? (size_t)MT * 1536 * 4 : (size_t)NSLOTS * D * 2);
constexpr size_t WS_OB = WS_OF + (size_t)MT * 512 * 4;
constexpr size_t WS_CAT = WS_OB + (size_t)MT * 512 * 4;
constexpr size_t WS_AFF = WS_CAT + (size_t)MT * D * 2;
constexpr size_t WS_SEL = WS_AFF + (size_t)MT * 16 * 4;
constexpr size_t WS_SELAFF = WS_SEL + (size_t)NSLOTS * 4;
constexpr size_t WS_SLOTOF = WS_SELAFF + (size_t)NSLOTS * 4;
constexpr size_t WS_WINT = WS_SLOTOF + (size_t)MT * 16 * 4;
constexpr size_t WS_WOUTT = WS_WINT + (size_t)DEPTH * PN * D * 2;
constexpr size_t WS_WGUT = WS_WOUTT + (size_t)DEPTH * D * D * 2;
constexpr size_t WS_WDT = WS_WGUT + (size_t)DEPTH * NE * 2048 * D * 2;
constexpr size_t WS_PWT = WS_WDT + (size_t)DEPTH * NE * D * D * 2;
constexpr size_t WS_W16T = WS_PWT + (size_t)DEPTH * 4 * 128 * 128 * 2;
constexpr size_t WS_SCN = WS_W16T + (size_t)DEPTH * 2 * 16 * D * 4;
constexpr int REC_W = 0, REC_KT = 16384, REC_QD = 32768, REC_QK = 49152, REC_UT = 57344, REC_MISC = 73728, REC_BYTES = 73984;
constexpr int NCHUNK = 36;
constexpr size_t WS_END = WS_SCN + (size_t)NB * 4 * 2 * NCHUNK * REC_BYTES + 4096;

constexpr int LDS_OFF = 1024;
constexpr int LDS_WORK = 160768;
constexpr int LDS_BYTES = LDS_OFF + LDS_WORK;

struct Params {
    const float *x, *c, *ctx, *c_ctx, *w_mod, *b_mod, *norm1, *norm2, *w_in, *conv_w, *a_log, *dt_bias, *dn_norm, *pool_w, *pool_scale, *w_out, *w_router, *w_gate, *w_up, *w_down, *norm_f;
    float* out;
    unsigned char* ws;
    int ph_lo, ph_hi;
};

#define XB_TMO      128
#define XB_XCNT(j)  (256  + 64 * (j))
#define XB_XSUB(j)  (1280 + 64 * (j))
#define XB_XGEN(j)  (2304 + 64 * (j))
#define XB_TOP      3328
#define XB_TOPGEN   3392
#define XCD_BAR_WORDS 3456
#define XB_SPIN_CAP (1u << 22)

__device__ __forceinline__ unsigned xb_ld(unsigned* p)              { return __hip_atomic_load(p, __ATOMIC_RELAXED, __HIP_MEMORY_SCOPE_AGENT); }
__device__ __forceinline__ unsigned xb_add(unsigned* p, unsigned v) { return __hip_atomic_fetch_add(p, v, __ATOMIC_RELAXED, __HIP_MEMORY_SCOPE_AGENT); }
__device__ __forceinline__ unsigned xb_xcc_id() { return (unsigned)__builtin_amdgcn_s_getreg((3 << 11) | 20) & 0xFu; }
#define XB_SPIN(cond, bar) do { unsigned _sp = 0; while (cond) { __builtin_amdgcn_s_sleep(1); \
    if ((++_sp & 255u) == 0u) { if (xb_ld(&(bar)[XB_TMO])) break; if (_sp > XB_SPIN_CAP) { atomicAdd(&(bar)[XB_TMO], 1u); break; } } } } while (0)

struct XcdBarrier { unsigned* bar; unsigned x; volatile LAS unsigned* st; };

__device__ __forceinline__ XcdBarrier xcd_barrier_post(unsigned* bar, volatile LAS unsigned* st) {
    XcdBarrier b; b.bar = bar; b.x = xb_xcc_id(); b.st = st;
    if (threadIdx.x == 0) (void)xb_add(&bar[XB_XCNT(b.x)], 1u);
    return b;
}
__device__ __forceinline__ void xcd_barrier_complete(unsigned* bar, unsigned x, unsigned& nloc, unsigned& nx) {
    const unsigned G = gridDim.x * gridDim.y * gridDim.z;
    unsigned sum, cnt, mine, sp = 0u;
    for (;;) {
        sum = 0u; cnt = 0u; mine = 0u;
#pragma unroll
        for (unsigned j = 0; j < 16; ++j) { const unsigned c = xb_ld(&bar[XB_XCNT(j)]); sum += c; cnt += (c > 0u) ? 1u : 0u; mine = (j == x) ? c : mine; }
        if (sum == G) break;
        __builtin_amdgcn_s_sleep(1);
        if ((++sp & 255u) == 0u) { if (xb_ld(&bar[XB_TMO])) break; if (sp > XB_SPIN_CAP) { atomicAdd(&bar[XB_TMO], 1u); break; } }
    }
    nloc = mine > 0u ? mine : 1u; nx = cnt > 0u ? cnt : 1u;
}
__device__ __forceinline__ void xcd_barrier(const XcdBarrier& b) {
    asm volatile("s_waitcnt vmcnt(0)" ::: "memory");
    __syncthreads();
    if (threadIdx.x == 0) {
        unsigned* bar = b.bar;
        __builtin_amdgcn_s_waitcnt(0);
        unsigned nloc = b.st[0], nx = b.st[1];
        if (nloc == 0u) { xcd_barrier_complete(bar, b.x, nloc, nx); b.st[0] = nloc; b.st[1] = nx; }
        const unsigned old = xb_add(&bar[XB_XSUB(b.x)], 1u);
        const unsigned gen = old / nloc;
        if (old + 1u == (gen + 1u) * nloc) {
            __builtin_amdgcn_fence(__ATOMIC_RELEASE, "agent");
            asm volatile("s_waitcnt vmcnt(0)" ::: "memory");
            const unsigned og = xb_add(&bar[XB_TOP], 1u);
            const unsigned tg = og / nx;
            if (og + 1u == (tg + 1u) * nx) xb_add(&bar[XB_TOPGEN], 1u);
            else XB_SPIN(xb_ld(&bar[XB_TOPGEN]) == tg, bar);
            __builtin_amdgcn_fence(__ATOMIC_ACQUIRE, "agent");
            xb_add(&bar[XB_XGEN(b.x)], 1u);
            asm volatile("s_waitcnt vmcnt(0)" ::: "memory");
        } else {
            XB_SPIN(xb_ld(&bar[XB_XGEN(b.x)]) == gen, bar);
            __builtin_amdgcn_fence(__ATOMIC_ACQUIRE, "agent");
            asm volatile("s_waitcnt vmcnt(0)" ::: "memory");
        }
    }
    __syncthreads();
}

typedef __bf16 bf16x2_t __attribute__((ext_vector_type(2)));
__device__ __forceinline__ unsigned pk_bf16(float lo, float hi) { const f32x2 v = {lo, hi}; const bf16x2_t b = __builtin_convertvector(v, bf16x2_t); return __builtin_bit_cast(unsigned, b); }
__device__ __forceinline__ float bf_lo(unsigned u) { return __uint_as_float(u << 16); }
__device__ __forceinline__ float bf_hi(unsigned u) { return __uint_as_float(u & 0xffff0000u); }
__device__ __forceinline__ float shx(float v, int mask, int lane) { return __int_as_float(__builtin_amdgcn_ds_bpermute((lane ^ mask) << 2, __float_as_int(v))); }
__device__ __forceinline__ float shup(float v, int o, int lane) { return __int_as_float(__builtin_amdgcn_ds_bpermute(((lane - o) & 63) << 2, __float_as_int(v))); }
__device__ __forceinline__ float wave_sum(float v, int lane) {
#pragma unroll
    for (int o = 32; o > 0; o >>= 1) v += shx(v, o, lane);
    return v;
}
__device__ __forceinline__ int opaque_tid() { int t = threadIdx.x; asm volatile("" : "+v"(t)); return t; }
__device__ __forceinline__ int opaque_s(int v) { asm volatile("" : "+s"(v)); return v; }
__device__ __forceinline__ float silu_f(float v) { return v / (1.f + __expf(-v)); }

__device__ __forceinline__ int lds_byte(int r, int c) { const int st = (r >> 4) * 2 + (c >> 5), rr = r & 15, cc = c & 31, ob = rr * 64 + cc * 2; return st * 1024 + (ob ^ (((ob >> 9) & 1) << 5)); }
__device__ __forceinline__ void stage_rc(int b, int& R, int& C) { const int st = b >> 10, sb = b & 1023, swz = sb ^ (((sb >> 9) & 1) << 5); R = (st >> 1) * 16 + (swz >> 6); C = (st & 1) * 32 + ((swz & 63) >> 1); }

constexpr int T_IN = 10 * 16, T_OUT = 4 * 16, T_EXP = NE * 4 * 16, T_LAYER = T_IN + T_OUT + 3 * T_EXP;
__device__ void convert_tiles(const Params& p, const int l, const int first, const int count, const int f, const int nf, LAS unsigned char* lds) {
    const int tid = opaque_tid();
    LAS float* tile = (LAS float*)lds;
    bf16_t* WINT = (bf16_t*)(p.ws + WS_WINT); bf16_t* WOUTT = (bf16_t*)(p.ws + WS_WOUTT); bf16_t* WGUT = (bf16_t*)(p.ws + WS_WGUT); bf16_t* WDT = (bf16_t*)(p.ws + WS_WDT);
    f32x4 rv[8]; const float* src = nullptr; size_t sld = 0;
#define CT_DECODE(t, SRC, SLD, DST, RS) do { int i = (t); RS = 16; \
        if (i < T_IN) { const int nt = i >> 4, kt = i & 15; const int n0 = nt < 6 ? nt * 256 : 1552 + (nt - 6) * 256; \
            SRC = p.w_in + ((size_t)l * D + kt * 64) * INC + n0; SLD = INC; DST = WINT + ((size_t)l * PN + nt * 256) * D + kt * 64; } \
        else if (i < T_IN + T_OUT) { i -= T_IN; const int nt = i >> 4, kt = i & 15; \
            SRC = p.w_out + ((size_t)l * D + kt * 64) * D + nt * 256; SLD = D; DST = WOUTT + ((size_t)l * D + nt * 256) * D + kt * 64; } \
        else { i -= T_IN + T_OUT; const int which = i / T_EXP; i %= T_EXP; const int e = i >> 6, nt = (i >> 4) & 3, kt = i & 15; \
            const size_t mo = ((size_t)(l * NE + e) * D + kt * 64) * D + nt * 256; \
            if (which == 2) { SRC = p.w_down + mo; DST = WDT + ((size_t)(l * NE + e) * D + nt * 256) * D + kt * 64; } \
            else { SRC = (which == 0 ? p.w_gate : p.w_up) + mo; RS = 32; DST = WGUT + ((size_t)(l * NE + e) * 2048 + nt * 512 + which * 16) * D + kt * 64; } \
            SLD = D; } } while (0)
#define CT_LOAD() do { _Pragma("unroll") for (int j = 0; j < 8; ++j) { const int e = tid * 4 + j * 2048; rv[j] = *(const f32x4*)(src + (size_t)(e >> 8) * sld + (e & 255)); } } while (0)
    bf16_t* dst = nullptr; int rs = 16;
    int t = first + f;
    if (t < first + count) { CT_DECODE(t, src, sld, dst, rs); CT_LOAD(); }
    for (; t < first + count; t += nf) {
#pragma unroll
        for (int j = 0; j < 8; ++j) {
            const int e = tid * 4 + j * 2048, k = e >> 8, n = e & 255;
            tile[k * 257 + n] = rv[j][0]; tile[k * 257 + n + 1] = rv[j][1]; tile[k * 257 + n + 2] = rv[j][2]; tile[k * 257 + n + 3] = rv[j][3];
        }
        bf16_t* dcur = dst; const int rcur = rs;
        if (t + nf < first + count) { CT_DECODE(t + nf, src, sld, dst, rs); CT_LOAD(); }
        __syncthreads();
#pragma unroll
        for (int ps = 0; ps < 4; ++ps) {
            const int n = ps * 64 + (tid >> 3), ks = (tid & 7) * 8;
            u32x4 o;
            o[0] = pk_bf16(tile[(ks + 0) * 257 + n], tile[(ks + 1) * 257 + n]); o[1] = pk_bf16(tile[(ks + 2) * 257 + n], tile[(ks + 3) * 257 + n]);
            o[2] = pk_bf16(tile[(ks + 4) * 257 + n], tile[(ks + 5) * 257 + n]); o[3] = pk_bf16(tile[(ks + 6) * 257 + n], tile[(ks + 7) * 257 + n]);
            *(u32x4*)(dcur + (size_t)((n >> 4) * rcur + (n & 15)) * D + ks) = o;
        }
        __syncthreads();
    }
#undef CT_DECODE
#undef CT_LOAD
}

__device__ void phase_prologue(const Params& p, LAS unsigned char* lds) {
    const int tid = opaque_tid();
    {
        LAS float* sc = (LAS float*)lds;
        LAS float* red = sc + 9 * 1024;
        for (int idx = tid; idx < 9 * 1024; idx += NTHREADS) {
            const int r = idx >> 10, k = idx & 1023;
            const float v = r < 8 ? p.c[r * 1024 + k] : p.c_ctx[k];
            sc[idx] = silu_f(v);
        }
        __syncthreads();
        float* MOD = (float*)(p.ws + WS_MOD);
        for (int u = blockIdx.x; u < DEPTH * 96; u += gridDim.x) {
            const int l = u / 96, c0 = (u % 96) * 64, col = tid & 63, kg = tid >> 6;
            float acc[9];
#pragma unroll
            for (int r = 0; r < 9; ++r) acc[r] = 0.f;
            const float* W = p.w_mod + (size_t)l * 1024 * 6144 + c0 + col;
#pragma unroll 4
            for (int kk = 0; kk < 128; ++kk) {
                const int k = kg * 128 + kk;
                const float w = W[(size_t)k * 6144];
#pragma unroll
                for (int r = 0; r < 9; ++r) acc[r] += sc[r * 1024 + k] * w;
            }
#pragma unroll
            for (int r = 0; r < 9; ++r) red[(kg * 9 + r) * 64 + col] = acc[r];
            __syncthreads();
            for (int idx = tid; idx < 576; idx += NTHREADS) {
                const int r = idx >> 6, cc = idx & 63;
                float s = 0.f;
#pragma unroll
                for (int g = 0; g < 8; ++g) s += red[(g * 9 + r) * 64 + cc];
                MOD[((size_t)l * 9 + r) * 6144 + c0 + cc] = s + p.b_mod[l * 6144 + c0 + cc];
            }
            __syncthreads();
        }
    }
    {
        f32x4* X4 = (f32x4*)(p.ws + WS_X);
        const f32x4* x4 = (const f32x4*)p.x; const f32x4* c4 = (const f32x4*)p.ctx;
        const int nlat = ROWS_LAT * D / 4, ntot = MT * D / 4;
        for (int i = blockIdx.x * NTHREADS + tid; i < ntot; i += gridDim.x * NTHREADS) X4[i] = i < nlat ? x4[i] : c4[i - nlat];
    }
    {
        convert_tiles(p, 0, 0, T_LAYER, (int)blockIdx.x, (int)gridDim.x, lds);
        {
            float* W16T = (float*)(p.ws + WS_W16T);
            for (int i = blockIdx.x * NTHREADS + tid; i < DEPTH * 2 * 16 * D; i += gridDim.x * NTHREADS) {
                const int l2 = i >> 15, wh = (i >> 14) & 1, j = (i >> 10) & 15, k = i & 1023;
                W16T[i] = wh ? p.w_router[((size_t)l2 * D + k) * NE + j] : p.w_in[((size_t)l2 * D + k) * INC + 1536 + j];
            }
        }
        bf16_t* PWT = (bf16_t*)(p.ws + WS_PWT);
        for (int i = blockIdx.x * NTHREADS + tid; i < DEPTH * 4 * 128 * 128; i += gridDim.x * NTHREADS) {
            const int lg = i >> 14, d = (i >> 7) & 127, c = i & 127;
            PWT[i] = (bf16_t)(pk_bf16(p.pool_w[((size_t)lg * 128 + c) * 128 + d], 0.f) & 0xffffu);
        }
    }
}

__device__ __forceinline__ float reduce4(const float v0, const float v1, const float v2, const float v3, const int lane) {
    const bool b5 = lane & 32, b4 = lane & 16;
    const float a0 = (b5 ? v2 : v0) + shx(b5 ? v0 : v2, 32, lane), a1 = (b5 ? v3 : v1) + shx(b5 ? v1 : v3, 32, lane);
    float c = (b4 ? a1 : a0) + shx(b4 ? a0 : a1, 16, lane);
    c += shx(c, 8, lane); c += shx(c, 4, lane); c += shx(c, 2, lane); c += shx(c, 1, lane);
    return c;
}

template <int WHICH>
__device__ void phase_norm(const Params& p, const int l, LAS unsigned char* lds) {
    const int tid = opaque_tid(), wid = tid >> 6, lane = tid & 63;
    LAS float* wsm = (LAS float*)lds;
    if (WHICH != 3) {
        const f32x4* src = (const f32x4*)(p.ws + WS_W16T) + (size_t)(l * 2 + (WHICH == 2 ? 1 : 0)) * 4096;
        f32x4 fv[8];
#pragma unroll
        for (int i = 0; i < 8; ++i) fv[i] = src[tid + i * NTHREADS];
#pragma unroll
        for (int i = 0; i < 8; ++i) *(LAS f32x4*)(wsm + (tid + i * NTHREADS) * 4) = fv[i];
        __syncthreads();
    }
    const float* nw = WHICH == 1 ? p.norm1 + l * D : (WHICH == 2 ? p.norm2 + l * D : p.norm_f);
    float* X = (float*)(p.ws + WS_X);
    const float* MOD = (const float*)(p.ws + WS_MOD);
    bf16_t* H = (bf16_t*)(p.ws + WS_H);
    const int nrows = (WHICH == 3 || (WHICH == 2 && l == DEPTH - 1)) ? ROWS_LAT : MT;
    constexpr int R = 3;
    const int rstride = gridDim.x * 8;
    const bool comb = (WHICH == 1 && l > 0) || WHICH == 3;
    f32x4 xn[R][4]; int svn[R];
#define NORM_LOAD(b0) do { _Pragma("unroll") for (int k = 0; k < R; ++k) { const int row = (b0) + k * rstride; svn[k] = -1; \
        if (row < nrows) { const float* xr = X + (size_t)row * D; _Pragma("unroll") for (int i = 0; i < 4; ++i) xn[k][i] = *(const f32x4*)(xr + i * 256 + lane * 4); \
            if (comb && lane < 16) svn[k] = ((const int*)(p.ws + WS_SLOTOF))[(size_t)row * 16 + lane]; } \
        else { _Pragma("unroll") for (int i = 0; i < 4; ++i) xn[k][i] = (f32x4){0.f, 0.f, 0.f, 0.f}; } } } while (0)
    NORM_LOAD(blockIdx.x * 8 + wid);
    for (int base = blockIdx.x * 8 + wid; base < nrows; base += rstride * R) {
        f32x4 xv[R][4]; int sv[R]; bool ok[R];
#pragma unroll
        for (int k = 0; k < R; ++k) { ok[k] = (base + k * rstride) < nrows; sv[k] = svn[k];
#pragma unroll
            for (int i = 0; i < 4; ++i) xv[k][i] = xn[k][i]; }
        if (comb) {
            const int lp = (WHICH == 3) ? DEPTH - 1 : l - 1;
            const bf16_t* YE = (const bf16_t*)(p.ws + WS_YE);
            f32x4 a[R][4]; unsigned long long msk[R];
#pragma unroll
            for (int k = 0; k < R; ++k) { msk[k] = __ballot(sv[k] >= 0);
#pragma unroll
                for (int i = 0; i < 4; ++i) a[k][i] = (f32x4){0.f, 0.f, 0.f, 0.f}; }
            while (msk[0] | msk[1] | msk[2]) {
                u32x2 t[R][4]; bool has[R];
#pragma unroll
                for (int k = 0; k < R; ++k) {
                    has[k] = msk[k] != 0ull;
                    if (has[k]) {
                        const int e = __builtin_ctzll(msk[k]); msk[k] &= msk[k] - 1ull;
                        const int sl = __builtin_amdgcn_readlane(sv[k], e);
                        const bf16_t* yr = YE + (size_t)sl * D;
#pragma unroll
                        for (int i = 0; i < 4; ++i) t[k][i] = *(const u32x2*)(yr + i * 256 + lane * 4);
                    }
                }
#pragma unroll
                for (int k = 0; k < R; ++k) if (has[k]) {
#pragma unroll
                    for (int i = 0; i < 4; ++i) { a[k][i][0] += bf_lo(t[k][i][0]); a[k][i][1] += bf_hi(t[k][i][0]); a[k][i][2] += bf_lo(t[k][i][1]); a[k][i][3] += bf_hi(t[k][i][1]); }
                }
            }
#pragma unroll
            for (int k = 0; k < R; ++k) if (ok[k]) {
                const int row = base + k * rstride, bidx = row < ROWS_LAT ? (row >> 11) : 8;
                const float* g2 = MOD + ((size_t)lp * 9 + bidx) * 6144 + 5 * 1024;
#pragma unroll
                for (int i = 0; i < 4; ++i) { const f32x4 g = *(const f32x4*)(g2 + i * 256 + lane * 4); xv[k][i] += g * a[k][i];
                    if (WHICH == 1) *(f32x4*)(X + (size_t)row * D + i * 256 + lane * 4) = xv[k][i]; }
            }
        }
        float rstd[R];
#pragma unroll
        for (int k = 0; k < R; ++k) {
            float ss = 0.f;
#pragma unroll
            for (int i = 0; i < 4; ++i) ss += xv[k][i][0] * xv[k][i][0] + xv[k][i][1] * xv[k][i][1] + xv[k][i][2] * xv[k][i][2] + xv[k][i][3] * xv[k][i][3];
            rstd[k] = rsqrtf(wave_sum(ss, lane) * (1.f / 1024.f) + EPS);
        }
        if (WHICH == 3) {
            if (base + rstride * R < nrows) NORM_LOAD(base + rstride * R);
#pragma unroll
            for (int k = 0; k < R; ++k) if (ok[k]) {
                const int row = base + k * rstride;
#pragma unroll
                for (int i = 0; i < 4; ++i) { const f32x4 w = *(const f32x4*)(nw + i * 256 + lane * 4); *(f32x4*)(p.out + (size_t)row * D + i * 256 + lane * 4) = xv[k][i] * rstd[k] * w; }
            }
            continue;
        }
#pragma unroll
        for (int k = 0; k < R; ++k) {
            const int row = base + k * rstride, bidx = row < ROWS_LAT ? (row >> 11) : 8;
            const float* md = MOD + ((size_t)l * 9 + bidx) * 6144 + (WHICH == 1 ? 0 : 3072);
#pragma unroll
            for (int i = 0; i < 4; ++i) {
                const int c = i * 256 + lane * 4;
                const f32x4 w = *(const f32x4*)(nw + c), sh = *(const f32x4*)(md + c), scl = *(const f32x4*)(md + 1024 + c);
                xv[k][i] = (xv[k][i] * rstd[k] * w) * (scl + 1.f) + sh;
                if (ok[k]) { u32x2 o; o[0] = pk_bf16(xv[k][i][0], xv[k][i][1]); o[1] = pk_bf16(xv[k][i][2], xv[k][i][3]); *(u32x2*)(H + (size_t)row * D + c) = o; }
            }
        }
        if (base + rstride * R < nrows) NORM_LOAD(base + rstride * R);
        float dj[R][4];
#pragma unroll
        for (int jg = 0; jg < 4; ++jg) {
            float sp[R][4];
#pragma unroll
            for (int jj = 0; jj < 4; ++jj) {
                const int j = jg * 4 + jj;
                float s0 = 0.f, s1 = 0.f, s2 = 0.f;
#pragma unroll
                for (int i = 0; i < 4; ++i) { const f32x4 w = *(const LAS f32x4*)(wsm + j * 1024 + i * 256 + lane * 4);
                    s0 += xv[0][i][0] * w[0] + xv[0][i][1] * w[1] + xv[0][i][2] * w[2] + xv[0][i][3] * w[3];
                    s1 += xv[1][i][0] * w[0] + xv[1][i][1] * w[1] + xv[1][i][2] * w[2] + xv[1][i][3] * w[3];
                    s2 += xv[2][i][0] * w[0] + xv[2][i][1] * w[1] + xv[2][i][2] * w[2] + xv[2][i][3] * w[3]; }
                sp[0][jj] = s0; sp[1][jj] = s1; sp[2][jj] = s2;
            }
#pragma unroll
            for (int k = 0; k < R; ++k) dj[k][jg] = reduce4(sp[k][0], sp[k][1], sp[k][2], sp[k][3], lane);
            __builtin_amdgcn_sched_barrier(0);
        }
        const int q = lane >> 4;
#pragma unroll
        for (int k = 0; k < R; ++k) {
            const int row = base + k * rstride;
            if (WHICH == 1) {
                if (ok[k] && (lane & 15) == 0) {
#pragma unroll
                    for (int jg = 0; jg < 4; ++jg) {
                        const int j = jg * 4 + q; const float v = dj[k][jg];
                        if (jg < 2) { const float xa = v + p.dt_bias[l * 8 + j]; const float sp2 = xa > 20.f ? xa : log1pf(__expf(xa));
                            ((float*)(p.ws + WS_LOGA))[(size_t)row * 8 + j] = -__expf(p.a_log[l * 8 + j]) * sp2; }
                        else ((float*)(p.ws + WS_BETA))[(size_t)row * 8 + (j - 8)] = 1.f / (1.f + __expf(-v));
                    }
                }
            } else {
                float m = fmaxf(fmaxf(dj[k][0], dj[k][1]), fmaxf(dj[k][2], dj[k][3]));
                m = fmaxf(m, shx(m, 16, lane)); m = fmaxf(m, shx(m, 32, lane));
                float e[4], sum = 0.f;
#pragma unroll
                for (int jg = 0; jg < 4; ++jg) { e[jg] = __expf(dj[k][jg] - m); sum += e[jg]; }
                sum += shx(sum, 16, lane); sum += shx(sum, 32, lane);
                const float inv = 1.f / sum;
                if (ok[k] && (lane & 15) == 0) {
#pragma unroll
                    for (int jg = 0; jg < 4; ++jg) ((float*)(p.ws + WS_AFF))[(size_t)row * 16 + jg * 4 + q] = e[jg] * inv;
                }
            }
        }
    }
}

#undef NORM_LOAD
__device__ __forceinline__ void gemm_core(const unsigned char* Ab, const unsigned (&aoff)[4], const unsigned char* Bb, const unsigned (&boff)[2], const int nt,
                                          LAS unsigned char* lds, f32x4 (&acc)[4][4], const int wid, const int lane) {
    const int wr = wid >> 1, wc = wid & 1, fr = lane & 15, fq = lane >> 4;
    const int ar = lds_byte(wr * 64 + fr, fq * 8), br = lds_byte(wc * 64 + fr, fq * 8);
    const unsigned ldsw = (unsigned)wid * 1024u;
#define G_STAGE(t, buf) do { const unsigned _ko = (unsigned)(t) * 128u; \
        _Pragma("unroll") for (int _i = 0; _i < 4; ++_i) __builtin_amdgcn_global_load_lds((const unsigned*)(Ab + aoff[_i] + _ko), (LAS unsigned*)(lds + (buf) * 49152 + ldsw + _i * 8192), 16, 0, 0); \
        _Pragma("unroll") for (int _i = 0; _i < 2; ++_i) __builtin_amdgcn_global_load_lds((const unsigned*)(Bb + boff[_i] + _ko), (LAS unsigned*)(lds + (buf) * 49152 + 32768 + ldsw + _i * 8192), 16, 0, 0); } while (0)
#pragma unroll
    for (int m = 0; m < 4; ++m)
#pragma unroll
        for (int n = 0; n < 4; ++n) acc[m][n] = (f32x4){0.f, 0.f, 0.f, 0.f};
#if REGSTAGE
    u32x4 ra[4], rb[2];
#pragma unroll
    for (int i = 0; i < 4; ++i) ra[i] = *(const u32x4*)(Ab + aoff[i]);
#pragma unroll
    for (int i = 0; i < 2; ++i) rb[i] = *(const u32x4*)(Bb + boff[i]);
    const unsigned tb = (unsigned)(wid * 64 + lane) * 16u;
    for (int t = 0; t < nt; ++t) {
        __syncthreads();
#pragma unroll
        for (int i = 0; i < 4; ++i) *(LAS u32x4*)(lds + tb + i * 8192) = ra[i];
#pragma unroll
        for (int i = 0; i < 2; ++i) *(LAS u32x4*)(lds + 32768 + tb + i * 8192) = rb[i];
        __syncthreads();
        if (t + 1 < nt) {
            const unsigned ko = (unsigned)(t + 1) * 128u;
#pragma unroll
            for (int i = 0; i < 4; ++i) ra[i] = *(const u32x4*)(Ab + aoff[i] + ko);
#pragma unroll
            for (int i = 0; i < 2; ++i) rb[i] = *(const u32x4*)(Bb + boff[i] + ko);
        }
        LAS unsigned char* bA = lds; LAS unsigned char* bB = bA + 32768;
        bf16x8 af[4][2], bfr[4][2];
#pragma unroll
        for (int m = 0; m < 4; ++m)
#pragma unroll
            for (int k = 0; k < 2; ++k) af[m][k] = *(const LAS bf16x8*)(bA + ar + m * 2048 + k * 1024);
#pragma unroll
        for (int n = 0; n < 4; ++n)
#pragma unroll
            for (int k = 0; k < 2; ++k) bfr[n][k] = *(const LAS bf16x8*)(bB + br + n * 2048 + k * 1024);
#pragma unroll
        for (int k = 0; k < 2; ++k)
#pragma unroll
            for (int m = 0; m < 4; ++m)
#pragma unroll
                for (int n = 0; n < 4; ++n) acc[m][n] = __builtin_amdgcn_mfma_f32_16x16x32_bf16(bfr[n][k], af[m][k], acc[m][n], 0, 0, 0);
    }
#else
    G_STAGE(0, 0);
    for (int t = 0; t < nt; ++t) {
        asm volatile("s_waitcnt vmcnt(0)" ::: "memory");
        __syncthreads();
        if (t + 1 < nt) { if ((t + 1) & 1) G_STAGE(t + 1, 1); else G_STAGE(t + 1, 0); }
        LAS unsigned char* bA = lds + (t & 1) * 49152; LAS unsigned char* bB = bA + 32768;
        bf16x8 af[4][2], bfr[4][2];
#pragma unroll
        for (int m = 0; m < 4; ++m)
#pragma unroll
            for (int k = 0; k < 2; ++k) af[m][k] = *(const LAS bf16x8*)(bA + ar + m * 2048 + k * 1024);
#pragma unroll
        for (int n = 0; n < 4; ++n)
#pragma unroll
            for (int k = 0; k < 2; ++k) bfr[n][k] = *(const LAS bf16x8*)(bB + br + n * 2048 + k * 1024);
#pragma unroll
        for (int k = 0; k < 2; ++k)
#pragma unroll
            for (int m = 0; m < 4; ++m)
#pragma unroll
                for (int n = 0; n < 4; ++n) acc[m][n] = __builtin_amdgcn_mfma_f32_16x16x32_bf16(bfr[n][k], af[m][k], acc[m][n], 0, 0, 0);
    }
#endif
    __syncthreads();
#undef G_STAGE
}

template <int MODE>
__device__ void phase_gemm(const Params& p, const int l, LAS unsigned char* lds) {
    const int tid = opaque_tid(), wid = __builtin_amdgcn_readfirstlane(tid >> 6), lane = tid & 63;
    const int wr = wid >> 1, wc = wid & 1, fr = lane & 15, fq = lane >> 4;
    int R0, C0; stage_rc(tid * 16, R0, C0);
    constexpr int nN = MODE == 0 ? 20 : (MODE == 1 ? 8 : (MODE == 2 ? 16 : 8));
    constexpr int nM = (MODE <= 1) ? MT / 256 : NGROUPS;
    const bf16_t* H = (const bf16_t*)(p.ws + WS_H);
    for (int u = blockIdx.x; u < nM * nN; u += gridDim.x) {
        const int pm = u / nN, pn = u % nN;
        const unsigned char* Ab; const unsigned char* Bb; unsigned aoff[4], boff[2];
#pragma unroll
        for (int i = 0; i < 2; ++i) boff[i] = (unsigned)((R0 + 64 * i) * D + C0) * 2u;
        int e = 0;
        if (MODE == 0) {
            Ab = (const unsigned char*)(H + (size_t)pm * 256 * D); Bb = (const unsigned char*)((const bf16_t*)(p.ws + WS_WINT) + ((size_t)l * PN + pn * 128) * D);
#pragma unroll
            for (int i = 0; i < 4; ++i) aoff[i] = (unsigned)((R0 + 64 * i) * D + C0) * 2u;
        } else if (MODE == 1) {
            Ab = (const unsigned char*)((const bf16_t*)(p.ws + WS_CAT) + (size_t)pm * 256 * D); Bb = (const unsigned char*)((const bf16_t*)(p.ws + WS_WOUTT) + ((size_t)l * D + pn * 128) * D);
#pragma unroll
            for (int i = 0; i < 4; ++i) aoff[i] = (unsigned)((R0 + 64 * i) * D + C0) * 2u;
        } else if (MODE == 2) {
            e = pm < 128 ? (pm >> 3) : (pm - 128);
            const int* SEL = (const int*)(p.ws + WS_SEL) + pm * 256;
            Ab = (const unsigned char*)H; Bb = (const unsigned char*)((const bf16_t*)(p.ws + WS_WGUT) + ((size_t)(l * NE + e) * 2048 + pn * 128) * D);
#pragma unroll
            for (int i = 0; i < 4; ++i) aoff[i] = (unsigned)(SEL[R0 + 64 * i] * D + C0) * 2u;
        } else {
            e = pm < 128 ? (pm >> 3) : (pm - 128);
            Ab = (const unsigned char*)((const bf16_t*)(p.ws + WS_HID) + (size_t)pm * 256 * D); Bb = (const unsigned char*)((const bf16_t*)(p.ws + WS_WDT) + ((size_t)(l * NE + e) * D + pn * 128) * D);
#pragma unroll
            for (int i = 0; i < 4; ++i) aoff[i] = (unsigned)((R0 + 64 * i) * D + C0) * 2u;
        }
        f32x4 acc[4][4];
        gemm_core(Ab, aoff, Bb, boff, D / 64, lds, acc, wid, lane);
        if (MODE == 0) {
            bf16_t* PROJ = (bf16_t*)(p.ws + WS_PROJ);
#pragma unroll
            for (int m = 0; m < 4; ++m) { const size_t row = (size_t)pm * 256 + wr * 64 + m * 16 + fr;
#pragma unroll
                for (int n = 0; n < 4; ++n) { u32x2 o; o[0] = pk_bf16(acc[m][n][0], acc[m][n][1]); o[1] = pk_bf16(acc[m][n][2], acc[m][n][3]);
                    *(u32x2*)(PROJ + row * PN + pn * 128 + wc * 64 + n * 16 + fq * 4) = o; } }
        } else if (MODE == 1) {
            float* X = (float*)(p.ws + WS_X);
            const int bidx = pm < 64 ? (pm >> 3) : 8;
            const float* g1 = (const float*)(p.ws + WS_MOD) + ((size_t)l * 9 + bidx) * 6144 + 2048;
#pragma unroll
            for (int n = 0; n < 4; ++n) { const int col = pn * 128 + wc * 64 + n * 16 + fq * 4; const f32x4 g = *(const f32x4*)(g1 + col);
#pragma unroll
                for (int m = 0; m < 4; ++m) { float* xp = X + ((size_t)pm * 256 + wr * 64 + m * 16 + fr) * D + col; *(f32x4*)xp = *(const f32x4*)xp + g * acc[m][n]; } }
        } else if (MODE == 2) {
            bf16_t* HID = (bf16_t*)(p.ws + WS_HID);
#pragma unroll
            for (int m = 0; m < 4; ++m) { const size_t slot = (size_t)pm * 256 + wr * 64 + m * 16 + fr;
#pragma unroll
                for (int q = 0; q < 2; ++q) { const f32x4 g = acc[m][2 * q], uu = acc[m][2 * q + 1];
                    u32x2 o; o[0] = pk_bf16(silu_f(g[0]) * uu[0], silu_f(g[1]) * uu[1]); o[1] = pk_bf16(silu_f(g[2]) * uu[2], silu_f(g[3]) * uu[3]);
                    *(u32x2*)(HID + slot * D + pn * 64 + wc * 32 + q * 16 + fq * 4) = o; } }
        } else {
            bf16_t* YE = (bf16_t*)(p.ws + WS_YE);
            const float* SELAFF = (const float*)(p.ws + WS_SELAFF);
#pragma unroll
            for (int m = 0; m < 4; ++m) { const size_t slot = (size_t)pm * 256 + wr * 64 + m * 16 + fr; const float a = SELAFF[slot];
#pragma unroll
                for (int n = 0; n < 4; ++n) { u32x2 o; o[0] = pk_bf16(acc[m][n][0] * a, acc[m][n][1] * a); o[1] = pk_bf16(acc[m][n][2] * a, acc[m][n][3] * a);
                    *(u32x2*)(YE + slot * D + pn * 128 + wc * 64 + n * 16 + fq * 4) = o; } }
        }
    }
}

struct UnitOps { const unsigned char* A; const unsigned char* B; unsigned va[2][2]; int pm, pn; };

template <int MODE> __device__ __forceinline__ int gemm_nunits(const int l) {
    const bool last = (l == DEPTH - 1);
    if (MODE == 0) return last ? 640 + 8 * 6 : 720;
    if (MODE == 1) return last ? 256 : 288;
    if (MODE == 2) return last ? 1024 : 1152;
    return last ? 512 : 576;
}
template <int MODE>
__device__ __forceinline__ bool gemm_unit(const Params& p, const int l, const int i, const int R0, const int C0, UnitOps& u) {
    constexpr int nN = MODE == 0 ? 10 : (MODE == 1 ? 4 : (MODE == 2 ? 8 : 4));
    const int G = gridDim.x, c = (G & 7) == 0 ? (int)(blockIdx.x & 7) * (G >> 3) + (int)(blockIdx.x >> 3) : (int)blockIdx.x;
    const int idx = c + i * G;
    if (idx >= gemm_nunits<MODE>(l)) return false;
    int pm = idx / nN, pn = idx % nN;
    if (MODE == 0 && idx >= 640 && l == DEPTH - 1) { pm = 64 + (idx - 640) / 6; pn = (idx - 640) % 6; }
    u.pm = pm; u.pn = pn;
    if (MODE == 2) {
        const int e = pm < 128 ? (pm >> 3) : (pm - 128);
        const int* SEL = (const int*)(p.ws + WS_SEL) + pm * 256;
        u.A = p.ws + WS_H; u.B = p.ws + WS_WGUT + ((size_t)(l * NE + e) * 2048 + pn * 256) * D * 2;
#pragma unroll
        for (int h = 0; h < 2; ++h)
#pragma unroll
            for (int k = 0; k < 2; ++k) u.va[h][k] = (unsigned)(SEL[h * 128 + R0 + 64 * k] * D + C0) * 2u;
    } else {
        if (MODE == 0) { u.A = p.ws + WS_H + (size_t)pm * 256 * D * 2; u.B = p.ws + WS_WINT + ((size_t)l * PN + pn * 256) * D * 2; }
        else if (MODE == 1) { u.A = p.ws + WS_CAT + (size_t)pm * 256 * D * 2; u.B = p.ws + WS_WOUTT + ((size_t)l * D + pn * 256) * D * 2; }
        else { const int e = pm < 128 ? (pm >> 3) : (pm - 128); u.A = p.ws + WS_HID + (size_t)pm * 256 * D * 2; u.B = p.ws + WS_WDT + ((size_t)(l * NE + e) * D + pn * 256) * D * 2; }
#pragma unroll
        for (int h = 0; h < 2; ++h)
#pragma unroll
            for (int k = 0; k < 2; ++k) u.va[h][k] = (unsigned)((h * 128 + R0 + 64 * k) * D + C0) * 2u;
    }
    return true;
}

template <int MODE>
__device__ __forceinline__ void gemm_epilogue(const Params& p, const int l, const f32x4 (&acc)[2][2][4][2], const UnitOps& u, const int wr, const int wc, const int fr, const int fq) {
    const int row0 = u.pm * 256 + wr * 64 + fr, col0 = u.pn * 256 + wc * 32 + 4 * fq;
    if (MODE == 0) {
        bf16_t* PROJ = (bf16_t*)(p.ws + WS_PROJ);
#pragma unroll
        for (int ai = 0; ai < 2; ++ai)
#pragma unroll
            for (int m = 0; m < 4; ++m) { bf16_t* rp = PROJ + (size_t)(row0 + ai * 128 + m * 16) * PN + col0;
#pragma unroll
                for (int bj = 0; bj < 2; ++bj)
#pragma unroll
                    for (int n = 0; n < 2; ++n) { const f32x4 v = acc[ai][bj][m][n]; u32x2 o; o[0] = pk_bf16(v[0], v[1]); o[1] = pk_bf16(v[2], v[3]); *(u32x2*)(rp + bj * 128 + n * 16) = o; } }
    } else if (MODE == 1) {
        float* X = (float*)(p.ws + WS_X);
        const int bidx = u.pm < 64 ? (u.pm >> 3) : 8;
        const float* g1 = (const float*)(p.ws + WS_MOD) + ((size_t)l * 9 + bidx) * 6144 + 2048 + col0;
        f32x4 gv[2][2];
#pragma unroll
        for (int bj = 0; bj < 2; ++bj)
#pragma unroll
            for (int n = 0; n < 2; ++n) gv[bj][n] = *(const f32x4*)(g1 + bj * 128 + n * 16);
#pragma unroll
        for (int ai = 0; ai < 2; ++ai)
#pragma unroll
            for (int m = 0; m < 4; ++m) { float* rp = X + (size_t)(row0 + ai * 128 + m * 16) * D + col0;
#pragma unroll
                for (int bj = 0; bj < 2; ++bj)
#pragma unroll
                    for (int n = 0; n < 2; ++n) { float* xp = rp + bj * 128 + n * 16; *(f32x4*)xp = *(const f32x4*)xp + gv[bj][n] * acc[ai][bj][m][n]; } }
    } else if (MODE == 2) {
        bf16_t* HID = (bf16_t*)(p.ws + WS_HID);
        const int f0 = u.pn * 128 + wc * 16 + 4 * fq;
#pragma unroll
        for (int ai = 0; ai < 2; ++ai)
#pragma unroll
            for (int m = 0; m < 4; ++m) { bf16_t* rp = HID + (size_t)(row0 + ai * 128 + m * 16) * D + f0;
#pragma unroll
                for (int bj = 0; bj < 2; ++bj) { const f32x4 g = acc[ai][bj][m][0], uu = acc[ai][bj][m][1];
                    u32x2 o; o[0] = pk_bf16(silu_f(g[0]) * uu[0], silu_f(g[1]) * uu[1]); o[1] = pk_bf16(silu_f(g[2]) * uu[2], silu_f(g[3]) * uu[3]);
                    *(u32x2*)(rp + bj * 64) = o; } }
    } else {
        bf16_t* YE = (bf16_t*)(p.ws + WS_YE);
        const float* SELAFF = (const float*)(p.ws + WS_SELAFF);
#pragma unroll
        for (int ai = 0; ai < 2; ++ai)
#pragma unroll
            for (int m = 0; m < 4; ++m) { const size_t slot = (size_t)(row0 + ai * 128 + m * 16); const float a = SELAFF[slot]; bf16_t* rp = YE + slot * D + col0;
#pragma unroll
                for (int bj = 0; bj < 2; ++bj)
#pragma unroll
                    for (int n = 0; n < 2; ++n) { const f32x4 v = acc[ai][bj][m][n]; u32x2 o; o[0] = pk_bf16(v[0] * a, v[1] * a); o[1] = pk_bf16(v[2] * a, v[3] * a); *(u32x2*)(rp + bj * 128 + n * 16) = o; } }
    }
}

template <int MODE>
__device__ __forceinline__ void gemm_filler(const Params& p, const int l, LAS unsigned char* lds) {
    if (MODE == 0 || l >= DEPTH - 1) return;
    const int G = gridDim.x, c = (G & 7) == 0 ? (int)(blockIdx.x & 7) * (G >> 3) + (int)(blockIdx.x >> 3) : (int)blockIdx.x;
    const int rem = gemm_nunits<MODE>(l) % G;
    if (rem == 0 || c < rem) return;
    constexpr int first = MODE == 1 ? 0 : (MODE == 2 ? 1344 : 2240), count = MODE == 1 ? 1344 : (MODE == 2 ? 896 : 1056);
    convert_tiles(p, l + 1, first, count, c - rem, G - rem, lds);
}

template <int MODE>
__device__ void phase_gemm8(const Params& p, const int l, LAS unsigned char* lds) {
    const int tid = opaque_tid(), wid = __builtin_amdgcn_readfirstlane(tid >> 6), lane = tid & 63, wr = wid >> 2, wc = wid & 3, fr = lane & 15, fq = lane >> 4;
    constexpr int HTB = 16384;
    constexpr int nt = D / 64;
    constexpr unsigned kstep = 128u, hstepB = 128u * D * 2u;
    int R0, C0; stage_rc(tid * 16, R0, C0);
    unsigned vb[2];
#pragma unroll
    for (int k = 0; k < 2; ++k) vb[k] = (unsigned)((R0 + 64 * k) * D + C0) * 2u;
    const unsigned ldsw = (unsigned)wid * 1024u;
    const int aoff = lds_byte(wr * 64 + fr, fq * 8), boff = lds_byte(wc * 32 + fr, fq * 8);
#define G8_SA(b, h) (((b) * 2 + (h)) * HTB)
#define G8_SB(b, h) ((4 + (b) * 2 + (h)) * HTB)
#define G8_STAGE_A(bufoff, U, h, ko) do { _Pragma("unroll") for (int _i = 0; _i < 2; ++_i) \
        __builtin_amdgcn_global_load_lds((const unsigned*)((U).A + (U).va[h][_i] + (ko)), (LAS unsigned*)(lds + (bufoff) + ldsw + _i * 8192), 16, 0, 0); } while (0)
#define G8_STAGE_B(bufoff, U, h, ko) do { _Pragma("unroll") for (int _i = 0; _i < 2; ++_i) \
        __builtin_amdgcn_global_load_lds((const unsigned*)((U).B + vb[_i] + (h) * hstepB + (ko)), (LAS unsigned*)(lds + (bufoff) + ldsw + _i * 8192), 16, 0, 0); } while (0)
#define G8_LDA(dst, b, h) do { _Pragma("unroll") for (int m = 0; m < 4; ++m) _Pragma("unroll") for (int k = 0; k < 2; ++k) dst[m][k] = *(const LAS bf16x8*)(lds + G8_SA(b, h) + aoff + m * 2048 + k * 1024); } while (0)
#define G8_LDB(dst, b, h) do { _Pragma("unroll") for (int n = 0; n < 2; ++n) _Pragma("unroll") for (int k = 0; k < 2; ++k) dst[n][k] = *(const LAS bf16x8*)(lds + G8_SB(b, h) + boff + n * 2048 + k * 1024); } while (0)
#define G8_MMA(ai, bj, At, Bt) do { __builtin_amdgcn_s_setprio(1); _Pragma("unroll") for (int m = 0; m < 4; ++m) _Pragma("unroll") for (int n = 0; n < 2; ++n) _Pragma("unroll") for (int k = 0; k < 2; ++k) \
        acc[ai][bj][m][n] = __builtin_amdgcn_mfma_f32_16x16x32_bf16(Bt[n][k], At[m][k], acc[ai][bj][m][n], 0, 0, 0); __builtin_amdgcn_s_setprio(0); } while (0)
#define G8_WAIT_V(n) asm volatile("s_waitcnt vmcnt(" #n ")" ::: "memory")
#define G8_WAIT_L(n) asm volatile("s_waitcnt lgkmcnt(" #n ")" ::: "memory")
#define G8_BAR __builtin_amdgcn_s_barrier()
#define G8_SCHED __builtin_amdgcn_sched_barrier(0)
    UnitOps cur, nxt; int ui = 0;
    if (!gemm_unit<MODE>(p, l, 0, R0, C0, cur)) { gemm_filler<MODE>(p, l, lds); return; }
    f32x4 acc[2][2][4][2];
#pragma unroll
    for (int a = 0; a < 2; ++a)
#pragma unroll
        for (int b = 0; b < 2; ++b)
#pragma unroll
            for (int m = 0; m < 4; ++m)
#pragma unroll
                for (int n = 0; n < 2; ++n) acc[a][b][m][n] = (f32x4){0.f, 0.f, 0.f, 0.f};
    bf16x8 At[4][2], B0[2][2], B1[2][2];
    bool has_next = gemm_unit<MODE>(p, l, 1, R0, C0, nxt);
    if (!has_next) nxt = cur;
    G8_STAGE_B(G8_SB(0, 0), cur, 0, 0u); G8_STAGE_A(G8_SA(0, 0), cur, 0, 0u); G8_STAGE_B(G8_SB(0, 1), cur, 1, 0u); G8_STAGE_A(G8_SA(0, 1), cur, 1, 0u);
    if (wr == 1) G8_BAR;
    G8_WAIT_V(4); G8_BAR;
    G8_STAGE_B(G8_SB(1, 0), cur, 0, kstep); G8_STAGE_A(G8_SA(1, 0), cur, 0, kstep); G8_STAGE_B(G8_SB(1, 1), cur, 1, kstep);
    G8_WAIT_V(6); G8_BAR;
    for (;;) {
#pragma unroll 1
        for (int t = 0; t < nt; t += 2) {
            const bool last = (t == nt - 2);
            const unsigned k1 = (unsigned)(t + 1) * kstep, k2 = last ? 0u : (unsigned)(t + 2) * kstep, k3 = k2 + kstep;
            UnitOps& U2 = last ? nxt : cur;
            G8_LDB(B0, 0, 0); G8_SCHED; G8_LDA(At, 0, 0); G8_STAGE_A(G8_SA(1, 1), cur, 1, k1);
            G8_WAIT_L(8); G8_BAR; G8_WAIT_L(0); G8_MMA(0, 0, At, B0); G8_BAR; G8_SCHED;
            G8_LDB(B1, 0, 1); G8_STAGE_B(G8_SB(0, 0), U2, 0, k2);
            G8_BAR; G8_WAIT_L(0); G8_MMA(0, 1, At, B1); G8_BAR;
            G8_LDA(At, 0, 1); G8_STAGE_A(G8_SA(0, 0), U2, 0, k2);
            G8_BAR; G8_WAIT_L(0); G8_MMA(1, 0, At, B0); G8_BAR; G8_SCHED;
            G8_STAGE_B(G8_SB(0, 1), U2, 1, k2);
            G8_WAIT_V(6); G8_BAR; G8_MMA(1, 1, At, B1); G8_BAR;
            G8_LDB(B0, 1, 0); G8_SCHED; G8_LDA(At, 1, 0); G8_STAGE_A(G8_SA(0, 1), U2, 1, k2);
            G8_WAIT_L(8); G8_BAR; G8_WAIT_L(0); G8_MMA(0, 0, At, B0); G8_BAR; G8_SCHED;
            G8_LDB(B1, 1, 1); G8_STAGE_B(G8_SB(1, 0), U2, 0, k3);
            G8_BAR; G8_WAIT_L(0); G8_MMA(0, 1, At, B1); G8_BAR;
            G8_LDA(At, 1, 1); G8_STAGE_A(G8_SA(1, 0), U2, 0, k3);
            G8_BAR; G8_WAIT_L(0); G8_MMA(1, 0, At, B0); G8_BAR; G8_SCHED;
            G8_STAGE_B(G8_SB(1, 1), U2, 1, k3);
            G8_WAIT_V(6); G8_BAR; G8_MMA(1, 1, At, B1); G8_BAR;
        }
        gemm_epilogue<MODE>(p, l, acc, cur, wr, wc, fr, fq);
        if (!has_next) break;
#pragma unroll
        for (int a = 0; a < 2; ++a)
#pragma unroll
            for (int b = 0; b < 2; ++b)
#pragma unroll
                for (int m = 0; m < 4; ++m)
#pragma unroll
                    for (int n = 0; n < 2; ++n) acc[a][b][m][n] = (f32x4){0.f, 0.f, 0.f, 0.f};
        cur = nxt; ++ui;
        has_next = gemm_unit<MODE>(p, l, ui + 1, R0, C0, nxt);
        if (!has_next) nxt = cur;
    }
    G8_WAIT_V(0);
    if (wr == 0) G8_BAR;
    G8_BAR;
    gemm_filler<MODE>(p, l, lds);
#undef G8_SA
#undef G8_SB
#undef G8_STAGE_A
#undef G8_STAGE_B
#undef G8_LDA
#undef G8_LDB
#undef G8_MMA
#undef G8_WAIT_V
#undef G8_WAIT_L
#undef G8_BAR
#undef G8_SCHED
}

__device__ void phase_conv_pool(const Params& p, const int l, LAS unsigned char* lds) {
    const int tid = opaque_tid(), wid = tid >> 6, lane = tid & 63;
    const bf16_t* PROJ = (const bf16_t*)(p.ws + WS_PROJ);
    if (NAIVE_SCAN) {
        float* QKV = (float*)(p.ws + WS_QKV);
        const float* cw = p.conv_w + (size_t)l * 4 * 1536;
        for (int task = blockIdx.x * 8 + wid; task < MT * 12; task += gridDim.x * 8) {
            const int row = task / 12, part = task % 12;
            int s0, len;
            if (row < ROWS_LAT) { s0 = row & ~2047; len = 2048; } else { s0 = ROWS_LAT + ((row - ROWS_LAT) & ~255); len = 256; }
            const int c = part * 128 + lane * 2;
            float a0 = 0.f, a1 = 0.f;
#pragma unroll
            for (int j = 0; j < 4; ++j) {
                const int r2 = row + j - 2;
                if (r2 >= s0 && r2 < s0 + len) {
                    const unsigned v = *(const unsigned*)(PROJ + (size_t)r2 * PN + c);
                    const f32x2 w = *(const f32x2*)(cw + j * 1536 + c);
                    a0 += w[0] * bf_lo(v); a1 += w[1] * bf_hi(v);
                }
            }
            a0 = silu_f(a0); a1 = silu_f(a1);
            if (part < 8) {
                const float ss = wave_sum(a0 * a0 + a1 * a1, lane);
                float sc = rsqrtf(ss + EPS);
                if (part < 4) sc *= 0.08838834764831845f;
                a0 *= sc; a1 *= sc;
            }
            *(f32x2*)(QKV + (size_t)row * 1536 + c) = (f32x2){a0, a1};
        }
    }
    {
        LAS float* V = (LAS float*)lds;
        LAS unsigned char* mt = lds + 40960;
        const bf16_t* PWT = (const bf16_t*)(p.ws + WS_PWT);
        bf16_t* CAT = (bf16_t*)(p.ws + WS_CAT);
        const int wr = wid >> 1, wc = wid & 1, fr = lane & 15, fq = lane >> 4;
        const int npool = (l == DEPTH - 1) ? 1024 : 1152;
        for (int u = blockIdx.x; u < npool; u += gridDim.x) {
            int g, r, nrows, ncols, c0, rowbase;
            if (u < 1024) { const int q = u & 255, b = q >> 5; g = (q + (u >> 8)) & 3; r = q & 31; nrows = 32; ncols = 64; c0 = 0; rowbase = b * 2048; }
            else { const int v = u - 1024; const int b = v >> 4; g = (v >> 2) & 3; r = 0; nrows = 1; ncols = 256; c0 = (v & 3) * 64; rowbase = ROWS_LAT + b * 256; }
            const int w = 2 << g, half = w >> 1;
            const int lo_r = max(r - half, 0), hi_r = min(r - half + w, nrows);
            const int cxlo = max(c0 - half, 0), cxhi = min(c0 + 64 + half, ncols);
            const bf16_t* ub = PROJ + 2048 + g * 128;
            for (int pi = tid; pi < (cxhi - cxlo) * 16; pi += NTHREADS) {
                const int cxi = pi >> 4, c8 = (pi & 15) * 8;
                float av[8];
#pragma unroll
                for (int e = 0; e < 8; ++e) av[e] = 0.f;
                const bf16_t* src = ub + (size_t)(rowbase + cxlo + cxi) * PN + c8;
                for (int r0 = lo_r; r0 < hi_r; r0 += 8) {
                    u32x4 v[8];
#pragma unroll
                    for (int k = 0; k < 8; ++k) { const int rr = min(r0 + k, hi_r - 1); v[k] = *(const u32x4*)(src + (size_t)rr * ncols * PN); }
#pragma unroll
                    for (int k = 0; k < 8; ++k) if (r0 + k < hi_r) {
#pragma unroll
                        for (int e = 0; e < 4; ++e) { av[2 * e] += bf_lo(v[k][e]); av[2 * e + 1] += bf_hi(v[k][e]); }
                    }
                }
                *(LAS f32x4*)(V + cxi * 128 + c8) = (f32x4){av[0], av[1], av[2], av[3]};
                *(LAS f32x4*)(V + cxi * 128 + c8 + 4) = (f32x4){av[4], av[5], av[6], av[7]};
            }
            __syncthreads();
            for (int idx = tid; idx < 64 * 64; idx += NTHREADS) {
                const int ci = idx >> 6, ch = (idx & 63) * 2, c = c0 + ci;
                const int lo_c = max(c - half, 0), hi_c = min(c - half + w, ncols);
                float s0 = 0.f, s1 = 0.f;
                for (int cx = lo_c; cx < hi_c; ++cx) { s0 += V[(cx - cxlo) * 128 + ch]; s1 += V[(cx - cxlo) * 128 + ch + 1]; }
                const float inv = 1.f / (float)((hi_r - lo_r) * (hi_c - lo_c));
                const unsigned v = *(const unsigned*)(ub + (size_t)(rowbase + r * ncols + c) * PN + ch);
                *(LAS unsigned*)(mt + ci * 272 + ch * 2) = pk_bf16(s0 * inv - bf_lo(v), s1 * inv - bf_hi(v));
            }
            __syncthreads();
            f32x4 acc[4];
#pragma unroll
            for (int n = 0; n < 4; ++n) acc[n] = (f32x4){0.f, 0.f, 0.f, 0.f};
            const bf16_t* pw = PWT + (size_t)(l * 4 + g) * 128 * 128;
#pragma unroll
            for (int kk = 0; kk < 4; ++kk) {
                const bf16x8 a = *(const LAS bf16x8*)(mt + (wr * 16 + fr) * 272 + (kk * 32 + fq * 8) * 2);
#pragma unroll
                for (int n = 0; n < 4; ++n) {
                    const bf16x8 b = *(const bf16x8*)(pw + (size_t)(wc * 64 + n * 16 + fr) * 128 + kk * 32 + fq * 8);
                    acc[n] = __builtin_amdgcn_mfma_f32_16x16x32_bf16(b, a, acc[n], 0, 0, 0);
                }
            }
            const size_t row = (size_t)rowbase + r * ncols + c0 + wr * 16 + fr;
#pragma unroll
            for (int n = 0; n < 4; ++n) {
                const int dcol = g * 128 + wc * 64 + n * 16 + fq * 4;
                const f32x4 s = *(const f32x4*)(p.pool_scale + l * 512 + dcol);
                u32x2 o; o[0] = pk_bf16(acc[n][0] * s[0], acc[n][1] * s[1]); o[1] = pk_bf16(acc[n][2] * s[2], acc[n][3] * s[3]);
                *(u32x2*)(CAT + row * D + 512 + dcol) = o;
            }
            __syncthreads();
        }
    }
}


__device__ __forceinline__ int img256(int row, int col) { return row * 256 + ((((col >> 3) ^ row) & 15) << 4) + (col & 7) * 2; }
__device__ __forceinline__ int img128(int row, int col) { return (row >> 1) * 256 + (row & 1) * 128 + ((((col >> 3) ^ (row >> 1)) & 7) << 4) + (col & 7) * 2; }

__device__ void phase_prep(const Params& p, const int l, LAS unsigned char* lds) {
    int tid = opaque_tid(), wid = __builtin_amdgcn_readfirstlane(tid >> 6), lane = tid & 63, fr = lane & 15, fq = lane >> 4;
#define RELAUNDER() do { asm volatile("" : "+v"(tid)); wid = __builtin_amdgcn_readfirstlane(tid >> 6); lane = tid & 63; fr = lane & 15; fq = lane >> 4; } while (0)
    constexpr int R_KK = 0, R_QK = 16640, R_TB = 33280, R_QN = 53248, R_KN = 70656, R_KNT = 88064, R_VT = 106496, R_TW = 124928, R_TU = 134144, R_MB = R_TW, R_G = 143360;
    LAS float* KK = (LAS float*)(lds + R_KK); LAS float* QK = (LAS float*)(lds + R_QK); LAS float* TB = (LAS float*)(lds + R_TB); LAS float* MB = (LAS float*)(lds + R_MB);
    LAS float* G_LA = (LAS float*)(lds + R_G);
    LAS float* G_BT = G_LA + 128;
    LAS float* G_GC = G_BT + 128;
    LAS float* G_TOT = G_GC + 128;
    LAS float* XS = G_TOT + 16;
    LAS float* CW = (LAS float*)(lds + 149504);
    const bf16_t* PROJ = (const bf16_t*)(p.ws + WS_PROJ);
    const float* LOGA = (const float*)(p.ws + WS_LOGA); const float* BETA = (const float*)(p.ws + WS_BETA);
    int cur_h = -1;
    for (int u = blockIdx.x; u < NB * 4 * NCHUNK; u += gridDim.x) {
        const int h = u & 3, b = (u >> 2) / 36, cc = (u >> 2) % 36;
        if (h != cur_h) {
            __syncthreads();
            for (int idx = tid; idx < 1536; idx += NTHREADS) { const int j = idx / 384, rm = idx % 384, seg = rm >> 7, c = rm & 127; CW[idx] = p.conv_w[(size_t)(l * 4 + j) * 1536 + seg * 512 + h * 128 + c]; }
            cur_h = h;
        }
        int rowbase, seqlen, cpos;
        if (cc < 32) { rowbase = b * SEQ; seqlen = SEQ; cpos = cc; } else { rowbase = ROWS_LAT + b * CTXL; seqlen = CTXL; cpos = cc - 32; }
        const int t0 = cpos * 64;
        RELAUNDER();
        {
            u32x4 rv[7];
#pragma unroll
            for (int it = 0; it < 7; ++it) {
                const int idx = tid + it * NTHREADS, rr = idx / 48, pc = idx % 48, seg = pc >> 4, po = pc & 15, tok = t0 - 2 + rr;
                rv[it] = (u32x4){0u, 0u, 0u, 0u};
                if (idx < 67 * 48 && tok >= 0 && tok < seqlen) rv[it] = *(const u32x4*)(PROJ + (size_t)(rowbase + tok) * PN + seg * 512 + h * 128 + po * 8);
            }
#pragma unroll
            for (int it = 0; it < 7; ++it) {
                const int idx = tid + it * NTHREADS, rr = idx / 48, pc = idx % 48, seg = pc >> 4, po = pc & 15;
                if (idx < 67 * 48) *(LAS u32x4*)(lds + rr * 784 + seg * 256 + po * 16) = rv[it];
            }
        }
        if (tid < 128) { const int d = tid >> 6; const size_t gi = (size_t)(rowbase + t0 + lane) * 8 + d * 4 + h; G_LA[tid] = LOGA[gi]; G_BT[tid] = BETA[gi]; }
        __syncthreads();
        RELAUNDER();
        if (wid < 2) {
            const int d = wid, pos = d ? 63 - lane : lane;
            float v = G_LA[d * 64 + pos];
#pragma unroll
            for (int o = 1; o < 64; o <<= 1) { const float t = shup(v, o, lane); if (lane >= o) v += t; }
            G_GC[d * 64 + pos] = v;
            if (lane == 63) G_TOT[d] = v;
        }
        RELAUNDER();
        {
            const int r = tid >> 3, cs = tid & 7;
            const LAS float* cw = CW + cs * 16;
#pragma unroll
            for (int seg = 0; seg < 3; ++seg) {
                float a[16];
#pragma unroll
                for (int e = 0; e < 16; ++e) a[e] = 0.f;
#pragma unroll
                for (int j = 0; j < 4; ++j) {
                    const u32x4 x0 = *(const LAS u32x4*)(lds + (r + j) * 784 + seg * 256 + cs * 32), x1 = *(const LAS u32x4*)(lds + (r + j) * 784 + seg * 256 + cs * 32 + 16);
                    const LAS float* wj = cw + j * 384 + seg * 128;
                    const f32x4 w0 = *(const LAS f32x4*)(wj), w1 = *(const LAS f32x4*)(wj + 4), w2 = *(const LAS f32x4*)(wj + 8), w3 = *(const LAS f32x4*)(wj + 12);
                    a[0] += w0[0] * bf_lo(x0[0]); a[1] += w0[1] * bf_hi(x0[0]); a[2] += w0[2] * bf_lo(x0[1]); a[3] += w0[3] * bf_hi(x0[1]);
                    a[4] += w1[0] * bf_lo(x0[2]); a[5] += w1[1] * bf_hi(x0[2]); a[6] += w1[2] * bf_lo(x0[3]); a[7] += w1[3] * bf_hi(x0[3]);
                    a[8] += w2[0] * bf_lo(x1[0]); a[9] += w2[1] * bf_hi(x1[0]); a[10] += w2[2] * bf_lo(x1[1]); a[11] += w2[3] * bf_hi(x1[1]);
                    a[12] += w3[0] * bf_lo(x1[2]); a[13] += w3[1] * bf_hi(x1[2]); a[14] += w3[2] * bf_lo(x1[3]); a[15] += w3[3] * bf_hi(x1[3]);
                    if (j & 1) __builtin_amdgcn_sched_barrier(0);
                }
                float ss = 0.f;
#pragma unroll
                for (int e = 0; e < 16; ++e) { a[e] = silu_f(a[e]); ss += a[e] * a[e]; }
                if (seg < 2) {
                    ss += shx(ss, 1, lane); ss += shx(ss, 2, lane); ss += shx(ss, 4, lane);
                    float sc = rsqrtf(ss + EPS); if (seg == 0) sc *= 0.08838834764831845f;
#pragma unroll
                    for (int e = 0; e < 16; ++e) a[e] *= sc;
                }
                unsigned pk[8];
#pragma unroll
                for (int e = 0; e < 8; ++e) pk[e] = pk_bf16(a[2 * e], a[2 * e + 1]);
                if (seg < 2) {
                    LAS unsigned char* dst = lds + (seg == 0 ? R_QN : R_KN) + r * 272 + cs * 32;
                    *(LAS u32x4*)dst = (u32x4){pk[0], pk[1], pk[2], pk[3]}; *(LAS u32x4*)(dst + 16) = (u32x4){pk[4], pk[5], pk[6], pk[7]};
                }
                if (seg >= 1) {
                    LAS unsigned char* dt = lds + (seg == 1 ? R_KNT : R_VT) + (cs * 16) * 144 + r * 2;
#pragma unroll
                    for (int e = 0; e < 8; ++e) { *(LAS unsigned short*)(dt + (2 * e) * 144) = (unsigned short)(pk[e] & 0xffffu); *(LAS unsigned short*)(dt + (2 * e + 1) * 144) = (unsigned short)(pk[e] >> 16); }
                }
            }
        }
        __syncthreads();
        RELAUNDER();
        {
            const int ib = wid & 3, pr = wid >> 2;
            LAS unsigned char* Ab = lds + (pr ? R_QN : R_KN) + (ib * 16 + fr) * 272 + fq * 16;
            bf16x8 a[4];
#pragma unroll
            for (int kk = 0; kk < 4; ++kk) a[kk] = *(const LAS bf16x8*)(Ab + kk * 64);
            LAS float* dstf = pr ? QK : KK;
#pragma unroll
            for (int jb = 0; jb < 4; ++jb) {
                f32x4 acc = (f32x4){0.f, 0.f, 0.f, 0.f};
#pragma unroll
                for (int kk = 0; kk < 4; ++kk) { const bf16x8 bb = *(const LAS bf16x8*)(lds + R_KN + (jb * 16 + fr) * 272 + fq * 16 + kk * 64); acc = __builtin_amdgcn_mfma_f32_16x16x32_bf16(a[kk], bb, acc, 0, 0, 0); }
#pragma unroll
                for (int r = 0; r < 4; ++r) dstf[(ib * 16 + fq * 4 + r) * 65 + jb * 16 + fr] = acc[r];
            }
        }
        __syncthreads();
        for (int d = 0; d < 2; ++d) {
            const LAS float* gc = G_GC + d * 64; const LAS float* bt = G_BT + d * 64;
            RELAUNDER();
            for (int idx = tid; idx < 4096; idx += NTHREADS) {
                const int i2 = idx >> 6, j2 = idx & 63, pi = d ? 63 - i2 : i2, pj = d ? 63 - j2 : j2;
                float v = 0.f;
                if (j2 < i2) v = bt[pi] * KK[pi * 65 + pj] * __expf(gc[pi] - gc[pj]);
                MB[i2 * 65 + j2] = v; TB[i2 * 65 + j2] = (i2 == j2) ? 1.f : 0.f;
            }
            __syncthreads();
            RELAUNDER();
            if (wid < 4 && lane < 16) {
                const int bb = wid; float tc[16], mrow[16];
#pragma unroll
                for (int b2 = 0; b2 < 16; ++b2) mrow[b2] = MB[(bb * 16 + lane) * 65 + bb * 16 + b2];
#pragma unroll
                for (int a = 0; a < 16; ++a) {
                    float sv = (a == lane) ? 1.f : 0.f;
#pragma unroll
                    for (int b2 = 0; b2 < a; ++b2) sv -= __int_as_float(__builtin_amdgcn_readlane(__float_as_int(mrow[b2]), a)) * tc[b2];
                    tc[a] = sv;
                }
#pragma unroll
                for (int a = 0; a < 16; ++a) TB[(bb * 16 + a) * 65 + bb * 16 + lane] = tc[a];
            }
            __syncthreads();
            RELAUNDER();
            if (wid < 2) {
                const int rb = 2 * wid + 1, cb = 2 * wid; LAS float* xs = XS + wid * 272;
                f32x4 acc = (f32x4){0.f, 0.f, 0.f, 0.f};
#pragma unroll
                for (int ks = 0; ks < 4; ++ks) acc = __builtin_amdgcn_mfma_f32_16x16x4f32(MB[(rb * 16 + fr) * 65 + cb * 16 + ks * 4 + fq], TB[(cb * 16 + ks * 4 + fq) * 65 + cb * 16 + fr], acc, 0, 0, 0);
#pragma unroll
                for (int r = 0; r < 4; ++r) xs[(fq * 4 + r) * 17 + fr] = acc[r];
                f32x4 acc2 = (f32x4){0.f, 0.f, 0.f, 0.f};
#pragma unroll
                for (int ks = 0; ks < 4; ++ks) acc2 = __builtin_amdgcn_mfma_f32_16x16x4f32(TB[(rb * 16 + fr) * 65 + rb * 16 + ks * 4 + fq], xs[(ks * 4 + fq) * 17 + fr], acc2, 0, 0, 0);
#pragma unroll
                for (int r = 0; r < 4; ++r) TB[(rb * 16 + fq * 4 + r) * 65 + cb * 16 + fr] = -acc2[r];
            }
            __syncthreads();
            RELAUNDER();
            if (wid < 4) {
                const int ti = wid >> 1, tj = wid & 1;
                f32x4 acc = (f32x4){0.f, 0.f, 0.f, 0.f};
#pragma unroll
                for (int ks = 0; ks < 8; ++ks) acc = __builtin_amdgcn_mfma_f32_16x16x4f32(MB[(32 + ti * 16 + fr) * 65 + ks * 4 + fq], TB[(ks * 4 + fq) * 65 + tj * 16 + fr], acc, 0, 0, 0);
#pragma unroll
                for (int r = 0; r < 4; ++r) XS[(ti * 16 + fq * 4 + r) * 33 + tj * 16 + fr] = acc[r];
            }
            __syncthreads();
            if (wid < 4) {
                const int ti = wid >> 1, tj = wid & 1;
                f32x4 acc = (f32x4){0.f, 0.f, 0.f, 0.f};
#pragma unroll
                for (int ks = 0; ks < 8; ++ks) acc = __builtin_amdgcn_mfma_f32_16x16x4f32(TB[(32 + ti * 16 + fr) * 65 + 32 + ks * 4 + fq], XS[(ks * 4 + fq) * 33 + tj * 16 + fr], acc, 0, 0, 0);
#pragma unroll
                for (int r = 0; r < 4; ++r) TB[(32 + ti * 16 + fq * 4 + r) * 65 + tj * 16 + fr] = -acc[r];
            }
            __syncthreads();
            RELAUNDER();
            for (int idx = tid; idx < 2048; idx += NTHREADS) {
                const int i = idx >> 5, j = (idx & 31) * 2, i2 = d ? 63 - i : i, j2 = d ? 63 - j : j, j3 = d ? j2 - 1 : j2 + 1;
                const float t0v = TB[i2 * 65 + j2], t1v = TB[i2 * 65 + j3];
                const float c0 = bt[j], c1 = bt[j + 1];
                *(LAS unsigned*)(lds + R_TU + i * 144 + j * 2) = pk_bf16(t0v * c0, t1v * c1);
                *(LAS unsigned*)(lds + R_TW + i * 144 + j * 2) = pk_bf16(t0v * c0 * __expf(gc[j]), t1v * c1 * __expf(gc[j + 1]));
            }
            __syncthreads();
            RELAUNDER();
            const int cposn = (cc < 32) ? 4 + (d ? 31 - cpos : cpos) : (d ? 3 - cpos : cpos);
            unsigned char* rec = p.ws + WS_SCN + ((size_t)((b * 4 + h) * 2 + d) * NCHUNK + cposn) * REC_BYTES;
            {
                bf16x8 ak[2], av[2];
#pragma unroll
                for (int kk = 0; kk < 2; ++kk) { ak[kk] = *(const LAS bf16x8*)(lds + R_KNT + (wid * 16 + fr) * 144 + kk * 64 + fq * 16); av[kk] = *(const LAS bf16x8*)(lds + R_VT + (wid * 16 + fr) * 144 + kk * 64 + fq * 16); }
#pragma unroll
                for (int ib = 0; ib < 4; ++ib) {
                    f32x4 aw = (f32x4){0.f, 0.f, 0.f, 0.f}, au = (f32x4){0.f, 0.f, 0.f, 0.f};
#pragma unroll
                    for (int kk = 0; kk < 2; ++kk) {
                        const bf16x8 tw = *(const LAS bf16x8*)(lds + R_TW + (ib * 16 + fr) * 144 + kk * 64 + fq * 16), tu = *(const LAS bf16x8*)(lds + R_TU + (ib * 16 + fr) * 144 + kk * 64 + fq * 16);
                        aw = __builtin_amdgcn_mfma_f32_16x16x32_bf16(ak[kk], tw, aw, 0, 0, 0);
                        au = __builtin_amdgcn_mfma_f32_16x16x32_bf16(tu, av[kk], au, 0, 0, 0);
                    }
                    u32x2 ow; ow[0] = pk_bf16(aw[0], aw[1]); ow[1] = pk_bf16(aw[2], aw[3]);
                    *(u32x2*)(rec + REC_W + img256(ib * 16 + fr, wid * 16 + fq * 4)) = ow;
                    u32x2 ou; ou[0] = pk_bf16(au[0], au[1]); ou[1] = pk_bf16(au[2], au[3]);
                    *(u32x2*)(rec + REC_UT + (wid * 16 + fr) * 128 + (ib * 16 + fq * 4) * 2) = ou;
                }
            }
            RELAUNDER();
            const float gtot = G_TOT[d];
            for (int idx = tid; idx < 1024; idx += NTHREADS) {
                const int dk = idx >> 3, i8 = (idx & 7) * 8;
                const u32x4 kv = *(const LAS u32x4*)(lds + R_KNT + dk * 144 + i8 * 2);
                u32x4 o;
#pragma unroll
                for (int e = 0; e < 4; ++e) o[e] = pk_bf16(bf_lo(kv[e]) * __expf(gtot - gc[i8 + 2 * e]), bf_hi(kv[e]) * __expf(gtot - gc[i8 + 2 * e + 1]));
                *(u32x4*)(rec + REC_KT + img128(dk, i8)) = o;
            }
            for (int idx = tid; idx < 1024; idx += NTHREADS) {
                const int i = idx >> 4, k8 = (idx & 15) * 8;
                const u32x4 qv = *(const LAS u32x4*)(lds + R_QN + i * 272 + k8 * 2);
                const float eg = __expf(gc[i]);
                u32x4 o;
#pragma unroll
                for (int e = 0; e < 4; ++e) o[e] = pk_bf16(bf_lo(qv[e]) * eg, bf_hi(qv[e]) * eg);
                *(u32x4*)(rec + REC_QD + img256(i, k8)) = o;
            }
            {
                const int i = tid >> 3, j8 = (tid & 7) * 8;
                float v[8];
#pragma unroll
                for (int e = 0; e < 8; ++e) { const int j = j8 + e; const bool ok = d ? (j >= i) : (j <= i); v[e] = ok ? QK[i * 65 + j] * __expf(gc[i] - gc[j]) : 0.f; }
                u32x4 o; o[0] = pk_bf16(v[0], v[1]); o[1] = pk_bf16(v[2], v[3]); o[2] = pk_bf16(v[4], v[5]); o[3] = pk_bf16(v[6], v[7]);
                *(u32x4*)(rec + REC_QK + img128(i, j8)) = o;
            }
            if (tid == 0) { *(float*)(rec + REC_MISC) = __expf(gtot); *(int*)(rec + REC_MISC + 4) = rowbase + t0; }
            __syncthreads();
        }
    }
}
#undef RELAUNDER

__device__ void phase_scan(const Params& p, const int l, LAS unsigned char* lds) {
    const int tid = opaque_tid(), wid = __builtin_amdgcn_readfirstlane(tid >> 6), lane = tid & 63, fr = lane & 15, fq = lane >> 4;
    constexpr int NSL = 2, DV = 128 / NSL, NBT = DV / 16;
    constexpr int UTB = DV * 128, MISC_O = 57344 + UTB, BUFB = MISC_O + 256, R_ST = 2 * BUFB, R_UTL = R_ST + DV * 272, R_DUM = R_UTL + DV * 144;
    static_assert(R_DUM + 8 * 256 <= LDS_WORK && NBT == 4, "scan LDS / tile assumptions");
    for (int id = blockIdx.x; id < 64 * NSL; id += gridDim.x) {
        const int bhd = (id & 7) * 8 + (id >> 4), sl = (id >> 3) & 1, h = (bhd >> 1) & 3, d = bhd & 1;
        bf16_t* O = (bf16_t*)(p.ws + (d ? WS_OB : WS_OF));
        const unsigned char* rec0 = p.ws + WS_SCN + (size_t)bhd * NCHUNK * REC_BYTES;
        __syncthreads();
        for (int i = tid; i < DV * 272 / 4; i += NTHREADS) ((LAS unsigned*)(lds + R_ST))[i] = 0u;
        f32x4 sacc[NBT];
#pragma unroll
        for (int n2 = 0; n2 < NBT; ++n2) sacc[n2] = (f32x4){0.f, 0.f, 0.f, 0.f};
#define S_ISSUE(n, bufo) do { const unsigned char* _r = rec0 + (size_t)(n) * REC_BYTES; \
        _Pragma("unroll") for (int _q = 0; _q < 7; ++_q) __builtin_amdgcn_global_load_lds((const unsigned*)(_r + lane * 16 + (wid + 8 * _q) * 1024), (LAS unsigned*)(lds + (bufo) + (wid + 8 * _q) * 1024), 16, 0, 0); \
        __builtin_amdgcn_global_load_lds((const unsigned*)(_r + lane * 16 + REC_UT + sl * UTB + wid * 1024), (LAS unsigned*)(lds + (bufo) + 57344 + wid * 1024), 16, 0, 0); \
        __builtin_amdgcn_global_load_lds((const unsigned*)(_r + REC_MISC + lane * 4), (LAS unsigned*)(lds + (bufo) + MISC_O), 4, 0, 0); } while (0)
#define S_TOUCH(n) do { const int _n = (n) < NCHUNK ? (n) : NCHUNK - 1; const int _ln = wid * 64 + lane; \
        const unsigned char* _t = rec0 + (size_t)_n * REC_BYTES + (_ln < 448 ? _ln * 128 : REC_UT + sl * UTB + (_ln - 448) * 128); \
        __builtin_amdgcn_global_load_lds((const unsigned*)_t, (LAS unsigned*)(lds + R_DUM + wid * 256), 4, 0, 0); } while (0)
        S_ISSUE(0, 0); S_TOUCH(1);
        const int ib = wid >> 1, nb0 = (wid & 1) * (NBT / 2);
        for (int n = 0; n < NCHUNK; ++n) {
            if (n == 0) asm volatile("s_waitcnt vmcnt(1)" ::: "memory"); else asm volatile("s_waitcnt vmcnt(3)" ::: "memory");
            asm volatile("s_waitcnt lgkmcnt(0)" ::: "memory");
            __builtin_amdgcn_s_barrier();
            LAS unsigned char* buf = lds + (n & 1) * BUFB;
            f32x4 accP[NBT / 2], accQ[NBT / 2];
#pragma unroll
            for (int t = 0; t < NBT / 2; ++t) { accP[t] = (f32x4){0.f, 0.f, 0.f, 0.f}; accQ[t] = (f32x4){0.f, 0.f, 0.f, 0.f}; }
            bf16x8 aw[4], aq[4], sb[NBT / 2][4];
#pragma unroll
            for (int kk = 0; kk < 4; ++kk) {
                aw[kk] = *(const LAS bf16x8*)(buf + REC_W + img256(ib * 16 + fr, kk * 32 + fq * 8));
                aq[kk] = *(const LAS bf16x8*)(buf + REC_QD + img256(ib * 16 + fr, kk * 32 + fq * 8));
#pragma unroll
                for (int t = 0; t < NBT / 2; ++t) sb[t][kk] = *(const LAS bf16x8*)(lds + R_ST + ((nb0 + t) * 16 + fr) * 272 + kk * 64 + fq * 16);
            }
            u32x2 uv[NBT / 2];
#pragma unroll
            for (int t = 0; t < NBT / 2; ++t) uv[t] = *(const LAS u32x2*)(buf + REC_UT + ((nb0 + t) * 16 + fr) * 128 + (ib * 16 + fq * 4) * 2);
            __builtin_amdgcn_sched_barrier(0);
#pragma unroll
            for (int kk = 0; kk < 4; ++kk)
#pragma unroll
                for (int t = 0; t < NBT / 2; ++t) accP[t] = __builtin_amdgcn_mfma_f32_16x16x32_bf16(aw[kk], sb[t][kk], accP[t], 0, 0, 0);
            if (n + 1 < NCHUNK) { if ((n + 1) & 1) S_ISSUE(n + 1, BUFB); else S_ISSUE(n + 1, 0); S_TOUCH(n + 2); }
            bf16x8 aqk[2], ak[2];
#pragma unroll
            for (int kk = 0; kk < 2; ++kk) { aqk[kk] = *(const LAS bf16x8*)(buf + REC_QK + img128(ib * 16 + fr, kk * 32 + fq * 8)); ak[kk] = *(const LAS bf16x8*)(buf + REC_KT + img128(wid * 16 + fr, kk * 32 + fq * 8)); }
            const float sd = *(const LAS float*)(buf + MISC_O); const int rowstart = *(const LAS int*)(buf + MISC_O + 4);
#pragma unroll
            for (int t = 0; t < NBT / 2; ++t) {
                u32x2 o; o[0] = pk_bf16(bf_lo(uv[t][0]) - accP[t][0], bf_hi(uv[t][0]) - accP[t][1]); o[1] = pk_bf16(bf_lo(uv[t][1]) - accP[t][2], bf_hi(uv[t][1]) - accP[t][3]);
                *(LAS u32x2*)(lds + R_UTL + ((nb0 + t) * 16 + fr) * 144 + (ib * 16 + fq * 4) * 2) = o;
            }
#pragma unroll
            for (int kk = 0; kk < 4; ++kk)
#pragma unroll
                for (int t = 0; t < NBT / 2; ++t) accQ[t] = __builtin_amdgcn_mfma_f32_16x16x32_bf16(sb[t][kk], aq[kk], accQ[t], 0, 0, 0);
            asm volatile("s_waitcnt lgkmcnt(0)" ::: "memory");
            __builtin_amdgcn_s_barrier();
            bf16x8 ub[NBT][2];
#pragma unroll
            for (int n2 = 0; n2 < NBT; ++n2)
#pragma unroll
                for (int kk = 0; kk < 2; ++kk) ub[n2][kk] = *(const LAS bf16x8*)(lds + R_UTL + (n2 * 16 + fr) * 144 + kk * 64 + fq * 16);
            bf16x8 un[NBT / 2][2];
#pragma unroll
            for (int t = 0; t < NBT / 2; ++t)
#pragma unroll
                for (int kk = 0; kk < 2; ++kk) un[t][kk] = *(const LAS bf16x8*)(lds + R_UTL + ((nb0 + t) * 16 + fr) * 144 + kk * 64 + fq * 16);
            __builtin_amdgcn_sched_barrier(0);
#pragma unroll
            for (int n2 = 0; n2 < NBT; ++n2) {
                sacc[n2] *= sd;
#pragma unroll
                for (int kk = 0; kk < 2; ++kk) sacc[n2] = __builtin_amdgcn_mfma_f32_16x16x32_bf16(ak[kk], ub[n2][kk], sacc[n2], 0, 0, 0);
            }
#pragma unroll
            for (int kk = 0; kk < 2; ++kk)
#pragma unroll
                for (int t = 0; t < NBT / 2; ++t) accQ[t] = __builtin_amdgcn_mfma_f32_16x16x32_bf16(un[t][kk], aqk[kk], accQ[t], 0, 0, 0);
#pragma unroll
            for (int n2 = 0; n2 < NBT; ++n2) {
                u32x2 o; o[0] = pk_bf16(sacc[n2][0], sacc[n2][1]); o[1] = pk_bf16(sacc[n2][2], sacc[n2][3]);
                *(LAS u32x2*)(lds + R_ST + (n2 * 16 + fr) * 272 + (wid * 16 + fq * 4) * 2) = o;
            }
#pragma unroll
            for (int t = 0; t < NBT / 2; ++t) {
                u32x2 o; o[0] = pk_bf16(accQ[t][0], accQ[t][1]); o[1] = pk_bf16(accQ[t][2], accQ[t][3]);
                *(u32x2*)(O + (size_t)(rowstart + ib * 16 + fr) * 512 + h * 128 + sl * DV + (nb0 + t) * 16 + fq * 4) = o;
            }
        }
#undef S_ISSUE
#undef S_TOUCH
        asm volatile("s_waitcnt vmcnt(0)" ::: "memory");
        __syncthreads();
    }
}

__device__ void phase_scan_naive(const Params& p, const int l, LAS unsigned char* lds) {
    const int tid = opaque_tid();
    const int lane = tid & 63;
    LAS float* ks = (LAS float*)lds;
    LAS float* qs = ks + 4096;
    LAS float* vs = qs + 4096;
    LAS float* as = vs + 4096;
    LAS float* bs = as + 32;
    LAS int* rws = (LAS int*)(bs + 32);
    const float* QKV = (const float*)(p.ws + WS_QKV);
    const float* LOGA = (const float*)(p.ws + WS_LOGA);
    const float* BETA = (const float*)(p.ws + WS_BETA);
    for (int u = blockIdx.x; u < 64; u += gridDim.x) {
        const int b = u >> 3, h = (u >> 1) & 3, d = u & 1;
        float* O = (float*)(p.ws + (d ? WS_OB : WS_OF));
        const int col = tid >> 2, part = tid & 3;
        float S[32];
#pragma unroll
        for (int i = 0; i < 32; ++i) S[i] = 0.f;
        for (int n0 = 0; n0 < CTXL + SEQ; n0 += 32) {
            __syncthreads();
            if (tid < 32) {
                const int n = n0 + tid; int row;
                if (n < CTXL) row = ROWS_LAT + b * CTXL + (d ? CTXL - 1 - n : n);
                else { const int m = n - CTXL; row = b * SEQ + (d ? SEQ - 1 - m : m); }
                rws[tid] = row;
                as[tid] = __expf(LOGA[(size_t)row * 8 + d * 4 + h]);
                bs[tid] = BETA[(size_t)row * 8 + d * 4 + h];
            }
            __syncthreads();
            for (int i = tid; i < 4096; i += NTHREADS) {
                const int tok = i >> 7, cc = i & 127; const size_t base = (size_t)rws[tok] * 1536 + h * 128 + cc;
                qs[i] = QKV[base]; ks[i] = QKV[base + 512]; vs[i] = QKV[base + 1024];
            }
            __syncthreads();
            for (int tok = 0; tok < 32; ++tok) {
                float kk[32];
#pragma unroll
                for (int i = 0; i < 8; ++i) { const f32x4 v = *(const LAS f32x4*)(ks + tok * 128 + part * 32 + i * 4); kk[i * 4] = v[0]; kk[i * 4 + 1] = v[1]; kk[i * 4 + 2] = v[2]; kk[i * 4 + 3] = v[3]; }
                float kp = 0.f;
#pragma unroll
                for (int i = 0; i < 32; ++i) kp += kk[i] * S[i];
                kp += shx(kp, 1, lane); kp += shx(kp, 2, lane);
                const float a = as[tok], bt = bs[tok];
                const float bv = bt * (vs[tok * 128 + col] - a * kp);
#pragma unroll
                for (int i = 0; i < 32; ++i) S[i] = a * S[i] + kk[i] * bv;
                float op = 0.f;
#pragma unroll
                for (int i = 0; i < 8; ++i) { const f32x4 v = *(const LAS f32x4*)(qs + tok * 128 + part * 32 + i * 4); op += v[0] * S[i * 4] + v[1] * S[i * 4 + 1] + v[2] * S[i * 4 + 2] + v[3] * S[i * 4 + 3]; }
                op += shx(op, 1, lane); op += shx(op, 2, lane);
                if (part == 0) O[(size_t)rws[tok] * 512 + h * 128 + col] = op;
            }
        }
        __syncthreads();
    }
}

__device__ void phase_onorm(const Params& p, const int l) {
    const int tid = opaque_tid(), wid = tid >> 6, lane = tid & 63;
    const unsigned char* OF = p.ws + WS_OF; const unsigned char* OB = p.ws + WS_OB;
    const bf16_t* PROJ = (const bf16_t*)(p.ws + WS_PROJ);
    bf16_t* CAT = (bf16_t*)(p.ws + WS_CAT);
    const int c = lane * 8;
    const f32x4 w0 = *(const f32x4*)(p.dn_norm + l * 128 + (c & 127)), w1 = *(const f32x4*)(p.dn_norm + l * 128 + (c & 127) + 4);
    const int nrows = (l == DEPTH - 1) ? ROWS_LAT : MT;
    for (int row = blockIdx.x * 8 + wid; row < nrows; row += gridDim.x * 8) {
        const size_t o = (size_t)row * 512 + c;
        f32x4 v0, v1;
        if (NAIVE_SCAN) { const float* F = (const float*)OF; const float* B = (const float*)OB;
            v0 = *(const f32x4*)(F + o) + *(const f32x4*)(B + o); v1 = *(const f32x4*)(F + o + 4) + *(const f32x4*)(B + o + 4); }
        else { const u32x4 a = *(const u32x4*)((const bf16_t*)OF + o), b = *(const u32x4*)((const bf16_t*)OB + o);
            v0 = (f32x4){bf_lo(a[0]) + bf_lo(b[0]), bf_hi(a[0]) + bf_hi(b[0]), bf_lo(a[1]) + bf_lo(b[1]), bf_hi(a[1]) + bf_hi(b[1])};
            v1 = (f32x4){bf_lo(a[2]) + bf_lo(b[2]), bf_hi(a[2]) + bf_hi(b[2]), bf_lo(a[3]) + bf_lo(b[3]), bf_hi(a[3]) + bf_hi(b[3])}; }
        float ss = v0[0] * v0[0] + v0[1] * v0[1] + v0[2] * v0[2] + v0[3] * v0[3] + v1[0] * v1[0] + v1[1] * v1[1] + v1[2] * v1[2] + v1[3] * v1[3];
        ss += shx(ss, 1, lane); ss += shx(ss, 2, lane); ss += shx(ss, 4, lane); ss += shx(ss, 8, lane);
        const float rs = rsqrtf(ss * (1.f / 128.f) + EPS);
        const u32x4 gv = *(const u32x4*)(PROJ + (size_t)row * PN + 1536 + c);
        u32x4 out;
        out[0] = pk_bf16(v0[0] * rs * w0[0] * silu_f(bf_lo(gv[0])), v0[1] * rs * w0[1] * silu_f(bf_hi(gv[0])));
        out[1] = pk_bf16(v0[2] * rs * w0[2] * silu_f(bf_lo(gv[1])), v0[3] * rs * w0[3] * silu_f(bf_hi(gv[1])));
        out[2] = pk_bf16(v1[0] * rs * w1[0] * silu_f(bf_lo(gv[2])), v1[1] * rs * w1[1] * silu_f(bf_hi(gv[2])));
        out[3] = pk_bf16(v1[2] * rs * w1[2] * silu_f(bf_lo(gv[3])), v1[3] * rs * w1[3] * silu_f(bf_hi(gv[3])));
        *(u32x4*)(CAT + (size_t)row * D + c) = out;
    }
}

__device__ void phase_topk(const Params& p, const int l, LAS unsigned char* lds) {
    const int tid = opaque_tid();
    LAS unsigned long long* ks = (LAS unsigned long long*)lds;
    const float* AFF = (const float*)(p.ws + WS_AFF);
    int* SEL = (int*)(p.ws + WS_SEL); float* SELAFF = (float*)(p.ws + WS_SELAFF); int* SLOTOF = (int*)(p.ws + WS_SLOTOF);
    const int ntk = (l == DEPTH - 1) ? 128 : 256;
    for (int u = blockIdx.x; u < ntk; u += gridDim.x) {
        int e, n, C, rowbase, slotbase;
        if (u < 128) { e = u >> 3; const int b = u & 7; n = SEQ; C = 256; rowbase = b * SEQ; slotbase = u * 256; }
        else { const int v = u - 128; e = v >> 3; const int b = v & 7; n = CTXL; C = 32; rowbase = ROWS_LAT + b * CTXL; slotbase = (128 + e) * 256 + b * 32; }
        for (int i = tid; i < n; i += NTHREADS) ks[i] = ((unsigned long long)__float_as_uint(AFF[(size_t)(rowbase + i) * 16 + e]) << 32) | (unsigned long long)(0xFFFFFFFFu - (unsigned)i);
        __syncthreads();
        for (int k = 2; k <= n; k <<= 1)
            for (int j = k >> 1; j > 0; j >>= 1) {
                for (int q = tid; q < (n >> 1); q += NTHREADS) {
                    const int i = ((q & ~(j - 1)) << 1) | (q & (j - 1)), i2 = i | j;
                    const unsigned long long a = ks[i], b2 = ks[i2];
                    const bool up = (i & k) == 0;
                    if (up ? (a < b2) : (a > b2)) { ks[i] = b2; ks[i2] = a; }
                }
                __syncthreads();
            }
        for (int i = tid; i < n; i += NTHREADS) {
            const unsigned long long key = ks[i];
            const int t = (int)(0xFFFFFFFFu - (unsigned)(key & 0xFFFFFFFFull));
            SLOTOF[(size_t)(rowbase + t) * 16 + e] = (i < C) ? slotbase + i : -1;
            if (i < C) { SEL[slotbase + i] = rowbase + t; SELAFF[slotbase + i] = __uint_as_float((unsigned)(key >> 32)); }
        }
        __syncthreads();
    }
}


#ifndef DUMP
#define DUMP 0
#endif
#if DUMP
__device__ void phase_dump(const Params& p, const size_t off, const int is_bf16, const size_t n_avail) {
    const int tid = opaque_tid();
    const size_t n = (size_t)ROWS_LAT * D;
    for (size_t i = (size_t)blockIdx.x * NTHREADS + tid; i < n; i += (size_t)gridDim.x * NTHREADS) {
        float v = 0.f;
        if (i < n_avail) v = is_bf16 ? __uint_as_float((unsigned)((const bf16_t*)(p.ws + off))[i] << 16) : ((const float*)(p.ws + off))[i];
        p.out[i] = v;
    }
}
#endif

__global__ void __launch_bounds__(NTHREADS, 2) fwd(const Params p) {
    extern __shared__ __attribute__((aligned(16))) unsigned char smem[];
    LAS unsigned char* lds = (LAS unsigned char*)smem + LDS_OFF;
    XcdBarrier bar; bar.bar = (unsigned*)(p.ws + WS_BAR); bar.x = 0; bar.st = nullptr;
    const bool multi = (p.ph_hi - p.ph_lo) > 1;
    if (multi) {
        if (threadIdx.x == 0) *(LAS u32x4*)((LAS unsigned char*)smem) = (u32x4){0u, 0u, 0u, 0u};
        __syncthreads();
        bar = xcd_barrier_post((unsigned*)(p.ws + WS_BAR), (volatile LAS unsigned*)((LAS unsigned char*)smem));
    }
#if DUMP
    if (p.ph_lo == 100) { phase_dump(p, (size_t)(DUMP_OFF), DUMP_BF16, (size_t)(DUMP_N)); return; }
#endif
    int ph = 0;
#define PHASE(body) do { if (ph >= p.ph_lo && ph < p.ph_hi) { const int l = opaque_s(lv); body; if (ph + 1 < p.ph_hi) xcd_barrier(bar); } ++ph; } while (0)
    int lv = 0;
    PHASE(phase_prologue(p, lds));
    for (lv = 0; lv < DEPTH; ++lv) {
        PHASE(phase_norm<1>(p, l, lds));
        PHASE(GEMM8 ? phase_gemm8<0>(p, l, lds) : phase_gemm<0>(p, l, lds));
#if NAIVE_SCAN
        PHASE(phase_conv_pool(p, l, lds));
        PHASE(phase_scan_naive(p, l, lds));
#else
        PHASE(phase_prep(p, l, lds); phase_conv_pool(p, l, lds));
        PHASE(phase_scan(p, l, lds));
#endif
        PHASE(phase_onorm(p, l));
        PHASE(GEMM8 ? phase_gemm8<1>(p, l, lds) : phase_gemm<1>(p, l, lds));
        PHASE(phase_norm<2>(p, l, lds));
        PHASE(phase_topk(p, l, lds));
        PHASE(GEMM8 ? phase_gemm8<2>(p, l, lds) : phase_gemm<2>(p, l, lds));
        PHASE(GEMM8 ? phase_gemm8<3>(p, l, lds) : phase_gemm<3>(p, l, lds));
    }
    lv = 0;
    PHASE(phase_norm<3>(p, l, lds));
#undef PHASE
}
constexpr int N_PHASES = 2 + DEPTH * 10;

extern "C" void kernel_launch(void* const* d_in, const int* in_sizes, int n_in, void* d_out, int out_size, void* d_ws, size_t ws_size, hipStream_t stream) {
    static int grid = 0;
    if (grid == 0) {
        if (n_in != 21 || out_size != ROWS_LAT * D || ws_size < WS_END) { fprintf(stderr, "kernel_launch: unexpected shapes (n_in %d out %d ws %zu need %zu)\n", n_in, out_size, ws_size, (size_t)WS_END); grid = -1; return; }
        int dev = 0, cus = 0, per_cu = 0;
        if (hipGetDevice(&dev) != hipSuccess || hipDeviceGetAttribute(&cus, hipDeviceAttributeMultiprocessorCount, dev) != hipSuccess) { grid = -1; return; }
        if (hipFuncSetAttribute((const void*)fwd, hipFuncAttributeMaxDynamicSharedMemorySize, LDS_BYTES) != hipSuccess) { fprintf(stderr, "kernel_launch: hipFuncSetAttribute failed\n"); grid = -1; return; }
        if (hipOccupancyMaxActiveBlocksPerMultiprocessor(&per_cu, (const void*)fwd, NTHREADS, LDS_BYTES) != hipSuccess || per_cu < 1) { fprintf(stderr, "kernel_launch: occupancy query says %d\n", per_cu); per_cu = 1; }
        (void)hipGetLastError();
        grid = cus;
    }
    if (grid < 0) return;
    (void)hipMemsetAsync((char*)d_ws + WS_BAR, 0, 16384, stream);
    Params p; memset(&p, 0, sizeof(p));
    const float** pp = (const float**)&p;
    for (int i = 0; i < 21; ++i) pp[i] = (const float*)d_in[i];
    p.out = (float*)d_out; p.ws = (unsigned char*)d_ws;
#if DUMP
    for (int ph = 0; ph <= DUMP_LAST; ++ph) { p.ph_lo = ph; p.ph_hi = ph + 1; hipLaunchKernelGGL(fwd, dim3(grid), dim3(NTHREADS), LDS_BYTES, stream, p); }
    p.ph_lo = 100; p.ph_hi = 101; hipLaunchKernelGGL(fwd, dim3(grid), dim3(NTHREADS), LDS_BYTES, stream, p);
#elif ONE_LAUNCH
    p.ph_lo = 0; p.ph_hi = N_PHASES;
    hipLaunchKernelGGL(fwd, dim3(grid), dim3(NTHREADS), LDS_BYTES, stream, p);
#else
    for (int ph = 0; ph < N_PHASES; ++ph) { p.ph_lo = ph; p.ph_hi = ph + 1; hipLaunchKernelGGL(fwd, dim3(grid), dim3(NTHREADS), LDS_BYTES, stream, p); }
#endif
}
```

```cpp
#include <hip/hip_runtime.h>
#include <stdint.h>
#include <stdio.h>
#include <string.h>

#ifndef ONE_LAUNCH
#define ONE_LAUNCH 1
#endif
#ifndef NAIVE_SCAN
#define NAIVE_SCAN 0
#endif
#ifndef GEMM8
#define GEMM8 1
#endif
#ifndef REGSTAGE
#define REGSTAGE 0
#endif

#define LAS __attribute__((address_space(3)))
typedef unsigned short bf16_t;
typedef short bf16x8 __attribute__((ext_vector_type(8)));
typedef float f32x4 __attribute__((ext_vector_type(4)));
typedef float f32x2 __attribute__((ext_vector_type(2)));
typedef unsigned u32x2 __attribute__((ext_vector_type(2)));
typedef unsigned u32x4 __attribute__((ext_vector_type(4)));

constexpr int D = 1024, NB = 8, SEQ = 2048, DEPTH = 4, CTXL = 256;
constexpr int ROWS_LAT = NB * SEQ;
constexpr int ROWS_CTX = NB * CTXL;
constexpr int MT = ROWS_LAT + ROWS_CTX;
constexpr int INC = 2576;
constexpr int PN = 2560;
constexpr int NE = 16;
constexpr int NGROUPS = 144;
constexpr int NSLOTS = NGROUPS * 256;
constexpr int NTHREADS = 512;
constexpr float EPS = 1e-6f;

constexpr size_t al256(size_t x) { return (x + 255) & ~(size_t)255; }
constexpr size_t WS_BAR = 0;
constexpr size_t WS_MOD = 16384;
constexpr size_t WS_X = WS_MOD + al256((size_t)DEPTH * 9 * 6144 * 4);
constexpr size_t WS_H = WS_X + (size_t)MT * D * 4;
constexpr size_t WS_PROJ = WS_H + (size_t)MT * D * 2;
constexpr size_t WS_YE = WS_PROJ;
constexpr size_t WS_LOGA = WS_PROJ + (size_t)MT * PN * 2;
constexpr size_t WS_BETA = WS_LOGA + (size_t)MT * 8 * 4;
constexpr size_t WS_QKV = WS_BETA + (size_t)MT * 8 * 4;
constexpr size_t WS_HID = WS_QKV;
constexpr size_t WS_OF = WS_QKV + (NAIVE_SCAN ? (size_t)MT * 1536 * 4 : (size_t)NSLOTS * D * 2);
constexpr size_t WS_OB = WS_OF + (size_t)MT * 512 * 4;
constexpr size_t WS_CAT = WS_OB + (size_t)MT * 512 * 4;
constexpr size_t WS_AFF = WS_CAT + (size_t)MT * D * 2;
constexpr size_t WS_SEL = WS_AFF + (size_t)MT * 16 * 4;
constexpr size_t WS_SELAFF = WS_SEL + (size_t)NSLOTS * 4;
constexpr size_t WS_SLOTOF = WS_SELAFF + (size_t)NSLOTS * 4;
constexpr size_t WS_WINT = WS_SLOTOF + (size_t)MT * 16 * 4;
constexpr size_t WS_WOUTT = WS_WINT + (size_t)DEPTH * PN * D * 2;
constexpr size_t WS_WGUT = WS_WOUTT + (size_t)DEPTH * D * D * 2;
constexpr size_t WS_WDT = WS_WGUT + (size_t)DEPTH * NE * 2048 * D * 2;
constexpr size_t WS_PWT = WS_WDT + (size_t)DEPTH * NE * D * D * 2;
constexpr size_t WS_W16T = WS_PWT + (size_t)DEPTH * 4 * 128 * 128 * 2;
constexpr size_t WS_SCN = WS_W16T + (size_t)DEPTH * 2 * 16 * D * 4;
constexpr int REC_W = 0, REC_KT = 16384, REC_QD = 32768, REC_QK = 49152, REC_UT = 57344, REC_MISC = 73728, REC_BYTES = 73984;
constexpr int NCHUNK = 36;
constexpr size_t WS_END = WS_SCN + (size_t)NB * 4 * 2 * NCHUNK * REC_BYTES + 4096;

constexpr int LDS_OFF = 1024;
constexpr int LDS_WORK = 161792;
constexpr int LDS_BYTES = LDS_OFF + LDS_WORK;

struct Params {
    const float *x, *c, *ctx, *c_ctx, *w_mod, *b_mod, *norm1, *norm2, *w_in, *conv_w, *a_log, *dt_bias, *dn_norm, *pool_w, *pool_scale, *w_out, *w_router, *w_gate, *w_up, *w_down, *norm_f;
    float* out;
    unsigned char* ws;
    int ph_lo, ph_hi;
};

#define XB_TMO      128
#define XB_XCNT(j)  (256  + 64 * (j))
#define XB_XSUB(j)  (1280 + 64 * (j))
#define XB_XGEN(j)  (2304 + 64 * (j))
#define XB_TOP      3328
#define XB_TOPGEN   3392
#define XCD_BAR_WORDS 3456
#define XB_SPIN_CAP (1u << 22)

__device__ __forceinline__ unsigned xb_ld(unsigned* p)              { return __hip_atomic_load(p, __ATOMIC_RELAXED, __HIP_MEMORY_SCOPE_AGENT); }
__device__ __forceinline__ unsigned xb_add(unsigned* p, unsigned v) { return __hip_atomic_fetch_add(p, v, __ATOMIC_RELAXED, __HIP_MEMORY_SCOPE_AGENT); }
__device__ __forceinline__ unsigned xb_xcc_id() { return (unsigned)__builtin_amdgcn_s_getreg((3 << 11) | 20) & 0xFu; }
#define XB_SPIN(cond, bar) do { unsigned _sp = 0; while (cond) { __builtin_amdgcn_s_sleep(1); \
    if ((++_sp & 255u) == 0u) { if (xb_ld(&(bar)[XB_TMO])) break; if (_sp > XB_SPIN_CAP) { atomicAdd(&(bar)[XB_TMO], 1u); break; } } } } while (0)

struct XcdBarrier { unsigned* bar; unsigned x; volatile LAS unsigned* st; };

__device__ __forceinline__ XcdBarrier xcd_barrier_post(unsigned* bar, volatile LAS unsigned* st) {
    XcdBarrier b; b.bar = bar; b.x = xb_xcc_id(); b.st = st;
    if (threadIdx.x == 0) (void)xb_add(&bar[XB_XCNT(b.x)], 1u);
    return b;
}
__device__ __forceinline__ void xcd_barrier_complete(unsigned* bar, unsigned x, unsigned& nloc, unsigned& nx) {
    const unsigned G = gridDim.x * gridDim.y * gridDim.z;
    unsigned sum, cnt, mine, sp = 0u;
    for (;;) {
        sum = 0u; cnt = 0u; mine = 0u;
#pragma unroll
        for (unsigned j = 0; j < 16; ++j) { const unsigned c = xb_ld(&bar[XB_XCNT(j)]); sum += c; cnt += (c > 0u) ? 1u : 0u; mine = (j == x) ? c : mine; }
        if (sum == G) break;
        __builtin_amdgcn_s_sleep(1);
        if ((++sp & 255u) == 0u) { if (xb_ld(&bar[XB_TMO])) break; if (sp > XB_SPIN_CAP) { atomicAdd(&bar[XB_TMO], 1u); break; } }
    }
    nloc = mine > 0u ? mine : 1u; nx = cnt > 0u ? cnt : 1u;
}
__device__ __forceinline__ void xcd_barrier(const XcdBarrier& b) {
    asm volatile("s_waitcnt vmcnt(0)" ::: "memory");
    __syncthreads();
    if (threadIdx.x == 0) {
        unsigned* bar = b.bar;
        __builtin_amdgcn_s_waitcnt(0);
        unsigned nloc = b.st[0], nx = b.st[1];
        if (nloc == 0u) { xcd_barrier_complete(bar, b.x, nloc, nx); b.st[0] = nloc; b.st[1] = nx; }
        const unsigned old = xb_add(&bar[XB_XSUB(b.x)], 1u);
        const unsigned gen = old / nloc;
        if (old + 1u == (gen + 1u) * nloc) {
            __builtin_amdgcn_fence(__ATOMIC_RELEASE, "agent");
            asm volatile("s_waitcnt vmcnt(0)" ::: "memory");
            const unsigned og = xb_add(&bar[XB_TOP], 1u);
            const unsigned tg = og / nx;
            if (og + 1u == (tg + 1u) * nx) xb_add(&bar[XB_TOPGEN], 1u);
            else XB_SPIN(xb_ld(&bar[XB_TOPGEN]) == tg, bar);
            __builtin_amdgcn_fence(__ATOMIC_ACQUIRE, "agent");
            xb_add(&bar[XB_XGEN(b.x)], 1u);
            asm volatile("s_waitcnt vmcnt(0)" ::: "memory");
        } else {
            XB_SPIN(xb_ld(&bar[XB_XGEN(b.x)]) == gen, bar);
            __builtin_amdgcn_fence(__ATOMIC_ACQUIRE, "agent");
            asm volatile("s_waitcnt vmcnt(0)" ::: "memory");
        }
    }
    __syncthreads();
}

typedef __bf16 bf16x2_t __attribute__((ext_vector_type(2)));
__device__ __forceinline__ unsigned pk_bf16(float lo, float hi) { const f32x2 v = {lo, hi}; const bf16x2_t b = __builtin_convertvector(v, bf16x2_t); return __builtin_bit_cast(unsigned, b); }
__device__ __forceinline__ float bf_lo(unsigned u) { return __uint_as_float(u << 16); }
__device__ __forceinline__ float bf_hi(unsigned u) { return __uint_as_float(u & 0xffff0000u); }
__device__ __forceinline__ float shx(float v, int mask, int lane) { return __int_as_float(__builtin_amdgcn_ds_bpermute((lane ^ mask) << 2, __float_as_int(v))); }
__device__ __forceinline__ float shup(float v, int o, int lane) { return __int_as_float(__builtin_amdgcn_ds_bpermute(((lane - o) & 63) << 2, __float_as_int(v))); }
__device__ __forceinline__ float wave_sum(float v, int lane) {
#pragma unroll
    for (int o = 32; o > 0; o >>= 1) v += shx(v, o, lane);
    return v;
}
__device__ __forceinline__ int opaque_tid() { int t = threadIdx.x; asm volatile("" : "+v"(t)); return t; }
__device__ __forceinline__ int opaque_s(int v) { asm volatile("" : "+s"(v)); return v; }
__device__ __forceinline__ float silu_f(float v) { return v * __builtin_amdgcn_rcpf(1.f + __expf(-v)); }

__device__ __forceinline__ int lds_byte(int r, int c) { const int st = (r >> 4) * 2 + (c >> 5), rr = r & 15, cc = c & 31, ob = rr * 64 + cc * 2; return st * 1024 + (ob ^ (((ob >> 9) & 1) << 5)); }
__device__ __forceinline__ void stage_rc(int b, int& R, int& C) { const int st = b >> 10, sb = b & 1023, swz = sb ^ (((sb >> 9) & 1) << 5); R = (st >> 1) * 16 + (swz >> 6); C = (st & 1) * 32 + ((swz & 63) >> 1); }

constexpr int T_IN = 10 * 16, T_OUT = 4 * 16, T_EXP = NE * 4 * 16, T_LAYER = T_IN + T_OUT + 3 * T_EXP;
__device__ __forceinline__ void convert_tiles(const Params& p, const int l, const int first, const int count, const int f, const int nf, LAS unsigned char* lds) {
    const int tid = opaque_tid();
    bf16_t* WINT = (bf16_t*)(p.ws + WS_WINT); bf16_t* WOUTT = (bf16_t*)(p.ws + WS_WOUTT); bf16_t* WGUT = (bf16_t*)(p.ws + WS_WGUT); bf16_t* WDT = (bf16_t*)(p.ws + WS_WDT);
    const int lane = tid & 63, wv = tid >> 6, ko = lane & 7, nq = wv * 8 + (lane >> 3);
    f32x4 rv[8]; const float* src = nullptr; size_t sld = 0;
#define CT_DECODE(t, SRC, SLD, DST, RS) do { int i = (t); RS = 16; \
        if (i < T_IN) { const int nt = i >> 4, kt = i & 15; const int n0 = nt < 6 ? nt * 256 : 1552 + (nt - 6) * 256; \
            SRC = p.w_in + ((size_t)l * D + kt * 64) * INC + n0; SLD = INC; DST = WINT + ((size_t)l * PN + nt * 256) * D + kt * 64; } \
        else if (i < T_IN + T_OUT) { i -= T_IN; const int nt = i >> 4, kt = i & 15; \
            SRC = p.w_out + ((size_t)l * D + kt * 64) * D + nt * 256; SLD = D; DST = WOUTT + ((size_t)l * D + nt * 256) * D + kt * 64; } \
        else { i -= T_IN + T_OUT; const int which = i / T_EXP; i %= T_EXP; const int e = i >> 6, nt = (i >> 4) & 3, kt = i & 15; \
            const size_t mo = ((size_t)(l * NE + e) * D + kt * 64) * D + nt * 256; \
            if (which == 2) { SRC = p.w_down + mo; DST = WDT + ((size_t)(l * NE + e) * D + nt * 256) * D + kt * 64; } \
            else { SRC = (which == 0 ? p.w_gate : p.w_up) + mo; RS = 32; DST = WGUT + ((size_t)(l * NE + e) * 2048 + nt * 512 + which * 16) * D + kt * 64; } \
            SLD = D; } } while (0)
#define CT_LOAD() do { _Pragma("unroll") for (int j = 0; j < 8; ++j) rv[j] = *(const f32x4*)(src + (size_t)(ko * 8 + j) * sld + nq * 4); } while (0)
    bf16_t* dst = nullptr; int rs = 16;
    int t = first + f;
    if (t < first + count) { CT_DECODE(t, src, sld, dst, rs); CT_LOAD(); }
    for (; t < first + count; t += nf) {
        u32x4 o[4];
#pragma unroll
        for (int e = 0; e < 4; ++e) { o[e][0] = pk_bf16(rv[0][e], rv[1][e]); o[e][1] = pk_bf16(rv[2][e], rv[3][e]); o[e][2] = pk_bf16(rv[4][e], rv[5][e]); o[e][3] = pk_bf16(rv[6][e], rv[7][e]); }
        bf16_t* dcur = dst; const int rcur = rs;
        if (t + nf < first + count) { CT_DECODE(t + nf, src, sld, dst, rs); CT_LOAD(); }
#pragma unroll
        for (int e = 0; e < 4; ++e) { const int n = nq * 4 + e; *(u32x4*)(dcur + (size_t)((n >> 4) * rcur + (n & 15)) * D + ko * 8) = o[e]; }
    }
#undef CT_DECODE
#undef CT_LOAD
}

__device__ __forceinline__ void phase_prologue(const Params& p, LAS unsigned char* lds) {
    const int tid = opaque_tid();
    {
        LAS float* sc = (LAS float*)lds;
        LAS float* red = sc + 9 * 1024;
        for (int idx = tid; idx < 9 * 1024; idx += NTHREADS) {
            const int r = idx >> 10, k = idx & 1023;
            const float v = r < 8 ? p.c[r * 1024 + k] : p.c_ctx[k];
            sc[idx] = silu_f(v);
        }
        __syncthreads();
        float* MOD = (float*)(p.ws + WS_MOD);
        for (int u = blockIdx.x; u < DEPTH * 96; u += gridDim.x) {
            const int l = u / 96, c0 = (u % 96) * 64, col = tid & 63, kg = tid >> 6;
            float acc[9];
#pragma unroll
            for (int r = 0; r < 9; ++r) acc[r] = 0.f;
            const float* W = p.w_mod + (size_t)l * 1024 * 6144 + c0 + col;
#pragma unroll 4
            for (int kk = 0; kk < 128; ++kk) {
                const int k = kg * 128 + kk;
                const float w = W[(size_t)k * 6144];
#pragma unroll
                for (int r = 0; r < 9; ++r) acc[r] += sc[r * 1024 + k] * w;
            }
#pragma unroll
            for (int r = 0; r < 9; ++r) red[(kg * 9 + r) * 64 + col] = acc[r];
            __syncthreads();
            for (int idx = tid; idx < 576; idx += NTHREADS) {
                const int r = idx >> 6, cc = idx & 63;
                float s = 0.f;
#pragma unroll
                for (int g = 0; g < 8; ++g) s += red[(g * 9 + r) * 64 + cc];
                MOD[((size_t)l * 9 + r) * 6144 + c0 + cc] = s + p.b_mod[l * 6144 + c0 + cc];
            }
            __syncthreads();
        }
    }
    {
        f32x4* X4 = (f32x4*)(p.ws + WS_X);
        const f32x4* x4 = (const f32x4*)p.x; const f32x4* c4 = (const f32x4*)p.ctx;
        const int nlat = ROWS_LAT * D / 4, ntot = MT * D / 4;
        for (int i = blockIdx.x * NTHREADS + tid; i < ntot; i += gridDim.x * NTHREADS) X4[i] = i < nlat ? x4[i] : c4[i - nlat];
    }
    {
        convert_tiles(p, 0, 0, T_LAYER, (int)blockIdx.x, (int)gridDim.x, lds);
        {
            float* W16T = (float*)(p.ws + WS_W16T);
            for (int i = blockIdx.x * NTHREADS + tid; i < DEPTH * 2 * 16 * D; i += gridDim.x * NTHREADS) {
                const int l2 = i >> 15, wh = (i >> 14) & 1, j = (i >> 10) & 15, k = i & 1023;
                W16T[i] = wh ? p.w_router[((size_t)l2 * D + k) * NE + j] : p.w_in[((size_t)l2 * D + k) * INC + 1536 + j];
            }
        }
        bf16_t* PWT = (bf16_t*)(p.ws + WS_PWT);
        for (int i = blockIdx.x * NTHREADS + tid; i < DEPTH * 4 * 128 * 128; i += gridDim.x * NTHREADS) {
            const int lg = i >> 14, d = (i >> 7) & 127, c = i & 127;
            PWT[i] = (bf16_t)(pk_bf16(p.pool_w[((size_t)lg * 128 + c) * 128 + d], 0.f) & 0xffffu);
        }
    }
}

__device__ __forceinline__ float reduce4(const float v0, const float v1, const float v2, const float v3, const int lane) {
    const bool b5 = lane & 32, b4 = lane & 16;
    const float a0 = (b5 ? v2 : v0) + shx(b5 ? v0 : v2, 32, lane), a1 = (b5 ? v3 : v1) + shx(b5 ? v1 : v3, 32, lane);
    float c = (b4 ? a1 : a0) + shx(b4 ? a0 : a1, 16, lane);
    c += shx(c, 8, lane); c += shx(c, 4, lane); c += shx(c, 2, lane); c += shx(c, 1, lane);
    return c;
}

template <int WHICH>
__device__ __forceinline__ void phase_norm(const Params& p, const int l, LAS unsigned char* lds) {
    const int tid = opaque_tid(), wid = tid >> 6, lane = tid & 63;
    LAS float* wsm = (LAS float*)lds;
    if (WHICH != 3) {
        const f32x4* src = (const f32x4*)(p.ws + WS_W16T) + (size_t)(l * 2 + (WHICH == 2 ? 1 : 0)) * 4096;
        f32x4 fv[8];
#pragma unroll
        for (int i = 0; i < 8; ++i) fv[i] = src[tid + i * NTHREADS];
#pragma unroll
        for (int i = 0; i < 8; ++i) *(LAS f32x4*)(wsm + (tid + i * NTHREADS) * 4) = fv[i];
        __syncthreads();
    }
    const float* nw = WHICH == 1 ? p.norm1 + l * D : (WHICH == 2 ? p.norm2 + l * D : p.norm_f);
    float* X = (float*)(p.ws + WS_X);
    const float* MOD = (const float*)(p.ws + WS_MOD);
    bf16_t* H = (bf16_t*)(p.ws + WS_H);
    const int nrows = (WHICH == 3 || (WHICH == 2 && l == DEPTH - 1)) ? ROWS_LAT : MT;
    constexpr int R = 3;
    const int rstride = gridDim.x * 8;
    const bool comb = (WHICH == 1 && l > 0) || WHICH == 3;
    f32x4 xn[R][4]; int svn[R];
#define NORM_LOAD(b0) do { _Pragma("unroll") for (int k = 0; k < R; ++k) { const int row = (b0) + k * rstride; svn[k] = -1; \
        if (row < nrows) { const float* xr = X + (size_t)row * D; _Pragma("unroll") for (int i = 0; i < 4; ++i) xn[k][i] = *(const f32x4*)(xr + i * 256 + lane * 4); \
            if (comb && lane < 16) svn[k] = ((const int*)(p.ws + WS_SLOTOF))[(size_t)row * 16 + lane]; } \
        else { _Pragma("unroll") for (int i = 0; i < 4; ++i) xn[k][i] = (f32x4){0.f, 0.f, 0.f, 0.f}; } } } while (0)
    NORM_LOAD(blockIdx.x * 8 + wid);
    for (int base = blockIdx.x * 8 + wid; base < nrows; base += rstride * R) {
        f32x4 xv[R][4]; int sv[R]; bool ok[R];
#pragma unroll
        for (int k = 0; k < R; ++k) { ok[k] = (base + k * rstride) < nrows; sv[k] = svn[k];
#pragma unroll
            for (int i = 0; i < 4; ++i) xv[k][i] = xn[k][i]; }
        if (comb) {
            const int lp = (WHICH == 3) ? DEPTH - 1 : l - 1;
            const bf16_t* YE = (const bf16_t*)(p.ws + WS_YE);
            f32x4 a[R][4]; unsigned long long msk[R];
#pragma unroll
            for (int k = 0; k < R; ++k) { msk[k] = __ballot(sv[k] >= 0);
#pragma unroll
                for (int i = 0; i < 4; ++i) a[k][i] = (f32x4){0.f, 0.f, 0.f, 0.f}; }
            while (msk[0] | msk[1] | msk[2]) {
                u32x2 t[R][4]; bool has[R];
#pragma unroll
                for (int k = 0; k < R; ++k) {
                    has[k] = msk[k] != 0ull;
                    if (has[k]) {
                        const int e = __builtin_ctzll(msk[k]); msk[k] &= msk[k] - 1ull;
                        const int sl = __builtin_amdgcn_readlane(sv[k], e);
                        const bf16_t* yr = YE + (size_t)sl * D;
#pragma unroll
                        for (int i = 0; i < 4; ++i) t[k][i] = *(const u32x2*)(yr + i * 256 + lane * 4);
                    }
                }
#pragma unroll
                for (int k = 0; k < R; ++k) if (has[k]) {
#pragma unroll
                    for (int i = 0; i < 4; ++i) { a[k][i][0] += bf_lo(t[k][i][0]); a[k][i][1] += bf_hi(t[k][i][0]); a[k][i][2] += bf_lo(t[k][i][1]); a[k][i][3] += bf_hi(t[k][i][1]); }
                }
            }
#pragma unroll
            for (int k = 0; k < R; ++k) if (ok[k]) {
                const int row = base + k * rstride, bidx = row < ROWS_LAT ? (row >> 11) : 8;
                const float* g2 = MOD + ((size_t)lp * 9 + bidx) * 6144 + 5 * 1024;
#pragma unroll
                for (int i = 0; i < 4; ++i) { const f32x4 g = *(const f32x4*)(g2 + i * 256 + lane * 4); xv[k][i] += g * a[k][i];
                    if (WHICH == 1) *(f32x4*)(X + (size_t)row * D + i * 256 + lane * 4) = xv[k][i]; }
            }
        }
        float rstd[R];
#pragma unroll
        for (int k = 0; k < R; ++k) {
            float ss = 0.f;
#pragma unroll
            for (int i = 0; i < 4; ++i) ss += xv[k][i][0] * xv[k][i][0] + xv[k][i][1] * xv[k][i][1] + xv[k][i][2] * xv[k][i][2] + xv[k][i][3] * xv[k][i][3];
            rstd[k] = rsqrtf(wave_sum(ss, lane) * (1.f / 1024.f) + EPS);
        }
        if (WHICH == 3) {
            if (base + rstride * R < nrows) NORM_LOAD(base + rstride * R);
#pragma unroll
            for (int k = 0; k < R; ++k) if (ok[k]) {
                const int row = base + k * rstride;
#pragma unroll
                for (int i = 0; i < 4; ++i) { const f32x4 w = *(const f32x4*)(nw + i * 256 + lane * 4); *(f32x4*)(p.out + (size_t)row * D + i * 256 + lane * 4) = xv[k][i] * rstd[k] * w; }
            }
            continue;
        }
#pragma unroll
        for (int k = 0; k < R; ++k) {
            const int row = base + k * rstride, bidx = row < ROWS_LAT ? (row >> 11) : 8;
            const float* md = MOD + ((size_t)l * 9 + bidx) * 6144 + (WHICH == 1 ? 0 : 3072);
#pragma unroll
            for (int i = 0; i < 4; ++i) {
                const int c = i * 256 + lane * 4;
                const f32x4 w = *(const f32x4*)(nw + c), sh = *(const f32x4*)(md + c), scl = *(const f32x4*)(md + 1024 + c);
                xv[k][i] = (xv[k][i] * rstd[k] * w) * (scl + 1.f) + sh;
                if (ok[k]) { u32x2 o; o[0] = pk_bf16(xv[k][i][0], xv[k][i][1]); o[1] = pk_bf16(xv[k][i][2], xv[k][i][3]); *(u32x2*)(H + (size_t)row * D + c) = o; }
            }
        }
        if (base + rstride * R < nrows) NORM_LOAD(base + rstride * R);
        float dj[R][4];
#pragma unroll
        for (int jg = 0; jg < 4; ++jg) {
            float sp[R][4];
#pragma unroll
            for (int jj = 0; jj < 4; ++jj) {
                const int j = jg * 4 + jj;
                float s0 = 0.f, s1 = 0.f, s2 = 0.f;
#pragma unroll
                for (int i = 0; i < 4; ++i) { const f32x4 w = *(const LAS f32x4*)(wsm + j * 1024 + i * 256 + lane * 4);
                    s0 += xv[0][i][0] * w[0] + xv[0][i][1] * w[1] + xv[0][i][2] * w[2] + xv[0][i][3] * w[3];
                    s1 += xv[1][i][0] * w[0] + xv[1][i][1] * w[1] + xv[1][i][2] * w[2] + xv[1][i][3] * w[3];
                    s2 += xv[2][i][0] * w[0] + xv[2][i][1] * w[1] + xv[2][i][2] * w[2] + xv[2][i][3] * w[3]; }
                sp[0][jj] = s0; sp[1][jj] = s1; sp[2][jj] = s2;
            }
#pragma unroll
            for (int k = 0; k < R; ++k) dj[k][jg] = reduce4(sp[k][0], sp[k][1], sp[k][2], sp[k][3], lane);
            __builtin_amdgcn_sched_barrier(0);
        }
        const int q = lane >> 4;
#pragma unroll
        for (int k = 0; k < R; ++k) {
            const int row = base + k * rstride;
            if (WHICH == 1) {
                if (ok[k] && (lane & 15) == 0) {
#pragma unroll
                    for (int jg = 0; jg < 4; ++jg) {
                        const int j = jg * 4 + q; const float v = dj[k][jg];
                        if (jg < 2) { const float xa = v + p.dt_bias[l * 8 + j]; const float sp2 = xa > 20.f ? xa : log1pf(__expf(xa));
                            ((float*)(p.ws + WS_LOGA))[(size_t)row * 8 + j] = -__expf(p.a_log[l * 8 + j]) * sp2; }
                        else ((float*)(p.ws + WS_BETA))[(size_t)row * 8 + (j - 8)] = 1.f / (1.f + __expf(-v));
                    }
                }
            } else {
                float m = fmaxf(fmaxf(dj[k][0], dj[k][1]), fmaxf(dj[k][2], dj[k][3]));
                m = fmaxf(m, shx(m, 16, lane)); m = fmaxf(m, shx(m, 32, lane));
                float e[4], sum = 0.f;
#pragma unroll
                for (int jg = 0; jg < 4; ++jg) { e[jg] = __expf(dj[k][jg] - m); sum += e[jg]; }
                sum += shx(sum, 16, lane); sum += shx(sum, 32, lane);
                const float inv = 1.f / sum;
                if (ok[k] && (lane & 15) == 0) {
#pragma unroll
                    for (int jg = 0; jg < 4; ++jg) ((float*)(p.ws + WS_AFF))[(size_t)row * 16 + jg * 4 + q] = e[jg] * inv;
                }
            }
        }
    }
}

#undef NORM_LOAD
__device__ __forceinline__ void gemm_core(const unsigned char* Ab, const unsigned (&aoff)[4], const unsigned char* Bb, const unsigned (&boff)[2], const int nt,
                                          LAS unsigned char* lds, f32x4 (&acc)[4][4], const int wid, const int lane) {
    const int wr = wid >> 1, wc = wid & 1, fr = lane & 15, fq = lane >> 4;
    const int ar = lds_byte(wr * 64 + fr, fq * 8), br = lds_byte(wc * 64 + fr, fq * 8);
    const unsigned ldsw = (unsigned)wid * 1024u;
#define G_STAGE(t, buf) do { const unsigned _ko = (unsigned)(t) * 128u; \
        _Pragma("unroll") for (int _i = 0; _i < 4; ++_i) __builtin_amdgcn_global_load_lds((const unsigned*)(Ab + aoff[_i] + _ko), (LAS unsigned*)(lds + (buf) * 49152 + ldsw + _i * 8192), 16, 0, 0); \
        _Pragma("unroll") for (int _i = 0; _i < 2; ++_i) __builtin_amdgcn_global_load_lds((const unsigned*)(Bb + boff[_i] + _ko), (LAS unsigned*)(lds + (buf) * 49152 + 32768 + ldsw + _i * 8192), 16, 0, 0); } while (0)
#pragma unroll
    for (int m = 0; m < 4; ++m)
#pragma unroll
        for (int n = 0; n < 4; ++n) acc[m][n] = (f32x4){0.f, 0.f, 0.f, 0.f};
#if REGSTAGE
    u32x4 ra[4], rb[2];
#pragma unroll
    for (int i = 0; i < 4; ++i) ra[i] = *(const u32x4*)(Ab + aoff[i]);
#pragma unroll
    for (int i = 0; i < 2; ++i) rb[i] = *(const u32x4*)(Bb + boff[i]);
    const unsigned tb = (unsigned)(wid * 64 + lane) * 16u;
    for (int t = 0; t < nt; ++t) {
        __syncthreads();
#pragma unroll
        for (int i = 0; i < 4; ++i) *(LAS u32x4*)(lds + tb + i * 8192) = ra[i];
#pragma unroll
        for (int i = 0; i < 2; ++i) *(LAS u32x4*)(lds + 32768 + tb + i * 8192) = rb[i];
        __syncthreads();
        if (t + 1 < nt) {
            const unsigned ko = (unsigned)(t + 1) * 128u;
#pragma unroll
            for (int i = 0; i < 4; ++i) ra[i] = *(const u32x4*)(Ab + aoff[i] + ko);
#pragma unroll
            for (int i = 0; i < 2; ++i) rb[i] = *(const u32x4*)(Bb + boff[i] + ko);
        }
        LAS unsigned char* bA = lds; LAS unsigned char* bB = bA + 32768;
        bf16x8 af[4][2], bfr[4][2];
#pragma unroll
        for (int m = 0; m < 4; ++m)
#pragma unroll
            for (int k = 0; k < 2; ++k) af[m][k] = *(const LAS bf16x8*)(bA + ar + m * 2048 + k * 1024);
#pragma unroll
        for (int n = 0; n < 4; ++n)
#pragma unroll
            for (int k = 0; k < 2; ++k) bfr[n][k] = *(const LAS bf16x8*)(bB + br + n * 2048 + k * 1024);
#pragma unroll
        for (int k = 0; k < 2; ++k)
#pragma unroll
            for (int m = 0; m < 4; ++m)
#pragma unroll
                for (int n = 0; n < 4; ++n) acc[m][n] = __builtin_amdgcn_mfma_f32_16x16x32_bf16(bfr[n][k], af[m][k], acc[m][n], 0, 0, 0);
    }
#else
    G_STAGE(0, 0);
    for (int t = 0; t < nt; ++t) {
        asm volatile("s_waitcnt vmcnt(0)" ::: "memory");
        __syncthreads();
        if (t + 1 < nt) { if ((t + 1) & 1) G_STAGE(t + 1, 1); else G_STAGE(t + 1, 0); }
        LAS unsigned char* bA = lds + (t & 1) * 49152; LAS unsigned char* bB = bA + 32768;
        bf16x8 af[4][2], bfr[4][2];
#pragma unroll
        for (int m = 0; m < 4; ++m)
#pragma unroll
            for (int k = 0; k < 2; ++k) af[m][k] = *(const LAS bf16x8*)(bA + ar + m * 2048 + k * 1024);
#pragma unroll
        for (int n = 0; n < 4; ++n)
#pragma unroll
            for (int k = 0; k < 2; ++k) bfr[n][k] = *(const LAS bf16x8*)(bB + br + n * 2048 + k * 1024);
#pragma unroll
        for (int k = 0; k < 2; ++k)
#pragma unroll
            for (int m = 0; m < 4; ++m)
#pragma unroll
                for (int n = 0; n < 4; ++n) acc[m][n] = __builtin_amdgcn_mfma_f32_16x16x32_bf16(bfr[n][k], af[m][k], acc[m][n], 0, 0, 0);
    }
#endif
    __syncthreads();
#undef G_STAGE
}

template <int MODE>
__device__ __forceinline__ void phase_gemm(const Params& p, const int l, LAS unsigned char* lds) {
    const int tid = opaque_tid(), wid = __builtin_amdgcn_readfirstlane(tid >> 6), lane = tid & 63;
    const int wr = wid >> 1, wc = wid & 1, fr = lane & 15, fq = lane >> 4;
    int R0, C0; stage_rc(tid * 16, R0, C0);
    constexpr int nN = MODE == 0 ? 20 : (MODE == 1 ? 8 : (MODE == 2 ? 16 : 8));
    constexpr int nM = (MODE <= 1) ? MT / 256 : NGROUPS;
    const bf16_t* H = (const bf16_t*)(p.ws + WS_H);
    for (int u = blockIdx.x; u < nM * nN; u += gridDim.x) {
        const int pm = u / nN, pn = u % nN;
        const unsigned char* Ab; const unsigned char* Bb; unsigned aoff[4], boff[2];
#pragma unroll
        for (int i = 0; i < 2; ++i) boff[i] = (unsigned)((R0 + 64 * i) * D + C0) * 2u;
        int e = 0;
        if (MODE == 0) {
            Ab = (const unsigned char*)(H + (size_t)pm * 256 * D); Bb = (const unsigned char*)((const bf16_t*)(p.ws + WS_WINT) + ((size_t)l * PN + pn * 128) * D);
#pragma unroll
            for (int i = 0; i < 4; ++i) aoff[i] = (unsigned)((R0 + 64 * i) * D + C0) * 2u;
        } else if (MODE == 1) {
            Ab = (const unsigned char*)((const bf16_t*)(p.ws + WS_CAT) + (size_t)pm * 256 * D); Bb = (const unsigned char*)((const bf16_t*)(p.ws + WS_WOUTT) + ((size_t)l * D + pn * 128) * D);
#pragma unroll
            for (int i = 0; i < 4; ++i) aoff[i] = (unsigned)((R0 + 64 * i) * D + C0) * 2u;
        } else if (MODE == 2) {
            e = pm < 128 ? (pm >> 3) : (pm - 128);
            const int* SEL = (const int*)(p.ws + WS_SEL) + pm * 256;
            Ab = (const unsigned char*)H; Bb = (const unsigned char*)((const bf16_t*)(p.ws + WS_WGUT) + ((size_t)(l * NE + e) * 2048 + pn * 128) * D);
#pragma unroll
            for (int i = 0; i < 4; ++i) aoff[i] = (unsigned)(SEL[R0 + 64 * i] * D + C0) * 2u;
        } else {
            e = pm < 128 ? (pm >> 3) : (pm - 128);
            Ab = (const unsigned char*)((const bf16_t*)(p.ws + WS_HID) + (size_t)pm * 256 * D); Bb = (const unsigned char*)((const bf16_t*)(p.ws + WS_WDT) + ((size_t)(l * NE + e) * D + pn * 128) * D);
#pragma unroll
            for (int i = 0; i < 4; ++i) aoff[i] = (unsigned)((R0 + 64 * i) * D + C0) * 2u;
        }
        f32x4 acc[4][4];
        gemm_core(Ab, aoff, Bb, boff, D / 64, lds, acc, wid, lane);
        if (MODE == 0) {
            bf16_t* PROJ = (bf16_t*)(p.ws + WS_PROJ);
#pragma unroll
            for (int m = 0; m < 4; ++m) { const size_t row = (size_t)pm * 256 + wr * 64 + m * 16 + fr;
#pragma unroll
                for (int n = 0; n < 4; ++n) { u32x2 o; o[0] = pk_bf16(acc[m][n][0], acc[m][n][1]); o[1] = pk_bf16(acc[m][n][2], acc[m][n][3]);
                    *(u32x2*)(PROJ + row * PN + pn * 128 + wc * 64 + n * 16 + fq * 4) = o; } }
        } else if (MODE == 1) {
            float* X = (float*)(p.ws + WS_X);
            const int bidx = pm < 64 ? (pm >> 3) : 8;
            const float* g1 = (const float*)(p.ws + WS_MOD) + ((size_t)l * 9 + bidx) * 6144 + 2048;
#pragma unroll
            for (int n = 0; n < 4; ++n) { const int col = pn * 128 + wc * 64 + n * 16 + fq * 4; const f32x4 g = *(const f32x4*)(g1 + col);
#pragma unroll
                for (int m = 0; m < 4; ++m) { float* xp = X + ((size_t)pm * 256 + wr * 64 + m * 16 + fr) * D + col; *(f32x4*)xp = *(const f32x4*)xp + g * acc[m][n]; } }
        } else if (MODE == 2) {
            bf16_t* HID = (bf16_t*)(p.ws + WS_HID);
#pragma unroll
            for (int m = 0; m < 4; ++m) { const size_t slot = (size_t)pm * 256 + wr * 64 + m * 16 + fr;
#pragma unroll
                for (int q = 0; q < 2; ++q) { const f32x4 g = acc[m][2 * q], uu = acc[m][2 * q + 1];
                    u32x2 o; o[0] = pk_bf16(silu_f(g[0]) * uu[0], silu_f(g[1]) * uu[1]); o[1] = pk_bf16(silu_f(g[2]) * uu[2], silu_f(g[3]) * uu[3]);
                    *(u32x2*)(HID + slot * D + pn * 64 + wc * 32 + q * 16 + fq * 4) = o; } }
        } else {
            bf16_t* YE = (bf16_t*)(p.ws + WS_YE);
            const float* SELAFF = (const float*)(p.ws + WS_SELAFF);
#pragma unroll
            for (int m = 0; m < 4; ++m) { const size_t slot = (size_t)pm * 256 + wr * 64 + m * 16 + fr; const float a = SELAFF[slot];
#pragma unroll
                for (int n = 0; n < 4; ++n) { u32x2 o; o[0] = pk_bf16(acc[m][n][0] * a, acc[m][n][1] * a); o[1] = pk_bf16(acc[m][n][2] * a, acc[m][n][3] * a);
                    *(u32x2*)(YE + slot * D + pn * 128 + wc * 64 + n * 16 + fq * 4) = o; } }
        }
    }
}

struct UnitOps { const unsigned char* A; const unsigned char* B; unsigned va[2][2]; int pm, pn; };

template <int MODE> __device__ __forceinline__ int gemm_nunits(const int l) {
    const bool last = (l == DEPTH - 1);
    if (MODE == 0) return last ? 640 + 8 * 6 : 720;
    if (MODE == 1) return last ? 256 : 288;
    if (MODE == 2) return last ? 1024 : 1152;
    return last ? 512 : 576;
}
template <int MODE>
__device__ __forceinline__ bool gemm_unit(const Params& p, const int l, const int i, const int R0, const int C0, UnitOps& u) {
    constexpr int nN = MODE == 0 ? 10 : (MODE == 1 ? 4 : (MODE == 2 ? 8 : 4));
    const int G = gridDim.x, c = (G & 7) == 0 ? (int)(blockIdx.x & 7) * (G >> 3) + (int)(blockIdx.x >> 3) : (int)blockIdx.x;
    const int idx = c + i * G;
    if (idx >= gemm_nunits<MODE>(l)) return false;
    int pm = idx / nN, pn = idx % nN;
    if (MODE == 0 && idx >= 640 && l == DEPTH - 1) { pm = 64 + (idx - 640) / 6; pn = (idx - 640) % 6; }
    u.pm = pm; u.pn = pn;
    if (MODE == 2) {
        const int e = pm < 128 ? (pm >> 3) : (pm - 128);
        const int* SEL = (const int*)(p.ws + WS_SEL) + pm * 256;
        u.A = p.ws + WS_H; u.B = p.ws + WS_WGUT + ((size_t)(l * NE + e) * 2048 + pn * 256) * D * 2;
#pragma unroll
        for (int h = 0; h < 2; ++h)
#pragma unroll
            for (int k = 0; k < 2; ++k) u.va[h][k] = (unsigned)(SEL[h * 128 + R0 + 64 * k] * D + C0) * 2u;
    } else {
        if (MODE == 0) { u.A = p.ws + WS_H + (size_t)pm * 256 * D * 2; u.B = p.ws + WS_WINT + ((size_t)l * PN + pn * 256) * D * 2; }
        else if (MODE == 1) { u.A = p.ws + WS_CAT + (size_t)pm * 256 * D * 2; u.B = p.ws + WS_WOUTT + ((size_t)l * D + pn * 256) * D * 2; }
        else { const int e = pm < 128 ? (pm >> 3) : (pm - 128); u.A = p.ws + WS_HID + (size_t)pm * 256 * D * 2; u.B = p.ws + WS_WDT + ((size_t)(l * NE + e) * D + pn * 256) * D * 2; }
#pragma unroll
        for (int h = 0; h < 2; ++h)
#pragma unroll
            for (int k = 0; k < 2; ++k) u.va[h][k] = (unsigned)((h * 128 + R0 + 64 * k) * D + C0) * 2u;
    }
    return true;
}

template <int MODE>
__device__ __forceinline__ void gemm_epilogue(const Params& p, const int l, const f32x4 (&acc)[2][2][4][2], const UnitOps& u, const int wr, const int wc, const int fr, const int fq) {
    const int row0 = u.pm * 256 + wr * 64 + fr, col0 = u.pn * 256 + wc * 32 + (MODE == 2 ? 4 : 8) * fq;
    if (MODE == 0) {
        bf16_t* PROJ = (bf16_t*)(p.ws + WS_PROJ);
#pragma unroll
        for (int ai = 0; ai < 2; ++ai)
#pragma unroll
            for (int m = 0; m < 4; ++m) { bf16_t* rp = PROJ + (size_t)(row0 + ai * 128 + m * 16) * PN + col0;
#pragma unroll
                for (int bj = 0; bj < 2; ++bj) { const f32x4 v0 = acc[ai][bj][m][0], v1 = acc[ai][bj][m][1];
                    u32x4 o; o[0] = pk_bf16(v0[0], v0[1]); o[1] = pk_bf16(v0[2], v0[3]); o[2] = pk_bf16(v1[0], v1[1]); o[3] = pk_bf16(v1[2], v1[3]); *(u32x4*)(rp + bj * 128) = o; } }
    } else if (MODE == 1) {
        float* X = (float*)(p.ws + WS_X);
        const int bidx = u.pm < 64 ? (u.pm >> 3) : 8;
        const float* g1 = (const float*)(p.ws + WS_MOD) + ((size_t)l * 9 + bidx) * 6144 + 2048 + col0;
        f32x4 gv[2][2];
#pragma unroll
        for (int bj = 0; bj < 2; ++bj)
#pragma unroll
            for (int n = 0; n < 2; ++n) gv[bj][n] = *(const f32x4*)(g1 + bj * 128 + n * 4);
#pragma unroll
        for (int ai = 0; ai < 2; ++ai)
#pragma unroll
            for (int m = 0; m < 4; ++m) { float* rp = X + (size_t)(row0 + ai * 128 + m * 16) * D + col0;
#pragma unroll
                for (int bj = 0; bj < 2; ++bj)
#pragma unroll
                    for (int n = 0; n < 2; ++n) { float* xp = rp + bj * 128 + n * 4; *(f32x4*)xp = *(const f32x4*)xp + gv[bj][n] * acc[ai][bj][m][n]; } }
    } else if (MODE == 2) {
        bf16_t* HID = (bf16_t*)(p.ws + WS_HID);
        const int f0 = u.pn * 128 + wc * 16 + 4 * fq;
#pragma unroll
        for (int ai = 0; ai < 2; ++ai)
#pragma unroll
            for (int m = 0; m < 4; ++m) { bf16_t* rp = HID + (size_t)(row0 + ai * 128 + m * 16) * D + f0;
#pragma unroll
                for (int bj = 0; bj < 2; ++bj) { const f32x4 g = acc[ai][bj][m][0], uu = acc[ai][bj][m][1];
                    u32x2 o; o[0] = pk_bf16(silu_f(g[0]) * uu[0], silu_f(g[1]) * uu[1]); o[1] = pk_bf16(silu_f(g[2]) * uu[2], silu_f(g[3]) * uu[3]);
                    *(u32x2*)(rp + bj * 64) = o; } }
    } else {
        bf16_t* YE = (bf16_t*)(p.ws + WS_YE);
        const float* SELAFF = (const float*)(p.ws + WS_SELAFF);
#pragma unroll
        for (int ai = 0; ai < 2; ++ai)
#pragma unroll
            for (int m = 0; m < 4; ++m) { const size_t slot = (size_t)(row0 + ai * 128 + m * 16); const float a = SELAFF[slot]; bf16_t* rp = YE + slot * D + col0;
#pragma unroll
                for (int bj = 0; bj < 2; ++bj) { const f32x4 v0 = acc[ai][bj][m][0], v1 = acc[ai][bj][m][1];
                    u32x4 o; o[0] = pk_bf16(v0[0] * a, v0[1] * a); o[1] = pk_bf16(v0[2] * a, v0[3] * a); o[2] = pk_bf16(v1[0] * a, v1[1] * a); o[3] = pk_bf16(v1[2] * a, v1[3] * a); *(u32x4*)(rp + bj * 128) = o; } }
    }
}

template <int MODE>
__device__ __forceinline__ void gemm_filler(const Params& p, const int l, LAS unsigned char* lds) {
    if (MODE == 0 || l >= DEPTH - 1) return;
    const int G = gridDim.x, c = (G & 7) == 0 ? (int)(blockIdx.x & 7) * (G >> 3) + (int)(blockIdx.x >> 3) : (int)blockIdx.x;
    const int rem = gemm_nunits<MODE>(l) % G;
    if (rem == 0 || c < rem) return;
    constexpr int first = MODE == 1 ? 0 : (MODE == 2 ? 1344 : 2240), count = MODE == 1 ? 1344 : (MODE == 2 ? 896 : 1056);
    convert_tiles(p, l + 1, first, count, c - rem, G - rem, lds);
}

template <int MODE>
__device__ __forceinline__ void phase_gemm8(const Params& p, const int l, LAS unsigned char* lds) {
    const int tid = opaque_tid(), wid = __builtin_amdgcn_readfirstlane(tid >> 6), lane = tid & 63, wr = wid >> 2, wc = wid & 3, fr = lane & 15, fq = lane >> 4;
    constexpr int HTB = 16384;
    constexpr int nt = D / 64;
    constexpr unsigned kstep = 128u, hstepB = 128u * D * 2u;
    int R0, C0; stage_rc(tid * 16, R0, C0);
    constexpr bool PERM = (MODE != 2);
    unsigned vb[2];
#pragma unroll
    for (int k = 0; k < 2; ++k) { const int R = R0 + 64 * k, rho = R & 31, Rb = PERM ? ((R & ~31) + 8 * ((rho & 15) >> 2) + 4 * (rho >> 4) + (rho & 3)) : R; vb[k] = (unsigned)(Rb * D + C0) * 2u; }
    const unsigned ldsw = (unsigned)wid * 1024u;
    const int aoff = lds_byte(wr * 64 + fr, fq * 8), boff = lds_byte(wc * 32 + fr, fq * 8);
#define G8_SA(b, h) (((b) * 2 + (h)) * HTB)
#define G8_SB(b, h) ((4 + (b) * 2 + (h)) * HTB)
#define G8_STAGE_A(bufoff, U, h, ko) do { _Pragma("unroll") for (int _i = 0; _i < 2; ++_i) \
        __builtin_amdgcn_global_load_lds((const unsigned*)((U).A + (U).va[h][_i] + (ko)), (LAS unsigned*)(lds + (bufoff) + ldsw + _i * 8192), 16, 0, 0); } while (0)
#define G8_STAGE_B(bufoff, U, h, ko) do { _Pragma("unroll") for (int _i = 0; _i < 2; ++_i) \
        __builtin_amdgcn_global_load_lds((const unsigned*)((U).B + vb[_i] + (h) * hstepB + (ko)), (LAS unsigned*)(lds + (bufoff) + ldsw + _i * 8192), 16, 0, 0); } while (0)
#define G8_LDA(dst, b, h) do { _Pragma("unroll") for (int m = 0; m < 4; ++m) _Pragma("unroll") for (int k = 0; k < 2; ++k) dst[m][k] = *(const LAS bf16x8*)(lds + G8_SA(b, h) + aoff + m * 2048 + k * 1024); } while (0)
#define G8_LDB(dst, b, h) do { _Pragma("unroll") for (int n = 0; n < 2; ++n) _Pragma("unroll") for (int k = 0; k < 2; ++k) dst[n][k] = *(const LAS bf16x8*)(lds + G8_SB(b, h) + boff + n * 2048 + k * 1024); } while (0)
#define G8_MMA(ai, bj, At, Bt) do { __builtin_amdgcn_s_setprio(1); _Pragma("unroll") for (int m = 0; m < 4; ++m) _Pragma("unroll") for (int n = 0; n < 2; ++n) _Pragma("unroll") for (int k = 0; k < 2; ++k) \
        acc[ai][bj][m][n] = __builtin_amdgcn_mfma_f32_16x16x32_bf16(Bt[n][k], At[m][k], acc[ai][bj][m][n], 0, 0, 0); __builtin_amdgcn_s_setprio(0); } while (0)
#define G8_WAIT_V(n) asm volatile("s_waitcnt vmcnt(" #n ")" ::: "memory")
#define G8_WAIT_L(n) asm volatile("s_waitcnt lgkmcnt(" #n ")" ::: "memory")
#define G8_BAR __builtin_amdgcn_s_barrier()
#define G8_SCHED __builtin_amdgcn_sched_barrier(0)
    UnitOps cur, nxt; int ui = 0;
    if (!gemm_unit<MODE>(p, l, 0, R0, C0, cur)) { gemm_filler<MODE>(p, l, lds); return; }
    f32x4 acc[2][2][4][2];
#pragma unroll
    for (int a = 0; a < 2; ++a)
#pragma unroll
        for (int b = 0; b < 2; ++b)
#pragma unroll
            for (int m = 0; m < 4; ++m)
#pragma unroll
                for (int n = 0; n < 2; ++n) acc[a][b][m][n] = (f32x4){0.f, 0.f, 0.f, 0.f};
    bf16x8 At[4][2], B0[2][2], B1[2][2];
    bool has_next = gemm_unit<MODE>(p, l, 1, R0, C0, nxt);
    if (!has_next) nxt = cur;
    G8_STAGE_B(G8_SB(0, 0), cur, 0, 0u); G8_STAGE_A(G8_SA(0, 0), cur, 0, 0u); G8_STAGE_B(G8_SB(0, 1), cur, 1, 0u); G8_STAGE_A(G8_SA(0, 1), cur, 1, 0u);
    if (wr == 1) G8_BAR;
    G8_WAIT_V(4); G8_BAR;
    G8_STAGE_B(G8_SB(1, 0), cur, 0, kstep); G8_STAGE_A(G8_SA(1, 0), cur, 0, kstep); G8_STAGE_B(G8_SB(1, 1), cur, 1, kstep);
    G8_WAIT_V(6); G8_BAR;
    for (;;) {
#pragma unroll 1
        for (int t = 0; t < nt; t += 2) {
            const bool last = (t == nt - 2);
            const unsigned k1 = (unsigned)(t + 1) * kstep, k2 = last ? 0u : (unsigned)(t + 2) * kstep, k3 = k2 + kstep;
            UnitOps& U2 = last ? nxt : cur;
            G8_LDB(B0, 0, 0); G8_SCHED; G8_LDA(At, 0, 0); G8_STAGE_A(G8_SA(1, 1), cur, 1, k1);
            G8_WAIT_L(8); G8_BAR; G8_WAIT_L(0); G8_MMA(0, 0, At, B0); G8_BAR; G8_SCHED;
            G8_LDB(B1, 0, 1); G8_STAGE_B(G8_SB(0, 0), U2, 0, k2);
            G8_BAR; G8_WAIT_L(0); G8_MMA(0, 1, At, B1); G8_BAR;
            G8_LDA(At, 0, 1); G8_STAGE_A(G8_SA(0, 0), U2, 0, k2);
            G8_BAR; G8_WAIT_L(0); G8_MMA(1, 0, At, B0); G8_BAR; G8_SCHED;
            G8_STAGE_B(G8_SB(0, 1), U2, 1, k2);
            G8_WAIT_V(6); G8_BAR; G8_MMA(1, 1, At, B1); G8_BAR;
            G8_LDB(B0, 1, 0); G8_SCHED; G8_LDA(At, 1, 0); G8_STAGE_A(G8_SA(0, 1), U2, 1, k2);
            G8_WAIT_L(8); G8_BAR; G8_WAIT_L(0); G8_MMA(0, 0, At, B0); G8_BAR; G8_SCHED;
            G8_LDB(B1, 1, 1); G8_STAGE_B(G8_SB(1, 0), U2, 0, k3);
            G8_BAR; G8_WAIT_L(0); G8_MMA(0, 1, At, B1); G8_BAR;
            G8_LDA(At, 1, 1); G8_STAGE_A(G8_SA(1, 0), U2, 0, k3);
            G8_BAR; G8_WAIT_L(0); G8_MMA(1, 0, At, B0); G8_BAR; G8_SCHED;
            G8_STAGE_B(G8_SB(1, 1), U2, 1, k3);
            G8_WAIT_V(6); G8_BAR; G8_MMA(1, 1, At, B1); G8_BAR;
        }
        gemm_epilogue<MODE>(p, l, acc, cur, wr, wc, fr, fq);
        if (!has_next) break;
#pragma unroll
        for (int a = 0; a < 2; ++a)
#pragma unroll
            for (int b = 0; b < 2; ++b)
#pragma unroll
                for (int m = 0; m < 4; ++m)
#pragma unroll
                    for (int n = 0; n < 2; ++n) acc[a][b][m][n] = (f32x4){0.f, 0.f, 0.f, 0.f};
        cur = nxt; ++ui;
        has_next = gemm_unit<MODE>(p, l, ui + 1, R0, C0, nxt);
        if (!has_next) nxt = cur;
    }
    G8_WAIT_V(0);
    if (wr == 0) G8_BAR;
    G8_BAR;
    gemm_filler<MODE>(p, l, lds);
#undef G8_SA
#undef G8_SB
#undef G8_STAGE_A
#undef G8_STAGE_B
#undef G8_LDA
#undef G8_LDB
#undef G8_MMA
#undef G8_WAIT_V
#undef G8_WAIT_L
#undef G8_BAR
#undef G8_SCHED
}

template <int B>
__device__ __forceinline__ void pool_vsum(const bf16_t* src0, const size_t rstep, const int lo_r, const int hi_r, const int rc, const int npieces, LAS float* V, LAS unsigned char* U, const int tid) {
    for (int p0 = tid; p0 < npieces; p0 += 2 * NTHREADS) {
        const int p1 = p0 + NTHREADS; const bool two = p1 < npieces;
        const bf16_t* sa = src0 + (size_t)(p0 >> 4) * PN + (p0 & 15) * 8;
        const bf16_t* sb = src0 + (size_t)((two ? p1 : p0) >> 4) * PN + ((two ? p1 : p0) & 15) * 8;
        float aa[8], ab[8];
#pragma unroll
        for (int e = 0; e < 8; ++e) { aa[e] = 0.f; ab[e] = 0.f; }
        for (int r0 = lo_r; r0 < hi_r; r0 += B) {
            u32x4 va[B], vb[B];
#pragma unroll
            for (int k = 0; k < B; ++k) { const int rr = min(r0 + k, hi_r - 1); va[k] = *(const u32x4*)(sa + (size_t)rr * rstep); vb[k] = *(const u32x4*)(sb + (size_t)rr * rstep); }
#pragma unroll
            for (int k = 0; k < B; ++k) if (r0 + k < hi_r) {
                if (r0 + k == rc) { *(LAS u32x4*)(U + (p0 >> 4) * 256 + (p0 & 15) * 16) = va[k]; if (two) *(LAS u32x4*)(U + (p1 >> 4) * 256 + (p1 & 15) * 16) = vb[k]; }
#pragma unroll
                for (int e = 0; e < 4; ++e) { aa[2 * e] += bf_lo(va[k][e]); aa[2 * e + 1] += bf_hi(va[k][e]); ab[2 * e] += bf_lo(vb[k][e]); ab[2 * e + 1] += bf_hi(vb[k][e]); }
            }
        }
        *(LAS f32x4*)(V + (p0 >> 4) * 128 + (p0 & 15) * 8) = (f32x4){aa[0], aa[1], aa[2], aa[3]};
        *(LAS f32x4*)(V + (p0 >> 4) * 128 + (p0 & 15) * 8 + 4) = (f32x4){aa[4], aa[5], aa[6], aa[7]};
        if (two) { *(LAS f32x4*)(V + (p1 >> 4) * 128 + (p1 & 15) * 8) = (f32x4){ab[0], ab[1], ab[2], ab[3]};
                   *(LAS f32x4*)(V + (p1 >> 4) * 128 + (p1 & 15) * 8 + 4) = (f32x4){ab[4], ab[5], ab[6], ab[7]}; }
    }
}

__device__ __forceinline__ void phase_conv_pool(const Params& p, const int l, LAS unsigned char* lds, const int wg0 = 0, const int nwg = 0) {
    const int tid = opaque_tid(), wid = tid >> 6, lane = tid & 63;
    const bf16_t* PROJ = (const bf16_t*)(p.ws + WS_PROJ);
    if (NAIVE_SCAN) {
        float* QKV = (float*)(p.ws + WS_QKV);
        const float* cw = p.conv_w + (size_t)l * 4 * 1536;
        for (int task = blockIdx.x * 8 + wid; task < MT * 12; task += gridDim.x * 8) {
            const int row = task / 12, part = task % 12;
            int s0, len;
            if (row < ROWS_LAT) { s0 = row & ~2047; len = 2048; } else { s0 = ROWS_LAT + ((row - ROWS_LAT) & ~255); len = 256; }
            const int c = part * 128 + lane * 2;
            float a0 = 0.f, a1 = 0.f;
#pragma unroll
            for (int j = 0; j < 4; ++j) {
                const int r2 = row + j - 2;
                if (r2 >= s0 && r2 < s0 + len) {
                    const unsigned v = *(const unsigned*)(PROJ + (size_t)r2 * PN + c);
                    const f32x2 w = *(const f32x2*)(cw + j * 1536 + c);
                    a0 += w[0] * bf_lo(v); a1 += w[1] * bf_hi(v);
                }
            }
            a0 = silu_f(a0); a1 = silu_f(a1);
            if (part < 8) {
                const float ss = wave_sum(a0 * a0 + a1 * a1, lane);
                float sc = rsqrtf(ss + EPS);
                if (part < 4) sc *= 0.08838834764831845f;
                a0 *= sc; a1 *= sc;
            }
            *(f32x2*)(QKV + (size_t)row * 1536 + c) = (f32x2){a0, a1};
        }
    }
    {
        LAS float* V = (LAS float*)lds;
        LAS unsigned char* mt = lds + 40960;
        const bf16_t* PWT = (const bf16_t*)(p.ws + WS_PWT);
        bf16_t* CAT = (bf16_t*)(p.ws + WS_CAT);
        const int wr = wid >> 1, wc = wid & 1, fr = lane & 15, fq = lane >> 4;
        const int npool = (l == DEPTH - 1) ? 1024 : 1152;
        const int pstep = nwg > 0 ? nwg : (int)gridDim.x;
        for (int u = ((int)blockIdx.x >= wg0) ? (int)blockIdx.x - wg0 : npool; u < npool; u += pstep) {
            int g, r, nrows, ncols, c0, rowbase;
            if (u < 1024) { const int q = u & 255, b = q >> 5; g = (q + (u >> 8)) & 3; r = q & 31; nrows = 32; ncols = 64; c0 = 0; rowbase = b * 2048; }
            else { const int v = u - 1024; const int b = v >> 4; g = (v >> 2) & 3; r = 0; nrows = 1; ncols = 256; c0 = (v & 3) * 64; rowbase = ROWS_LAT + b * 256; }
            const int w = 2 << g, half = w >> 1;
            const int lo_r = max(r - half, 0), hi_r = min(r - half + w, nrows);
            const int cxlo = max(c0 - half, 0), cxhi = min(c0 + 64 + half, ncols);
            const bf16_t* ub = PROJ + 2048 + g * 128;
            const bf16_t* pw = PWT + (size_t)(l * 4 + g) * 128 * 128;
            bf16x8 pwf[4][4];
#pragma unroll
            for (int kk = 0; kk < 4; ++kk)
#pragma unroll
                for (int n = 0; n < 4; ++n) pwf[kk][n] = *(const bf16x8*)(pw + (size_t)(wc * 64 + n * 16 + fr) * 128 + kk * 32 + fq * 8);
            {
                const int npieces = (cxhi - cxlo) * 16;
                const size_t rstep = (size_t)ncols * PN;
                if (g == 0) pool_vsum<2>(ub + (size_t)(rowbase + cxlo) * PN, rstep, lo_r, hi_r, r, npieces, V, lds + 58368, tid);
                else if (g == 1) pool_vsum<4>(ub + (size_t)(rowbase + cxlo) * PN, rstep, lo_r, hi_r, r, npieces, V, lds + 58368, tid);
                else pool_vsum<8>(ub + (size_t)(rowbase + cxlo) * PN, rstep, lo_r, hi_r, r, npieces, V, lds + 58368, tid);
            }
            __syncthreads();
            for (int idx = tid; idx < 64 * 64; idx += NTHREADS) {
                const int ci = idx >> 6, ch = (idx & 63) * 2, c = c0 + ci;
                const int lo_c = max(c - half, 0), hi_c = min(c - half + w, ncols);
                float s0 = 0.f, s1 = 0.f;
                for (int cx = lo_c; cx < hi_c; ++cx) { s0 += V[(cx - cxlo) * 128 + ch]; s1 += V[(cx - cxlo) * 128 + ch + 1]; }
                const float inv = __builtin_amdgcn_rcpf((float)((hi_r - lo_r) * (hi_c - lo_c)));
                const unsigned v = *(const LAS unsigned*)(lds + 58368 + (c - cxlo) * 256 + ch * 2);
                *(LAS unsigned*)(mt + ci * 272 + ch * 2) = pk_bf16(s0 * inv - bf_lo(v), s1 * inv - bf_hi(v));
            }
            __syncthreads();
            f32x4 acc[4];
#pragma unroll
            for (int n = 0; n < 4; ++n) acc[n] = (f32x4){0.f, 0.f, 0.f, 0.f};
#pragma unroll
            for (int kk = 0; kk < 4; ++kk) {
                const bf16x8 a = *(const LAS bf16x8*)(mt + (wr * 16 + fr) * 272 + (kk * 32 + fq * 8) * 2);
#pragma unroll
                for (int n = 0; n < 4; ++n) acc[n] = __builtin_amdgcn_mfma_f32_16x16x32_bf16(pwf[kk][n], a, acc[n], 0, 0, 0);
            }
            const size_t row = (size_t)rowbase + r * ncols + c0 + wr * 16 + fr;
#pragma unroll
            for (int n = 0; n < 4; ++n) {
                const int dcol = g * 128 + wc * 64 + n * 16 + fq * 4;
                const f32x4 s = *(const f32x4*)(p.pool_scale + l * 512 + dcol);
                u32x2 o; o[0] = pk_bf16(acc[n][0] * s[0], acc[n][1] * s[1]); o[1] = pk_bf16(acc[n][2] * s[2], acc[n][3] * s[3]);
                *(u32x2*)(CAT + row * D + 512 + dcol) = o;
            }
            __syncthreads();
        }
    }
}


__device__ __forceinline__ int img256(int row, int col) { return row * 256 + ((((col >> 3) ^ row) & 15) << 4) + (col & 7) * 2; }
__device__ __forceinline__ int img128(int row, int col) { return (row >> 1) * 256 + (row & 1) * 128 + ((((col >> 3) ^ (row >> 1)) & 7) << 4) + (col & 7) * 2; }

__device__ __forceinline__ void prep_tchain(const int lane, LAS float* MT, LAS float* XS) {
    const int fr = lane & 15, fq = lane >> 4;
    {
        const int bb = lane >> 4, c = lane & 15;
        float tc[16];
#pragma unroll
        for (int a = 0; a < 16; ++a) {
            float sv = (a == c) ? 1.f : 0.f;
#pragma unroll
            for (int q = 0; q < (a + 3) / 4; ++q) {
                const f32x4 m4 = *(const LAS f32x4*)(MT + (bb * 16 + a) * 68 + bb * 16 + q * 4);
#pragma unroll
                for (int e = 0; e < 4; ++e) if (q * 4 + e < a) sv -= m4[e] * tc[q * 4 + e];
            }
            tc[a] = sv;
        }
#pragma unroll
        for (int a = 0; a < 16; ++a) MT[(bb * 16 + a) * 68 + bb * 16 + c] = tc[a];
    }
    {
        f32x4 x0 = (f32x4){0.f, 0.f, 0.f, 0.f}, x1 = (f32x4){0.f, 0.f, 0.f, 0.f};
#pragma unroll
        for (int ks = 0; ks < 4; ++ks) {
            x0 = __builtin_amdgcn_mfma_f32_16x16x4f32(MT[(16 + fr) * 68 + ks * 4 + fq], MT[(ks * 4 + fq) * 68 + fr], x0, 0, 0, 0);
            x1 = __builtin_amdgcn_mfma_f32_16x16x4f32(MT[(48 + fr) * 68 + 32 + ks * 4 + fq], MT[(32 + ks * 4 + fq) * 68 + 32 + fr], x1, 0, 0, 0);
        }
#pragma unroll
        for (int r = 0; r < 4; ++r) { XS[(fq * 4 + r) * 17 + fr] = x0[r]; XS[272 + (fq * 4 + r) * 17 + fr] = x1[r]; }
        f32x4 y0 = (f32x4){0.f, 0.f, 0.f, 0.f}, y1 = (f32x4){0.f, 0.f, 0.f, 0.f};
#pragma unroll
        for (int ks = 0; ks < 4; ++ks) {
            y0 = __builtin_amdgcn_mfma_f32_16x16x4f32(MT[(16 + fr) * 68 + 16 + ks * 4 + fq], XS[(ks * 4 + fq) * 17 + fr], y0, 0, 0, 0);
            y1 = __builtin_amdgcn_mfma_f32_16x16x4f32(MT[(48 + fr) * 68 + 48 + ks * 4 + fq], XS[272 + (ks * 4 + fq) * 17 + fr], y1, 0, 0, 0);
        }
#pragma unroll
        for (int r = 0; r < 4; ++r) { MT[(16 + fq * 4 + r) * 68 + fr] = -y0[r]; MT[(48 + fq * 4 + r) * 68 + 32 + fr] = -y1[r]; }
    }
    {
        f32x4 y[2][2];
#pragma unroll
        for (int ti = 0; ti < 2; ++ti)
#pragma unroll
            for (int tj = 0; tj < 2; ++tj) y[ti][tj] = (f32x4){0.f, 0.f, 0.f, 0.f};
#pragma unroll
        for (int ks = 0; ks < 8; ++ks) {
            const float b0 = MT[(ks * 4 + fq) * 68 + fr], b1 = MT[(ks * 4 + fq) * 68 + 16 + fr];
#pragma unroll
            for (int ti = 0; ti < 2; ++ti) {
                const float a = MT[(32 + ti * 16 + fr) * 68 + ks * 4 + fq];
                y[ti][0] = __builtin_amdgcn_mfma_f32_16x16x4f32(a, b0, y[ti][0], 0, 0, 0);
                y[ti][1] = __builtin_amdgcn_mfma_f32_16x16x4f32(a, b1, y[ti][1], 0, 0, 0);
            }
        }
#pragma unroll
        for (int ti = 0; ti < 2; ++ti)
#pragma unroll
            for (int tj = 0; tj < 2; ++tj)
#pragma unroll
                for (int r = 0; r < 4; ++r) XS[(ti * 16 + fq * 4 + r) * 33 + tj * 16 + fr] = y[ti][tj][r];
        f32x4 z[2][2];
#pragma unroll
        for (int ti = 0; ti < 2; ++ti)
#pragma unroll
            for (int tj = 0; tj < 2; ++tj) z[ti][tj] = (f32x4){0.f, 0.f, 0.f, 0.f};
#pragma unroll
        for (int ks = 0; ks < 8; ++ks) {
            const float b0 = XS[(ks * 4 + fq) * 33 + fr], b1 = XS[(ks * 4 + fq) * 33 + 16 + fr];
#pragma unroll
            for (int ti = 0; ti < 2; ++ti) {
                const float a = MT[(32 + ti * 16 + fr) * 68 + 32 + ks * 4 + fq];
                z[ti][0] = __builtin_amdgcn_mfma_f32_16x16x4f32(a, b0, z[ti][0], 0, 0, 0);
                z[ti][1] = __builtin_amdgcn_mfma_f32_16x16x4f32(a, b1, z[ti][1], 0, 0, 0);
            }
        }
#pragma unroll
        for (int ti = 0; ti < 2; ++ti)
#pragma unroll
            for (int tj = 0; tj < 2; ++tj)
#pragma unroll
                for (int r = 0; r < 4; ++r) MT[(32 + ti * 16 + fq * 4 + r) * 68 + tj * 16 + fr] = -z[ti][tj][r];
    }
}

__device__ __forceinline__ int imgT(int i, int j) { return i * 128 + ((((j >> 3) ^ i) & 7) << 4) + (j & 7) * 2; }

__device__ __forceinline__ void phase_prep(const Params& p, const int l, LAS unsigned char* lds) {
    int tid = opaque_tid(), wid = __builtin_amdgcn_readfirstlane(tid >> 6), lane = tid & 63, fr = lane & 15, fq = lane >> 4;
#define RELAUNDER() do { asm volatile("" : "+v"(tid)); wid = __builtin_amdgcn_readfirstlane(tid >> 6); lane = tid & 63; fr = lane & 15; fq = lane >> 4; } while (0)
    constexpr int R_MT0 = 0, R_MT1 = 17408, R_QK = 34816, R_QN = 53248, R_KN = 70656, R_KNT = 88064, R_VT = 106496, R_G = 143360;
    constexpr int R_T0 = R_QK, R_T1 = 124928;
    LAS float* QK = (LAS float*)(lds + R_QK);
    LAS float* G_LA = (LAS float*)(lds + R_G);
    LAS float* G_BT = G_LA + 128;
    LAS float* G_GC = G_BT + 128;
    LAS float* G_TOT = G_GC + 128;
    LAS float* G_E1 = G_TOT + 16;
    LAS float* G_E2 = G_E1 + 128;
    LAS float* XS = G_E2 + 128;
    LAS float* CW = XS + 2176;
    static_assert(R_G + (128 * 5 + 16 + 2176 + 1536) * 4 <= LDS_WORK, "prep LDS");
    const bf16_t* PROJ = (const bf16_t*)(p.ws + WS_PROJ);
    const float* LOGA = (const float*)(p.ws + WS_LOGA); const float* BETA = (const float*)(p.ws + WS_BETA);
    int cur_h = -1;
    for (int u = blockIdx.x; u < NB * 4 * NCHUNK; u += gridDim.x) {
        const int h = u & 3, b = (u >> 2) / 36, cc = (u >> 2) % 36;
        if (h != cur_h) {
            __syncthreads();
            for (int idx = tid; idx < 1536; idx += NTHREADS) { const int j = idx / 384, rm = idx % 384, seg = rm >> 7, c = rm & 127; CW[idx] = p.conv_w[(size_t)(l * 4 + j) * 1536 + seg * 512 + h * 128 + c]; }
            cur_h = h;
        }
        int rowbase, seqlen, cpos;
        if (cc < 32) { rowbase = b * SEQ; seqlen = SEQ; cpos = cc; } else { rowbase = ROWS_LAT + b * CTXL; seqlen = CTXL; cpos = cc - 32; }
        const int t0 = cpos * 64;
        RELAUNDER();
        {
            u32x4 rv[7];
#pragma unroll
            for (int it = 0; it < 7; ++it) {
                const int idx = tid + it * NTHREADS, rr = idx / 48, pc = idx % 48, seg = pc >> 4, po = pc & 15, tok = t0 - 2 + rr;
                rv[it] = (u32x4){0u, 0u, 0u, 0u};
                if (idx < 67 * 48 && tok >= 0 && tok < seqlen) rv[it] = *(const u32x4*)(PROJ + (size_t)(rowbase + tok) * PN + seg * 512 + h * 128 + po * 8);
            }
#pragma unroll
            for (int it = 0; it < 7; ++it) {
                const int idx = tid + it * NTHREADS, rr = idx / 48, pc = idx % 48, seg = pc >> 4, po = pc & 15;
                if (idx < 67 * 48) *(LAS u32x4*)(lds + rr * 784 + seg * 256 + po * 16) = rv[it];
            }
        }
        if (tid < 128) { const int d = tid >> 6; const size_t gi = (size_t)(rowbase + t0 + lane) * 8 + d * 4 + h; G_LA[tid] = LOGA[gi]; G_BT[tid] = BETA[gi]; }
        __syncthreads();
        RELAUNDER();
        if (wid < 2) {
            const int d = wid, pos = d ? 63 - lane : lane;
            float v = G_LA[d * 64 + pos];
#pragma unroll
            for (int o = 1; o < 64; o <<= 1) { const float t = shup(v, o, lane); if (lane >= o) v += t; }
            G_GC[d * 64 + pos] = v;
            if (lane == 63) G_TOT[d] = v;
            const float tot = __int_as_float(__builtin_amdgcn_readlane(__float_as_int(v), 63));
            G_E1[d * 64 + pos] = __expf(tot - v); G_E2[d * 64 + pos] = __expf(v);
        }
        RELAUNDER();
        {
            const int r = tid >> 3, cs = tid & 7;
            const LAS float* cw = CW + cs * 16;
#pragma unroll
            for (int seg = 0; seg < 3; ++seg) {
                float a[16];
#pragma unroll
                for (int e = 0; e < 16; ++e) a[e] = 0.f;
#pragma unroll
                for (int j = 0; j < 4; ++j) {
                    const u32x4 x0 = *(const LAS u32x4*)(lds + (r + j) * 784 + seg * 256 + cs * 32), x1 = *(const LAS u32x4*)(lds + (r + j) * 784 + seg * 256 + cs * 32 + 16);
                    const LAS float* wj = cw + j * 384 + seg * 128;
                    const f32x4 w0 = *(const LAS f32x4*)(wj), w1 = *(const LAS f32x4*)(wj + 4), w2 = *(const LAS f32x4*)(wj + 8), w3 = *(const LAS f32x4*)(wj + 12);
                    a[0] += w0[0] * bf_lo(x0[0]); a[1] += w0[1] * bf_hi(x0[0]); a[2] += w0[2] * bf_lo(x0[1]); a[3] += w0[3] * bf_hi(x0[1]);
                    a[4] += w1[0] * bf_lo(x0[2]); a[5] += w1[1] * bf_hi(x0[2]); a[6] += w1[2] * bf_lo(x0[3]); a[7] += w1[3] * bf_hi(x0[3]);
                    a[8] += w2[0] * bf_lo(x1[0]); a[9] += w2[1] * bf_hi(x1[0]); a[10] += w2[2] * bf_lo(x1[1]); a[11] += w2[3] * bf_hi(x1[1]);
                    a[12] += w3[0] * bf_lo(x1[2]); a[13] += w3[1] * bf_hi(x1[2]); a[14] += w3[2] * bf_lo(x1[3]); a[15] += w3[3] * bf_hi(x1[3]);
                    if (j & 1) __builtin_amdgcn_sched_barrier(0);
                }
                float ss = 0.f;
#pragma unroll
                for (int e = 0; e < 16; ++e) { a[e] = silu_f(a[e]); ss += a[e] * a[e]; }
                if (seg < 2) {
                    ss += shx(ss, 1, lane); ss += shx(ss, 2, lane); ss += shx(ss, 4, lane);
                    float sc = rsqrtf(ss + EPS); if (seg == 0) sc *= 0.08838834764831845f;
#pragma unroll
                    for (int e = 0; e < 16; ++e) a[e] *= sc;
                }
                unsigned pk[8];
#pragma unroll
                for (int e = 0; e < 8; ++e) pk[e] = pk_bf16(a[2 * e], a[2 * e + 1]);
                if (seg < 2) {
                    LAS unsigned char* dst = lds + (seg == 0 ? R_QN : R_KN) + r * 272 + cs * 32;
                    *(LAS u32x4*)dst = (u32x4){pk[0], pk[1], pk[2], pk[3]}; *(LAS u32x4*)(dst + 16) = (u32x4){pk[4], pk[5], pk[6], pk[7]};
                }
                if (seg >= 1) {
                    LAS unsigned char* dt = lds + (seg == 1 ? R_KNT : R_VT) + (cs * 16) * 144 + ((((r >> 3) ^ cs) & 7) << 4) + (r & 7) * 2;
#pragma unroll
                    for (int e = 0; e < 8; ++e) { *(LAS unsigned short*)(dt + (2 * e) * 144) = (unsigned short)(pk[e] & 0xffffu); *(LAS unsigned short*)(dt + (2 * e + 1) * 144) = (unsigned short)(pk[e] >> 16); }
                }
            }
        }
        __syncthreads();
        RELAUNDER();
        {
            const int ib = wid & 3, pr = wid >> 2;
            LAS unsigned char* Ab = lds + (pr ? R_QN : R_KN) + (ib * 16 + fr) * 272 + fq * 16;
            bf16x8 a[4];
#pragma unroll
            for (int kk = 0; kk < 4; ++kk) a[kk] = *(const LAS bf16x8*)(Ab + kk * 64);
#pragma unroll
            for (int jb = 0; jb < 4; ++jb) {
                f32x4 acc = (f32x4){0.f, 0.f, 0.f, 0.f};
#pragma unroll
                for (int kk = 0; kk < 4; ++kk) { const bf16x8 bb = *(const LAS bf16x8*)(lds + R_KN + (jb * 16 + fr) * 272 + fq * 16 + kk * 64); acc = __builtin_amdgcn_mfma_f32_16x16x32_bf16(a[kk], bb, acc, 0, 0, 0); }
                if (pr) {
#pragma unroll
                    for (int r = 0; r < 4; ++r) QK[(ib * 16 + fq * 4 + r) * 65 + jb * 16 + fr] = acc[r];
                } else {
                    const int j = jb * 16 + fr;
                    const float g0j = G_GC[j], g1j = G_GC[64 + j];
#pragma unroll
                    for (int r = 0; r < 4; ++r) {
                        const int i = ib * 16 + fq * 4 + r;
                        ((LAS float*)(lds + R_MT0))[i * 68 + j] = (j < i) ? G_BT[i] * acc[r] * __expf(G_GC[i] - g0j) : 0.f;
                        ((LAS float*)(lds + R_MT1))[(63 - i) * 68 + (63 - j)] = (j > i) ? G_BT[64 + i] * acc[r] * __expf(G_GC[64 + i] - g1j) : 0.f;
                    }
                }
            }
        }
        __syncthreads();
        RELAUNDER();
        unsigned char* recd[2];
#pragma unroll
        for (int d = 0; d < 2; ++d) { const int cposn = (cc < 32) ? 4 + (d ? 31 - cpos : cpos) : (d ? 3 - cpos : cpos);
            recd[d] = p.ws + WS_SCN + ((size_t)((b * 4 + h) * 2 + d) * NCHUNK + cposn) * REC_BYTES; }
        if ((wid & 3) == 0) {
            const int d = wid >> 2;
            prep_tchain(lane, (LAS float*)(lds + (d ? R_MT1 : R_MT0)), XS + d * 1088);
        } else {
            const int wt = (wid - 1 - (wid > 4 ? 1 : 0)) * 64 + lane;
            for (int it = wt; it < 5120; it += 384) {
                const int d = it >= 2560 ? 1 : 0, r = it - d * 2560;
                const LAS float* gc = G_GC + d * 64;
                unsigned char* rec = d ? recd[1] : recd[0];
                if (r < 1024) {
                    const int dk = r >> 3, i8 = (r & 7) * 8;
                    const u32x4 kv = *(const LAS u32x4*)(lds + R_KNT + dk * 144 + ((((i8 >> 3) ^ (dk >> 4)) & 7) << 4));
                    const LAS float* e1 = G_E1 + d * 64 + i8;
                    const f32x4 ea = *(const LAS f32x4*)e1, eb = *(const LAS f32x4*)(e1 + 4);
                    u32x4 o;
                    o[0] = pk_bf16(bf_lo(kv[0]) * ea[0], bf_hi(kv[0]) * ea[1]); o[1] = pk_bf16(bf_lo(kv[1]) * ea[2], bf_hi(kv[1]) * ea[3]);
                    o[2] = pk_bf16(bf_lo(kv[2]) * eb[0], bf_hi(kv[2]) * eb[1]); o[3] = pk_bf16(bf_lo(kv[3]) * eb[2], bf_hi(kv[3]) * eb[3]);
                    *(u32x4*)(rec + REC_KT + img128(dk, i8)) = o;
                } else if (r < 2048) {
                    const int i = (r - 1024) >> 4, k8 = (r & 15) * 8;
                    const u32x4 qv = *(const LAS u32x4*)(lds + R_QN + i * 272 + k8 * 2);
                    const float eg = G_E2[d * 64 + i];
                    u32x4 o;
#pragma unroll
                    for (int e = 0; e < 4; ++e) o[e] = pk_bf16(bf_lo(qv[e]) * eg, bf_hi(qv[e]) * eg);
                    *(u32x4*)(rec + REC_QD + img256(i, k8)) = o;
                } else {
                    const int i = (r - 2048) >> 3, j8 = (r & 7) * 8;
                    float v[8];
#pragma unroll
                    for (int e = 0; e < 8; ++e) { const int j = j8 + e; const bool ok = d ? (j >= i) : (j <= i); v[e] = ok ? QK[i * 65 + j] * __expf(gc[i] - gc[j]) : 0.f; }
                    u32x4 o; o[0] = pk_bf16(v[0], v[1]); o[1] = pk_bf16(v[2], v[3]); o[2] = pk_bf16(v[4], v[5]); o[3] = pk_bf16(v[6], v[7]);
                    *(u32x4*)(rec + REC_QK + img128(i, j8)) = o;
                }
            }
            if (wt < 2) { *(float*)(recd[wt] + REC_MISC) = __expf(G_TOT[wt]); *(int*)(recd[wt] + REC_MISC + 4) = rowbase + t0; }
        }
        __syncthreads();
        RELAUNDER();
        for (int idx = tid; idx < 4096; idx += NTHREADS) {
            const int d = idx >> 11, q = idx & 2047, i = q >> 5, j = (q & 31) * 2, i2 = d ? 63 - i : i, j2 = d ? 63 - j : j, j3 = d ? j2 - 1 : j2 + 1;
            const LAS float* TBd = (const LAS float*)(lds + (d ? R_MT1 : R_MT0));
            const LAS float* e2 = G_E2 + d * 64; const LAS float* bt = G_BT + d * 64;
            const float t0v = TBd[i2 * 68 + j2], t1v = TBd[i2 * 68 + j3];
            const float c0 = bt[j], c1 = bt[j + 1];
            LAS unsigned char* tw = lds + (d ? R_T1 : R_T0);
            *(LAS unsigned*)(tw + 8192 + imgT(i, j)) = pk_bf16(t0v * c0, t1v * c1);
            *(LAS unsigned*)(tw + imgT(i, j)) = pk_bf16(t0v * c0 * e2[j], t1v * c1 * e2[j + 1]);
        }
        __syncthreads();
        RELAUNDER();
        {
            const int d = wid >> 2;
            unsigned char* rec = d ? recd[1] : recd[0];
            const LAS unsigned char* tw = lds + (d ? R_T1 : R_T0);
#pragma unroll
            for (int hb = 0; hb < 2; ++hb) {
                const int blk = (wid & 3) * 2 + hb;
                bf16x8 ak[2], av[2];
#pragma unroll
                for (int kk = 0; kk < 2; ++kk) { const int so = (((kk * 4 + fq) ^ blk) & 7) << 4; ak[kk] = *(const LAS bf16x8*)(lds + R_KNT + (blk * 16 + fr) * 144 + so); av[kk] = *(const LAS bf16x8*)(lds + R_VT + (blk * 16 + fr) * 144 + so); }
#pragma unroll
                for (int ib = 0; ib < 4; ++ib) {
                    f32x4 aw = (f32x4){0.f, 0.f, 0.f, 0.f}, au = (f32x4){0.f, 0.f, 0.f, 0.f};
#pragma unroll
                    for (int kk = 0; kk < 2; ++kk) {
                        const bf16x8 twf = *(const LAS bf16x8*)(tw + imgT(ib * 16 + fr, kk * 32 + fq * 8)), tuf = *(const LAS bf16x8*)(tw + 8192 + imgT(ib * 16 + fr, kk * 32 + fq * 8));
                        aw = __builtin_amdgcn_mfma_f32_16x16x32_bf16(ak[kk], twf, aw, 0, 0, 0);
                        au = __builtin_amdgcn_mfma_f32_16x16x32_bf16(tuf, av[kk], au, 0, 0, 0);
                    }
                    u32x2 ow; ow[0] = pk_bf16(aw[0], aw[1]); ow[1] = pk_bf16(aw[2], aw[3]);
                    *(u32x2*)(rec + REC_W + img256(ib * 16 + fr, blk * 16 + fq * 4)) = ow;
                    u32x2 ou; ou[0] = pk_bf16(au[0], au[1]); ou[1] = pk_bf16(au[2], au[3]);
                    *(u32x2*)(rec + REC_UT + (blk * 16 + fr) * 128 + (ib * 16 + fq * 4) * 2) = ou;
                }
            }
        }
        __syncthreads();
    }
}
#undef RELAUNDER

__device__ __forceinline__ void phase_scan(const Params& p, const int l, LAS unsigned char* lds) {
    const int tid = opaque_tid(), wid = __builtin_amdgcn_readfirstlane(tid >> 6), lane = tid & 63, fr = lane & 15, fq = lane >> 4;
    constexpr int NSL = 2, DV = 128 / NSL, NBT = DV / 16;
    constexpr int UTB = DV * 128, MISC_O = 57344 + UTB, BUFB = MISC_O + 256, R_ST = 2 * BUFB, R_UTL = R_ST + DV * 272, R_DUM = R_UTL + DV * 144;
    static_assert(R_DUM + 8 * 256 <= LDS_WORK && NBT == 4, "scan LDS / tile assumptions");
    for (int id = blockIdx.x; id < 64 * NSL; id += gridDim.x) {
        const int bhd = (id & 7) * 8 + (id >> 4), sl = (id >> 3) & 1, h = (bhd >> 1) & 3, d = bhd & 1;
        bf16_t* O = (bf16_t*)(p.ws + (d ? WS_OB : WS_OF));
        const unsigned char* rec0 = p.ws + WS_SCN + (size_t)bhd * NCHUNK * REC_BYTES;
        __syncthreads();
        for (int i = tid; i < DV * 272 / 4; i += NTHREADS) ((LAS unsigned*)(lds + R_ST))[i] = 0u;
        f32x4 sacc[NBT];
#pragma unroll
        for (int n2 = 0; n2 < NBT; ++n2) sacc[n2] = (f32x4){0.f, 0.f, 0.f, 0.f};
#define S_ISSUE(n, bufo) do { const unsigned char* _r = rec0 + (size_t)(n) * REC_BYTES; \
        _Pragma("unroll") for (int _q = 0; _q < 7; ++_q) __builtin_amdgcn_global_load_lds((const unsigned*)(_r + lane * 16 + (wid + 8 * _q) * 1024), (LAS unsigned*)(lds + (bufo) + (wid + 8 * _q) * 1024), 16, 0, 0); \
        __builtin_amdgcn_global_load_lds((const unsigned*)(_r + lane * 16 + REC_UT + sl * UTB + wid * 1024), (LAS unsigned*)(lds + (bufo) + 57344 + wid * 1024), 16, 0, 0); \
        __builtin_amdgcn_global_load_lds((const unsigned*)(_r + REC_MISC + lane * 4), (LAS unsigned*)(lds + (bufo) + MISC_O), 4, 0, 0); } while (0)
#define S_TOUCH(n) do { const int _n = (n) < NCHUNK ? (n) : NCHUNK - 1; const int _ln = wid * 64 + lane; \
        const unsigned char* _t = rec0 + (size_t)_n * REC_BYTES + (_ln < 448 ? _ln * 128 : REC_UT + sl * UTB + (_ln - 448) * 128); \
        __builtin_amdgcn_global_load_lds((const unsigned*)_t, (LAS unsigned*)(lds + R_DUM + wid * 256), 4, 0, 0); } while (0)
        S_ISSUE(0, 0); S_TOUCH(1);
        const int ib = wid >> 1, nb0 = (wid & 1) * (NBT / 2);
        for (int n = 0; n < NCHUNK; ++n) {
            if (n == 0) asm volatile("s_waitcnt vmcnt(1)" ::: "memory"); else asm volatile("s_waitcnt vmcnt(3)" ::: "memory");
            asm volatile("s_waitcnt lgkmcnt(0)" ::: "memory");
            __builtin_amdgcn_s_barrier();
            LAS unsigned char* buf = lds + (n & 1) * BUFB;
            f32x4 accP[NBT / 2], accQ[NBT / 2];
#pragma unroll
            for (int t = 0; t < NBT / 2; ++t) { accP[t] = (f32x4){0.f, 0.f, 0.f, 0.f}; accQ[t] = (f32x4){0.f, 0.f, 0.f, 0.f}; }
            bf16x8 aw[4], aq[4], sb[NBT / 2][4];
#pragma unroll
            for (int kk = 0; kk < 4; ++kk) {
                aw[kk] = *(const LAS bf16x8*)(buf + REC_W + img256(ib * 16 + fr, kk * 32 + fq * 8));
                aq[kk] = *(const LAS bf16x8*)(buf + REC_QD + img256(ib * 16 + fr, kk * 32 + fq * 8));
#pragma unroll
                for (int t = 0; t < NBT / 2; ++t) sb[t][kk] = *(const LAS bf16x8*)(lds + R_ST + ((nb0 + t) * 16 + fr) * 272 + kk * 64 + fq * 16);
            }
            u32x2 uv[NBT / 2];
#pragma unroll
            for (int t = 0; t < NBT / 2; ++t) uv[t] = *(const LAS u32x2*)(buf + REC_UT + ((nb0 + t) * 16 + fr) * 128 + (ib * 16 + fq * 4) * 2);
            __builtin_amdgcn_sched_barrier(0);
#pragma unroll
            for (int kk = 0; kk < 4; ++kk)
#pragma unroll
                for (int t = 0; t < NBT / 2; ++t) accP[t] = __builtin_amdgcn_mfma_f32_16x16x32_bf16(aw[kk], sb[t][kk], accP[t], 0, 0, 0);
            if (n + 1 < NCHUNK) { if ((n + 1) & 1) S_ISSUE(n + 1, BUFB); else S_ISSUE(n + 1, 0); S_TOUCH(n + 2); }
            bf16x8 aqk[2], ak[2];
#pragma unroll
            for (int kk = 0; kk < 2; ++kk) { aqk[kk] = *(const LAS bf16x8*)(buf + REC_QK + img128(ib * 16 + fr, kk * 32 + fq * 8)); ak[kk] = *(const LAS bf16x8*)(buf + REC_KT + img128(wid * 16 + fr, kk * 32 + fq * 8)); }
            const float sd = *(const LAS float*)(buf + MISC_O); const int rowstart = *(const LAS int*)(buf + MISC_O + 4);
#pragma unroll
            for (int t = 0; t < NBT / 2; ++t) {
                u32x2 o; o[0] = pk_bf16(bf_lo(uv[t][0]) - accP[t][0], bf_hi(uv[t][0]) - accP[t][1]); o[1] = pk_bf16(bf_lo(uv[t][1]) - accP[t][2], bf_hi(uv[t][1]) - accP[t][3]);
                *(LAS u32x2*)(lds + R_UTL + ((nb0 + t) * 16 + fr) * 144 + (ib * 16 + fq * 4) * 2) = o;
            }
#pragma unroll
            for (int kk = 0; kk < 4; ++kk)
#pragma unroll
                for (int t = 0; t < NBT / 2; ++t) accQ[t] = __builtin_amdgcn_mfma_f32_16x16x32_bf16(sb[t][kk], aq[kk], accQ[t], 0, 0, 0);
            asm volatile("s_waitcnt lgkmcnt(0)" ::: "memory");
            __builtin_amdgcn_s_barrier();
            bf16x8 ub[NBT][2];
#pragma unroll
            for (int n2 = 0; n2 < NBT; ++n2)
#pragma unroll
                for (int kk = 0; kk < 2; ++kk) ub[n2][kk] = *(const LAS bf16x8*)(lds + R_UTL + (n2 * 16 + fr) * 144 + kk * 64 + fq * 16);
            bf16x8 un[NBT / 2][2];
#pragma unroll
            for (int t = 0; t < NBT / 2; ++t)
#pragma unroll
                for (int kk = 0; kk < 2; ++kk) un[t][kk] = *(const LAS bf16x8*)(lds + R_UTL + ((nb0 + t) * 16 + fr) * 144 + kk * 64 + fq * 16);
            __builtin_amdgcn_sched_barrier(0);
#pragma unroll
            for (int n2 = 0; n2 < NBT; ++n2) {
                sacc[n2] *= sd;
#pragma unroll
                for (int kk = 0; kk < 2; ++kk) sacc[n2] = __builtin_amdgcn_mfma_f32_16x16x32_bf16(ak[kk], ub[n2][kk], sacc[n2], 0, 0, 0);
            }
#pragma unroll
            for (int kk = 0; kk < 2; ++kk)
#pragma unroll
                for (int t = 0; t < NBT / 2; ++t) accQ[t] = __builtin_amdgcn_mfma_f32_16x16x32_bf16(un[t][kk], aqk[kk], accQ[t], 0, 0, 0);
#pragma unroll
            for (int n2 = 0; n2 < NBT; ++n2) {
                u32x2 o; o[0] = pk_bf16(sacc[n2][0], sacc[n2][1]); o[1] = pk_bf16(sacc[n2][2], sacc[n2][3]);
                *(LAS u32x2*)(lds + R_ST + (n2 * 16 + fr) * 272 + (wid * 16 + fq * 4) * 2) = o;
            }
#pragma unroll
            for (int t = 0; t < NBT / 2; ++t) {
                u32x2 o; o[0] = pk_bf16(accQ[t][0], accQ[t][1]); o[1] = pk_bf16(accQ[t][2], accQ[t][3]);
                *(u32x2*)(O + (size_t)(rowstart + ib * 16 + fr) * 512 + h * 128 + sl * DV + (nb0 + t) * 16 + fq * 4) = o;
            }
        }
#undef S_ISSUE
#undef S_TOUCH
        asm volatile("s_waitcnt vmcnt(0)" ::: "memory");
        __syncthreads();
    }
}

__device__ __forceinline__ void phase_scan_naive(const Params& p, const int l, LAS unsigned char* lds) {
    const int tid = opaque_tid();
    const int lane = tid & 63;
    LAS float* ks = (LAS float*)lds;
    LAS float* qs = ks + 4096;
    LAS float* vs = qs + 4096;
    LAS float* as = vs + 4096;
    LAS float* bs = as + 32;
    LAS int* rws = (LAS int*)(bs + 32);
    const float* QKV = (const float*)(p.ws + WS_QKV);
    const float* LOGA = (const float*)(p.ws + WS_LOGA);
    const float* BETA = (const float*)(p.ws + WS_BETA);
    for (int u = blockIdx.x; u < 64; u += gridDim.x) {
        const int b = u >> 3, h = (u >> 1) & 3, d = u & 1;
        float* O = (float*)(p.ws + (d ? WS_OB : WS_OF));
        const int col = tid >> 2, part = tid & 3;
        float S[32];
#pragma unroll
        for (int i = 0; i < 32; ++i) S[i] = 0.f;
        for (int n0 = 0; n0 < CTXL + SEQ; n0 += 32) {
            __syncthreads();
            if (tid < 32) {
                const int n = n0 + tid; int row;
                if (n < CTXL) row = ROWS_LAT + b * CTXL + (d ? CTXL - 1 - n : n);
                else { const int m = n - CTXL; row = b * SEQ + (d ? SEQ - 1 - m : m); }
                rws[tid] = row;
                as[tid] = __expf(LOGA[(size_t)row * 8 + d * 4 + h]);
                bs[tid] = BETA[(size_t)row * 8 + d * 4 + h];
            }
            __syncthreads();
            for (int i = tid; i < 4096; i += NTHREADS) {
                const int tok = i >> 7, cc = i & 127; const size_t base = (size_t)rws[tok] * 1536 + h * 128 + cc;
                qs[i] = QKV[base]; ks[i] = QKV[base + 512]; vs[i] = QKV[base + 1024];
            }
            __syncthreads();
            for (int tok = 0; tok < 32; ++tok) {
                float kk[32];
#pragma unroll
                for (int i = 0; i < 8; ++i) { const f32x4 v = *(const LAS f32x4*)(ks + tok * 128 + part * 32 + i * 4); kk[i * 4] = v[0]; kk[i * 4 + 1] = v[1]; kk[i * 4 + 2] = v[2]; kk[i * 4 + 3] = v[3]; }
                float kp = 0.f;
#pragma unroll
                for (int i = 0; i < 32; ++i) kp += kk[i] * S[i];
                kp += shx(kp, 1, lane); kp += shx(kp, 2, lane);
                const float a = as[tok], bt = bs[tok];
                const float bv = bt * (vs[tok * 128 + col] - a * kp);
#pragma unroll
                for (int i = 0; i < 32; ++i) S[i] = a * S[i] + kk[i] * bv;
                float op = 0.f;
#pragma unroll
                for (int i = 0; i < 8; ++i) { const f32x4 v = *(const LAS f32x4*)(qs + tok * 128 + part * 32 + i * 4); op += v[0] * S[i * 4] + v[1] * S[i * 4 + 1] + v[2] * S[i * 4 + 2] + v[3] * S[i * 4 + 3]; }
                op += shx(op, 1, lane); op += shx(op, 2, lane);
                if (part == 0) O[(size_t)rws[tok] * 512 + h * 128 + col] = op;
            }
        }
        __syncthreads();
    }
}

__device__ __forceinline__ void phase_onorm(const Params& p, const int l) {
    const int tid = opaque_tid(), wid = tid >> 6, lane = tid & 63;
    const unsigned char* OF = p.ws + WS_OF; const unsigned char* OB = p.ws + WS_OB;
    const bf16_t* PROJ = (const bf16_t*)(p.ws + WS_PROJ);
    bf16_t* CAT = (bf16_t*)(p.ws + WS_CAT);
    const int c = lane * 8;
    const f32x4 w0 = *(const f32x4*)(p.dn_norm + l * 128 + (c & 127)), w1 = *(const f32x4*)(p.dn_norm + l * 128 + (c & 127) + 4);
    const int nrows = (l == DEPTH - 1) ? ROWS_LAT : MT;
    for (int row = blockIdx.x * 8 + wid; row < nrows; row += gridDim.x * 8) {
        const size_t o = (size_t)row * 512 + c;
        f32x4 v0, v1;
        if (NAIVE_SCAN) { const float* F = (const float*)OF; const float* B = (const float*)OB;
            v0 = *(const f32x4*)(F + o) + *(const f32x4*)(B + o); v1 = *(const f32x4*)(F + o + 4) + *(const f32x4*)(B + o + 4); }
        else { const u32x4 a = *(const u32x4*)((const bf16_t*)OF + o), b = *(const u32x4*)((const bf16_t*)OB + o);
            v0 = (f32x4){bf_lo(a[0]) + bf_lo(b[0]), bf_hi(a[0]) + bf_hi(b[0]), bf_lo(a[1]) + bf_lo(b[1]), bf_hi(a[1]) + bf_hi(b[1])};
            v1 = (f32x4){bf_lo(a[2]) + bf_lo(b[2]), bf_hi(a[2]) + bf_hi(b[2]), bf_lo(a[3]) + bf_lo(b[3]), bf_hi(a[3]) + bf_hi(b[3])}; }
        float ss = v0[0] * v0[0] + v0[1] * v0[1] + v0[2] * v0[2] + v0[3] * v0[3] + v1[0] * v1[0] + v1[1] * v1[1] + v1[2] * v1[2] + v1[3] * v1[3];
        ss += shx(ss, 1, lane); ss += shx(ss, 2, lane); ss += shx(ss, 4, lane); ss += shx(ss, 8, lane);
        const float rs = rsqrtf(ss * (1.f / 128.f) + EPS);
        const u32x4 gv = *(const u32x4*)(PROJ + (size_t)row * PN + 1536 + c);
        u32x4 out;
        out[0] = pk_bf16(v0[0] * rs * w0[0] * silu_f(bf_lo(gv[0])), v0[1] * rs * w0[1] * silu_f(bf_hi(gv[0])));
        out[1] = pk_bf16(v0[2] * rs * w0[2] * silu_f(bf_lo(gv[1])), v0[3] * rs * w0[3] * silu_f(bf_hi(gv[1])));
        out[2] = pk_bf16(v1[0] * rs * w1[0] * silu_f(bf_lo(gv[2])), v1[1] * rs * w1[1] * silu_f(bf_hi(gv[2])));
        out[3] = pk_bf16(v1[2] * rs * w1[2] * silu_f(bf_lo(gv[3])), v1[3] * rs * w1[3] * silu_f(bf_hi(gv[3])));
        *(u32x4*)(CAT + (size_t)row * D + c) = out;
    }
}

__device__ __forceinline__ unsigned block_incl_scan(unsigned v, const int tid, LAS unsigned* wsum, unsigned& total) {
    const int lane = tid & 63, wv = tid >> 6;
#pragma unroll
    for (int o = 1; o < 64; o <<= 1) { const unsigned t = (unsigned)__builtin_amdgcn_ds_bpermute(((lane - o) & 63) << 2, (int)v); if (lane >= o) v += t; }
    if (lane == 63) wsum[wv] = v;
    __syncthreads();
    unsigned base = 0u, tot = 0u;
#pragma unroll
    for (int w = 0; w < 8; ++w) { const unsigned x = wsum[w]; tot += x; base += (w < wv) ? x : 0u; }
    total = tot;
    return v + base;
}

__device__ __forceinline__ void phase_topk(const Params& p, const int l, LAS unsigned char* lds) {
    const int tid = opaque_tid();
    LAS unsigned* hist = (LAS unsigned*)lds;
    LAS unsigned* wsum = hist + 4096;
    LAS unsigned* misc = wsum + 8;
    LAS unsigned long long* cand = (LAS unsigned long long*)(misc + 8);
    LAS unsigned char* selb = (LAS unsigned char*)(cand + 2048);
    const float* AFF = (const float*)(p.ws + WS_AFF);
    int* SEL = (int*)(p.ws + WS_SEL); float* SELAFF = (float*)(p.ws + WS_SELAFF); int* SLOTOF = (int*)(p.ws + WS_SLOTOF);
    const int ntk = (l == DEPTH - 1) ? 128 : 256;
    for (int u = blockIdx.x; u < ntk; u += gridDim.x) {
        int e, n, C, rowbase, slotbase;
        if (u < 128) { e = u >> 3; const int b = u & 7; n = SEQ; C = 256; rowbase = b * SEQ; slotbase = u * 256; }
        else { const int v = u - 128; e = v >> 3; const int b = v & 7; n = CTXL; C = 32; rowbase = ROWS_LAT + b * CTXL; slotbase = (128 + e) * 256 + b * 32; }
        unsigned kb[4];
#pragma unroll
        for (int k = 0; k < 4; ++k) { const int i = tid * 4 + k; kb[k] = (i < n) ? __float_as_uint(AFF[(size_t)(rowbase + i) * 16 + e]) : 0u; }
#pragma unroll
        for (int k = 0; k < 8; ++k) hist[tid * 8 + k] = 0u;
        if (tid == 0) misc[2] = 0u;
        __syncthreads();
#pragma unroll
        for (int k = 0; k < 4; ++k) if (tid * 4 + k < n) __hip_atomic_fetch_add(&hist[kb[k] >> 19], 1u, __ATOMIC_RELAXED, __HIP_MEMORY_SCOPE_WORKGROUP);
        __syncthreads();
        unsigned hl[8], s8 = 0u;
#pragma unroll
        for (int k = 0; k < 8; ++k) { hl[k] = hist[tid * 8 + k]; s8 += hl[k]; }
        unsigned total;
        const unsigned incl = block_incl_scan(s8, tid, wsum, total);
        unsigned cum = total - incl;
#pragma unroll
        for (int k = 7; k >= 0; --k) { if (cum < (unsigned)C && cum + hl[k] >= (unsigned)C) { misc[0] = (unsigned)(tid * 8 + k); misc[1] = cum; } cum += hl[k]; }
        __syncthreads();
        const unsigned thr = misc[0], G = misc[1], R = (unsigned)C - G;
#pragma unroll
        for (int k = 0; k < 4; ++k) { const int i = tid * 4 + k; if (i < n && (kb[k] >> 19) == thr) { const unsigned q = __hip_atomic_fetch_add(&misc[2], 1u, __ATOMIC_RELAXED, __HIP_MEMORY_SCOPE_WORKGROUP); cand[q] = ((unsigned long long)kb[k] << 32) | (unsigned long long)(0xFFFFFFFFu - (unsigned)i); } }
        __syncthreads();
        const unsigned E = misc[2];
        for (unsigned j = tid; j < E; j += NTHREADS) {
            const unsigned long long me = cand[j]; unsigned rank = 0u;
            for (unsigned k = 0; k < E; ++k) rank += (cand[k] > me) ? 1u : 0u;
            selb[0xFFFFFFFFu - (unsigned)(me & 0xFFFFFFFFull)] = (rank < R) ? 1 : 0;
        }
        __syncthreads();
        unsigned fl = 0u, cnt = 0u;
#pragma unroll
        for (int k = 0; k < 4; ++k) { const int i = tid * 4 + k; const unsigned bin = kb[k] >> 19;
            const bool in = (i < n) && (bin > thr || (bin == thr && selb[i] != 0)); fl |= in ? (1u << k) : 0u; cnt += in ? 1u : 0u; }
        unsigned tot2;
        unsigned pos = block_incl_scan(cnt, tid, wsum, tot2) - cnt;
#pragma unroll
        for (int k = 0; k < 4; ++k) { const int i = tid * 4 + k;
            if (i < n) { const bool in = (fl >> k) & 1u;
                SLOTOF[(size_t)(rowbase + i) * 16 + e] = in ? slotbase + (int)pos : -1;
                if (in) { SEL[slotbase + pos] = rowbase + i; SELAFF[slotbase + pos] = __uint_as_float(kb[k]); ++pos; } } }
        __syncthreads();
    }
}

#ifndef DUMP
#define DUMP 0
#endif
#if DUMP
__device__ __forceinline__ void phase_dump(const Params& p, const size_t off, const int is_bf16, const size_t n_avail) {
    const int tid = opaque_tid();
    const size_t n = (size_t)ROWS_LAT * D;
    for (size_t i = (size_t)blockIdx.x * NTHREADS + tid; i < n; i += (size_t)gridDim.x * NTHREADS) {
        float v = 0.f;
        if (i < n_avail) v = is_bf16 ? __uint_as_float((unsigned)((const bf16_t*)(p.ws + off))[i] << 16) : ((const float*)(p.ws + off))[i];
        p.out[i] = v;
    }
}
#endif

__global__ void __launch_bounds__(NTHREADS, 2) fwd(const Params p) {
    extern __shared__ __attribute__((aligned(16))) unsigned char smem[];
    LAS unsigned char* lds = (LAS unsigned char*)smem + LDS_OFF;
    XcdBarrier bar; bar.bar = (unsigned*)(p.ws + WS_BAR); bar.x = 0; bar.st = nullptr;
    const bool multi = (p.ph_hi - p.ph_lo) > 1;
    if (multi) {
        if (threadIdx.x == 0) *(LAS u32x4*)((LAS unsigned char*)smem) = (u32x4){0u, 0u, 0u, 0u};
        __syncthreads();
        bar = xcd_barrier_post((unsigned*)(p.ws + WS_BAR), (volatile LAS unsigned*)((LAS unsigned char*)smem));
    }
#if DUMP
    if (p.ph_lo == 100) { phase_dump(p, (size_t)(DUMP_OFF), DUMP_BF16, (size_t)(DUMP_N)); return; }
#endif
    int ph = 0;
#define PHASE(body) do { if (ph >= p.ph_lo && ph < p.ph_hi) { const int l = opaque_s(lv); body; if (ph + 1 < p.ph_hi) xcd_barrier(bar); } ++ph; } while (0)
    int lv = 0;
    PHASE(phase_prologue(p, lds));
    for (lv = 0; lv < DEPTH; ++lv) {
        PHASE(phase_norm<1>(p, l, lds));
        PHASE(GEMM8 ? phase_gemm8<0>(p, l, lds) : phase_gemm<0>(p, l, lds));
#if NAIVE_SCAN
        PHASE(phase_conv_pool(p, l, lds));
        PHASE(phase_scan_naive(p, l, lds));
#else
        PHASE(phase_prep(p, l, lds));
        PHASE(phase_scan(p, l, lds); phase_conv_pool(p, l, lds, (int)gridDim.x >= 256 ? 128 : 0, (int)gridDim.x >= 256 ? (int)gridDim.x - 128 : (int)gridDim.x));
#endif
        PHASE(phase_onorm(p, l));
        PHASE(GEMM8 ? phase_gemm8<1>(p, l, lds) : phase_gemm<1>(p, l, lds));
        PHASE(phase_norm<2>(p, l, lds));
        PHASE(phase_topk(p, l, lds));
        PHASE(GEMM8 ? phase_gemm8<2>(p, l, lds) : phase_gemm<2>(p, l, lds));
        PHASE(GEMM8 ? phase_gemm8<3>(p, l, lds) : phase_gemm<3>(p, l, lds));
    }
    lv = 0;
    PHASE(phase_norm<3>(p, l, lds));
#undef PHASE
}
constexpr int N_PHASES = 2 + DEPTH * 10;

extern "C" void kernel_launch(void* const* d_in, const int* in_sizes, int n_in, void* d_out, int out_size, void* d_ws, size_t ws_size, hipStream_t stream) {
    static int grid = 0;
    if (grid == 0) {
        if (n_in != 21 || out_size != ROWS_LAT * D || ws_size < WS_END) { fprintf(stderr, "kernel_launch: unexpected shapes (n_in %d out %d ws %zu need %zu)\n", n_in, out_size, ws_size, (size_t)WS_END); grid = -1; return; }
        int dev = 0, cus = 0, per_cu = 0;
        if (hipGetDevice(&dev) != hipSuccess || hipDeviceGetAttribute(&cus, hipDeviceAttributeMultiprocessorCount, dev) != hipSuccess) { grid = -1; return; }
        if (hipFuncSetAttribute((const void*)fwd, hipFuncAttributeMaxDynamicSharedMemorySize, LDS_BYTES) != hipSuccess) { fprintf(stderr, "kernel_launch: hipFuncSetAttribute failed\n"); grid = -1; return; }
        if (hipOccupancyMaxActiveBlocksPerMultiprocessor(&per_cu, (const void*)fwd, NTHREADS, LDS_BYTES) != hipSuccess || per_cu < 1) { fprintf(stderr, "kernel_launch: occupancy query says %d\n", per_cu); per_cu = 1; }
        (void)hipGetLastError();
        grid = cus;
    }
    if (grid < 0) return;
    (void)hipMemsetAsync((char*)d_ws + WS_BAR, 0, 16384, stream);
    Params p; memset(&p, 0, sizeof(p));
    const float** pp = (const float**)&p;
    for (int i = 0; i < 21; ++i) pp[i] = (const float*)d_in[i];
    p.out = (float*)d_out; p.ws = (unsigned char*)d_ws;
#if DUMP
    for (int ph = 0; ph <= DUMP_LAST; ++ph) { p.ph_lo = ph; p.ph_hi = ph + 1; hipLaunchKernelGGL(fwd, dim3(grid), dim3(NTHREADS), LDS_BYTES, stream, p); }
    p.ph_lo = 100; p.ph_hi = 101; hipLaunchKernelGGL(fwd, dim3(grid), dim3(NTHREADS), LDS_BYTES, stream, p);
#elif ONE_LAUNCH
    p.ph_lo = 0; p.ph_hi = N_PHASES;
    hipLaunchKernelGGL(fwd, dim3(grid), dim3(NTHREADS), LDS_BYTES, stream, p);
#else
    for (int ph = 0; ph < N_PHASES; ++ph) { p.ph_lo = ph; p.ph_hi = ph + 1; hipLaunchKernelGGL(fwd, dim3(grid), dim3(NTHREADS), LDS_BYTES, stream, p); }
#endif
}
```

```cpp
#include <hip/hip_runtime.h>
#include <stdint.h>
#include <stdio.h>
#include <string.h>

#ifndef ONE_LAUNCH
#define ONE_LAUNCH 1
#endif
#ifndef NAIVE_SCAN
#define NAIVE_SCAN 0
#endif
#ifndef GEMM8
#define GEMM8 1
#endif
#ifndef REGSTAGE
#define REGSTAGE 0
#endif

#define LAS __attribute__((address_space(3)))
typedef unsigned short bf16_t;
typedef short bf16x8 __attribute__((ext_vector_type(8)));
typedef float f32x4 __attribute__((ext_vector_type(4)));
typedef float f32x2 __attribute__((ext_vector_type(2)));
typedef unsigned u32x2 __attribute__((ext_vector_type(2)));
typedef unsigned u32x4 __attribute__((ext_vector_type(4)));

constexpr int D = 1024, NB = 8, SEQ = 2048, DEPTH = 4, CTXL = 256;
constexpr int ROWS_LAT = NB * SEQ;
constexpr int ROWS_CTX = NB * CTXL;
constexpr int MT = ROWS_LAT + ROWS_CTX;
constexpr int INC = 2576;
constexpr int PN = 2560;
constexpr int NE = 16;
constexpr int NGROUPS = 144;
constexpr int NSLOTS = NGROUPS * 256;
constexpr int NTHREADS = 512;
constexpr float EPS = 1e-6f;

constexpr size_t al256(size_t x) { return (x + 255) & ~(size_t)255; }
constexpr size_t WS_BAR = 0;
constexpr size_t WS_MOD = 16384;
constexpr size_t WS_X = WS_MOD + al256((size_t)DEPTH * 9 * 6144 * 4);
constexpr size_t WS_H = WS_X + (size_t)MT * D * 4;
constexpr size_t WS_PROJ = WS_H + (size_t)MT * D * 2;
constexpr size_t WS_YE = WS_PROJ;
constexpr size_t WS_LOGA = WS_PROJ + (size_t)MT * PN * 2;
constexpr size_t WS_BETA = WS_LOGA + (size_t)MT * 8 * 4;
constexpr size_t WS_QKV = WS_BETA + (size_t)MT * 8 * 4;
constexpr size_t WS_HID = WS_QKV;
constexpr size_t WS_OF = WS_QKV + (NAIVE_SCAN ? (size_t)MT * 1536 * 4 : (size_t)NSLOTS * D * 2);
constexpr size_t WS_OB = WS_OF + (size_t)MT * 512 * 4;
constexpr size_t WS_CAT = WS_OB + (size_t)MT * 512 * 4;
constexpr size_t WS_AFF = WS_CAT + (size_t)MT * D * 2;
constexpr size_t WS_SEL = WS_AFF + (size_t)MT * 16 * 4;
constexpr size_t WS_SELAFF = WS_SEL + (size_t)NSLOTS * 4;
constexpr size_t WS_SLOTOF = WS_SELAFF + (size_t)NSLOTS * 4;
constexpr size_t WS_WINT = WS_SLOTOF + (size_t)MT * 16 * 4;
constexpr size_t WS_WOUTT = WS_WINT + (size_t)DEPTH * PN * D * 2;
constexpr size_t WS_WGUT = WS_WOUTT + (size_t)DEPTH * D * D * 2;
constexpr size_t WS_WDT = WS_WGUT + (size_t)DEPTH * NE * 2048 * D * 2;
constexpr size_t WS_PWT = WS_WDT + (size_t)DEPTH * NE * D * D * 2;
constexpr size_t WS_W16T = WS_PWT + (size_t)DEPTH * 4 * 128 * 128 * 2;
constexpr size_t WS_SCN = WS_W16T + (size_t)DEPTH * 2 * 16 * D * 4;
constexpr int REC_W = 0, REC_KT = 16384, REC_QD = 32768, REC_QK = 49152, REC_UT = 57344, REC_MISC = 73728, REC_BYTES = 73984;
constexpr int NCHUNK = 36;
constexpr size_t WS_END = WS_SCN + (size_t)NB * 4 * 2 * NCHUNK * REC_BYTES + 4096;

constexpr int LDS_OFF = 1024;
constexpr int LDS_WORK = 161792;
constexpr int LDS_BYTES = LDS_OFF + LDS_WORK;

struct Params {
    const float *x, *c, *ctx, *c_ctx, *w_mod, *b_mod, *norm1, *norm2, *w_in, *conv_w, *a_log, *dt_bias, *dn_norm, *pool_w, *pool_scale, *w_out, *w_router, *w_gate, *w_up, *w_down, *norm_f;
    float* out;
    unsigned char* ws;
    int ph_lo, ph_hi;
};

#define XB_TMO      128
#define XB_XCNT(j)  (256  + 64 * (j))
#define XB_XSUB(j)  (1280 + 64 * (j))
#define XB_XGEN(j)  (2304 + 64 * (j))
#define XB_TOP      3328
#define XB_TOPGEN   3392
#define XCD_BAR_WORDS 3456
#define XB_SPIN_CAP (1u << 22)

__device__ __forceinline__ unsigned xb_ld(unsigned* p)              { return __hip_atomic_load(p, __ATOMIC_RELAXED, __HIP_MEMORY_SCOPE_AGENT); }
__device__ __forceinline__ unsigned xb_add(unsigned* p, unsigned v) { return __hip_atomic_fetch_add(p, v, __ATOMIC_RELAXED, __HIP_MEMORY_SCOPE_AGENT); }
__device__ __forceinline__ unsigned xb_xcc_id() { return (unsigned)__builtin_amdgcn_s_getreg((3 << 11) | 20) & 0xFu; }
#define XB_SPIN(cond, bar) do { unsigned _sp = 0; while (cond) { __builtin_amdgcn_s_sleep(1); \
    if ((++_sp & 255u) == 0u) { if (xb_ld(&(bar)[XB_TMO])) break; if (_sp > XB_SPIN_CAP) { atomicAdd(&(bar)[XB_TMO], 1u); break; } } } } while (0)

struct XcdBarrier { unsigned* bar; unsigned x; volatile LAS unsigned* st; };

__device__ __forceinline__ XcdBarrier xcd_barrier_post(unsigned* bar, volatile LAS unsigned* st) {
    XcdBarrier b; b.bar = bar; b.x = xb_xcc_id(); b.st = st;
    if (threadIdx.x == 0) (void)xb_add(&bar[XB_XCNT(b.x)], 1u);
    return b;
}
__device__ __forceinline__ void xcd_barrier_complete(unsigned* bar, unsigned x, unsigned& nloc, unsigned& nx) {
    const unsigned G = gridDim.x * gridDim.y * gridDim.z;
    unsigned sum, cnt, mine, sp = 0u;
    for (;;) {
        sum = 0u; cnt = 0u; mine = 0u;
#pragma unroll
        for (unsigned j = 0; j < 16; ++j) { const unsigned c = xb_ld(&bar[XB_XCNT(j)]); sum += c; cnt += (c > 0u) ? 1u : 0u; mine = (j == x) ? c : mine; }
        if (sum == G) break;
        __builtin_amdgcn_s_sleep(1);
        if ((++sp & 255u) == 0u) { if (xb_ld(&bar[XB_TMO])) break; if (sp > XB_SPIN_CAP) { atomicAdd(&bar[XB_TMO], 1u); break; } }
    }
    nloc = mine > 0u ? mine : 1u; nx = cnt > 0u ? cnt : 1u;
}
__device__ __forceinline__ void xcd_barrier(const XcdBarrier& b) {
    asm volatile("s_waitcnt vmcnt(0)" ::: "memory");
    __syncthreads();
    if (threadIdx.x == 0) {
        unsigned* bar = b.bar;
        __builtin_amdgcn_s_waitcnt(0);
        unsigned nloc = b.st[0], nx = b.st[1];
        if (nloc == 0u) { xcd_barrier_complete(bar, b.x, nloc, nx); b.st[0] = nloc; b.st[1] = nx; }
        const unsigned old = xb_add(&bar[XB_XSUB(b.x)], 1u);
        const unsigned gen = old / nloc;
        if (old + 1u == (gen + 1u) * nloc) {
            __builtin_amdgcn_fence(__ATOMIC_RELEASE, "agent");
            asm volatile("s_waitcnt vmcnt(0)" ::: "memory");
            const unsigned og = xb_add(&bar[XB_TOP], 1u);
            const unsigned tg = og / nx;
            if (og + 1u == (tg + 1u) * nx) xb_add(&bar[XB_TOPGEN], 1u);
            else XB_SPIN(xb_ld(&bar[XB_TOPGEN]) == tg, bar);
            __builtin_amdgcn_fence(__ATOMIC_ACQUIRE, "agent");
            xb_add(&bar[XB_XGEN(b.x)], 1u);
            asm volatile("s_waitcnt vmcnt(0)" ::: "memory");
        } else {
            XB_SPIN(xb_ld(&bar[XB_XGEN(b.x)]) == gen, bar);
            __builtin_amdgcn_fence(__ATOMIC_ACQUIRE, "agent");
            asm volatile("s_waitcnt vmcnt(0)" ::: "memory");
        }
    }
    __syncthreads();
}

typedef __bf16 bf16x2_t __attribute__((ext_vector_type(2)));
__device__ __forceinline__ unsigned pk_bf16(float lo, float hi) { const f32x2 v = {lo, hi}; const bf16x2_t b = __builtin_convertvector(v, bf16x2_t); return __builtin_bit_cast(unsigned, b); }
__device__ __forceinline__ float bf_lo(unsigned u) { return __uint_as_float(u << 16); }
__device__ __forceinline__ float bf_hi(unsigned u) { return __uint_as_float(u & 0xffff0000u); }
__device__ __forceinline__ float shx(float v, int mask, int lane) { return __int_as_float(__builtin_amdgcn_ds_bpermute((lane ^ mask) << 2, __float_as_int(v))); }
__device__ __forceinline__ float shup(float v, int o, int lane) { return __int_as_float(__builtin_amdgcn_ds_bpermute(((lane - o) & 63) << 2, __float_as_int(v))); }
__device__ __forceinline__ float wave_sum(float v, int lane) {
#pragma unroll
    for (int o = 32; o > 0; o >>= 1) v += shx(v, o, lane);
    return v;
}
__device__ __forceinline__ int opaque_tid() { int t = threadIdx.x; asm volatile("" : "+v"(t)); return t; }
__device__ __forceinline__ int opaque_s(int v) { asm volatile("" : "+s"(v)); return v; }
__device__ __forceinline__ float silu_f(float v) { return v * __builtin_amdgcn_rcpf(1.f + __expf(-v)); }

__device__ __forceinline__ int lds_byte(int r, int c) { const int st = (r >> 4) * 2 + (c >> 5), rr = r & 15, cc = c & 31, ob = rr * 64 + cc * 2; return st * 1024 + (ob ^ (((ob >> 9) & 1) << 5)); }
__device__ __forceinline__ void stage_rc(int b, int& R, int& C) { const int st = b >> 10, sb = b & 1023, swz = sb ^ (((sb >> 9) & 1) << 5); R = (st >> 1) * 16 + (swz >> 6); C = (st & 1) * 32 + ((swz & 63) >> 1); }

constexpr int T_IN = 10 * 16, T_OUT = 4 * 16, T_EXP = NE * 4 * 16, T_LAYER = T_IN + T_OUT + 3 * T_EXP;
__device__ __forceinline__ void convert_tiles(const Params& p, const int l, const int first, const int count, const int f, const int nf, LAS unsigned char* lds) {
    const int tid = opaque_tid();
    bf16_t* WINT = (bf16_t*)(p.ws + WS_WINT); bf16_t* WOUTT = (bf16_t*)(p.ws + WS_WOUTT); bf16_t* WGUT = (bf16_t*)(p.ws + WS_WGUT); bf16_t* WDT = (bf16_t*)(p.ws + WS_WDT);
    const int lane = tid & 63, wv = tid >> 6, ko = lane & 7, nq = wv * 8 + (lane >> 3);
    f32x4 rv[8]; const float* src = nullptr; size_t sld = 0;
#define CT_DECODE(t, SRC, SLD, DST, RS) do { int i = (t); RS = 16; \
        if (i < T_IN) { const int nt = i >> 4, kt = i & 15; const int n0 = nt < 6 ? nt * 256 : 1552 + (nt - 6) * 256; \
            SRC = p.w_in + ((size_t)l * D + kt * 64) * INC + n0; SLD = INC; DST = WINT + ((size_t)l * PN + nt * 256) * D + kt * 64; } \
        else if (i < T_IN + T_OUT) { i -= T_IN; const int nt = i >> 4, kt = i & 15; \
            SRC = p.w_out + ((size_t)l * D + kt * 64) * D + nt * 256; SLD = D; DST = WOUTT + ((size_t)l * D + nt * 256) * D + kt * 64; } \
        else { i -= T_IN + T_OUT; const int which = i / T_EXP; i %= T_EXP; const int e = i >> 6, nt = (i >> 4) & 3, kt = i & 15; \
            const size_t mo = ((size_t)(l * NE + e) * D + kt * 64) * D + nt * 256; \
            if (which == 2) { SRC = p.w_down + mo; DST = WDT + ((size_t)(l * NE + e) * D + nt * 256) * D + kt * 64; } \
            else { SRC = (which == 0 ? p.w_gate : p.w_up) + mo; RS = 32; DST = WGUT + ((size_t)(l * NE + e) * 2048 + nt * 512 + which * 16) * D + kt * 64; } \
            SLD = D; } } while (0)
#define CT_LOAD() do { _Pragma("unroll") for (int j = 0; j < 8; ++j) rv[j] = *(const f32x4*)(src + (size_t)(ko * 8 + j) * sld + nq * 4); } while (0)
    bf16_t* dst = nullptr; int rs = 16;
    int t = first + f;
    if (t < first + count) { CT_DECODE(t, src, sld, dst, rs); CT_LOAD(); }
    for (; t < first + count; t += nf) {
        u32x4 o[4];
#pragma unroll
        for (int e = 0; e < 4; ++e) { o[e][0] = pk_bf16(rv[0][e], rv[1][e]); o[e][1] = pk_bf16(rv[2][e], rv[3][e]); o[e][2] = pk_bf16(rv[4][e], rv[5][e]); o[e][3] = pk_bf16(rv[6][e], rv[7][e]); }
        bf16_t* dcur = dst; const int rcur = rs;
        if (t + nf < first + count) { CT_DECODE(t + nf, src, sld, dst, rs); CT_LOAD(); }
#pragma unroll
        for (int e = 0; e < 4; ++e) { const int n = nq * 4 + e; *(u32x4*)(dcur + (size_t)((n >> 4) * rcur + (n & 15)) * D + ko * 8) = o[e]; }
    }
#undef CT_DECODE
#undef CT_LOAD
}

__device__ __forceinline__ void phase_prologue(const Params& p, LAS unsigned char* lds) {
    const int tid = opaque_tid();
    {
        LAS float* sc = (LAS float*)lds;
        LAS float* red = sc + 9 * 1024;
        for (int idx = tid; idx < 9 * 1024; idx += NTHREADS) {
            const int r = idx >> 10, k = idx & 1023;
            const float v = r < 8 ? p.c[r * 1024 + k] : p.c_ctx[k];
            sc[idx] = silu_f(v);
        }
        __syncthreads();
        float* MOD = (float*)(p.ws + WS_MOD);
        for (int u = blockIdx.x; u < DEPTH * 192; u += gridDim.x) {
            const int l = u / 192, c0 = (u % 192) * 32, col = tid & 31, kg = tid >> 5;
            float acc[9];
#pragma unroll
            for (int r = 0; r < 9; ++r) acc[r] = 0.f;
            const float* W = p.w_mod + ((size_t)l * 1024 + kg * 64) * 6144 + c0 + col;
            for (int k0 = 0; k0 < 64; k0 += 8) {
                float w[8];
#pragma unroll
                for (int j = 0; j < 8; ++j) w[j] = W[(size_t)(k0 + j) * 6144];
#pragma unroll
                for (int r = 0; r < 9; ++r) {
                    const f32x4 s0 = *(const LAS f32x4*)(sc + r * 1024 + kg * 64 + k0), s1 = *(const LAS f32x4*)(sc + r * 1024 + kg * 64 + k0 + 4);
                    acc[r] += s0[0] * w[0] + s0[1] * w[1] + s0[2] * w[2] + s0[3] * w[3] + s1[0] * w[4] + s1[1] * w[5] + s1[2] * w[6] + s1[3] * w[7];
                }
            }
#pragma unroll
            for (int r = 0; r < 9; ++r) red[(kg * 9 + r) * 32 + col] = acc[r];
            __syncthreads();
            if (tid < 288) {
                const int r = tid >> 5, cc = tid & 31;
                float sv = 0.f;
#pragma unroll
                for (int g = 0; g < 16; ++g) sv += red[(g * 9 + r) * 32 + cc];
                MOD[((size_t)l * 9 + r) * 6144 + c0 + cc] = sv + p.b_mod[l * 6144 + c0 + cc];
            }
            __syncthreads();
        }
    }
    {
        convert_tiles(p, 0, 0, T_LAYER, (int)blockIdx.x, (int)gridDim.x, lds);
        {
            float* W16T = (float*)(p.ws + WS_W16T);
            for (int i = blockIdx.x * NTHREADS + tid; i < DEPTH * 2 * 16 * D; i += gridDim.x * NTHREADS) {
                const int l2 = i >> 15, wh = (i >> 14) & 1, j = (i >> 10) & 15, k = i & 1023;
                W16T[i] = wh ? p.w_router[((size_t)l2 * D + k) * NE + j] : p.w_in[((size_t)l2 * D + k) * INC + 1536 + j];
            }
        }
        bf16_t* PWT = (bf16_t*)(p.ws + WS_PWT);
        for (int i = blockIdx.x * NTHREADS + tid; i < DEPTH * 4 * 128 * 128; i += gridDim.x * NTHREADS) {
            const int lg = i >> 14, d = (i >> 7) & 127, c = i & 127;
            PWT[i] = (bf16_t)(pk_bf16(p.pool_w[((size_t)lg * 128 + c) * 128 + d], 0.f) & 0xffffu);
        }
    }
}

__device__ __forceinline__ float reduce4(const float v0, const float v1, const float v2, const float v3, const int lane) {
    const bool b5 = lane & 32, b4 = lane & 16;
    const float a0 = (b5 ? v2 : v0) + shx(b5 ? v0 : v2, 32, lane), a1 = (b5 ? v3 : v1) + shx(b5 ? v1 : v3, 32, lane);
    float c = (b4 ? a1 : a0) + shx(b4 ? a0 : a1, 16, lane);
    c += shx(c, 8, lane); c += shx(c, 4, lane); c += shx(c, 2, lane); c += shx(c, 1, lane);
    return c;
}

template <int WHICH>
__device__ __forceinline__ void phase_norm(const Params& p, const int l, LAS unsigned char* lds) {
    const int tid = opaque_tid(), wid = tid >> 6, lane = tid & 63;
    LAS float* wsm = (LAS float*)lds;
    if (WHICH != 3) {
        const f32x4* src = (const f32x4*)(p.ws + WS_W16T) + (size_t)(l * 2 + (WHICH == 2 ? 1 : 0)) * 4096;
        f32x4 fv[8];
#pragma unroll
        for (int i = 0; i < 8; ++i) fv[i] = src[tid + i * NTHREADS];
#pragma unroll
        for (int i = 0; i < 8; ++i) *(LAS f32x4*)(wsm + (tid + i * NTHREADS) * 4) = fv[i];
        {
            const float* nwp = WHICH == 1 ? p.norm1 + l * D : p.norm2 + l * D;
            const float* mdp = (const float*)(p.ws + WS_MOD) + (size_t)l * 9 * 6144 + (WHICH == 1 ? 0 : 3072);
            for (int idx = tid; idx < 9 * 256; idx += NTHREADS) {
                const int sm = idx >> 8, c = (idx & 255) * 4;
                const f32x4 w = *(const f32x4*)(nwp + c), sh = *(const f32x4*)(mdp + (size_t)sm * 6144 + c), scl = *(const f32x4*)(mdp + (size_t)sm * 6144 + 1024 + c);
                *(LAS f32x4*)(wsm + 16384 + sm * 1024 + c) = w * (scl + 1.f);
                *(LAS f32x4*)(wsm + 16384 + 9216 + sm * 1024 + c) = sh;
            }
        }
        __syncthreads();
    }
    const float* nw = WHICH == 1 ? p.norm1 + l * D : (WHICH == 2 ? p.norm2 + l * D : p.norm_f);
    float* X = (float*)(p.ws + WS_X);
    const float* MOD = (const float*)(p.ws + WS_MOD);
    bf16_t* H = (bf16_t*)(p.ws + WS_H);
    const int nrows = (WHICH == 3 || (WHICH == 2 && l == DEPTH - 1)) ? ROWS_LAT : MT;
    constexpr int R = 3;
    const int rstride = gridDim.x * 8;
    const bool comb = (WHICH == 1 && l > 0) || WHICH == 3;
    const bool first_layer = (WHICH == 1 && l == 0);
    f32x4 xn[R][4]; int svn[R];
#define NORM_LOAD(b0) do { _Pragma("unroll") for (int k = 0; k < R; ++k) { const int row = (b0) + k * rstride; svn[k] = -1; \
        if (row < nrows) { const float* xr = first_layer ? (row < ROWS_LAT ? p.x + (size_t)row * D : p.ctx + (size_t)(row - ROWS_LAT) * D) : X + (size_t)row * D; \
            _Pragma("unroll") for (int i = 0; i < 4; ++i) xn[k][i] = *(const f32x4*)(xr + i * 256 + lane * 4); \
            if (comb && lane < 16) svn[k] = ((const int*)(p.ws + WS_SLOTOF))[(size_t)row * 16 + lane]; } \
        else { _Pragma("unroll") for (int i = 0; i < 4; ++i) xn[k][i] = (f32x4){0.f, 0.f, 0.f, 0.f}; } } } while (0)
    NORM_LOAD(blockIdx.x * 8 + wid);
    for (int base = blockIdx.x * 8 + wid; base < nrows; base += rstride * R) {
        f32x4 xv[R][4]; int sv[R]; bool ok[R];
#pragma unroll
        for (int k = 0; k < R; ++k) { ok[k] = (base + k * rstride) < nrows; sv[k] = svn[k];
#pragma unroll
            for (int i = 0; i < 4; ++i) xv[k][i] = xn[k][i]; }
        if (first_layer) {
#pragma unroll
            for (int k = 0; k < R; ++k) if (ok[k]) {
#pragma unroll
                for (int i = 0; i < 4; ++i) *(f32x4*)(X + (size_t)(base + k * rstride) * D + i * 256 + lane * 4) = xv[k][i]; }
        }
        if (comb) {
            const bf16_t* YE = (const bf16_t*)(p.ws + WS_YE);
            f32x4 a[R][4]; unsigned long long msk[R];
#pragma unroll
            for (int k = 0; k < R; ++k) { msk[k] = __ballot(sv[k] >= 0);
#pragma unroll
                for (int i = 0; i < 4; ++i) a[k][i] = (f32x4){0.f, 0.f, 0.f, 0.f}; }
            while (msk[0] | msk[1] | msk[2]) {
                u32x2 t[R][2][4]; bool has[R][2];
#pragma unroll
                for (int k = 0; k < R; ++k)
#pragma unroll
                    for (int q = 0; q < 2; ++q) {
                        has[k][q] = msk[k] != 0ull;
                        if (has[k][q]) {
                            const int e = __builtin_ctzll(msk[k]); msk[k] &= msk[k] - 1ull;
                            const int sl = __builtin_amdgcn_readlane(sv[k], e);
                            const bf16_t* yr = YE + (size_t)sl * D;
#pragma unroll
                            for (int i = 0; i < 4; ++i) t[k][q][i] = *(const u32x2*)(yr + i * 256 + lane * 4);
                        }
                    }
#pragma unroll
                for (int k = 0; k < R; ++k)
#pragma unroll
                    for (int q = 0; q < 2; ++q) if (has[k][q]) {
#pragma unroll
                        for (int i = 0; i < 4; ++i) { a[k][i][0] += bf_lo(t[k][q][i][0]); a[k][i][1] += bf_hi(t[k][q][i][0]); a[k][i][2] += bf_lo(t[k][q][i][1]); a[k][i][3] += bf_hi(t[k][q][i][1]); }
                    }
            }
#pragma unroll
            for (int k = 0; k < R; ++k) if (ok[k]) {
                const int row = base + k * rstride;
#pragma unroll
                for (int i = 0; i < 4; ++i) { xv[k][i] += a[k][i];
                    if (WHICH == 1) *(f32x4*)(X + (size_t)row * D + i * 256 + lane * 4) = xv[k][i]; }
            }
        }
        float rstd[R];
#pragma unroll
        for (int k = 0; k < R; ++k) {
            float ss = 0.f;
#pragma unroll
            for (int i = 0; i < 4; ++i) ss += xv[k][i][0] * xv[k][i][0] + xv[k][i][1] * xv[k][i][1] + xv[k][i][2] * xv[k][i][2] + xv[k][i][3] * xv[k][i][3];
            rstd[k] = rsqrtf(wave_sum(ss, lane) * (1.f / 1024.f) + EPS);
        }
        if (WHICH == 3) {
            if (base + rstride * R < nrows) NORM_LOAD(base + rstride * R);
#pragma unroll
            for (int k = 0; k < R; ++k) if (ok[k]) {
                const int row = base + k * rstride;
#pragma unroll
                for (int i = 0; i < 4; ++i) { const f32x4 w = *(const f32x4*)(nw + i * 256 + lane * 4); *(f32x4*)(p.out + (size_t)row * D + i * 256 + lane * 4) = xv[k][i] * rstd[k] * w; }
            }
            continue;
        }
#pragma unroll
        for (int k = 0; k < R; ++k) {
            const int row = base + k * rstride, bidx = row < ROWS_LAT ? (row >> 11) : 8;
#pragma unroll
            for (int i = 0; i < 4; ++i) {
                const int c = i * 256 + lane * 4;
                const f32x4 av = *(const LAS f32x4*)(wsm + 16384 + bidx * 1024 + c), sh = *(const LAS f32x4*)(wsm + 16384 + 9216 + bidx * 1024 + c);
                xv[k][i] = (xv[k][i] * rstd[k]) * av + sh;
                if (ok[k]) { u32x2 o; o[0] = pk_bf16(xv[k][i][0], xv[k][i][1]); o[1] = pk_bf16(xv[k][i][2], xv[k][i][3]); *(u32x2*)(H + (size_t)row * D + c) = o; }
            }
        }
        if (base + rstride * R < nrows) NORM_LOAD(base + rstride * R);
        float dj[R][4];
#pragma unroll
        for (int jg = 0; jg < 4; ++jg) {
            float sp[R][4];
#pragma unroll
            for (int jj = 0; jj < 4; ++jj) {
                const int j = jg * 4 + jj;
                f32x2 s0 = {0.f, 0.f}, s1 = {0.f, 0.f}, s2 = {0.f, 0.f};
#pragma unroll
                for (int i = 0; i < 4; ++i) { const f32x4 w = *(const LAS f32x4*)(wsm + j * 1024 + i * 256 + lane * 4);
                    const f32x2 wl = {w[0], w[1]}, wh = {w[2], w[3]};
                    s0 += (f32x2){xv[0][i][0], xv[0][i][1]} * wl; s0 += (f32x2){xv[0][i][2], xv[0][i][3]} * wh;
                    s1 += (f32x2){xv[1][i][0], xv[1][i][1]} * wl; s1 += (f32x2){xv[1][i][2], xv[1][i][3]} * wh;
                    s2 += (f32x2){xv[2][i][0], xv[2][i][1]} * wl; s2 += (f32x2){xv[2][i][2], xv[2][i][3]} * wh; }
                sp[0][jj] = s0[0] + s0[1]; sp[1][jj] = s1[0] + s1[1]; sp[2][jj] = s2[0] + s2[1];
            }
#pragma unroll
            for (int k = 0; k < R; ++k) dj[k][jg] = reduce4(sp[k][0], sp[k][1], sp[k][2], sp[k][3], lane);
            __builtin_amdgcn_sched_barrier(0);
        }
        const int q = lane >> 4;
#pragma unroll
        for (int k = 0; k < R; ++k) {
            const int row = base + k * rstride;
            if (WHICH == 1) {
                if (ok[k] && (lane & 15) == 0) {
#pragma unroll
                    for (int jg = 0; jg < 4; ++jg) {
                        const int j = jg * 4 + q; const float v = dj[k][jg];
                        if (jg < 2) { const float xa = v + p.dt_bias[l * 8 + j]; const float sp2 = xa > 20.f ? xa : log1pf(__expf(xa));
                            ((float*)(p.ws + WS_LOGA))[(size_t)row * 8 + j] = -__expf(p.a_log[l * 8 + j]) * sp2; }
                        else ((float*)(p.ws + WS_BETA))[(size_t)row * 8 + (j - 8)] = 1.f / (1.f + __expf(-v));
                    }
                }
            } else {
                float m = fmaxf(fmaxf(dj[k][0], dj[k][1]), fmaxf(dj[k][2], dj[k][3]));
                m = fmaxf(m, shx(m, 16, lane)); m = fmaxf(m, shx(m, 32, lane));
                float e[4], sum = 0.f;
#pragma unroll
                for (int jg = 0; jg < 4; ++jg) { e[jg] = __expf(dj[k][jg] - m); sum += e[jg]; }
                sum += shx(sum, 16, lane); sum += shx(sum, 32, lane);
                const float inv = 1.f / sum;
                if (ok[k] && (lane & 15) == 0) {
#pragma unroll
                    for (int jg = 0; jg < 4; ++jg) ((float*)(p.ws + WS_AFF))[(size_t)row * 16 + jg * 4 + q] = e[jg] * inv;
                }
            }
        }
    }
}

#undef NORM_LOAD
__device__ __forceinline__ void gemm_core(const unsigned char* Ab, const unsigned (&aoff)[4], const unsigned char* Bb, const unsigned (&boff)[2], const int nt,
                                          LAS unsigned char* lds, f32x4 (&acc)[4][4], const int wid, const int lane) {
    const int wr = wid >> 1, wc = wid & 1, fr = lane & 15, fq = lane >> 4;
    const int ar = lds_byte(wr * 64 + fr, fq * 8), br = lds_byte(wc * 64 + fr, fq * 8);
    const unsigned ldsw = (unsigned)wid * 1024u;
#define G_STAGE(t, buf) do { const unsigned _ko = (unsigned)(t) * 128u; \
        _Pragma("unroll") for (int _i = 0; _i < 4; ++_i) __builtin_amdgcn_global_load_lds((const unsigned*)(Ab + aoff[_i] + _ko), (LAS unsigned*)(lds + (buf) * 49152 + ldsw + _i * 8192), 16, 0, 0); \
        _Pragma("unroll") for (int _i = 0; _i < 2; ++_i) __builtin_amdgcn_global_load_lds((const unsigned*)(Bb + boff[_i] + _ko), (LAS unsigned*)(lds + (buf) * 49152 + 32768 + ldsw + _i * 8192), 16, 0, 0); } while (0)
#pragma unroll
    for (int m = 0; m < 4; ++m)
#pragma unroll
        for (int n = 0; n < 4; ++n) acc[m][n] = (f32x4){0.f, 0.f, 0.f, 0.f};
#if REGSTAGE
    u32x4 ra[4], rb[2];
#pragma unroll
    for (int i = 0; i < 4; ++i) ra[i] = *(const u32x4*)(Ab + aoff[i]);
#pragma unroll
    for (int i = 0; i < 2; ++i) rb[i] = *(const u32x4*)(Bb + boff[i]);
    const unsigned tb = (unsigned)(wid * 64 + lane) * 16u;
    for (int t = 0; t < nt; ++t) {
        __syncthreads();
#pragma unroll
        for (int i = 0; i < 4; ++i) *(LAS u32x4*)(lds + tb + i * 8192) = ra[i];
#pragma unroll
        for (int i = 0; i < 2; ++i) *(LAS u32x4*)(lds + 32768 + tb + i * 8192) = rb[i];
        __syncthreads();
        if (t + 1 < nt) {
            const unsigned ko = (unsigned)(t + 1) * 128u;
#pragma unroll
            for (int i = 0; i < 4; ++i) ra[i] = *(const u32x4*)(Ab + aoff[i] + ko);
#pragma unroll
            for (int i = 0; i < 2; ++i) rb[i] = *(const u32x4*)(Bb + boff[i] + ko);
        }
        LAS unsigned char* bA = lds; LAS unsigned char* bB = bA + 32768;
        bf16x8 af[4][2], bfr[4][2];
#pragma unroll
        for (int m = 0; m < 4; ++m)
#pragma unroll
            for (int k = 0; k < 2; ++k) af[m][k] = *(const LAS bf16x8*)(bA + ar + m * 2048 + k * 1024);
#pragma unroll
        for (int n = 0; n < 4; ++n)
#pragma unroll
            for (int k = 0; k < 2; ++k) bfr[n][k] = *(const LAS bf16x8*)(bB + br + n * 2048 + k * 1024);
#pragma unroll
        for (int k = 0; k < 2; ++k)
#pragma unroll
            for (int m = 0; m < 4; ++m)
#pragma unroll
                for (int n = 0; n < 4; ++n) acc[m][n] = __builtin_amdgcn_mfma_f32_16x16x32_bf16(bfr[n][k], af[m][k], acc[m][n], 0, 0, 0);
    }
#else
    G_STAGE(0, 0);
    for (int t = 0; t < nt; ++t) {
        asm volatile("s_waitcnt vmcnt(0)" ::: "memory");
        __syncthreads();
        if (t + 1 < nt) { if ((t + 1) & 1) G_STAGE(t + 1, 1); else G_STAGE(t + 1, 0); }
        LAS unsigned char* bA = lds + (t & 1) * 49152; LAS unsigned char* bB = bA + 32768;
        bf16x8 af[4][2], bfr[4][2];
#pragma unroll
        for (int m = 0; m < 4; ++m)
#pragma unroll
            for (int k = 0; k < 2; ++k) af[m][k] = *(const LAS bf16x8*)(bA + ar + m * 2048 + k * 1024);
#pragma unroll
        for (int n = 0; n < 4; ++n)
#pragma unroll
            for (int k = 0; k < 2; ++k) bfr[n][k] = *(const LAS bf16x8*)(bB + br + n * 2048 + k * 1024);
#pragma unroll
        for (int k = 0; k < 2; ++k)
#pragma unroll
            for (int m = 0; m < 4; ++m)
#pragma unroll
                for (int n = 0; n < 4; ++n) acc[m][n] = __builtin_amdgcn_mfma_f32_16x16x32_bf16(bfr[n][k], af[m][k], acc[m][n], 0, 0, 0);
    }
#endif
    __syncthreads();
#undef G_STAGE
}

template <int MODE>
__device__ __forceinline__ void phase_gemm(const Params& p, const int l, LAS unsigned char* lds) {
    const int tid = opaque_tid(), wid = __builtin_amdgcn_readfirstlane(tid >> 6), lane = tid & 63;
    const int wr = wid >> 1, wc = wid & 1, fr = lane & 15, fq = lane >> 4;
    int R0, C0; stage_rc(tid * 16, R0, C0);
    constexpr int nN = MODE == 0 ? 20 : (MODE == 1 ? 8 : (MODE == 2 ? 16 : 8));
    constexpr int nM = (MODE <= 1) ? MT / 256 : NGROUPS;
    const bf16_t* H = (const bf16_t*)(p.ws + WS_H);
    for (int u = blockIdx.x; u < nM * nN; u += gridDim.x) {
        const int pm = u / nN, pn = u % nN;
        const unsigned char* Ab; const unsigned char* Bb; unsigned aoff[4], boff[2];
#pragma unroll
        for (int i = 0; i < 2; ++i) boff[i] = (unsigned)((R0 + 64 * i) * D + C0) * 2u;
        int e = 0;
        if (MODE == 0) {
            Ab = (const unsigned char*)(H + (size_t)pm * 256 * D); Bb = (const unsigned char*)((const bf16_t*)(p.ws + WS_WINT) + ((size_t)l * PN + pn * 128) * D);
#pragma unroll
            for (int i = 0; i < 4; ++i) aoff[i] = (unsigned)((R0 + 64 * i) * D + C0) * 2u;
        } else if (MODE == 1) {
            Ab = (const unsigned char*)((const bf16_t*)(p.ws + WS_CAT) + (size_t)pm * 256 * D); Bb = (const unsigned char*)((const bf16_t*)(p.ws + WS_WOUTT) + ((size_t)l * D + pn * 128) * D);
#pragma unroll
            for (int i = 0; i < 4; ++i) aoff[i] = (unsigned)((R0 + 64 * i) * D + C0) * 2u;
        } else if (MODE == 2) {
            e = pm < 128 ? (pm >> 3) : (pm - 128);
            const int* SEL = (const int*)(p.ws + WS_SEL) + pm * 256;
            Ab = (const unsigned char*)H; Bb = (const unsigned char*)((const bf16_t*)(p.ws + WS_WGUT) + ((size_t)(l * NE + e) * 2048 + pn * 128) * D);
#pragma unroll
            for (int i = 0; i < 4; ++i) aoff[i] = (unsigned)(SEL[R0 + 64 * i] * D + C0) * 2u;
        } else {
            e = pm < 128 ? (pm >> 3) : (pm - 128);
            Ab = (const unsigned char*)((const bf16_t*)(p.ws + WS_HID) + (size_t)pm * 256 * D); Bb = (const unsigned char*)((const bf16_t*)(p.ws + WS_WDT) + ((size_t)(l * NE + e) * D + pn * 128) * D);
#pragma unroll
            for (int i = 0; i < 4; ++i) aoff[i] = (unsigned)((R0 + 64 * i) * D + C0) * 2u;
        }
        f32x4 acc[4][4];
        gemm_core(Ab, aoff, Bb, boff, D / 64, lds, acc, wid, lane);
        if (MODE == 0) {
            bf16_t* PROJ = (bf16_t*)(p.ws + WS_PROJ);
#pragma unroll
            for (int m = 0; m < 4; ++m) { const size_t row = (size_t)pm * 256 + wr * 64 + m * 16 + fr;
#pragma unroll
                for (int n = 0; n < 4; ++n) { u32x2 o; o[0] = pk_bf16(acc[m][n][0], acc[m][n][1]); o[1] = pk_bf16(acc[m][n][2], acc[m][n][3]);
                    *(u32x2*)(PROJ + row * PN + pn * 128 + wc * 64 + n * 16 + fq * 4) = o; } }
        } else if (MODE == 1) {
            float* X = (float*)(p.ws + WS_X);
            const int bidx = pm < 64 ? (pm >> 3) : 8;
            const float* g1 = (const float*)(p.ws + WS_MOD) + ((size_t)l * 9 + bidx) * 6144 + 2048;
#pragma unroll
            for (int n = 0; n < 4; ++n) { const int col = pn * 128 + wc * 64 + n * 16 + fq * 4; const f32x4 g = *(const f32x4*)(g1 + col);
#pragma unroll
                for (int m = 0; m < 4; ++m) { float* xp = X + ((size_t)pm * 256 + wr * 64 + m * 16 + fr) * D + col; *(f32x4*)xp = *(const f32x4*)xp + g * acc[m][n]; } }
        } else if (MODE == 2) {
            bf16_t* HID = (bf16_t*)(p.ws + WS_HID);
#pragma unroll
            for (int m = 0; m < 4; ++m) { const size_t slot = (size_t)pm * 256 + wr * 64 + m * 16 + fr;
#pragma unroll
                for (int q = 0; q < 2; ++q) { const f32x4 g = acc[m][2 * q], uu = acc[m][2 * q + 1];
                    u32x2 o; o[0] = pk_bf16(silu_f(g[0]) * uu[0], silu_f(g[1]) * uu[1]); o[1] = pk_bf16(silu_f(g[2]) * uu[2], silu_f(g[3]) * uu[3]);
                    *(u32x2*)(HID + slot * D + pn * 64 + wc * 32 + q * 16 + fq * 4) = o; } }
        } else {
            bf16_t* YE = (bf16_t*)(p.ws + WS_YE);
            const float* SELAFF = (const float*)(p.ws + WS_SELAFF);
#pragma unroll
            for (int m = 0; m < 4; ++m) { const size_t slot = (size_t)pm * 256 + wr * 64 + m * 16 + fr; const float a = SELAFF[slot];
#pragma unroll
                for (int n = 0; n < 4; ++n) { const f32x4 g = *(const f32x4*)((const float*)(p.ws + WS_MOD) + ((size_t)l * 9 + (pm < 128 ? (pm & 7) : 8)) * 6144 + 5 * 1024 + pn * 128 + wc * 64 + n * 16 + fq * 4);
                    u32x2 o; o[0] = pk_bf16(acc[m][n][0] * a * g[0], acc[m][n][1] * a * g[1]); o[1] = pk_bf16(acc[m][n][2] * a * g[2], acc[m][n][3] * a * g[3]);
                    *(u32x2*)(YE + slot * D + pn * 128 + wc * 64 + n * 16 + fq * 4) = o; } }
        }
    }
}

struct UnitOps { const unsigned char* A; const unsigned char* B; unsigned va[2][2]; int pm, pn; };

template <int MODE> __device__ __forceinline__ int gemm_nunits(const int l) {
    const bool last = (l == DEPTH - 1);
    if (MODE == 0) return last ? 640 + 8 * 6 : 720;
    if (MODE == 1) return last ? 256 : 288;
    if (MODE == 2) return last ? 1024 : 1152;
    return last ? 512 : 576;
}
template <int MODE>
__device__ __forceinline__ bool gemm_unit(const Params& p, const int l, const int i, const int R0, const int C0, UnitOps& u) {
    constexpr int nN = MODE == 0 ? 10 : (MODE == 1 ? 4 : (MODE == 2 ? 8 : 4));
    const int G = gridDim.x, c = (G & 7) == 0 ? (int)(blockIdx.x & 7) * (G >> 3) + (int)(blockIdx.x >> 3) : (int)blockIdx.x;
    const int idx = c + i * G;
    if (idx >= gemm_nunits<MODE>(l)) return false;
    int pm = idx / nN, pn = idx % nN;
    if (MODE == 0 && idx >= 640 && l == DEPTH - 1) { pm = 64 + (idx - 640) / 6; pn = (idx - 640) % 6; }
    u.pm = pm; u.pn = pn;
    if (MODE == 2) {
        const int e = pm < 128 ? (pm >> 3) : (pm - 128);
        const int* SEL = (const int*)(p.ws + WS_SEL) + pm * 256;
        u.A = p.ws + WS_H; u.B = p.ws + WS_WGUT + ((size_t)(l * NE + e) * 2048 + pn * 256) * D * 2;
#pragma unroll
        for (int h = 0; h < 2; ++h)
#pragma unroll
            for (int k = 0; k < 2; ++k) u.va[h][k] = (unsigned)(SEL[h * 128 + R0 + 64 * k] * D + C0) * 2u;
    } else {
        if (MODE == 0) { u.A = p.ws + WS_H + (size_t)pm * 256 * D * 2; u.B = p.ws + WS_WINT + ((size_t)l * PN + pn * 256) * D * 2; }
        else if (MODE == 1) { u.A = p.ws + WS_CAT + (size_t)pm * 256 * D * 2; u.B = p.ws + WS_WOUTT + ((size_t)l * D + pn * 256) * D * 2; }
        else { const int e = pm < 128 ? (pm >> 3) : (pm - 128); u.A = p.ws + WS_HID + (size_t)pm * 256 * D * 2; u.B = p.ws + WS_WDT + ((size_t)(l * NE + e) * D + pn * 256) * D * 2; }
#pragma unroll
        for (int h = 0; h < 2; ++h)
#pragma unroll
            for (int k = 0; k < 2; ++k) u.va[h][k] = (unsigned)((h * 128 + R0 + 64 * k) * D + C0) * 2u;
    }
    return true;
}

template <int MODE>
__device__ __forceinline__ void gemm_epilogue(const Params& p, const int l, const f32x4 (&acc)[2][2][4][2], const UnitOps& u, const int wr, const int wc, const int fr, const int fq) {
    const int row0 = u.pm * 256 + wr * 64 + fr, col0 = u.pn * 256 + wc * 32 + (MODE == 2 ? 4 : 8) * fq;
    if (MODE == 0) {
        bf16_t* PROJ = (bf16_t*)(p.ws + WS_PROJ);
#pragma unroll
        for (int ai = 0; ai < 2; ++ai)
#pragma unroll
            for (int m = 0; m < 4; ++m) { bf16_t* rp = PROJ + (size_t)(row0 + ai * 128 + m * 16) * PN + col0;
#pragma unroll
                for (int bj = 0; bj < 2; ++bj) { const f32x4 v0 = acc[ai][bj][m][0], v1 = acc[ai][bj][m][1];
                    u32x4 o; o[0] = pk_bf16(v0[0], v0[1]); o[1] = pk_bf16(v0[2], v0[3]); o[2] = pk_bf16(v1[0], v1[1]); o[3] = pk_bf16(v1[2], v1[3]); *(u32x4*)(rp + bj * 128) = o; } }
    } else if (MODE == 1) {
        float* X = (float*)(p.ws + WS_X);
        const int bidx = u.pm < 64 ? (u.pm >> 3) : 8;
        const float* g1 = (const float*)(p.ws + WS_MOD) + ((size_t)l * 9 + bidx) * 6144 + 2048 + col0;
        f32x4 gv[2][2];
#pragma unroll
        for (int bj = 0; bj < 2; ++bj)
#pragma unroll
            for (int n = 0; n < 2; ++n) gv[bj][n] = *(const f32x4*)(g1 + bj * 128 + n * 4);
#pragma unroll
        for (int ai = 0; ai < 2; ++ai)
#pragma unroll
            for (int m = 0; m < 4; ++m) { float* rp = X + (size_t)(row0 + ai * 128 + m * 16) * D + col0;
#pragma unroll
                for (int bj = 0; bj < 2; ++bj)
#pragma unroll
                    for (int n = 0; n < 2; ++n) { float* xp = rp + bj * 128 + n * 4; *(f32x4*)xp = *(const f32x4*)xp + gv[bj][n] * acc[ai][bj][m][n]; } }
    } else if (MODE == 2) {
        bf16_t* HID = (bf16_t*)(p.ws + WS_HID);
        const int f0 = u.pn * 128 + wc * 16 + 4 * fq;
#pragma unroll
        for (int ai = 0; ai < 2; ++ai)
#pragma unroll
            for (int m = 0; m < 4; ++m) { bf16_t* rp = HID + (size_t)(row0 + ai * 128 + m * 16) * D + f0;
#pragma unroll
                for (int bj = 0; bj < 2; ++bj) { const f32x4 g = acc[ai][bj][m][0], uu = acc[ai][bj][m][1];
                    u32x2 o; o[0] = pk_bf16(silu_f(g[0]) * uu[0], silu_f(g[1]) * uu[1]); o[1] = pk_bf16(silu_f(g[2]) * uu[2], silu_f(g[3]) * uu[3]);
                    *(u32x2*)(rp + bj * 64) = o; } }
    } else {
        bf16_t* YE = (bf16_t*)(p.ws + WS_YE);
        const float* SELAFF = (const float*)(p.ws + WS_SELAFF);
        const int bidx = u.pm < 128 ? (u.pm & 7) : 8;
        const float* g2 = (const float*)(p.ws + WS_MOD) + ((size_t)l * 9 + bidx) * 6144 + 5 * 1024 + col0;
        f32x4 gv[2][2];
#pragma unroll
        for (int bj = 0; bj < 2; ++bj)
#pragma unroll
            for (int n = 0; n < 2; ++n) gv[bj][n] = *(const f32x4*)(g2 + bj * 128 + n * 4);
#pragma unroll
        for (int ai = 0; ai < 2; ++ai)
#pragma unroll
            for (int m = 0; m < 4; ++m) { const size_t slot = (size_t)(row0 + ai * 128 + m * 16); const float a = SELAFF[slot]; bf16_t* rp = YE + slot * D + col0;
#pragma unroll
                for (int bj = 0; bj < 2; ++bj) { const f32x4 v0 = acc[ai][bj][m][0] * gv[bj][0] * a, v1 = acc[ai][bj][m][1] * gv[bj][1] * a;
                    u32x4 o; o[0] = pk_bf16(v0[0], v0[1]); o[1] = pk_bf16(v0[2], v0[3]); o[2] = pk_bf16(v1[0], v1[1]); o[3] = pk_bf16(v1[2], v1[3]); *(u32x4*)(rp + bj * 128) = o; } }
    }
}

template <int MODE>
__device__ __forceinline__ void gemm_filler(const Params& p, const int l, LAS unsigned char* lds) {
    if (MODE == 0 || l >= DEPTH - 1) return;
    const int G = gridDim.x, c = (G & 7) == 0 ? (int)(blockIdx.x & 7) * (G >> 3) + (int)(blockIdx.x >> 3) : (int)blockIdx.x;
    const int rem = gemm_nunits<MODE>(l) % G;
    if (rem == 0 || c < rem) return;
    constexpr int first = MODE == 1 ? 0 : (MODE == 2 ? 1344 : 2240), count = MODE == 1 ? 1344 : (MODE == 2 ? 896 : 1056);
    convert_tiles(p, l + 1, first, count, c - rem, G - rem, lds);
}

template <int MODE>
__device__ __forceinline__ void phase_gemm8(const Params& p, const int l, LAS unsigned char* lds) {
    const int tid = opaque_tid(), wid = __builtin_amdgcn_readfirstlane(tid >> 6), lane = tid & 63, wr = wid >> 2, wc = wid & 3, fr = lane & 15, fq = lane >> 4;
    constexpr int HTB = 16384;
    constexpr int nt = D / 64;
    constexpr unsigned kstep = 128u, hstepB = 128u * D * 2u;
    int R0, C0; stage_rc(tid * 16, R0, C0);
    constexpr bool PERM = (MODE != 2);
    unsigned vb[2];
#pragma unroll
    for (int k = 0; k < 2; ++k) { const int R = R0 + 64 * k, rho = R & 31, Rb = PERM ? ((R & ~31) + 8 * ((rho & 15) >> 2) + 4 * (rho >> 4) + (rho & 3)) : R; vb[k] = (unsigned)(Rb * D + C0) * 2u; }
    const unsigned ldsw = (unsigned)wid * 1024u;
    const int aoff = lds_byte(wr * 64 + fr, fq * 8), boff = lds_byte(wc * 32 + fr, fq * 8);
#define G8_SA(b, h) (((b) * 2 + (h)) * HTB)
#define G8_SB(b, h) ((4 + (b) * 2 + (h)) * HTB)
#define G8_STAGE_A(bufoff, U, h, ko) do { _Pragma("unroll") for (int _i = 0; _i < 2; ++_i) \
        __builtin_amdgcn_global_load_lds((const unsigned*)((U).A + (U).va[h][_i] + (ko)), (LAS unsigned*)(lds + (bufoff) + ldsw + _i * 8192), 16, 0, 0); } while (0)
#define G8_STAGE_B(bufoff, U, h, ko) do { _Pragma("unroll") for (int _i = 0; _i < 2; ++_i) \
        __builtin_amdgcn_global_load_lds((const unsigned*)((U).B + vb[_i] + (h) * hstepB + (ko)), (LAS unsigned*)(lds + (bufoff) + ldsw + _i * 8192), 16, 0, 0); } while (0)
#define G8_LDA(dst, b, h) do { _Pragma("unroll") for (int m = 0; m < 4; ++m) _Pragma("unroll") for (int k = 0; k < 2; ++k) dst[m][k] = *(const LAS bf16x8*)(lds + G8_SA(b, h) + aoff + m * 2048 + k * 1024); } while (0)
#define G8_LDB(dst, b, h) do { _Pragma("unroll") for (int n = 0; n < 2; ++n) _Pragma("unroll") for (int k = 0; k < 2; ++k) dst[n][k] = *(const LAS bf16x8*)(lds + G8_SB(b, h) + boff + n * 2048 + k * 1024); } while (0)
#define G8_MMA(ai, bj, At, Bt) do { __builtin_amdgcn_s_setprio(1); _Pragma("unroll") for (int m = 0; m < 4; ++m) _Pragma("unroll") for (int n = 0; n < 2; ++n) _Pragma("unroll") for (int k = 0; k < 2; ++k) \
        acc[ai][bj][m][n] = __builtin_amdgcn_mfma_f32_16x16x32_bf16(Bt[n][k], At[m][k], acc[ai][bj][m][n], 0, 0, 0); __builtin_amdgcn_s_setprio(0); } while (0)
#define G8_WAIT_V(n) asm volatile("s_waitcnt vmcnt(" #n ")" ::: "memory")
#define G8_WAIT_L(n) asm volatile("s_waitcnt lgkmcnt(" #n ")" ::: "memory")
#define G8_BAR __builtin_amdgcn_s_barrier()
#define G8_SCHED __builtin_amdgcn_sched_barrier(0)
    UnitOps cur, nxt; int ui = 0;
    if (!gemm_unit<MODE>(p, l, 0, R0, C0, cur)) { gemm_filler<MODE>(p, l, lds); return; }
    f32x4 acc[2][2][4][2];
#pragma unroll
    for (int a = 0; a < 2; ++a)
#pragma unroll
        for (int b = 0; b < 2; ++b)
#pragma unroll
            for (int m = 0; m < 4; ++m)
#pragma unroll
                for (int n = 0; n < 2; ++n) acc[a][b][m][n] = (f32x4){0.f, 0.f, 0.f, 0.f};
    bf16x8 At[4][2], B0[2][2], B1[2][2];
    bool has_next = gemm_unit<MODE>(p, l, 1, R0, C0, nxt);
    if (!has_next) nxt = cur;
    G8_STAGE_B(G8_SB(0, 0), cur, 0, 0u); G8_STAGE_A(G8_SA(0, 0), cur, 0, 0u); G8_STAGE_B(G8_SB(0, 1), cur, 1, 0u); G8_STAGE_A(G8_SA(0, 1), cur, 1, 0u);
    if (wr == 1) G8_BAR;
    G8_WAIT_V(4); G8_BAR;
    G8_STAGE_B(G8_SB(1, 0), cur, 0, kstep); G8_STAGE_A(G8_SA(1, 0), cur, 0, kstep); G8_STAGE_B(G8_SB(1, 1), cur, 1, kstep);
    G8_WAIT_V(6); G8_BAR;
    for (;;) {
#pragma unroll 1
        for (int t = 0; t < nt; t += 2) {
            const bool last = (t == nt - 2);
            const unsigned k1 = (unsigned)(t + 1) * kstep, k2 = last ? 0u : (unsigned)(t + 2) * kstep, k3 = k2 + kstep;
            UnitOps& U2 = last ? nxt : cur;
            G8_LDB(B0, 0, 0); G8_SCHED; G8_LDA(At, 0, 0); G8_STAGE_A(G8_SA(1, 1), cur, 1, k1);
            G8_WAIT_L(8); G8_BAR; G8_WAIT_L(0); G8_MMA(0, 0, At, B0); G8_BAR; G8_SCHED;
            G8_LDB(B1, 0, 1); G8_STAGE_B(G8_SB(0, 0), U2, 0, k2);
            G8_BAR; G8_WAIT_L(0); G8_MMA(0, 1, At, B1); G8_BAR;
            G8_LDA(At, 0, 1); G8_STAGE_A(G8_SA(0, 0), U2, 0, k2);
            G8_BAR; G8_WAIT_L(0); G8_MMA(1, 0, At, B0); G8_BAR; G8_SCHED;
            G8_STAGE_B(G8_SB(0, 1), U2, 1, k2);
            G8_WAIT_V(6); G8_BAR; G8_MMA(1, 1, At, B1); G8_BAR;
            G8_LDB(B0, 1, 0); G8_SCHED; G8_LDA(At, 1, 0); G8_STAGE_A(G8_SA(0, 1), U2, 1, k2);
            G8_WAIT_L(8); G8_BAR; G8_WAIT_L(0); G8_MMA(0, 0, At, B0); G8_BAR; G8_SCHED;
            G8_LDB(B1, 1, 1); G8_STAGE_B(G8_SB(1, 0), U2, 0, k3);
            G8_BAR; G8_WAIT_L(0); G8_MMA(0, 1, At, B1); G8_BAR;
            G8_LDA(At, 1, 1); G8_STAGE_A(G8_SA(1, 0), U2, 0, k3);
            G8_BAR; G8_WAIT_L(0); G8_MMA(1, 0, At, B0); G8_BAR; G8_SCHED;
            G8_STAGE_B(G8_SB(1, 1), U2, 1, k3);
            G8_WAIT_V(6); G8_BAR; G8_MMA(1, 1, At, B1); G8_BAR;
        }
        gemm_epilogue<MODE>(p, l, acc, cur, wr, wc, fr, fq);
        if (!has_next) break;
#pragma unroll
        for (int a = 0; a < 2; ++a)
#pragma unroll
            for (int b = 0; b < 2; ++b)
#pragma unroll
                for (int m = 0; m < 4; ++m)
#pragma unroll
                    for (int n = 0; n < 2; ++n) acc[a][b][m][n] = (f32x4){0.f, 0.f, 0.f, 0.f};
        cur = nxt; ++ui;
        has_next = gemm_unit<MODE>(p, l, ui + 1, R0, C0, nxt);
        if (!has_next) nxt = cur;
    }
    G8_WAIT_V(0);
    if (wr == 0) G8_BAR;
    G8_BAR;
    gemm_filler<MODE>(p, l, lds);
#undef G8_SA
#undef G8_SB
#undef G8_STAGE_A
#undef G8_STAGE_B
#undef G8_LDA
#undef G8_LDB
#undef G8_MMA
#undef G8_WAIT_V
#undef G8_WAIT_L
#undef G8_BAR
#undef G8_SCHED
}

template <int B>
__device__ __forceinline__ void pool_vsum(const bf16_t* src0, const size_t rstep, const int lo_r, const int hi_r, const int rc, const int npieces, LAS float* V, LAS unsigned char* U, const int tid) {
    for (int p0 = tid; p0 < npieces; p0 += 2 * NTHREADS) {
        const int p1 = p0 + NTHREADS; const bool two = p1 < npieces;
        const bf16_t* sa = src0 + (size_t)(p0 >> 4) * PN + (p0 & 15) * 8;
        const bf16_t* sb = src0 + (size_t)((two ? p1 : p0) >> 4) * PN + ((two ? p1 : p0) & 15) * 8;
        float aa[8], ab[8];
#pragma unroll
        for (int e = 0; e < 8; ++e) { aa[e] = 0.f; ab[e] = 0.f; }
        for (int r0 = lo_r; r0 < hi_r; r0 += B) {
            u32x4 va[B], vb[B];
#pragma unroll
            for (int k = 0; k < B; ++k) { const int rr = min(r0 + k, hi_r - 1); va[k] = *(const u32x4*)(sa + (size_t)rr * rstep); vb[k] = *(const u32x4*)(sb + (size_t)rr * rstep); }
#pragma unroll
            for (int k = 0; k < B; ++k) if (r0 + k < hi_r) {
                if (r0 + k == rc) { *(LAS u32x4*)(U + (p0 >> 4) * 256 + (p0 & 15) * 16) = va[k]; if (two) *(LAS u32x4*)(U + (p1 >> 4) * 256 + (p1 & 15) * 16) = vb[k]; }
#pragma unroll
                for (int e = 0; e < 4; ++e) { aa[2 * e] += bf_lo(va[k][e]); aa[2 * e + 1] += bf_hi(va[k][e]); ab[2 * e] += bf_lo(vb[k][e]); ab[2 * e + 1] += bf_hi(vb[k][e]); }
            }
        }
        *(LAS f32x4*)(V + (p0 >> 4) * 128 + (p0 & 15) * 8) = (f32x4){aa[0], aa[1], aa[2], aa[3]};
        *(LAS f32x4*)(V + (p0 >> 4) * 128 + (p0 & 15) * 8 + 4) = (f32x4){aa[4], aa[5], aa[6], aa[7]};
        if (two) { *(LAS f32x4*)(V + (p1 >> 4) * 128 + (p1 & 15) * 8) = (f32x4){ab[0], ab[1], ab[2], ab[3]};
                   *(LAS f32x4*)(V + (p1 >> 4) * 128 + (p1 & 15) * 8 + 4) = (f32x4){ab[4], ab[5], ab[6], ab[7]}; }
    }
}

__device__ __forceinline__ void phase_conv_pool(const Params& p, const int l, LAS unsigned char* lds, const int wg0 = 0, const int nwg = 0) {
    const int tid = opaque_tid(), wid = tid >> 6, lane = tid & 63;
    const bf16_t* PROJ = (const bf16_t*)(p.ws + WS_PROJ);
    if (NAIVE_SCAN) {
        float* QKV = (float*)(p.ws + WS_QKV);
        const float* cw = p.conv_w + (size_t)l * 4 * 1536;
        for (int task = blockIdx.x * 8 + wid; task < MT * 12; task += gridDim.x * 8) {
            const int row = task / 12, part = task % 12;
            int s0, len;
            if (row < ROWS_LAT) { s0 = row & ~2047; len = 2048; } else { s0 = ROWS_LAT + ((row - ROWS_LAT) & ~255); len = 256; }
            const int c = part * 128 + lane * 2;
            float a0 = 0.f, a1 = 0.f;
#pragma unroll
            for (int j = 0; j < 4; ++j) {
                const int r2 = row + j - 2;
                if (r2 >= s0 && r2 < s0 + len) {
                    const unsigned v = *(const unsigned*)(PROJ + (size_t)r2 * PN + c);
                    const f32x2 w = *(const f32x2*)(cw + j * 1536 + c);
                    a0 += w[0] * bf_lo(v); a1 += w[1] * bf_hi(v);
                }
            }
            a0 = silu_f(a0); a1 = silu_f(a1);
            if (part < 8) {
                const float ss = wave_sum(a0 * a0 + a1 * a1, lane);
                float sc = rsqrtf(ss + EPS);
                if (part < 4) sc *= 0.08838834764831845f;
                a0 *= sc; a1 *= sc;
            }
            *(f32x2*)(QKV + (size_t)row * 1536 + c) = (f32x2){a0, a1};
        }
    }
    {
        LAS float* V = (LAS float*)lds;
        LAS unsigned char* mt = lds + 40960;
        const bf16_t* PWT = (const bf16_t*)(p.ws + WS_PWT);
        bf16_t* CAT = (bf16_t*)(p.ws + WS_CAT);
        const int wr = wid >> 1, wc = wid & 1, fr = lane & 15, fq = lane >> 4;
        const int npool = (l == DEPTH - 1) ? 1024 : 1152;
        const int pstep = nwg > 0 ? nwg : (int)gridDim.x;
        for (int u = ((int)blockIdx.x >= wg0) ? (int)blockIdx.x - wg0 : npool; u < npool; u += pstep) {
            int g, r, nrows, ncols, c0, rowbase;
            if (u < 1024) { const int q = u & 255, b = q >> 5; g = (q + (u >> 8)) & 3; r = q & 31; nrows = 32; ncols = 64; c0 = 0; rowbase = b * 2048; }
            else { const int v = u - 1024; const int b = v >> 4; g = (v >> 2) & 3; r = 0; nrows = 1; ncols = 256; c0 = (v & 3) * 64; rowbase = ROWS_LAT + b * 256; }
            const int w = 2 << g, half = w >> 1;
            const int lo_r = max(r - half, 0), hi_r = min(r - half + w, nrows);
            const int cxlo = max(c0 - half, 0), cxhi = min(c0 + 64 + half, ncols);
            const bf16_t* ub = PROJ + 2048 + g * 128;
            const bf16_t* pw = PWT + (size_t)(l * 4 + g) * 128 * 128;
            bf16x8 pwf[4][4];
#pragma unroll
            for (int kk = 0; kk < 4; ++kk)
#pragma unroll
                for (int n = 0; n < 4; ++n) pwf[kk][n] = *(const bf16x8*)(pw + (size_t)(wc * 64 + n * 16 + fr) * 128 + kk * 32 + fq * 8);
            {
                const int npieces = (cxhi - cxlo) * 16;
                const size_t rstep = (size_t)ncols * PN;
                if (g == 0) pool_vsum<2>(ub + (size_t)(rowbase + cxlo) * PN, rstep, lo_r, hi_r, r, npieces, V, lds + 58368, tid);
                else if (g == 1) pool_vsum<4>(ub + (size_t)(rowbase + cxlo) * PN, rstep, lo_r, hi_r, r, npieces, V, lds + 58368, tid);
                else pool_vsum<8>(ub + (size_t)(rowbase + cxlo) * PN, rstep, lo_r, hi_r, r, npieces, V, lds + 58368, tid);
            }
            __syncthreads();
            for (int idx = tid; idx < 64 * 64; idx += NTHREADS) {
                const int ci = idx >> 6, ch = (idx & 63) * 2, c = c0 + ci;
                const int lo_c = max(c - half, 0), hi_c = min(c - half + w, ncols);
                float s0 = 0.f, s1 = 0.f;
                for (int cx = lo_c; cx < hi_c; ++cx) { s0 += V[(cx - cxlo) * 128 + ch]; s1 += V[(cx - cxlo) * 128 + ch + 1]; }
                const float inv = __builtin_amdgcn_rcpf((float)((hi_r - lo_r) * (hi_c - lo_c)));
                const unsigned v = *(const LAS unsigned*)(lds + 58368 + (c - cxlo) * 256 + ch * 2);
                *(LAS unsigned*)(mt + ci * 272 + ch * 2) = pk_bf16(s0 * inv - bf_lo(v), s1 * inv - bf_hi(v));
            }
            __syncthreads();
            f32x4 acc[4];
#pragma unroll
            for (int n = 0; n < 4; ++n) acc[n] = (f32x4){0.f, 0.f, 0.f, 0.f};
#pragma unroll
            for (int kk = 0; kk < 4; ++kk) {
                const bf16x8 a = *(const LAS bf16x8*)(mt + (wr * 16 + fr) * 272 + (kk * 32 + fq * 8) * 2);
#pragma unroll
                for (int n = 0; n < 4; ++n) acc[n] = __builtin_amdgcn_mfma_f32_16x16x32_bf16(pwf[kk][n], a, acc[n], 0, 0, 0);
            }
            const size_t row = (size_t)rowbase + r * ncols + c0 + wr * 16 + fr;
#pragma unroll
            for (int n = 0; n < 4; ++n) {
                const int dcol = g * 128 + wc * 64 + n * 16 + fq * 4;
                const f32x4 s = *(const f32x4*)(p.pool_scale + l * 512 + dcol);
                u32x2 o; o[0] = pk_bf16(acc[n][0] * s[0], acc[n][1] * s[1]); o[1] = pk_bf16(acc[n][2] * s[2], acc[n][3] * s[3]);
                *(u32x2*)(CAT + row * D + 512 + dcol) = o;
            }
            __syncthreads();
        }
    }
}


__device__ __forceinline__ int img256(int row, int col) { return row * 256 + ((((col >> 3) ^ row) & 15) << 4) + (col & 7) * 2; }
__device__ __forceinline__ int img128(int row, int col) { return (row >> 1) * 256 + (row & 1) * 128 + ((((col >> 3) ^ (row >> 1)) & 7) << 4) + (col & 7) * 2; }

__device__ __forceinline__ void prep_tchain(const int lane, LAS float* MT, LAS float* XS) {
    const int fr = lane & 15, fq = lane >> 4;
    {
        const int bb = lane >> 4, c = lane & 15;
        float tc[16];
#pragma unroll
        for (int a = 0; a < 16; ++a) {
            float sv = (a == c) ? 1.f : 0.f;
#pragma unroll
            for (int q = 0; q < (a + 3) / 4; ++q) {
                const f32x4 m4 = *(const LAS f32x4*)(MT + (bb * 16 + a) * 68 + bb * 16 + q * 4);
#pragma unroll
                for (int e = 0; e < 4; ++e) if (q * 4 + e < a) sv -= m4[e] * tc[q * 4 + e];
            }
            tc[a] = sv;
        }
#pragma unroll
        for (int a = 0; a < 16; ++a) MT[(bb * 16 + a) * 68 + bb * 16 + c] = tc[a];
    }
    {
        f32x4 x0 = (f32x4){0.f, 0.f, 0.f, 0.f}, x1 = (f32x4){0.f, 0.f, 0.f, 0.f};
#pragma unroll
        for (int ks = 0; ks < 4; ++ks) {
            x0 = __builtin_amdgcn_mfma_f32_16x16x4f32(MT[(16 + fr) * 68 + ks * 4 + fq], MT[(ks * 4 + fq) * 68 + fr], x0, 0, 0, 0);
            x1 = __builtin_amdgcn_mfma_f32_16x16x4f32(MT[(48 + fr) * 68 + 32 + ks * 4 + fq], MT[(32 + ks * 4 + fq) * 68 + 32 + fr], x1, 0, 0, 0);
        }
#pragma unroll
        for (int r = 0; r < 4; ++r) { XS[(fq * 4 + r) * 17 + fr] = x0[r]; XS[272 + (fq * 4 + r) * 17 + fr] = x1[r]; }
        f32x4 y0 = (f32x4){0.f, 0.f, 0.f, 0.f}, y1 = (f32x4){0.f, 0.f, 0.f, 0.f};
#pragma unroll
        for (int ks = 0; ks < 4; ++ks) {
            y0 = __builtin_amdgcn_mfma_f32_16x16x4f32(MT[(16 + fr) * 68 + 16 + ks * 4 + fq], XS[(ks * 4 + fq) * 17 + fr], y0, 0, 0, 0);
            y1 = __builtin_amdgcn_mfma_f32_16x16x4f32(MT[(48 + fr) * 68 + 48 + ks * 4 + fq], XS[272 + (ks * 4 + fq) * 17 + fr], y1, 0, 0, 0);
        }
#pragma unroll
        for (int r = 0; r < 4; ++r) { MT[(16 + fq * 4 + r) * 68 + fr] = -y0[r]; MT[(48 + fq * 4 + r) * 68 + 32 + fr] = -y1[r]; }
    }
    {
        f32x4 y[2][2];
#pragma unroll
        for (int ti = 0; ti < 2; ++ti)
#pragma unroll
            for (int tj = 0; tj < 2; ++tj) y[ti][tj] = (f32x4){0.f, 0.f, 0.f, 0.f};
#pragma unroll
        for (int ks = 0; ks < 8; ++ks) {
            const float b0 = MT[(ks * 4 + fq) * 68 + fr], b1 = MT[(ks * 4 + fq) * 68 + 16 + fr];
#pragma unroll
            for (int ti = 0; ti < 2; ++ti) {
                const float a = MT[(32 + ti * 16 + fr) * 68 + ks * 4 + fq];
                y[ti][0] = __builtin_amdgcn_mfma_f32_16x16x4f32(a, b0, y[ti][0], 0, 0, 0);
                y[ti][1] = __builtin_amdgcn_mfma_f32_16x16x4f32(a, b1, y[ti][1], 0, 0, 0);
            }
        }
#pragma unroll
        for (int ti = 0; ti < 2; ++ti)
#pragma unroll
            for (int tj = 0; tj < 2; ++tj)
#pragma unroll
                for (int r = 0; r < 4; ++r) XS[(ti * 16 + fq * 4 + r) * 33 + tj * 16 + fr] = y[ti][tj][r];
        f32x4 z[2][2];
#pragma unroll
        for (int ti = 0; ti < 2; ++ti)
#pragma unroll
            for (int tj = 0; tj < 2; ++tj) z[ti][tj] = (f32x4){0.f, 0.f, 0.f, 0.f};
#pragma unroll
        for (int ks = 0; ks < 8; ++ks) {
            const float b0 = XS[(ks * 4 + fq) * 33 + fr], b1 = XS[(ks * 4 + fq) * 33 + 16 + fr];
#pragma unroll
            for (int ti = 0; ti < 2; ++ti) {
                const float a = MT[(32 + ti * 16 + fr) * 68 + 32 + ks * 4 + fq];
                z[ti][0] = __builtin_amdgcn_mfma_f32_16x16x4f32(a, b0, z[ti][0], 0, 0, 0);
                z[ti][1] = __builtin_amdgcn_mfma_f32_16x16x4f32(a, b1, z[ti][1], 0, 0, 0);
            }
        }
#pragma unroll
        for (int ti = 0; ti < 2; ++ti)
#pragma unroll
            for (int tj = 0; tj < 2; ++tj)
#pragma unroll
                for (int r = 0; r < 4; ++r) MT[(32 + ti * 16 + fq * 4 + r) * 68 + tj * 16 + fr] = -z[ti][tj][r];
    }
}

__device__ __forceinline__ int imgT(int i, int j) { return i * 128 + ((((j >> 3) ^ i) & 7) << 4) + (j & 7) * 2; }

__device__ __forceinline__ void phase_prep(const Params& p, const int l, LAS unsigned char* lds) {
    int tid = opaque_tid(), wid = __builtin_amdgcn_readfirstlane(tid >> 6), lane = tid & 63, fr = lane & 15, fq = lane >> 4;
#define RELAUNDER() do { asm volatile("" : "+v"(tid)); wid = __builtin_amdgcn_readfirstlane(tid >> 6); lane = tid & 63; fr = lane & 15; fq = lane >> 4; } while (0)
    constexpr int R_MT0 = 0, R_MT1 = 17408, R_QK = 34816, R_QN = 53248, R_KN = 70656, R_KNT = 88064, R_VT = 106496, R_G = 143360;
    constexpr int R_T0 = R_QK, R_T1 = 124928;
    LAS float* QK = (LAS float*)(lds + R_QK);
    LAS float* G_LA = (LAS float*)(lds + R_G);
    LAS float* G_BT = G_LA + 128;
    LAS float* G_GC = G_BT + 128;
    LAS float* G_TOT = G_GC + 128;
    LAS float* G_E1 = G_TOT + 16;
    LAS float* G_E2 = G_E1 + 128;
    LAS float* XS = G_E2 + 128;
    LAS float* CW = XS + 2176;
    static_assert(R_G + (128 * 5 + 16 + 2176 + 1536) * 4 <= LDS_WORK, "prep LDS");
    const bf16_t* PROJ = (const bf16_t*)(p.ws + WS_PROJ);
    const float* LOGA = (const float*)(p.ws + WS_LOGA); const float* BETA = (const float*)(p.ws + WS_BETA);
    int cur_h = -1;
    for (int u = blockIdx.x; u < NB * 4 * NCHUNK; u += gridDim.x) {
        const int h = u & 3, b = (u >> 2) / 36, cc = (u >> 2) % 36;
        if (h != cur_h) {
            __syncthreads();
            for (int idx = tid; idx < 1536; idx += NTHREADS) { const int j = idx / 384, rm = idx % 384, seg = rm >> 7, c = rm & 127; CW[idx] = p.conv_w[(size_t)(l * 4 + j) * 1536 + seg * 512 + h * 128 + c]; }
            cur_h = h;
        }
        int rowbase, seqlen, cpos;
        if (cc < 32) { rowbase = b * SEQ; seqlen = SEQ; cpos = cc; } else { rowbase = ROWS_LAT + b * CTXL; seqlen = CTXL; cpos = cc - 32; }
        const int t0 = cpos * 64;
        RELAUNDER();
        {
            u32x4 rv[7];
#pragma unroll
            for (int it = 0; it < 7; ++it) {
                const int idx = tid + it * NTHREADS, rr = idx / 48, pc = idx % 48, seg = pc >> 4, po = pc & 15, tok = t0 - 2 + rr;
                rv[it] = (u32x4){0u, 0u, 0u, 0u};
                if (idx < 67 * 48 && tok >= 0 && tok < seqlen) rv[it] = *(const u32x4*)(PROJ + (size_t)(rowbase + tok) * PN + seg * 512 + h * 128 + po * 8);
            }
#pragma unroll
            for (int it = 0; it < 7; ++it) {
                const int idx = tid + it * NTHREADS, rr = idx / 48, pc = idx % 48, seg = pc >> 4, po = pc & 15;
                if (idx < 67 * 48) *(LAS u32x4*)(lds + rr * 784 + seg * 256 + po * 16) = rv[it];
            }
        }
        if (tid < 128) { const int d = tid >> 6; const size_t gi = (size_t)(rowbase + t0 + lane) * 8 + d * 4 + h; G_LA[tid] = LOGA[gi]; G_BT[tid] = BETA[gi]; }
        __syncthreads();
        RELAUNDER();
        if (wid < 2) {
            const int d = wid, pos = d ? 63 - lane : lane;
            float v = G_LA[d * 64 + pos];
#pragma unroll
            for (int o = 1; o < 64; o <<= 1) { const float t = shup(v, o, lane); if (lane >= o) v += t; }
            G_GC[d * 64 + pos] = v;
            if (lane == 63) G_TOT[d] = v;
            const float tot = __int_as_float(__builtin_amdgcn_readlane(__float_as_int(v), 63));
            G_E1[d * 64 + pos] = __expf(tot - v); G_E2[d * 64 + pos] = __expf(v);
        }
        RELAUNDER();
        {
            const int r = tid >> 3, cs = tid & 7;
            const LAS float* cw = CW + cs * 16;
#pragma unroll
            for (int seg = 0; seg < 3; ++seg) {
                float a[16];
#pragma unroll
                for (int e = 0; e < 16; ++e) a[e] = 0.f;
#pragma unroll
                for (int j = 0; j < 4; ++j) {
                    const u32x4 x0 = *(const LAS u32x4*)(lds + (r + j) * 784 + seg * 256 + cs * 32), x1 = *(const LAS u32x4*)(lds + (r + j) * 784 + seg * 256 + cs * 32 + 16);
                    const LAS float* wj = cw + j * 384 + seg * 128;
                    const f32x4 w0 = *(const LAS f32x4*)(wj), w1 = *(const LAS f32x4*)(wj + 4), w2 = *(const LAS f32x4*)(wj + 8), w3 = *(const LAS f32x4*)(wj + 12);
                    a[0] += w0[0] * bf_lo(x0[0]); a[1] += w0[1] * bf_hi(x0[0]); a[2] += w0[2] * bf_lo(x0[1]); a[3] += w0[3] * bf_hi(x0[1]);
                    a[4] += w1[0] * bf_lo(x0[2]); a[5] += w1[1] * bf_hi(x0[2]); a[6] += w1[2] * bf_lo(x0[3]); a[7] += w1[3] * bf_hi(x0[3]);
                    a[8] += w2[0] * bf_lo(x1[0]); a[9] += w2[1] * bf_hi(x1[0]); a[10] += w2[2] * bf_lo(x1[1]); a[11] += w2[3] * bf_hi(x1[1]);
                    a[12] += w3[0] * bf_lo(x1[2]); a[13] += w3[1] * bf_hi(x1[2]); a[14] += w3[2] * bf_lo(x1[3]); a[15] += w3[3] * bf_hi(x1[3]);
                    if (j & 1) __builtin_amdgcn_sched_barrier(0);
                }
                float ss = 0.f;
#pragma unroll
                for (int e = 0; e < 16; ++e) { a[e] = silu_f(a[e]); ss += a[e] * a[e]; }
                if (seg < 2) {
                    ss += shx(ss, 1, lane); ss += shx(ss, 2, lane); ss += shx(ss, 4, lane);
                    float sc = rsqrtf(ss + EPS); if (seg == 0) sc *= 0.08838834764831845f;
#pragma unroll
                    for (int e = 0; e < 16; ++e) a[e] *= sc;
                }
                unsigned pk[8];
#pragma unroll
                for (int e = 0; e < 8; ++e) pk[e] = pk_bf16(a[2 * e], a[2 * e + 1]);
                if (seg < 2) {
                    LAS unsigned char* dst = lds + (seg == 0 ? R_QN : R_KN) + r * 272 + cs * 32;
                    *(LAS u32x4*)dst = (u32x4){pk[0], pk[1], pk[2], pk[3]}; *(LAS u32x4*)(dst + 16) = (u32x4){pk[4], pk[5], pk[6], pk[7]};
                }
                if (seg >= 1) {
                    LAS unsigned char* dt = lds + (seg == 1 ? R_KNT : R_VT) + (cs * 16) * 144 + ((((r >> 3) ^ cs) & 7) << 4) + (r & 7) * 2;
#pragma unroll
                    for (int e = 0; e < 8; ++e) { *(LAS unsigned short*)(dt + (2 * e) * 144) = (unsigned short)(pk[e] & 0xffffu); *(LAS unsigned short*)(dt + (2 * e + 1) * 144) = (unsigned short)(pk[e] >> 16); }
                }
            }
        }
        __syncthreads();
        RELAUNDER();
        {
            const int ib = wid & 3, pr = wid >> 2;
            LAS unsigned char* Ab = lds + (pr ? R_QN : R_KN) + (ib * 16 + fr) * 272 + fq * 16;
            bf16x8 a[4];
#pragma unroll
            for (int kk = 0; kk < 4; ++kk) a[kk] = *(const LAS bf16x8*)(Ab + kk * 64);
#pragma unroll
            for (int jb = 0; jb < 4; ++jb) {
                f32x4 acc = (f32x4){0.f, 0.f, 0.f, 0.f};
#pragma unroll
                for (int kk = 0; kk < 4; ++kk) { const bf16x8 bb = *(const LAS bf16x8*)(lds + R_KN + (jb * 16 + fr) * 272 + fq * 16 + kk * 64); acc = __builtin_amdgcn_mfma_f32_16x16x32_bf16(a[kk], bb, acc, 0, 0, 0); }
                if (pr) {
#pragma unroll
                    for (int r = 0; r < 4; ++r) QK[(ib * 16 + fq * 4 + r) * 65 + jb * 16 + fr] = acc[r];
                } else {
                    const int j = jb * 16 + fr;
                    const float g0j = G_GC[j], g1j = G_GC[64 + j];
#pragma unroll
                    for (int r = 0; r < 4; ++r) {
                        const int i = ib * 16 + fq * 4 + r;
                        ((LAS float*)(lds + R_MT0))[i * 68 + j] = (j < i) ? G_BT[i] * acc[r] * __expf(G_GC[i] - g0j) : 0.f;
                        ((LAS float*)(lds + R_MT1))[(63 - i) * 68 + (63 - j)] = (j > i) ? G_BT[64 + i] * acc[r] * __expf(G_GC[64 + i] - g1j) : 0.f;
                    }
                }
            }
        }
        __syncthreads();
        RELAUNDER();
        unsigned char* recd[2];
#pragma unroll
        for (int d = 0; d < 2; ++d) { const int cposn = (cc < 32) ? 4 + (d ? 31 - cpos : cpos) : (d ? 3 - cpos : cpos);
            recd[d] = p.ws + WS_SCN + ((size_t)((b * 4 + h) * 2 + d) * NCHUNK + cposn) * REC_BYTES; }
        if ((wid & 3) == 0) {
            const int d = wid >> 2;
            prep_tchain(lane, (LAS float*)(lds + (d ? R_MT1 : R_MT0)), XS + d * 1088);
        } else {
            const int wt = (wid - 1 - (wid > 4 ? 1 : 0)) * 64 + lane;
            for (int it = wt; it < 5120; it += 384) {
                const int d = it >= 2560 ? 1 : 0, r = it - d * 2560;
                const LAS float* gc = G_GC + d * 64;
                unsigned char* rec = d ? recd[1] : recd[0];
                if (r < 1024) {
                    const int dk = r >> 3, i8 = (r & 7) * 8;
                    const u32x4 kv = *(const LAS u32x4*)(lds + R_KNT + dk * 144 + ((((i8 >> 3) ^ (dk >> 4)) & 7) << 4));
                    const LAS float* e1 = G_E1 + d * 64 + i8;
                    const f32x4 ea = *(const LAS f32x4*)e1, eb = *(const LAS f32x4*)(e1 + 4);
                    u32x4 o;
                    o[0] = pk_bf16(bf_lo(kv[0]) * ea[0], bf_hi(kv[0]) * ea[1]); o[1] = pk_bf16(bf_lo(kv[1]) * ea[2], bf_hi(kv[1]) * ea[3]);
                    o[2] = pk_bf16(bf_lo(kv[2]) * eb[0], bf_hi(kv[2]) * eb[1]); o[3] = pk_bf16(bf_lo(kv[3]) * eb[2], bf_hi(kv[3]) * eb[3]);
                    *(u32x4*)(rec + REC_KT + img128(dk, i8)) = o;
                } else if (r < 2048) {
                    const int i = (r - 1024) >> 4, k8 = (r & 15) * 8;
                    const u32x4 qv = *(const LAS u32x4*)(lds + R_QN + i * 272 + k8 * 2);
                    const float eg = G_E2[d * 64 + i];
                    u32x4 o;
#pragma unroll
                    for (int e = 0; e < 4; ++e) o[e] = pk_bf16(bf_lo(qv[e]) * eg, bf_hi(qv[e]) * eg);
                    *(u32x4*)(rec + REC_QD + img256(i, k8)) = o;
                } else {
                    const int i = (r - 2048) >> 3, j8 = (r & 7) * 8;
                    float v[8];
#pragma unroll
                    for (int e = 0; e < 8; ++e) { const int j = j8 + e; const bool ok = d ? (j >= i) : (j <= i); v[e] = ok ? QK[i * 65 + j] * __expf(gc[i] - gc[j]) : 0.f; }
                    u32x4 o; o[0] = pk_bf16(v[0], v[1]); o[1] = pk_bf16(v[2], v[3]); o[2] = pk_bf16(v[4], v[5]); o[3] = pk_bf16(v[6], v[7]);
                    *(u32x4*)(rec + REC_QK + img128(i, j8)) = o;
                }
            }
            if (wt < 2) { *(float*)(recd[wt] + REC_MISC) = __expf(G_TOT[wt]); *(int*)(recd[wt] + REC_MISC + 4) = rowbase + t0; }
        }
        __syncthreads();
        RELAUNDER();
        for (int idx = tid; idx < 4096; idx += NTHREADS) {
            const int d = idx >> 11, q = idx & 2047, i = q >> 5, j = (q & 31) * 2, i2 = d ? 63 - i : i, j2 = d ? 63 - j : j, j3 = d ? j2 - 1 : j2 + 1;
            const LAS float* TBd = (const LAS float*)(lds + (d ? R_MT1 : R_MT0));
            const LAS float* e2 = G_E2 + d * 64; const LAS float* bt = G_BT + d * 64;
            const float t0v = TBd[i2 * 68 + j2], t1v = TBd[i2 * 68 + j3];
            const float c0 = bt[j], c1 = bt[j + 1];
            LAS unsigned char* tw = lds + (d ? R_T1 : R_T0);
            *(LAS unsigned*)(tw + 8192 + imgT(i, j)) = pk_bf16(t0v * c0, t1v * c1);
            *(LAS unsigned*)(tw + imgT(i, j)) = pk_bf16(t0v * c0 * e2[j], t1v * c1 * e2[j + 1]);
        }
        __syncthreads();
        RELAUNDER();
        {
            const int d = wid >> 2;
            unsigned char* rec = d ? recd[1] : recd[0];
            const LAS unsigned char* tw = lds + (d ? R_T1 : R_T0);
#pragma unroll
            for (int hb = 0; hb < 2; ++hb) {
                const int blk = (wid & 3) * 2 + hb;
                bf16x8 ak[2], av[2];
#pragma unroll
                for (int kk = 0; kk < 2; ++kk) { const int so = (((kk * 4 + fq) ^ blk) & 7) << 4; ak[kk] = *(const LAS bf16x8*)(lds + R_KNT + (blk * 16 + fr) * 144 + so); av[kk] = *(const LAS bf16x8*)(lds + R_VT + (blk * 16 + fr) * 144 + so); }
#pragma unroll
                for (int ib = 0; ib < 4; ++ib) {
                    f32x4 aw = (f32x4){0.f, 0.f, 0.f, 0.f}, au = (f32x4){0.f, 0.f, 0.f, 0.f};
#pragma unroll
                    for (int kk = 0; kk < 2; ++kk) {
                        const bf16x8 twf = *(const LAS bf16x8*)(tw + imgT(ib * 16 + fr, kk * 32 + fq * 8)), tuf = *(const LAS bf16x8*)(tw + 8192 + imgT(ib * 16 + fr, kk * 32 + fq * 8));
                        aw = __builtin_amdgcn_mfma_f32_16x16x32_bf16(ak[kk], twf, aw, 0, 0, 0);
                        au = __builtin_amdgcn_mfma_f32_16x16x32_bf16(tuf, av[kk], au, 0, 0, 0);
                    }
                    u32x2 ow; ow[0] = pk_bf16(aw[0], aw[1]); ow[1] = pk_bf16(aw[2], aw[3]);
                    *(u32x2*)(rec + REC_W + img256(ib * 16 + fr, blk * 16 + fq * 4)) = ow;
                    u32x2 ou; ou[0] = pk_bf16(au[0], au[1]); ou[1] = pk_bf16(au[2], au[3]);
                    *(u32x2*)(rec + REC_UT + (blk * 16 + fr) * 128 + (ib * 16 + fq * 4) * 2) = ou;
                }
            }
        }
        __syncthreads();
    }
}
#undef RELAUNDER

__device__ __forceinline__ void phase_scan(const Params& p, const int l, LAS unsigned char* lds) {
    const int tid = opaque_tid(), wid = __builtin_amdgcn_readfirstlane(tid >> 6), lane = tid & 63, fr = lane & 15, fq = lane >> 4;
    constexpr int NSL = 2, DV = 128 / NSL, NBT = DV / 16;
    constexpr int UTB = DV * 128, MISC_O = 57344 + UTB, BUFB = MISC_O + 256, R_ST = 2 * BUFB, R_UTL = R_ST + DV * 272, R_DUM = R_UTL + DV * 144;
    static_assert(R_DUM + 8 * 256 <= LDS_WORK && NBT == 4, "scan LDS / tile assumptions");
    for (int id = blockIdx.x; id < 64 * NSL; id += gridDim.x) {
        const int bhd = (id & 7) * 8 + (id >> 4), sl = (id >> 3) & 1, h = (bhd >> 1) & 3, d = bhd & 1;
        bf16_t* O = (bf16_t*)(p.ws + (d ? WS_OB : WS_OF));
        const unsigned char* rec0 = p.ws + WS_SCN + (size_t)bhd * NCHUNK * REC_BYTES;
        __syncthreads();
        for (int i = tid; i < DV * 272 / 4; i += NTHREADS) ((LAS unsigned*)(lds + R_ST))[i] = 0u;
        f32x4 sacc[NBT];
#pragma unroll
        for (int n2 = 0; n2 < NBT; ++n2) sacc[n2] = (f32x4){0.f, 0.f, 0.f, 0.f};
#define S_ISSUE(n, bufo) do { const unsigned char* _r = rec0 + (size_t)(n) * REC_BYTES; \
        _Pragma("unroll") for (int _q = 0; _q < 7; ++_q) __builtin_amdgcn_global_load_lds((const unsigned*)(_r + lane * 16 + (wid + 8 * _q) * 1024), (LAS unsigned*)(lds + (bufo) + (wid + 8 * _q) * 1024), 16, 0, 0); \
        __builtin_amdgcn_global_load_lds((const unsigned*)(_r + lane * 16 + REC_UT + sl * UTB + wid * 1024), (LAS unsigned*)(lds + (bufo) + 57344 + wid * 1024), 16, 0, 0); \
        __builtin_amdgcn_global_load_lds((const unsigned*)(_r + REC_MISC + lane * 4), (LAS unsigned*)(lds + (bufo) + MISC_O), 4, 0, 0); } while (0)
#define S_TOUCH(n) do { const int _n = (n) < NCHUNK ? (n) : NCHUNK - 1; const int _ln = wid * 64 + lane; \
        const unsigned char* _t = rec0 + (size_t)_n * REC_BYTES + (_ln < 448 ? _ln * 128 : REC_UT + sl * UTB + (_ln - 448) * 128); \
        __builtin_amdgcn_global_load_lds((const unsigned*)_t, (LAS unsigned*)(lds + R_DUM + wid * 256), 4, 0, 0); } while (0)
        S_ISSUE(0, 0); S_TOUCH(1);
        const int ib = wid >> 1, nb0 = (wid & 1) * (NBT / 2);
        for (int n = 0; n < NCHUNK; ++n) {
            if (n == 0) asm volatile("s_waitcnt vmcnt(1)" ::: "memory"); else asm volatile("s_waitcnt vmcnt(3)" ::: "memory");
            asm volatile("s_waitcnt lgkmcnt(0)" ::: "memory");
            __builtin_amdgcn_s_barrier();
            LAS unsigned char* buf = lds + (n & 1) * BUFB;
            f32x4 accP[NBT / 2], accQ[NBT / 2];
#pragma unroll
            for (int t = 0; t < NBT / 2; ++t) { accP[t] = (f32x4){0.f, 0.f, 0.f, 0.f}; accQ[t] = (f32x4){0.f, 0.f, 0.f, 0.f}; }
            bf16x8 aw[4], aq[4], sb[NBT / 2][4];
#pragma unroll
            for (int kk = 0; kk < 4; ++kk) {
                aw[kk] = *(const LAS bf16x8*)(buf + REC_W + img256(ib * 16 + fr, kk * 32 + fq * 8));
                aq[kk] = *(const LAS bf16x8*)(buf + REC_QD + img256(ib * 16 + fr, kk * 32 + fq * 8));
#pragma unroll
                for (int t = 0; t < NBT / 2; ++t) sb[t][kk] = *(const LAS bf16x8*)(lds + R_ST + ((nb0 + t) * 16 + fr) * 272 + kk * 64 + fq * 16);
            }
            u32x2 uv[NBT / 2];
#pragma unroll
            for (int t = 0; t < NBT / 2; ++t) uv[t] = *(const LAS u32x2*)(buf + REC_UT + ((nb0 + t) * 16 + fr) * 128 + (ib * 16 + fq * 4) * 2);
            __builtin_amdgcn_sched_barrier(0);
#pragma unroll
            for (int kk = 0; kk < 4; ++kk)
#pragma unroll
                for (int t = 0; t < NBT / 2; ++t) accP[t] = __builtin_amdgcn_mfma_f32_16x16x32_bf16(aw[kk], sb[t][kk], accP[t], 0, 0, 0);
            if (n + 1 < NCHUNK) { if ((n + 1) & 1) S_ISSUE(n + 1, BUFB); else S_ISSUE(n + 1, 0); S_TOUCH(n + 2); }
            bf16x8 aqk[2], ak[2];
#pragma unroll
            for (int kk = 0; kk < 2; ++kk) { aqk[kk] = *(const LAS bf16x8*)(buf + REC_QK + img128(ib * 16 + fr, kk * 32 + fq * 8)); ak[kk] = *(const LAS bf16x8*)(buf + REC_KT + img128(wid * 16 + fr, kk * 32 + fq * 8)); }
            const float sd = *(const LAS float*)(buf + MISC_O); const int rowstart = *(const LAS int*)(buf + MISC_O + 4);
#pragma unroll
            for (int t = 0; t < NBT / 2; ++t) {
                u32x2 o; o[0] = pk_bf16(bf_lo(uv[t][0]) - accP[t][0], bf_hi(uv[t][0]) - accP[t][1]); o[1] = pk_bf16(bf_lo(uv[t][1]) - accP[t][2], bf_hi(uv[t][1]) - accP[t][3]);
                *(LAS u32x2*)(lds + R_UTL + ((nb0 + t) * 16 + fr) * 144 + (ib * 16 + fq * 4) * 2) = o;
            }
#pragma unroll
            for (int kk = 0; kk < 4; ++kk)
#pragma unroll
                for (int t = 0; t < NBT / 2; ++t) accQ[t] = __builtin_amdgcn_mfma_f32_16x16x32_bf16(sb[t][kk], aq[kk], accQ[t], 0, 0, 0);
            asm volatile("s_waitcnt lgkmcnt(0)" ::: "memory");
            __builtin_amdgcn_s_barrier();
            bf16x8 ub[NBT][2];
#pragma unroll
            for (int n2 = 0; n2 < NBT; ++n2)
#pragma unroll
                for (int kk = 0; kk < 2; ++kk) ub[n2][kk] = *(const LAS bf16x8*)(lds + R_UTL + (n2 * 16 + fr) * 144 + kk * 64 + fq * 16);
            bf16x8 un[NBT / 2][2];
#pragma unroll
            for (int t = 0; t < NBT / 2; ++t)
#pragma unroll
                for (int kk = 0; kk < 2; ++kk) un[t][kk] = *(const LAS bf16x8*)(lds + R_UTL + ((nb0 + t) * 16 + fr) * 144 + kk * 64 + fq * 16);
            __builtin_amdgcn_sched_barrier(0);
#pragma unroll
            for (int n2 = 0; n2 < NBT; ++n2) {
                sacc[n2] *= sd;
#pragma unroll
                for (int kk = 0; kk < 2; ++kk) sacc[n2] = __builtin_amdgcn_mfma_f32_16x16x32_bf16(ak[kk], ub[n2][kk], sacc[n2], 0, 0, 0);
            }
#pragma unroll
            for (int kk = 0; kk < 2; ++kk)
#pragma unroll
                for (int t = 0; t < NBT / 2; ++t) accQ[t] = __builtin_amdgcn_mfma_f32_16x16x32_bf16(un[t][kk], aqk[kk], accQ[t], 0, 0, 0);
#pragma unroll
            for (int n2 = 0; n2 < NBT; ++n2) {
                u32x2 o; o[0] = pk_bf16(sacc[n2][0], sacc[n2][1]); o[1] = pk_bf16(sacc[n2][2], sacc[n2][3]);
                *(LAS u32x2*)(lds + R_ST + (n2 * 16 + fr) * 272 + (wid * 16 + fq * 4) * 2) = o;
            }
#pragma unroll
            for (int t = 0; t < NBT / 2; ++t) {
                u32x2 o; o[0] = pk_bf16(accQ[t][0], accQ[t][1]); o[1] = pk_bf16(accQ[t][2], accQ[t][3]);
                *(u32x2*)(O + (size_t)(rowstart + ib * 16 + fr) * 512 + h * 128 + sl * DV + (nb0 + t) * 16 + fq * 4) = o;
            }
        }
#undef S_ISSUE
#undef S_TOUCH
        asm volatile("s_waitcnt vmcnt(0)" ::: "memory");
        __syncthreads();
    }
}

__device__ __forceinline__ void phase_scan_naive(const Params& p, const int l, LAS unsigned char* lds) {
    const int tid = opaque_tid();
    const int lane = tid & 63;
    LAS float* ks = (LAS float*)lds;
    LAS float* qs = ks + 4096;
    LAS float* vs = qs + 4096;
    LAS float* as = vs + 4096;
    LAS float* bs = as + 32;
    LAS int* rws = (LAS int*)(bs + 32);
    const float* QKV = (const float*)(p.ws + WS_QKV);
    const float* LOGA = (const float*)(p.ws + WS_LOGA);
    const float* BETA = (const float*)(p.ws + WS_BETA);
    for (int u = blockIdx.x; u < 64; u += gridDim.x) {
        const int b = u >> 3, h = (u >> 1) & 3, d = u & 1;
        float* O = (float*)(p.ws + (d ? WS_OB : WS_OF));
        const int col = tid >> 2, part = tid & 3;
        float S[32];
#pragma unroll
        for (int i = 0; i < 32; ++i) S[i] = 0.f;
        for (int n0 = 0; n0 < CTXL + SEQ; n0 += 32) {
            __syncthreads();
            if (tid < 32) {
                const int n = n0 + tid; int row;
                if (n < CTXL) row = ROWS_LAT + b * CTXL + (d ? CTXL - 1 - n : n);
                else { const int m = n - CTXL; row = b * SEQ + (d ? SEQ - 1 - m : m); }
                rws[tid] = row;
                as[tid] = __expf(LOGA[(size_t)row * 8 + d * 4 + h]);
                bs[tid] = BETA[(size_t)row * 8 + d * 4 + h];
            }
            __syncthreads();
            for (int i = tid; i < 4096; i += NTHREADS) {
                const int tok = i >> 7, cc = i & 127; const size_t base = (size_t)rws[tok] * 1536 + h * 128 + cc;
                qs[i] = QKV[base]; ks[i] = QKV[base + 512]; vs[i] = QKV[base + 1024];
            }
            __syncthreads();
            for (int tok = 0; tok < 32; ++tok) {
                float kk[32];
#pragma unroll
                for (int i = 0; i < 8; ++i) { const f32x4 v = *(const LAS f32x4*)(ks + tok * 128 + part * 32 + i * 4); kk[i * 4] = v[0]; kk[i * 4 + 1] = v[1]; kk[i * 4 + 2] = v[2]; kk[i * 4 + 3] = v[3]; }
                float kp = 0.f;
#pragma unroll
                for (int i = 0; i < 32; ++i) kp += kk[i] * S[i];
                kp += shx(kp, 1, lane); kp += shx(kp, 2, lane);
                const float a = as[tok], bt = bs[tok];
                const float bv = bt * (vs[tok * 128 + col] - a * kp);
#pragma unroll
                for (int i = 0; i < 32; ++i) S[i] = a * S[i] + kk[i] * bv;
                float op = 0.f;
#pragma unroll
                for (int i = 0; i < 8; ++i) { const f32x4 v = *(const LAS f32x4*)(qs + tok * 128 + part * 32 + i * 4); op += v[0] * S[i * 4] + v[1] * S[i * 4 + 1] + v[2] * S[i * 4 + 2] + v[3] * S[i * 4 + 3]; }
                op += shx(op, 1, lane); op += shx(op, 2, lane);
                if (part == 0) O[(size_t)rws[tok] * 512 + h * 128 + col] = op;
            }
        }
        __syncthreads();
    }
}

__device__ __forceinline__ void phase_onorm(const Params& p, const int l) {
    const int tid = opaque_tid(), wid = tid >> 6, lane = tid & 63;
    const bf16_t* OF = (const bf16_t*)(p.ws + WS_OF); const bf16_t* OB = (const bf16_t*)(p.ws + WS_OB);
    const bf16_t* PROJ = (const bf16_t*)(p.ws + WS_PROJ);
    bf16_t* CAT = (bf16_t*)(p.ws + WS_CAT);
    const int c = lane * 8;
    const f32x4 w0 = *(const f32x4*)(p.dn_norm + l * 128 + (c & 127)), w1 = *(const f32x4*)(p.dn_norm + l * 128 + (c & 127) + 4);
    const int nrows = (l == DEPTH - 1) ? ROWS_LAT : MT;
    constexpr int R = 3;
    const int rstride = gridDim.x * 8;
    for (int base = blockIdx.x * 8 + wid; base < nrows; base += rstride * R) {
        u32x4 a[R], b[R], gv[R];
#pragma unroll
        for (int k = 0; k < R; ++k) {
            const int row = base + k * rstride; const int rr = row < nrows ? row : base;
            a[k] = *(const u32x4*)(OF + (size_t)rr * 512 + c); b[k] = *(const u32x4*)(OB + (size_t)rr * 512 + c); gv[k] = *(const u32x4*)(PROJ + (size_t)rr * PN + 1536 + c);
        }
#pragma unroll
        for (int k = 0; k < R; ++k) {
            const int row = base + k * rstride;
            const f32x4 v0 = (f32x4){bf_lo(a[k][0]) + bf_lo(b[k][0]), bf_hi(a[k][0]) + bf_hi(b[k][0]), bf_lo(a[k][1]) + bf_lo(b[k][1]), bf_hi(a[k][1]) + bf_hi(b[k][1])};
            const f32x4 v1 = (f32x4){bf_lo(a[k][2]) + bf_lo(b[k][2]), bf_hi(a[k][2]) + bf_hi(b[k][2]), bf_lo(a[k][3]) + bf_lo(b[k][3]), bf_hi(a[k][3]) + bf_hi(b[k][3])};
            float ss = v0[0] * v0[0] + v0[1] * v0[1] + v0[2] * v0[2] + v0[3] * v0[3] + v1[0] * v1[0] + v1[1] * v1[1] + v1[2] * v1[2] + v1[3] * v1[3];
            ss += shx(ss, 1, lane); ss += shx(ss, 2, lane); ss += shx(ss, 4, lane); ss += shx(ss, 8, lane);
            const float rs = rsqrtf(ss * (1.f / 128.f) + EPS);
            u32x4 out;
            out[0] = pk_bf16(v0[0] * rs * w0[0] * silu_f(bf_lo(gv[k][0])), v0[1] * rs * w0[1] * silu_f(bf_hi(gv[k][0])));
            out[1] = pk_bf16(v0[2] * rs * w0[2] * silu_f(bf_lo(gv[k][1])), v0[3] * rs * w0[3] * silu_f(bf_hi(gv[k][1])));
            out[2] = pk_bf16(v1[0] * rs * w1[0] * silu_f(bf_lo(gv[k][2])), v1[1] * rs * w1[1] * silu_f(bf_hi(gv[k][2])));
            out[3] = pk_bf16(v1[2] * rs * w1[2] * silu_f(bf_lo(gv[k][3])), v1[3] * rs * w1[3] * silu_f(bf_hi(gv[k][3])));
            if (row < nrows) *(u32x4*)(CAT + (size_t)row * D + c) = out;
        }
    }
}

__device__ __forceinline__ unsigned block_incl_scan(unsigned v, const int tid, LAS unsigned* wsum, unsigned& total) {
    const int lane = tid & 63, wv = tid >> 6;
#pragma unroll
    for (int o = 1; o < 64; o <<= 1) { const unsigned t = (unsigned)__builtin_amdgcn_ds_bpermute(((lane - o) & 63) << 2, (int)v); if (lane >= o) v += t; }
    if (lane == 63) wsum[wv] = v;
    __syncthreads();
    unsigned base = 0u, tot = 0u;
#pragma unroll
    for (int w = 0; w < 8; ++w) { const unsigned x = wsum[w]; tot += x; base += (w < wv) ? x : 0u; }
    total = tot;
    return v + base;
}

__device__ __forceinline__ void phase_topk(const Params& p, const int l, LAS unsigned char* lds) {
    const int tid = opaque_tid();
    LAS unsigned* hist = (LAS unsigned*)lds;
    LAS unsigned* wsum = hist + 4096;
    LAS unsigned* misc = wsum + 8;
    LAS unsigned long long* cand = (LAS unsigned long long*)(misc + 8);
    LAS unsigned char* selb = (LAS unsigned char*)(cand + 2048);
    const float* AFF = (const float*)(p.ws + WS_AFF);
    int* SEL = (int*)(p.ws + WS_SEL); float* SELAFF = (float*)(p.ws + WS_SELAFF); int* SLOTOF = (int*)(p.ws + WS_SLOTOF);
    const int ntk = (l == DEPTH - 1) ? 128 : 256;
    for (int u = blockIdx.x; u < ntk; u += gridDim.x) {
        int e, n, C, rowbase, slotbase;
        if (u < 128) { e = u >> 3; const int b = u & 7; n = SEQ; C = 256; rowbase = b * SEQ; slotbase = u * 256; }
        else { const int v = u - 128; e = v >> 3; const int b = v & 7; n = CTXL; C = 32; rowbase = ROWS_LAT + b * CTXL; slotbase = (128 + e) * 256 + b * 32; }
        unsigned kb[4];
#pragma unroll
        for (int k = 0; k < 4; ++k) { const int i = tid * 4 + k; kb[k] = (i < n) ? __float_as_uint(AFF[(size_t)(rowbase + i) * 16 + e]) : 0u; }
#pragma unroll
        for (int k = 0; k < 8; ++k) hist[tid * 8 + k] = 0u;
        if (tid == 0) misc[2] = 0u;
        __syncthreads();
#pragma unroll
        for (int k = 0; k < 4; ++k) if (tid * 4 + k < n) __hip_atomic_fetch_add(&hist[kb[k] >> 19], 1u, __ATOMIC_RELAXED, __HIP_MEMORY_SCOPE_WORKGROUP);
        __syncthreads();
        unsigned hl[8], s8 = 0u;
#pragma unroll
        for (int k = 0; k < 8; ++k) { hl[k] = hist[tid * 8 + k]; s8 += hl[k]; }
        unsigned total;
        const unsigned incl = block_incl_scan(s8, tid, wsum, total);
        unsigned cum = total - incl;
#pragma unroll
        for (int k = 7; k >= 0; --k) { if (cum < (unsigned)C && cum + hl[k] >= (unsigned)C) { misc[0] = (unsigned)(tid * 8 + k); misc[1] = cum; } cum += hl[k]; }
        __syncthreads();
        const unsigned thr = misc[0], G = misc[1], R = (unsigned)C - G;
#pragma unroll
        for (int k = 0; k < 4; ++k) { const int i = tid * 4 + k; if (i < n && (kb[k] >> 19) == thr) { const unsigned q = __hip_atomic_fetch_add(&misc[2], 1u, __ATOMIC_RELAXED, __HIP_MEMORY_SCOPE_WORKGROUP); cand[q] = ((unsigned long long)kb[k] << 32) | (unsigned long long)(0xFFFFFFFFu - (unsigned)i); } }
        __syncthreads();
        const unsigned E = misc[2];
        for (unsigned j = tid; j < E; j += NTHREADS) {
            const unsigned long long me = cand[j]; unsigned rank = 0u;
            for (unsigned k = 0; k < E; ++k) rank += (cand[k] > me) ? 1u : 0u;
            selb[0xFFFFFFFFu - (unsigned)(me & 0xFFFFFFFFull)] = (rank < R) ? 1 : 0;
        }
        __syncthreads();
        unsigned fl = 0u, cnt = 0u;
#pragma unroll
        for (int k = 0; k < 4; ++k) { const int i = tid * 4 + k; const unsigned bin = kb[k] >> 19;
            const bool in = (i < n) && (bin > thr || (bin == thr && selb[i] != 0)); fl |= in ? (1u << k) : 0u; cnt += in ? 1u : 0u; }
        unsigned tot2;
        unsigned pos = block_incl_scan(cnt, tid, wsum, tot2) - cnt;
#pragma unroll
        for (int k = 0; k < 4; ++k) { const int i = tid * 4 + k;
            if (i < n) { const bool in = (fl >> k) & 1u;
                SLOTOF[(size_t)(rowbase + i) * 16 + e] = in ? slotbase + (int)pos : -1;
                if (in) { SEL[slotbase + pos] = rowbase + i; SELAFF[slotbase + pos] = __uint_as_float(kb[k]); ++pos; } } }
        __syncthreads();
    }
}

#ifndef DUMP
#define DUMP 0
#endif
#if DUMP
__device__ __forceinline__ void phase_dump(const Params& p, const size_t off, const int is_bf16, const size_t n_avail) {
    const int tid = opaque_tid();
    const size_t n = (size_t)ROWS_LAT * D;
    for (size_t i = (size_t)blockIdx.x * NTHREADS + tid; i < n; i += (size_t)gridDim.x * NTHREADS) {
        float v = 0.f;
        if (i < n_avail) v = is_bf16 ? __uint_as_float((unsigned)((const bf16_t*)(p.ws + off))[i] << 16) : ((const float*)(p.ws + off))[i];
        p.out[i] = v;
    }
}
#endif

__global__ void __launch_bounds__(NTHREADS, 2) fwd(const Params p) {
    extern __shared__ __attribute__((aligned(16))) unsigned char smem[];
    LAS unsigned char* lds = (LAS unsigned char*)smem + LDS_OFF;
    XcdBarrier bar; bar.bar = (unsigned*)(p.ws + WS_BAR); bar.x = 0; bar.st = nullptr;
    const bool multi = (p.ph_hi - p.ph_lo) > 1;
    if (multi) {
        if (threadIdx.x == 0) *(LAS u32x4*)((LAS unsigned char*)smem) = (u32x4){0u, 0u, 0u, 0u};
        __syncthreads();
        bar = xcd_barrier_post((unsigned*)(p.ws + WS_BAR), (volatile LAS unsigned*)((LAS unsigned char*)smem));
    }
#if DUMP
    if (p.ph_lo == 100) { phase_dump(p, (size_t)(DUMP_OFF), DUMP_BF16, (size_t)(DUMP_N)); return; }
#endif
    int ph = 0;
#define PHASE(body) do { if (ph >= p.ph_lo && ph < p.ph_hi) { const int l = opaque_s(lv); body; if (ph + 1 < p.ph_hi) xcd_barrier(bar); } ++ph; } while (0)
    int lv = 0;
    PHASE(phase_prologue(p, lds));
    for (lv = 0; lv < DEPTH; ++lv) {
        PHASE(phase_norm<1>(p, l, lds));
        PHASE(GEMM8 ? phase_gemm8<0>(p, l, lds) : phase_gemm<0>(p, l, lds));
#if NAIVE_SCAN
        PHASE(phase_conv_pool(p, l, lds));
        PHASE(phase_scan_naive(p, l, lds));
#else
        PHASE(phase_prep(p, l, lds));
        PHASE(phase_scan(p, l, lds); phase_conv_pool(p, l, lds, (int)gridDim.x >= 256 ? 128 : 0, (int)gridDim.x >= 256 ? (int)gridDim.x - 128 : (int)gridDim.x));
#endif
        PHASE(phase_onorm(p, l));
        PHASE(GEMM8 ? phase_gemm8<1>(p, l, lds) : phase_gemm<1>(p, l, lds));
        PHASE(phase_norm<2>(p, l, lds));
        PHASE(phase_topk(p, l, lds));
        PHASE(GEMM8 ? phase_gemm8<2>(p, l, lds) : phase_gemm<2>(p, l, lds));
        PHASE(GEMM8 ? phase_gemm8<3>(p, l, lds) : phase_gemm<3>(p, l, lds));
    }
    lv = 0;
    PHASE(phase_norm<3>(p, l, lds));
#undef PHASE
}
constexpr int N_PHASES = 2 + DEPTH * 10;

extern "C" void kernel_launch(void* const* d_in, const int* in_sizes, int n_in, void* d_out, int out_size, void* d_ws, size_t ws_size, hipStream_t stream) {
    static int grid = 0;
    if (grid == 0) {
        if (n_in != 21 || out_size != ROWS_LAT * D || ws_size < WS_END) { fprintf(stderr, "kernel_launch: unexpected shapes (n_in %d out %d ws %zu need %zu)\n", n_in, out_size, ws_size, (size_t)WS_END); grid = -1; return; }
        int dev = 0, cus = 0, per_cu = 0;
        if (hipGetDevice(&dev) != hipSuccess || hipDeviceGetAttribute(&cus, hipDeviceAttributeMultiprocessorCount, dev) != hipSuccess) { grid = -1; return; }
        if (hipFuncSetAttribute((const void*)fwd, hipFuncAttributeMaxDynamicSharedMemorySize, LDS_BYTES) != hipSuccess) { fprintf(stderr, "kernel_launch: hipFuncSetAttribute failed\n"); grid = -1; return; }
        if (hipOccupancyMaxActiveBlocksPerMultiprocessor(&per_cu, (const void*)fwd, NTHREADS, LDS_BYTES) != hipSuccess || per_cu < 1) { fprintf(stderr, "kernel_launch: occupancy query says %d\n", per_cu); per_cu = 1; }
        (void)hipGetLastError();
        grid = cus;
    }
    if (grid < 0) return;
    (void)hipMemsetAsync((char*)d_ws + WS_BAR, 0, 16384, stream);
    Params p; memset(&p, 0, sizeof(p));
    const float** pp = (const float**)&p;
    for (int i = 0; i < 21; ++i) pp[i] = (const float*)d_in[i];
    p.out = (float*)d_out; p.ws = (unsigned char*)d_ws;
#if DUMP
    for (int ph = 0; ph <= DUMP_LAST; ++ph) { p.ph_lo = ph; p.ph_hi = ph + 1; hipLaunchKernelGGL(fwd, dim3(grid), dim3(NTHREADS), LDS_BYTES, stream, p); }
    p.ph_lo = 100; p.ph_hi = 101; hipLaunchKernelGGL(fwd, dim3(grid), dim3(NTHREADS), LDS_BYTES, stream, p);
#elif ONE_LAUNCH
    p.ph_lo = 0; p.ph_hi = N_PHASES;
    hipLaunchKernelGGL(fwd, dim3(grid), dim3(NTHREADS), LDS_BYTES, stream, p);
#else
    for (int ph = 0; ph < N_PHASES; ++ph) { p.ph_lo = ph; p.ph_hi = ph + 1; hipLaunchKernelGGL(fwd, dim3(grid), dim3(NTHREADS), LDS_BYTES, stream, p); }
#endif
}
```

```cpp
#include <hip/hip_runtime.h>
#include <stdint.h>
#include <stdio.h>
#include <string.h>

#ifndef ONE_LAUNCH
#define ONE_LAUNCH 1
#endif
#ifndef NAIVE_SCAN
#define NAIVE_SCAN 0
#endif
#ifndef GEMM8
#define GEMM8 1
#endif
#ifndef MOE_FP8
#define MOE_FP8 1
#endif
#ifndef REGSTAGE
#define REGSTAGE 0
#endif

#define LAS __attribute__((address_space(3)))
typedef unsigned short bf16_t;
typedef short bf16x8 __attribute__((ext_vector_type(8)));
typedef float f32x4 __attribute__((ext_vector_type(4)));
typedef float f32x2 __attribute__((ext_vector_type(2)));
typedef unsigned u32x2 __attribute__((ext_vector_type(2)));
typedef unsigned u32x4 __attribute__((ext_vector_type(4)));
typedef long i64x2 __attribute__((ext_vector_type(2)));

constexpr int D = 1024, NB = 8, SEQ = 2048, DEPTH = 4, CTXL = 256;
constexpr int ROWS_LAT = NB * SEQ;
constexpr int ROWS_CTX = NB * CTXL;
constexpr int MT = ROWS_LAT + ROWS_CTX;
constexpr int INC = 2576;
constexpr int PN = 2560;
constexpr int NE = 16;
constexpr int NGROUPS = 144;
constexpr int NSLOTS = NGROUPS * 256;
constexpr int NTHREADS = 512;
constexpr float EPS = 1e-6f;

constexpr size_t al256(size_t x) { return (x + 255) & ~(size_t)255; }
constexpr size_t WS_BAR = 0;
constexpr size_t WS_MOD = 16384;
constexpr size_t WS_X = WS_MOD + al256((size_t)DEPTH * 9 * 6144 * 4);
constexpr size_t WS_H = WS_X + (size_t)MT * D * 4;
constexpr size_t WS_PROJ = WS_H + (size_t)MT * D * 2;
constexpr size_t WS_YE = WS_PROJ;
constexpr size_t WS_LOGA = WS_PROJ + (size_t)MT * PN * 2;
constexpr size_t WS_BETA = WS_LOGA + (size_t)MT * 8 * 4;
constexpr size_t WS_QKV = WS_BETA + (size_t)MT * 8 * 4;
constexpr size_t WS_HID = WS_QKV;
constexpr size_t WS_OF = WS_QKV + (NAIVE_SCAN ? (size_t)MT * 1536 * 4 : (size_t)NSLOTS * D * 2);
constexpr size_t WS_OB = WS_OF + (size_t)MT * 512 * 4;
constexpr size_t WS_CAT = WS_OB + (size_t)MT * 512 * 4;
constexpr size_t WS_AFF = WS_CAT + (size_t)MT * D * 2;
constexpr size_t WS_SEL = WS_AFF + (size_t)MT * 16 * 4;
constexpr size_t WS_SELAFF = WS_SEL + (size_t)NSLOTS * 4;
constexpr size_t WS_SLOTOF = WS_SELAFF + (size_t)NSLOTS * 4;
constexpr size_t WS_WINT = WS_SLOTOF + (size_t)MT * 16 * 4;
constexpr size_t WS_WOUTT = WS_WINT + (size_t)DEPTH * PN * D * 2;
constexpr size_t WS_WGUT = WS_WOUTT + (size_t)DEPTH * D * D * 2;
constexpr size_t WS_WDT = WS_WGUT + (size_t)DEPTH * NE * 2048 * D * 2;
constexpr size_t WS_PWT = WS_WDT + (size_t)DEPTH * NE * D * D * 2;
constexpr size_t WS_W16T = WS_PWT + (size_t)DEPTH * 4 * 128 * 128 * 2;
constexpr size_t WS_SCN = WS_W16T + (size_t)DEPTH * 2 * 16 * D * 4;
constexpr int REC_W = 0, REC_KT = 16384, REC_QD = 32768, REC_QK = 49152, REC_UT = 57344, REC_MISC = 73728, REC_BYTES = 73984;
constexpr int NCHUNK = 36;
constexpr size_t WS_END = WS_SCN + (size_t)NB * 4 * 2 * NCHUNK * REC_BYTES + 4096;

constexpr int LDS_OFF = 1024;
constexpr int LDS_WORK = 161792;
constexpr int LDS_BYTES = LDS_OFF + LDS_WORK;

struct Params {
    const float *x, *c, *ctx, *c_ctx, *w_mod, *b_mod, *norm1, *norm2, *w_in, *conv_w, *a_log, *dt_bias, *dn_norm, *pool_w, *pool_scale, *w_out, *w_router, *w_gate, *w_up, *w_down, *norm_f;
    float* out;
    unsigned char* ws;
    int ph_lo, ph_hi;
};

#define XB_TMO      128
#define XB_XCNT(j)  (256  + 64 * (j))
#define XB_XSUB(j)  (1280 + 64 * (j))
#define XB_XGEN(j)  (2304 + 64 * (j))
#define XB_TOP      3328
#define XB_TOPGEN   3392
#define XCD_BAR_WORDS 3456
#define XB_SPIN_CAP (1u << 22)

__device__ __forceinline__ unsigned xb_ld(unsigned* p)              { return __hip_atomic_load(p, __ATOMIC_RELAXED, __HIP_MEMORY_SCOPE_AGENT); }
__device__ __forceinline__ unsigned xb_add(unsigned* p, unsigned v) { return __hip_atomic_fetch_add(p, v, __ATOMIC_RELAXED, __HIP_MEMORY_SCOPE_AGENT); }
__device__ __forceinline__ unsigned xb_xcc_id() { return (unsigned)__builtin_amdgcn_s_getreg((3 << 11) | 20) & 0xFu; }
#define XB_SPIN(cond, bar) do { unsigned _sp = 0; while (cond) { __builtin_amdgcn_s_sleep(1); \
    if ((++_sp & 255u) == 0u) { if (xb_ld(&(bar)[XB_TMO])) break; if (_sp > XB_SPIN_CAP) { atomicAdd(&(bar)[XB_TMO], 1u); break; } } } } while (0)

struct XcdBarrier { unsigned* bar; unsigned x; volatile LAS unsigned* st; };

__device__ __forceinline__ XcdBarrier xcd_barrier_post(unsigned* bar, volatile LAS unsigned* st) {
    XcdBarrier b; b.bar = bar; b.x = xb_xcc_id(); b.st = st;
    if (threadIdx.x == 0) (void)xb_add(&bar[XB_XCNT(b.x)], 1u);
    return b;
}
__device__ __forceinline__ void xcd_barrier_complete(unsigned* bar, unsigned x, unsigned& nloc, unsigned& nx) {
    const unsigned G = gridDim.x * gridDim.y * gridDim.z;
    unsigned sum, cnt, mine, sp = 0u;
    for (;;) {
        sum = 0u; cnt = 0u; mine = 0u;
#pragma unroll
        for (unsigned j = 0; j < 16; ++j) { const unsigned c = xb_ld(&bar[XB_XCNT(j)]); sum += c; cnt += (c > 0u) ? 1u : 0u; mine = (j == x) ? c : mine; }
        if (sum == G) break;
        __builtin_amdgcn_s_sleep(1);
        if ((++sp & 255u) == 0u) { if (xb_ld(&bar[XB_TMO])) break; if (sp > XB_SPIN_CAP) { atomicAdd(&bar[XB_TMO], 1u); break; } }
    }
    nloc = mine > 0u ? mine : 1u; nx = cnt > 0u ? cnt : 1u;
}
__device__ __forceinline__ void xcd_barrier(const XcdBarrier& b) {
    asm volatile("s_waitcnt vmcnt(0)" ::: "memory");
    __syncthreads();
    if (threadIdx.x == 0) {
        unsigned* bar = b.bar;
        __builtin_amdgcn_s_waitcnt(0);
        unsigned nloc = b.st[0], nx = b.st[1];
        if (nloc == 0u) { xcd_barrier_complete(bar, b.x, nloc, nx); b.st[0] = nloc; b.st[1] = nx; }
        const unsigned old = xb_add(&bar[XB_XSUB(b.x)], 1u);
        const unsigned gen = old / nloc;
        if (old + 1u == (gen + 1u) * nloc) {
            __builtin_amdgcn_fence(__ATOMIC_RELEASE, "agent");
            asm volatile("s_waitcnt vmcnt(0)" ::: "memory");
            const unsigned og = xb_add(&bar[XB_TOP], 1u);
            const unsigned tg = og / nx;
            if (og + 1u == (tg + 1u) * nx) xb_add(&bar[XB_TOPGEN], 1u);
            else XB_SPIN(xb_ld(&bar[XB_TOPGEN]) == tg, bar);
            __builtin_amdgcn_fence(__ATOMIC_ACQUIRE, "agent");
            xb_add(&bar[XB_XGEN(b.x)], 1u);
            asm volatile("s_waitcnt vmcnt(0)" ::: "memory");
        } else {
            XB_SPIN(xb_ld(&bar[XB_XGEN(b.x)]) == gen, bar);
            __builtin_amdgcn_fence(__ATOMIC_ACQUIRE, "agent");
            asm volatile("s_waitcnt vmcnt(0)" ::: "memory");
        }
    }
    __syncthreads();
}

typedef __bf16 bf16x2_t __attribute__((ext_vector_type(2)));
__device__ __forceinline__ unsigned pk_bf16(float lo, float hi) { const f32x2 v = {lo, hi}; const bf16x2_t b = __builtin_convertvector(v, bf16x2_t); return __builtin_bit_cast(unsigned, b); }
__device__ __forceinline__ unsigned pk_fp8x4(float a, float b, float c, float d) {
    int w = 0; w = __builtin_amdgcn_cvt_pk_fp8_f32(a, b, w, false); w = __builtin_amdgcn_cvt_pk_fp8_f32(c, d, w, true); return (unsigned)w; }
constexpr float F8_SW = 64.f, F8_SHID = 16.f;
__device__ __forceinline__ float bf_lo(unsigned u) { return __uint_as_float(u << 16); }
__device__ __forceinline__ float bf_hi(unsigned u) { return __uint_as_float(u & 0xffff0000u); }
__device__ __forceinline__ float shx(float v, int mask, int lane) { return __int_as_float(__builtin_amdgcn_ds_bpermute((lane ^ mask) << 2, __float_as_int(v))); }
__device__ __forceinline__ float shup(float v, int o, int lane) { return __int_as_float(__builtin_amdgcn_ds_bpermute(((lane - o) & 63) << 2, __float_as_int(v))); }
__device__ __forceinline__ float wave_sum(float v, int lane) {
#pragma unroll
    for (int o = 32; o > 0; o >>= 1) v += shx(v, o, lane);
    return v;
}
__device__ __forceinline__ int opaque_tid() { int t = threadIdx.x; asm volatile("" : "+v"(t)); return t; }
__device__ __forceinline__ int opaque_s(int v) { asm volatile("" : "+s"(v)); return v; }
__device__ __forceinline__ float silu_f(float v) { return v * __builtin_amdgcn_rcpf(1.f + __expf(-v)); }

__device__ __forceinline__ int lds_byte(int r, int c) { const int st = (r >> 4) * 2 + (c >> 5), rr = r & 15, cc = c & 31, ob = rr * 64 + cc * 2; return st * 1024 + (ob ^ (((ob >> 9) & 1) << 5)); }
__device__ __forceinline__ void stage_rc(int b, int& R, int& C) { const int st = b >> 10, sb = b & 1023, swz = sb ^ (((sb >> 9) & 1) << 5); R = (st >> 1) * 16 + (swz >> 6); C = (st & 1) * 32 + ((swz & 63) >> 1); }

constexpr int T_IN = 10 * 16, T_OUT = 4 * 16, T_EXP = NE * 4 * 16, T_LAYER = T_IN + T_OUT + 3 * T_EXP;
__device__ __forceinline__ void convert_tiles(const Params& p, const int l, const int first, const int count, const int f, const int nf, LAS unsigned char* lds) {
    const int tid = opaque_tid();
    bf16_t* WINT = (bf16_t*)(p.ws + WS_WINT); bf16_t* WOUTT = (bf16_t*)(p.ws + WS_WOUTT); bf16_t* WGUT = (bf16_t*)(p.ws + WS_WGUT); bf16_t* WDT = (bf16_t*)(p.ws + WS_WDT);
    const int lane = tid & 63, wv = tid >> 6, ko = lane & 7, nq = wv * 8 + (lane >> 3);
    f32x4 rv[8]; const float* src = nullptr; size_t sld = 0;
#define CT_DECODE(t, SRC, SLD, DST, RS, F8) do { int i = (t); RS = 16; F8 = 0; \
        if (i < T_IN) { const int nt = i >> 4, kt = i & 15; const int n0 = nt < 6 ? nt * 256 : 1552 + (nt - 6) * 256; \
            SRC = p.w_in + ((size_t)l * D + kt * 64) * INC + n0; SLD = INC; DST = WINT + ((size_t)l * PN + nt * 256) * D + kt * 64; } \
        else if (i < T_IN + T_OUT) { i -= T_IN; const int nt = i >> 4, kt = i & 15; \
            SRC = p.w_out + ((size_t)l * D + kt * 64) * D + nt * 256; SLD = D; DST = WOUTT + ((size_t)l * D + nt * 256) * D + kt * 64; } \
        else { i -= T_IN + T_OUT; const int which = i / T_EXP; i %= T_EXP; const int e = i >> 6, nt = (i >> 4) & 3, kt = i & 15; \
            const size_t mo = ((size_t)(l * NE + e) * D + kt * 64) * D + nt * 256; \
            F8 = MOE_FP8; \
            if (which == 2) { SRC = p.w_down + mo; DST = WDT + (((size_t)(l * NE + e) * D + nt * 256) * D + kt * 64) / (MOE_FP8 ? 2 : 1); } \
            else { SRC = (which == 0 ? p.w_gate : p.w_up) + mo; RS = 32; DST = WGUT + (((size_t)(l * NE + e) * 2048 + nt * 512 + which * 16) * D + kt * 64) / (MOE_FP8 ? 2 : 1); } \
            SLD = D; } } while (0)
#define CT_LOAD() do { _Pragma("unroll") for (int j = 0; j < 8; ++j) rv[j] = *(const f32x4*)(src + (size_t)(ko * 8 + j) * sld + nq * 4); } while (0)
    bf16_t* dst = nullptr; int rs = 16, f8 = 0;
    int t = first + f;
    if (t < first + count) { CT_DECODE(t, src, sld, dst, rs, f8); CT_LOAD(); }
    for (; t < first + count; t += nf) {
        u32x4 o[4];
        const int fcur = f8;
        if (fcur) {
#pragma unroll
            for (int e = 0; e < 4; ++e) { o[e][0] = pk_fp8x4(rv[0][e] * F8_SW, rv[1][e] * F8_SW, rv[2][e] * F8_SW, rv[3][e] * F8_SW); o[e][1] = pk_fp8x4(rv[4][e] * F8_SW, rv[5][e] * F8_SW, rv[6][e] * F8_SW, rv[7][e] * F8_SW); o[e][2] = 0u; o[e][3] = 0u; }
        } else {
#pragma unroll
            for (int e = 0; e < 4; ++e) { o[e][0] = pk_bf16(rv[0][e], rv[1][e]); o[e][1] = pk_bf16(rv[2][e], rv[3][e]); o[e][2] = pk_bf16(rv[4][e], rv[5][e]); o[e][3] = pk_bf16(rv[6][e], rv[7][e]); }
        }
        bf16_t* dcur = dst; const int rcur = rs;
        if (t + nf < first + count) { CT_DECODE(t + nf, src, sld, dst, rs, f8); CT_LOAD(); }
        if (fcur) {
#pragma unroll
            for (int e = 0; e < 4; ++e) { const int n = nq * 4 + e; u32x2 o2; o2[0] = o[e][0]; o2[1] = o[e][1];
                *(u32x2*)((unsigned char*)dcur + (size_t)((n >> 4) * rcur + (n & 15)) * D + ko * 8) = o2; }
        } else {
#pragma unroll
            for (int e = 0; e < 4; ++e) { const int n = nq * 4 + e; *(u32x4*)(dcur + (size_t)((n >> 4) * rcur + (n & 15)) * D + ko * 8) = o[e]; }
        }
    }
#undef CT_DECODE
#undef CT_LOAD
}

__device__ __forceinline__ void phase_prologue(const Params& p, LAS unsigned char* lds) {
    const int tid = opaque_tid();
    {
        LAS float* sc = (LAS float*)lds;
        LAS float* red = sc + 9 * 1024;
        for (int idx = tid; idx < 9 * 1024; idx += NTHREADS) {
            const int r = idx >> 10, k = idx & 1023;
            const float v = r < 8 ? p.c[r * 1024 + k] : p.c_ctx[k];
            sc[idx] = silu_f(v);
        }
        __syncthreads();
        float* MOD = (float*)(p.ws + WS_MOD);
        for (int u = blockIdx.x; u < DEPTH * 192; u += gridDim.x) {
            const int l = u / 192, c0 = (u % 192) * 32, col = tid & 31, kg = tid >> 5;
            float acc[9];
#pragma unroll
            for (int r = 0; r < 9; ++r) acc[r] = 0.f;
            const float* W = p.w_mod + ((size_t)l * 1024 + kg * 64) * 6144 + c0 + col;
            for (int k0 = 0; k0 < 64; k0 += 8) {
                float w[8];
#pragma unroll
                for (int j = 0; j < 8; ++j) w[j] = W[(size_t)(k0 + j) * 6144];
#pragma unroll
                for (int r = 0; r < 9; ++r) {
                    const f32x4 s0 = *(const LAS f32x4*)(sc + r * 1024 + kg * 64 + k0), s1 = *(const LAS f32x4*)(sc + r * 1024 + kg * 64 + k0 + 4);
                    acc[r] += s0[0] * w[0] + s0[1] * w[1] + s0[2] * w[2] + s0[3] * w[3] + s1[0] * w[4] + s1[1] * w[5] + s1[2] * w[6] + s1[3] * w[7];
                }
            }
#pragma unroll
            for (int r = 0; r < 9; ++r) red[(kg * 9 + r) * 32 + col] = acc[r];
            __syncthreads();
            if (tid < 288) {
                const int r = tid >> 5, cc = tid & 31;
                float sv = 0.f;
#pragma unroll
                for (int g = 0; g < 16; ++g) sv += red[(g * 9 + r) * 32 + cc];
                MOD[((size_t)l * 9 + r) * 6144 + c0 + cc] = sv + p.b_mod[l * 6144 + c0 + cc];
            }
            __syncthreads();
        }
    }
    {
        convert_tiles(p, 0, 0, T_LAYER, (int)blockIdx.x, (int)gridDim.x, lds);
        {
            float* W16T = (float*)(p.ws + WS_W16T);
            for (int i = blockIdx.x * NTHREADS + tid; i < DEPTH * 2 * 16 * D; i += gridDim.x * NTHREADS) {
                const int l2 = i >> 15, wh = (i >> 14) & 1, j = (i >> 10) & 15, k = i & 1023;
                W16T[i] = wh ? p.w_router[((size_t)l2 * D + k) * NE + j] : p.w_in[((size_t)l2 * D + k) * INC + 1536 + j];
            }
        }
        bf16_t* PWT = (bf16_t*)(p.ws + WS_PWT);
        for (int i = blockIdx.x * NTHREADS + tid; i < DEPTH * 4 * 128 * 128; i += gridDim.x * NTHREADS) {
            const int lg = i >> 14, d = (i >> 7) & 127, c = i & 127;
            PWT[i] = (bf16_t)(pk_bf16(p.pool_w[((size_t)lg * 128 + c) * 128 + d], 0.f) & 0xffffu);
        }
    }
}

__device__ __forceinline__ float reduce4(const float v0, const float v1, const float v2, const float v3, const int lane) {
    const bool b5 = lane & 32, b4 = lane & 16;
    const float a0 = (b5 ? v2 : v0) + shx(b5 ? v0 : v2, 32, lane), a1 = (b5 ? v3 : v1) + shx(b5 ? v1 : v3, 32, lane);
    float c = (b4 ? a1 : a0) + shx(b4 ? a0 : a1, 16, lane);
    c += shx(c, 8, lane); c += shx(c, 4, lane); c += shx(c, 2, lane); c += shx(c, 1, lane);
    return c;
}

template <int WHICH>
__device__ __forceinline__ void phase_norm(const Params& p, const int l, LAS unsigned char* lds) {
    const int tid = opaque_tid(), wid = tid >> 6, lane = tid & 63;
    LAS float* wsm = (LAS float*)lds;
    if (WHICH != 3) {
        const f32x4* src = (const f32x4*)(p.ws + WS_W16T) + (size_t)(l * 2 + (WHICH == 2 ? 1 : 0)) * 4096;
        f32x4 fv[8];
#pragma unroll
        for (int i = 0; i < 8; ++i) fv[i] = src[tid + i * NTHREADS];
#pragma unroll
        for (int i = 0; i < 8; ++i) *(LAS f32x4*)(wsm + (tid + i * NTHREADS) * 4) = fv[i];
        {
            const float* nwp = WHICH == 1 ? p.norm1 + l * D : p.norm2 + l * D;
            const float* mdp = (const float*)(p.ws + WS_MOD) + (size_t)l * 9 * 6144 + (WHICH == 1 ? 0 : 3072);
            for (int idx = tid; idx < 9 * 256; idx += NTHREADS) {
                const int sm = idx >> 8, c = (idx & 255) * 4;
                const f32x4 w = *(const f32x4*)(nwp + c), sh = *(const f32x4*)(mdp + (size_t)sm * 6144 + c), scl = *(const f32x4*)(mdp + (size_t)sm * 6144 + 1024 + c);
                *(LAS f32x4*)(wsm + 16384 + sm * 1024 + c) = w * (scl + 1.f);
                *(LAS f32x4*)(wsm + 16384 + 9216 + sm * 1024 + c) = sh;
            }
        }
        __syncthreads();
    }
    const float* nw = WHICH == 1 ? p.norm1 + l * D : (WHICH == 2 ? p.norm2 + l * D : p.norm_f);
    float* X = (float*)(p.ws + WS_X);
    const float* MOD = (const float*)(p.ws + WS_MOD);
    bf16_t* H = (bf16_t*)(p.ws + WS_H);
    const int nrows = (WHICH == 3 || (WHICH == 2 && l == DEPTH - 1)) ? ROWS_LAT : MT;
    constexpr int R = 3;
    const int rstride = gridDim.x * 8;
    const bool comb = (WHICH == 1 && l > 0) || WHICH == 3;
    const bool first_layer = (WHICH == 1 && l == 0);
    f32x4 xn[R][4]; int svn[R];
#define NORM_LOAD(b0) do { _Pragma("unroll") for (int k = 0; k < R; ++k) { const int row = (b0) + k * rstride; svn[k] = -1; \
        if (row < nrows) { const float* xr = first_layer ? (row < ROWS_LAT ? p.x + (size_t)row * D : p.ctx + (size_t)(row - ROWS_LAT) * D) : X + (size_t)row * D; \
            _Pragma("unroll") for (int i = 0; i < 4; ++i) xn[k][i] = *(const f32x4*)(xr + i * 256 + lane * 4); \
            if (comb && lane < 16) svn[k] = ((const int*)(p.ws + WS_SLOTOF))[(size_t)row * 16 + lane]; } \
        else { _Pragma("unroll") for (int i = 0; i < 4; ++i) xn[k][i] = (f32x4){0.f, 0.f, 0.f, 0.f}; } } } while (0)
    NORM_LOAD(blockIdx.x * 8 + wid);
    for (int base = blockIdx.x * 8 + wid; base < nrows; base += rstride * R) {
        f32x4 xv[R][4]; int sv[R]; bool ok[R];
#pragma unroll
        for (int k = 0; k < R; ++k) { ok[k] = (base + k * rstride) < nrows; sv[k] = svn[k];
#pragma unroll
            for (int i = 0; i < 4; ++i) xv[k][i] = xn[k][i]; }
        if (first_layer) {
#pragma unroll
            for (int k = 0; k < R; ++k) if (ok[k]) {
#pragma unroll
                for (int i = 0; i < 4; ++i) *(f32x4*)(X + (size_t)(base + k * rstride) * D + i * 256 + lane * 4) = xv[k][i]; }
        }
        if (comb) {
            const bf16_t* YE = (const bf16_t*)(p.ws + WS_YE);
            f32x4 a[R][4]; unsigned long long msk[R];
#pragma unroll
            for (int k = 0; k < R; ++k) { msk[k] = __ballot(sv[k] >= 0);
#pragma unroll
                for (int i = 0; i < 4; ++i) a[k][i] = (f32x4){0.f, 0.f, 0.f, 0.f}; }
            while (msk[0] | msk[1] | msk[2]) {
                u32x2 t[R][2][4]; bool has[R][2];
#pragma unroll
                for (int k = 0; k < R; ++k)
#pragma unroll
                    for (int q = 0; q < 2; ++q) {
                        has[k][q] = msk[k] != 0ull;
                        if (has[k][q]) {
                            const int e = __builtin_ctzll(msk[k]); msk[k] &= msk[k] - 1ull;
                            const int sl = __builtin_amdgcn_readlane(sv[k], e);
                            const bf16_t* yr = YE + (size_t)sl * D;
#pragma unroll
                            for (int i = 0; i < 4; ++i) t[k][q][i] = *(const u32x2*)(yr + i * 256 + lane * 4);
                        }
                    }
#pragma unroll
                for (int k = 0; k < R; ++k)
#pragma unroll
                    for (int q = 0; q < 2; ++q) if (has[k][q]) {
#pragma unroll
                        for (int i = 0; i < 4; ++i) { a[k][i][0] += bf_lo(t[k][q][i][0]); a[k][i][1] += bf_hi(t[k][q][i][0]); a[k][i][2] += bf_lo(t[k][q][i][1]); a[k][i][3] += bf_hi(t[k][q][i][1]); }
                    }
            }
#pragma unroll
            for (int k = 0; k < R; ++k) if (ok[k]) {
                const int row = base + k * rstride;
#pragma unroll
                for (int i = 0; i < 4; ++i) { xv[k][i] += a[k][i];
                    if (WHICH == 1) *(f32x4*)(X + (size_t)row * D + i * 256 + lane * 4) = xv[k][i]; }
            }
        }
        float rstd[R];
#pragma unroll
        for (int k = 0; k < R; ++k) {
            float ss = 0.f;
#pragma unroll
            for (int i = 0; i < 4; ++i) ss += xv[k][i][0] * xv[k][i][0] + xv[k][i][1] * xv[k][i][1] + xv[k][i][2] * xv[k][i][2] + xv[k][i][3] * xv[k][i][3];
            rstd[k] = rsqrtf(wave_sum(ss, lane) * (1.f / 1024.f) + EPS);
        }
        if (WHICH == 3) {
            if (base + rstride * R < nrows) NORM_LOAD(base + rstride * R);
#pragma unroll
            for (int k = 0; k < R; ++k) if (ok[k]) {
                const int row = base + k * rstride;
#pragma unroll
                for (int i = 0; i < 4; ++i) { const f32x4 w = *(const f32x4*)(nw + i * 256 + lane * 4); *(f32x4*)(p.out + (size_t)row * D + i * 256 + lane * 4) = xv[k][i] * rstd[k] * w; }
            }
            continue;
        }
#pragma unroll
        for (int k = 0; k < R; ++k) {
            const int row = base + k * rstride, bidx = row < ROWS_LAT ? (row >> 11) : 8;
#pragma unroll
            for (int i = 0; i < 4; ++i) {
                const int c = i * 256 + lane * 4;
                const f32x4 av = *(const LAS f32x4*)(wsm + 16384 + bidx * 1024 + c), sh = *(const LAS f32x4*)(wsm + 16384 + 9216 + bidx * 1024 + c);
                xv[k][i] = (xv[k][i] * rstd[k]) * av + sh;
                if (ok[k]) {
                    if (MOE_FP8 && WHICH == 2) *(unsigned*)((unsigned char*)H + (size_t)row * D + c) = pk_fp8x4(xv[k][i][0], xv[k][i][1], xv[k][i][2], xv[k][i][3]);
                    else { u32x2 o; o[0] = pk_bf16(xv[k][i][0], xv[k][i][1]); o[1] = pk_bf16(xv[k][i][2], xv[k][i][3]); *(u32x2*)(H + (size_t)row * D + c) = o; }
                }
            }
        }
        if (base + rstride * R < nrows) NORM_LOAD(base + rstride * R);
        float dj[R][4];
#pragma unroll
        for (int jg = 0; jg < 4; ++jg) {
            float sp[R][4];
#pragma unroll
            for (int jj = 0; jj < 4; ++jj) {
                const int j = jg * 4 + jj;
                f32x2 s0 = {0.f, 0.f}, s1 = {0.f, 0.f}, s2 = {0.f, 0.f};
#pragma unroll
                for (int i = 0; i < 4; ++i) { const f32x4 w = *(const LAS f32x4*)(wsm + j * 1024 + i * 256 + lane * 4);
                    const f32x2 wl = {w[0], w[1]}, wh = {w[2], w[3]};
                    s0 += (f32x2){xv[0][i][0], xv[0][i][1]} * wl; s0 += (f32x2){xv[0][i][2], xv[0][i][3]} * wh;
                    s1 += (f32x2){xv[1][i][0], xv[1][i][1]} * wl; s1 += (f32x2){xv[1][i][2], xv[1][i][3]} * wh;
                    s2 += (f32x2){xv[2][i][0], xv[2][i][1]} * wl; s2 += (f32x2){xv[2][i][2], xv[2][i][3]} * wh; }
                sp[0][jj] = s0[0] + s0[1]; sp[1][jj] = s1[0] + s1[1]; sp[2][jj] = s2[0] + s2[1];
            }
#pragma unroll
            for (int k = 0; k < R; ++k) dj[k][jg] = reduce4(sp[k][0], sp[k][1], sp[k][2], sp[k][3], lane);
            __builtin_amdgcn_sched_barrier(0);
        }
        const int q = lane >> 4;
#pragma unroll
        for (int k = 0; k < R; ++k) {
            const int row = base + k * rstride;
            if (WHICH == 1) {
                if (ok[k] && (lane & 15) == 0) {
#pragma unroll
                    for (int jg = 0; jg < 4; ++jg) {
                        const int j = jg * 4 + q; const float v = dj[k][jg];
                        if (jg < 2) { const float xa = v + p.dt_bias[l * 8 + j]; const float sp2 = xa > 20.f ? xa : log1pf(__expf(xa));
                            ((float*)(p.ws + WS_LOGA))[(size_t)row * 8 + j] = -__expf(p.a_log[l * 8 + j]) * sp2; }
                        else ((float*)(p.ws + WS_BETA))[(size_t)row * 8 + (j - 8)] = 1.f / (1.f + __expf(-v));
                    }
                }
            } else {
                float m = fmaxf(fmaxf(dj[k][0], dj[k][1]), fmaxf(dj[k][2], dj[k][3]));
                m = fmaxf(m, shx(m, 16, lane)); m = fmaxf(m, shx(m, 32, lane));
                float e[4], sum = 0.f;
#pragma unroll
                for (int jg = 0; jg < 4; ++jg) { e[jg] = __expf(dj[k][jg] - m); sum += e[jg]; }
                sum += shx(sum, 16, lane); sum += shx(sum, 32, lane);
                const float inv = 1.f / sum;
                if (ok[k] && (lane & 15) == 0) {
#pragma unroll
                    for (int jg = 0; jg < 4; ++jg) ((float*)(p.ws + WS_AFF))[(size_t)row * 16 + jg * 4 + q] = e[jg] * inv;
                }
            }
        }
    }
}

#undef NORM_LOAD
__device__ __forceinline__ void gemm_core(const unsigned char* Ab, const unsigned (&aoff)[4], const unsigned char* Bb, const unsigned (&boff)[2], const int nt,
                                          LAS unsigned char* lds, f32x4 (&acc)[4][4], const int wid, const int lane) {
    const int wr = wid >> 1, wc = wid & 1, fr = lane & 15, fq = lane >> 4;
    const int ar = lds_byte(wr * 64 + fr, fq * 8), br = lds_byte(wc * 64 + fr, fq * 8);
    const unsigned ldsw = (unsigned)wid * 1024u;
#define G_STAGE(t, buf) do { const unsigned _ko = (unsigned)(t) * 128u; \
        _Pragma("unroll") for (int _i = 0; _i < 4; ++_i) __builtin_amdgcn_global_load_lds((const unsigned*)(Ab + aoff[_i] + _ko), (LAS unsigned*)(lds + (buf) * 49152 + ldsw + _i * 8192), 16, 0, 0); \
        _Pragma("unroll") for (int _i = 0; _i < 2; ++_i) __builtin_amdgcn_global_load_lds((const unsigned*)(Bb + boff[_i] + _ko), (LAS unsigned*)(lds + (buf) * 49152 + 32768 + ldsw + _i * 8192), 16, 0, 0); } while (0)
#pragma unroll
    for (int m = 0; m < 4; ++m)
#pragma unroll
        for (int n = 0; n < 4; ++n) acc[m][n] = (f32x4){0.f, 0.f, 0.f, 0.f};
#if REGSTAGE
    u32x4 ra[4], rb[2];
#pragma unroll
    for (int i = 0; i < 4; ++i) ra[i] = *(const u32x4*)(Ab + aoff[i]);
#pragma unroll
    for (int i = 0; i < 2; ++i) rb[i] = *(const u32x4*)(Bb + boff[i]);
    const unsigned tb = (unsigned)(wid * 64 + lane) * 16u;
    for (int t = 0; t < nt; ++t) {
        __syncthreads();
#pragma unroll
        for (int i = 0; i < 4; ++i) *(LAS u32x4*)(lds + tb + i * 8192) = ra[i];
#pragma unroll
        for (int i = 0; i < 2; ++i) *(LAS u32x4*)(lds + 32768 + tb + i * 8192) = rb[i];
        __syncthreads();
        if (t + 1 < nt) {
            const unsigned ko = (unsigned)(t + 1) * 128u;
#pragma unroll
            for (int i = 0; i < 4; ++i) ra[i] = *(const u32x4*)(Ab + aoff[i] + ko);
#pragma unroll
            for (int i = 0; i < 2; ++i) rb[i] = *(const u32x4*)(Bb + boff[i] + ko);
        }
        LAS unsigned char* bA = lds; LAS unsigned char* bB = bA + 32768;
        bf16x8 af[4][2], bfr[4][2];
#pragma unroll
        for (int m = 0; m < 4; ++m)
#pragma unroll
            for (int k = 0; k < 2; ++k) af[m][k] = *(const LAS bf16x8*)(bA + ar + m * 2048 + k * 1024);
#pragma unroll
        for (int n = 0; n < 4; ++n)
#pragma unroll
            for (int k = 0; k < 2; ++k) bfr[n][k] = *(const LAS bf16x8*)(bB + br + n * 2048 + k * 1024);
#pragma unroll
        for (int k = 0; k < 2; ++k)
#pragma unroll
            for (int m = 0; m < 4; ++m)
#pragma unroll
                for (int n = 0; n < 4; ++n) acc[m][n] = __builtin_amdgcn_mfma_f32_16x16x32_bf16(bfr[n][k], af[m][k], acc[m][n], 0, 0, 0);
    }
#else
    G_STAGE(0, 0);
    for (int t = 0; t < nt; ++t) {
        asm volatile("s_waitcnt vmcnt(0)" ::: "memory");
        __syncthreads();
        if (t + 1 < nt) { if ((t + 1) & 1) G_STAGE(t + 1, 1); else G_STAGE(t + 1, 0); }
        LAS unsigned char* bA = lds + (t & 1) * 49152; LAS unsigned char* bB = bA + 32768;
        bf16x8 af[4][2], bfr[4][2];
#pragma unroll
        for (int m = 0; m < 4; ++m)
#pragma unroll
            for (int k = 0; k < 2; ++k) af[m][k] = *(const LAS bf16x8*)(bA + ar + m * 2048 + k * 1024);
#pragma unroll
        for (int n = 0; n < 4; ++n)
#pragma unroll
            for (int k = 0; k < 2; ++k) bfr[n][k] = *(const LAS bf16x8*)(bB + br + n * 2048 + k * 1024);
#pragma unroll
        for (int k = 0; k < 2; ++k)
#pragma unroll
            for (int m = 0; m < 4; ++m)
#pragma unroll
                for (int n = 0; n < 4; ++n) acc[m][n] = __builtin_amdgcn_mfma_f32_16x16x32_bf16(bfr[n][k], af[m][k], acc[m][n], 0, 0, 0);
    }
#endif
    __syncthreads();
#undef G_STAGE
}

template <int MODE>
__device__ __forceinline__ void phase_gemm(const Params& p, const int l, LAS unsigned char* lds) {
    const int tid = opaque_tid(), wid = __builtin_amdgcn_readfirstlane(tid >> 6), lane = tid & 63;
    const int wr = wid >> 1, wc = wid & 1, fr = lane & 15, fq = lane >> 4;
    int R0, C0; stage_rc(tid * 16, R0, C0);
    constexpr int nN = MODE == 0 ? 20 : (MODE == 1 ? 8 : (MODE == 2 ? 16 : 8));
    constexpr int nM = (MODE <= 1) ? MT / 256 : NGROUPS;
    const bf16_t* H = (const bf16_t*)(p.ws + WS_H);
    for (int u = blockIdx.x; u < nM * nN; u += gridDim.x) {
        const int pm = u / nN, pn = u % nN;
        const unsigned char* Ab; const unsigned char* Bb; unsigned aoff[4], boff[2];
#pragma unroll
        for (int i = 0; i < 2; ++i) boff[i] = (unsigned)((R0 + 64 * i) * D + C0) * 2u;
        int e = 0;
        if (MODE == 0) {
            Ab = (const unsigned char*)(H + (size_t)pm * 256 * D); Bb = (const unsigned char*)((const bf16_t*)(p.ws + WS_WINT) + ((size_t)l * PN + pn * 128) * D);
#pragma unroll
            for (int i = 0; i < 4; ++i) aoff[i] = (unsigned)((R0 + 64 * i) * D + C0) * 2u;
        } else if (MODE == 1) {
            Ab = (const unsigned char*)((const bf16_t*)(p.ws + WS_CAT) + (size_t)pm * 256 * D); Bb = (const unsigned char*)((const bf16_t*)(p.ws + WS_WOUTT) + ((size_t)l * D + pn * 128) * D);
#pragma unroll
            for (int i = 0; i < 4; ++i) aoff[i] = (unsigned)((R0 + 64 * i) * D + C0) * 2u;
        } else if (MODE == 2) {
            e = pm < 128 ? (pm >> 3) : (pm - 128);
            const int* SEL = (const int*)(p.ws + WS_SEL) + pm * 256;
            Ab = (const unsigned char*)H; Bb = (const unsigned char*)((const bf16_t*)(p.ws + WS_WGUT) + ((size_t)(l * NE + e) * 2048 + pn * 128) * D);
#pragma unroll
            for (int i = 0; i < 4; ++i) aoff[i] = (unsigned)(SEL[R0 + 64 * i] * D + C0) * 2u;
        } else {
            e = pm < 128 ? (pm >> 3) : (pm - 128);
            Ab = (const unsigned char*)((const bf16_t*)(p.ws + WS_HID) + (size_t)pm * 256 * D); Bb = (const unsigned char*)((const bf16_t*)(p.ws + WS_WDT) + ((size_t)(l * NE + e) * D + pn * 128) * D);
#pragma unroll
            for (int i = 0; i < 4; ++i) aoff[i] = (unsigned)((R0 + 64 * i) * D + C0) * 2u;
        }
        f32x4 acc[4][4];
        gemm_core(Ab, aoff, Bb, boff, D / 64, lds, acc, wid, lane);
        if (MODE == 0) {
            bf16_t* PROJ = (bf16_t*)(p.ws + WS_PROJ);
#pragma unroll
            for (int m = 0; m < 4; ++m) { const size_t row = (size_t)pm * 256 + wr * 64 + m * 16 + fr;
#pragma unroll
                for (int n = 0; n < 4; ++n) { u32x2 o; o[0] = pk_bf16(acc[m][n][0], acc[m][n][1]); o[1] = pk_bf16(acc[m][n][2], acc[m][n][3]);
                    *(u32x2*)(PROJ + row * PN + pn * 128 + wc * 64 + n * 16 + fq * 4) = o; } }
        } else if (MODE == 1) {
            float* X = (float*)(p.ws + WS_X);
            const int bidx = pm < 64 ? (pm >> 3) : 8;
            const float* g1 = (const float*)(p.ws + WS_MOD) + ((size_t)l * 9 + bidx) * 6144 + 2048;
#pragma unroll
            for (int n = 0; n < 4; ++n) { const int col = pn * 128 + wc * 64 + n * 16 + fq * 4; const f32x4 g = *(const f32x4*)(g1 + col);
#pragma unroll
                for (int m = 0; m < 4; ++m) { float* xp = X + ((size_t)pm * 256 + wr * 64 + m * 16 + fr) * D + col; *(f32x4*)xp = *(const f32x4*)xp + g * acc[m][n]; } }
        } else if (MODE == 2) {
            bf16_t* HID = (bf16_t*)(p.ws + WS_HID);
#pragma unroll
            for (int m = 0; m < 4; ++m) { const size_t slot = (size_t)pm * 256 + wr * 64 + m * 16 + fr;
#pragma unroll
                for (int q = 0; q < 2; ++q) { const f32x4 g = acc[m][2 * q], uu = acc[m][2 * q + 1];
                    u32x2 o; o[0] = pk_bf16(silu_f(g[0]) * uu[0], silu_f(g[1]) * uu[1]); o[1] = pk_bf16(silu_f(g[2]) * uu[2], silu_f(g[3]) * uu[3]);
                    *(u32x2*)(HID + slot * D + pn * 64 + wc * 32 + q * 16 + fq * 4) = o; } }
        } else {
            bf16_t* YE = (bf16_t*)(p.ws + WS_YE);
            const float* SELAFF = (const float*)(p.ws + WS_SELAFF);
#pragma unroll
            for (int m = 0; m < 4; ++m) { const size_t slot = (size_t)pm * 256 + wr * 64 + m * 16 + fr; const float a = SELAFF[slot];
#pragma unroll
                for (int n = 0; n < 4; ++n) { const f32x4 g = *(const f32x4*)((const float*)(p.ws + WS_MOD) + ((size_t)l * 9 + (pm < 128 ? (pm & 7) : 8)) * 6144 + 5 * 1024 + pn * 128 + wc * 64 + n * 16 + fq * 4);
                    u32x2 o; o[0] = pk_bf16(acc[m][n][0] * a * g[0], acc[m][n][1] * a * g[1]); o[1] = pk_bf16(acc[m][n][2] * a * g[2], acc[m][n][3] * a * g[3]);
                    *(u32x2*)(YE + slot * D + pn * 128 + wc * 64 + n * 16 + fq * 4) = o; } }
        }
    }
}

struct UnitOps { const unsigned char* A; const unsigned char* B; unsigned va[2][2]; int pm, pn; };

template <int MODE> __device__ __forceinline__ int gemm_nunits(const int l) {
    const bool last = (l == DEPTH - 1);
    if (MODE == 0) return last ? 640 + 8 * 6 : 720;
    if (MODE == 1) return last ? 256 : 288;
    if (MODE == 2) return last ? 1024 : 1152;
    return last ? 512 : 576;
}
template <int MODE>
__device__ __forceinline__ bool gemm_unit(const Params& p, const int l, const int i, const int R0, const int C0, UnitOps& u) {
    constexpr int nN = MODE == 0 ? 10 : (MODE == 1 ? 4 : (MODE == 2 ? 8 : 4));
    const int G = gridDim.x, c = (G & 7) == 0 ? (int)(blockIdx.x & 7) * (G >> 3) + (int)(blockIdx.x >> 3) : (int)blockIdx.x;
    const int idx = c + i * G;
    if (idx >= gemm_nunits<MODE>(l)) return false;
    int pm = idx / nN, pn = idx % nN;
    if (MODE == 0 && idx >= 640 && l == DEPTH - 1) { pm = 64 + (idx - 640) / 6; pn = (idx - 640) % 6; }
    u.pm = pm; u.pn = pn;
    constexpr unsigned RB = (MOE_FP8 && MODE >= 2) ? D : 2 * D;
    if (MODE == 2) {
        const int e = pm < 128 ? (pm >> 3) : (pm - 128);
        const int* SEL = (const int*)(p.ws + WS_SEL) + pm * 256;
        u.A = p.ws + WS_H; u.B = p.ws + WS_WGUT + ((size_t)(l * NE + e) * 2048 + pn * 256) * RB;
#pragma unroll
        for (int h = 0; h < 2; ++h)
#pragma unroll
            for (int k = 0; k < 2; ++k) u.va[h][k] = (unsigned)SEL[h * 128 + R0 + 64 * k] * RB + (unsigned)C0 * 2u;
    } else {
        if (MODE == 0) { u.A = p.ws + WS_H + (size_t)pm * 256 * RB; u.B = p.ws + WS_WINT + ((size_t)l * PN + pn * 256) * RB; }
        else if (MODE == 1) { u.A = p.ws + WS_CAT + (size_t)pm * 256 * RB; u.B = p.ws + WS_WOUTT + ((size_t)l * D + pn * 256) * RB; }
        else { const int e = pm < 128 ? (pm >> 3) : (pm - 128); u.A = p.ws + WS_HID + (size_t)pm * 256 * RB; u.B = p.ws + WS_WDT + ((size_t)(l * NE + e) * D + pn * 256) * RB; }
#pragma unroll
        for (int h = 0; h < 2; ++h)
#pragma unroll
            for (int k = 0; k < 2; ++k) u.va[h][k] = (unsigned)(h * 128 + R0 + 64 * k) * RB + (unsigned)C0 * 2u;
    }
    return true;
}

template <int MODE>
__device__ __forceinline__ void gemm_epilogue(const Params& p, const int l, const f32x4 (&acc)[2][2][4][2], const UnitOps& u, const int wr, const int wc, const int fr, const int fq) {
    const int row0 = u.pm * 256 + wr * 64 + fr, col0 = u.pn * 256 + wc * 32 + (MODE == 2 ? 4 : 8) * fq;
    if (MODE == 0) {
        bf16_t* PROJ = (bf16_t*)(p.ws + WS_PROJ);
#pragma unroll
        for (int ai = 0; ai < 2; ++ai)
#pragma unroll
            for (int m = 0; m < 4; ++m) { bf16_t* rp = PROJ + (size_t)(row0 + ai * 128 + m * 16) * PN + col0;
#pragma unroll
                for (int bj = 0; bj < 2; ++bj) { const f32x4 v0 = acc[ai][bj][m][0], v1 = acc[ai][bj][m][1];
                    u32x4 o; o[0] = pk_bf16(v0[0], v0[1]); o[1] = pk_bf16(v0[2], v0[3]); o[2] = pk_bf16(v1[0], v1[1]); o[3] = pk_bf16(v1[2], v1[3]); *(u32x4*)(rp + bj * 128) = o; } }
    } else if (MODE == 1) {
        float* X = (float*)(p.ws + WS_X);
        const int bidx = u.pm < 64 ? (u.pm >> 3) : 8;
        const float* g1 = (const float*)(p.ws + WS_MOD) + ((size_t)l * 9 + bidx) * 6144 + 2048 + col0;
        f32x4 gv[2][2];
#pragma unroll
        for (int bj = 0; bj < 2; ++bj)
#pragma unroll
            for (int n = 0; n < 2; ++n) gv[bj][n] = *(const f32x4*)(g1 + bj * 128 + n * 4);
#pragma unroll
        for (int ai = 0; ai < 2; ++ai)
#pragma unroll
            for (int m = 0; m < 4; ++m) { float* rp = X + (size_t)(row0 + ai * 128 + m * 16) * D + col0;
#pragma unroll
                for (int bj = 0; bj < 2; ++bj)
#pragma unroll
                    for (int n = 0; n < 2; ++n) { float* xp = rp + bj * 128 + n * 4; *(f32x4*)xp = *(const f32x4*)xp + gv[bj][n] * acc[ai][bj][m][n]; } }
    } else if (MODE == 2) {
        const int f0 = u.pn * 128 + wc * 16 + 4 * fq;
        if (MOE_FP8) {
            unsigned char* HID8 = p.ws + WS_HID;
            constexpr float us = 1.f / F8_SW;
#pragma unroll
            for (int ai = 0; ai < 2; ++ai)
#pragma unroll
                for (int m = 0; m < 4; ++m) { unsigned char* rp = HID8 + (size_t)(row0 + ai * 128 + m * 16) * D + f0;
#pragma unroll
                    for (int bj = 0; bj < 2; ++bj) { const f32x4 g = acc[ai][bj][m][0] * us, uu = acc[ai][bj][m][1] * (us * F8_SHID);
                        *(unsigned*)(rp + bj * 64) = pk_fp8x4(silu_f(g[0]) * uu[0], silu_f(g[1]) * uu[1], silu_f(g[2]) * uu[2], silu_f(g[3]) * uu[3]); } }
        } else {
        bf16_t* HID = (bf16_t*)(p.ws + WS_HID);
#pragma unroll
        for (int ai = 0; ai < 2; ++ai)
#pragma unroll
            for (int m = 0; m < 4; ++m) { bf16_t* rp = HID + (size_t)(row0 + ai * 128 + m * 16) * D + f0;
#pragma unroll
                for (int bj = 0; bj < 2; ++bj) { const f32x4 g = acc[ai][bj][m][0], uu = acc[ai][bj][m][1];
                    u32x2 o; o[0] = pk_bf16(silu_f(g[0]) * uu[0], silu_f(g[1]) * uu[1]); o[1] = pk_bf16(silu_f(g[2]) * uu[2], silu_f(g[3]) * uu[3]);
                    *(u32x2*)(rp + bj * 64) = o; } }
        }
    } else {
        bf16_t* YE = (bf16_t*)(p.ws + WS_YE);
        const float* SELAFF = (const float*)(p.ws + WS_SELAFF);
        const int bidx = u.pm < 128 ? (u.pm & 7) : 8;
        const float* g2 = (const float*)(p.ws + WS_MOD) + ((size_t)l * 9 + bidx) * 6144 + 5 * 1024 + col0;
        f32x4 gv[2][2];
#pragma unroll
        for (int bj = 0; bj < 2; ++bj)
#pragma unroll
            for (int n = 0; n < 2; ++n) gv[bj][n] = *(const f32x4*)(g2 + bj * 128 + n * 4);
#pragma unroll
        for (int ai = 0; ai < 2; ++ai)
#pragma unroll
            for (int m = 0; m < 4; ++m) { const size_t slot = (size_t)(row0 + ai * 128 + m * 16); const float a = SELAFF[slot] * (MOE_FP8 ? 1.f / (F8_SW * F8_SHID) : 1.f); bf16_t* rp = YE + slot * D + col0;
#pragma unroll
                for (int bj = 0; bj < 2; ++bj) { const f32x4 v0 = acc[ai][bj][m][0] * gv[bj][0] * a, v1 = acc[ai][bj][m][1] * gv[bj][1] * a;
                    u32x4 o; o[0] = pk_bf16(v0[0], v0[1]); o[1] = pk_bf16(v0[2], v0[3]); o[2] = pk_bf16(v1[0], v1[1]); o[3] = pk_bf16(v1[2], v1[3]); *(u32x4*)(rp + bj * 128) = o; } }
    }
}

template <int MODE>
__device__ __forceinline__ void gemm_filler(const Params& p, const int l, LAS unsigned char* lds) {
    if (MODE == 0 || l >= DEPTH - 1) return;
    const int G = gridDim.x, c = (G & 7) == 0 ? (int)(blockIdx.x & 7) * (G >> 3) + (int)(blockIdx.x >> 3) : (int)blockIdx.x;
    const int rem = gemm_nunits<MODE>(l) % G;
    if (rem == 0 || c < rem) return;
    constexpr int first = MODE == 1 ? 0 : (MODE == 2 ? 1344 : 2240), count = MODE == 1 ? 1344 : (MODE == 2 ? 896 : 1056);
    convert_tiles(p, l + 1, first, count, c - rem, G - rem, lds);
}

template <int MODE>
__device__ __forceinline__ void phase_gemm8(const Params& p, const int l, LAS unsigned char* lds) {
    const int tid = opaque_tid(), wid = __builtin_amdgcn_readfirstlane(tid >> 6), lane = tid & 63, wr = wid >> 2, wc = wid & 3, fr = lane & 15, fq = lane >> 4;
    constexpr int HTB = 16384;
    constexpr bool F8 = MOE_FP8 && MODE >= 2;
    constexpr int nt = F8 ? D / 128 : D / 64;
    constexpr unsigned RB = F8 ? D : 2 * D;
    constexpr unsigned kstep = 128u, hstepB = 128u * RB;
    int R0, C0; stage_rc(tid * 16, R0, C0);
    constexpr bool PERM = (MODE != 2);
    unsigned vb[2];
#pragma unroll
    for (int k = 0; k < 2; ++k) { const int R = R0 + 64 * k, rho = R & 31, Rb = PERM ? ((R & ~31) + 8 * ((rho & 15) >> 2) + 4 * (rho >> 4) + (rho & 3)) : R; vb[k] = (unsigned)Rb * RB + (unsigned)C0 * 2u; }
    const unsigned ldsw = (unsigned)wid * 1024u;
    const int aoff = lds_byte(wr * 64 + fr, fq * 8), boff = lds_byte(wc * 32 + fr, fq * 8);
#define G8_SA(b, h) (((b) * 2 + (h)) * HTB)
#define G8_SB(b, h) ((4 + (b) * 2 + (h)) * HTB)
#define G8_STAGE_A(bufoff, U, h, ko) do { _Pragma("unroll") for (int _i = 0; _i < 2; ++_i) \
        __builtin_amdgcn_global_load_lds((const unsigned*)((U).A + (U).va[h][_i] + (ko)), (LAS unsigned*)(lds + (bufoff) + ldsw + _i * 8192), 16, 0, 0); } while (0)
#define G8_STAGE_B(bufoff, U, h, ko) do { _Pragma("unroll") for (int _i = 0; _i < 2; ++_i) \
        __builtin_amdgcn_global_load_lds((const unsigned*)((U).B + vb[_i] + (h) * hstepB + (ko)), (LAS unsigned*)(lds + (bufoff) + ldsw + _i * 8192), 16, 0, 0); } while (0)
#define G8_LDA(dst, b, h) do { _Pragma("unroll") for (int m = 0; m < 4; ++m) _Pragma("unroll") for (int k = 0; k < 2; ++k) dst[m][k] = *(const LAS bf16x8*)(lds + G8_SA(b, h) + aoff + m * 2048 + k * 1024); } while (0)
#define G8_LDB(dst, b, h) do { _Pragma("unroll") for (int n = 0; n < 2; ++n) _Pragma("unroll") for (int k = 0; k < 2; ++k) dst[n][k] = *(const LAS bf16x8*)(lds + G8_SB(b, h) + boff + n * 2048 + k * 1024); } while (0)
#define G8_MMA(ai, bj, At, Bt) do { __builtin_amdgcn_s_setprio(1); _Pragma("unroll") for (int m = 0; m < 4; ++m) _Pragma("unroll") for (int n = 0; n < 2; ++n) _Pragma("unroll") for (int k = 0; k < 2; ++k) { \
        if (F8) { const i64x2 _a = __builtin_bit_cast(i64x2, At[m][k]), _b = __builtin_bit_cast(i64x2, Bt[n][k]); \
            acc[ai][bj][m][n] = __builtin_amdgcn_mfma_f32_16x16x32_fp8_fp8(_b[0], _a[0], acc[ai][bj][m][n], 0, 0, 0); \
            acc[ai][bj][m][n] = __builtin_amdgcn_mfma_f32_16x16x32_fp8_fp8(_b[1], _a[1], acc[ai][bj][m][n], 0, 0, 0); } \
        else acc[ai][bj][m][n] = __builtin_amdgcn_mfma_f32_16x16x32_bf16(Bt[n][k], At[m][k], acc[ai][bj][m][n], 0, 0, 0); } __builtin_amdgcn_s_setprio(0); } while (0)
#define G8_WAIT_V(n) asm volatile("s_waitcnt vmcnt(" #n ")" ::: "memory")
#define G8_WAIT_L(n) asm volatile("s_waitcnt lgkmcnt(" #n ")" ::: "memory")
#define G8_BAR __builtin_amdgcn_s_barrier()
#define G8_SCHED __builtin_amdgcn_sched_barrier(0)
    UnitOps cur, nxt; int ui = 0;
    if (!gemm_unit<MODE>(p, l, 0, R0, C0, cur)) { gemm_filler<MODE>(p, l, lds); return; }
    f32x4 acc[2][2][4][2];
#pragma unroll
    for (int a = 0; a < 2; ++a)
#pragma unroll
        for (int b = 0; b < 2; ++b)
#pragma unroll
            for (int m = 0; m < 4; ++m)
#pragma unroll
                for (int n = 0; n < 2; ++n) acc[a][b][m][n] = (f32x4){0.f, 0.f, 0.f, 0.f};
    bf16x8 At[4][2], B0[2][2], B1[2][2];
    bool has_next = gemm_unit<MODE>(p, l, 1, R0, C0, nxt);
    if (!has_next) nxt = cur;
    G8_STAGE_B(G8_SB(0, 0), cur, 0, 0u); G8_STAGE_A(G8_SA(0, 0), cur, 0, 0u); G8_STAGE_B(G8_SB(0, 1), cur, 1, 0u); G8_STAGE_A(G8_SA(0, 1), cur, 1, 0u);
    if (wr == 1) G8_BAR;
    G8_WAIT_V(4); G8_BAR;
    G8_STAGE_B(G8_SB(1, 0), cur, 0, kstep); G8_STAGE_A(G8_SA(1, 0), cur, 0, kstep); G8_STAGE_B(G8_SB(1, 1), cur, 1, kstep);
    G8_WAIT_V(6); G8_BAR;
    for (;;) {
#pragma unroll 1
        for (int t = 0; t < nt; t += 2) {
            const bool last = (t == nt - 2);
            const unsigned k1 = (unsigned)(t + 1) * kstep, k2 = last ? 0u : (unsigned)(t + 2) * kstep, k3 = k2 + kstep;
            UnitOps& U2 = last ? nxt : cur;
            G8_LDB(B0, 0, 0); G8_SCHED; G8_LDA(At, 0, 0); G8_STAGE_A(G8_SA(1, 1), cur, 1, k1);
            G8_WAIT_L(8); G8_BAR; G8_WAIT_L(0); G8_MMA(0, 0, At, B0); G8_BAR; G8_SCHED;
            G8_LDB(B1, 0, 1); G8_STAGE_B(G8_SB(0, 0), U2, 0, k2);
            G8_BAR; G8_WAIT_L(0); G8_MMA(0, 1, At, B1); G8_BAR;
            G8_LDA(At, 0, 1); G8_STAGE_A(G8_SA(0, 0), U2, 0, k2);
            G8_BAR; G8_WAIT_L(0); G8_MMA(1, 0, At, B0); G8_BAR; G8_SCHED;
            G8_STAGE_B(G8_SB(0, 1), U2, 1, k2);
            G8_WAIT_V(6); G8_BAR; G8_MMA(1, 1, At, B1); G8_BAR;
            G8_LDB(B0, 1, 0); G8_SCHED; G8_LDA(At, 1, 0); G8_STAGE_A(G8_SA(0, 1), U2, 1, k2);
            G8_WAIT_L(8); G8_BAR; G8_WAIT_L(0); G8_MMA(0, 0, At, B0); G8_BAR; G8_SCHED;
            G8_LDB(B1, 1, 1); G8_STAGE_B(G8_SB(1, 0), U2, 0, k3);
            G8_BAR; G8_WAIT_L(0); G8_MMA(0, 1, At, B1); G8_BAR;
            G8_LDA(At, 1, 1); G8_STAGE_A(G8_SA(1, 0), U2, 0, k3);
            G8_BAR; G8_WAIT_L(0); G8_MMA(1, 0, At, B0); G8_BAR; G8_SCHED;
            G8_STAGE_B(G8_SB(1, 1), U2, 1, k3);
            G8_WAIT_V(6); G8_BAR; G8_MMA(1, 1, At, B1); G8_BAR;
        }
        gemm_epilogue<MODE>(p, l, acc, cur, wr, wc, fr, fq);
        if (!has_next) break;
#pragma unroll
        for (int a = 0; a < 2; ++a)
#pragma unroll
            for (int b = 0; b < 2; ++b)
#pragma unroll
                for (int m = 0; m < 4; ++m)
#pragma unroll
                    for (int n = 0; n < 2; ++n) acc[a][b][m][n] = (f32x4){0.f, 0.f, 0.f, 0.f};
        cur = nxt; ++ui;
        has_next = gemm_unit<MODE>(p, l, ui + 1, R0, C0, nxt);
        if (!has_next) nxt = cur;
    }
    G8_WAIT_V(0);
    if (wr == 0) G8_BAR;
    G8_BAR;
    gemm_filler<MODE>(p, l, lds);
#undef G8_SA
#undef G8_SB
#undef G8_STAGE_A
#undef G8_STAGE_B
#undef G8_LDA
#undef G8_LDB
#undef G8_MMA
#undef G8_WAIT_V
#undef G8_WAIT_L
#undef G8_BAR
#undef G8_SCHED
}

template <int B>
__device__ __forceinline__ void pool_vsum(const bf16_t* src0, const size_t rstep, const int lo_r, const int hi_r, const int rc, const int npieces, LAS float* V, LAS unsigned char* U, const int tid) {
    for (int p0 = tid; p0 < npieces; p0 += 2 * NTHREADS) {
        const int p1 = p0 + NTHREADS; const bool two = p1 < npieces;
        const bf16_t* sa = src0 + (size_t)(p0 >> 4) * PN + (p0 & 15) * 8;
        const bf16_t* sb = src0 + (size_t)((two ? p1 : p0) >> 4) * PN + ((two ? p1 : p0) & 15) * 8;
        float aa[8], ab[8];
#pragma unroll
        for (int e = 0; e < 8; ++e) { aa[e] = 0.f; ab[e] = 0.f; }
        for (int r0 = lo_r; r0 < hi_r; r0 += B) {
            u32x4 va[B], vb[B];
#pragma unroll
            for (int k = 0; k < B; ++k) { const int rr = min(r0 + k, hi_r - 1); va[k] = *(const u32x4*)(sa + (size_t)rr * rstep); vb[k] = *(const u32x4*)(sb + (size_t)rr * rstep); }
#pragma unroll
            for (int k = 0; k < B; ++k) if (r0 + k < hi_r) {
                if (r0 + k == rc) { *(LAS u32x4*)(U + (p0 >> 4) * 256 + (p0 & 15) * 16) = va[k]; if (two) *(LAS u32x4*)(U + (p1 >> 4) * 256 + (p1 & 15) * 16) = vb[k]; }
#pragma unroll
                for (int e = 0; e < 4; ++e) { aa[2 * e] += bf_lo(va[k][e]); aa[2 * e + 1] += bf_hi(va[k][e]); ab[2 * e] += bf_lo(vb[k][e]); ab[2 * e + 1] += bf_hi(vb[k][e]); }
            }
        }
        *(LAS f32x4*)(V + (p0 >> 4) * 128 + (p0 & 15) * 8) = (f32x4){aa[0], aa[1], aa[2], aa[3]};
        *(LAS f32x4*)(V + (p0 >> 4) * 128 + (p0 & 15) * 8 + 4) = (f32x4){aa[4], aa[5], aa[6], aa[7]};
        if (two) { *(LAS f32x4*)(V + (p1 >> 4) * 128 + (p1 & 15) * 8) = (f32x4){ab[0], ab[1], ab[2], ab[3]};
                   *(LAS f32x4*)(V + (p1 >> 4) * 128 + (p1 & 15) * 8 + 4) = (f32x4){ab[4], ab[5], ab[6], ab[7]}; }
    }
}

__device__ __forceinline__ void phase_conv_pool(const Params& p, const int l, LAS unsigned char* lds, const int wg0 = 0, const int nwg = 0) {
    const int tid = opaque_tid(), wid = tid >> 6, lane = tid & 63;
    const bf16_t* PROJ = (const bf16_t*)(p.ws + WS_PROJ);
    if (NAIVE_SCAN) {
        float* QKV = (float*)(p.ws + WS_QKV);
        const float* cw = p.conv_w + (size_t)l * 4 * 1536;
        for (int task = blockIdx.x * 8 + wid; task < MT * 12; task += gridDim.x * 8) {
            const int row = task / 12, part = task % 12;
            int s0, len;
            if (row < ROWS_LAT) { s0 = row & ~2047; len = 2048; } else { s0 = ROWS_LAT + ((row - ROWS_LAT) & ~255); len = 256; }
            const int c = part * 128 + lane * 2;
            float a0 = 0.f, a1 = 0.f;
#pragma unroll
            for (int j = 0; j < 4; ++j) {
                const int r2 = row + j - 2;
                if (r2 >= s0 && r2 < s0 + len) {
                    const unsigned v = *(const unsigned*)(PROJ + (size_t)r2 * PN + c);
                    const f32x2 w = *(const f32x2*)(cw + j * 1536 + c);
                    a0 += w[0] * bf_lo(v); a1 += w[1] * bf_hi(v);
                }
            }
            a0 = silu_f(a0); a1 = silu_f(a1);
            if (part < 8) {
                const float ss = wave_sum(a0 * a0 + a1 * a1, lane);
                float sc = rsqrtf(ss + EPS);
                if (part < 4) sc *= 0.08838834764831845f;
                a0 *= sc; a1 *= sc;
            }
            *(f32x2*)(QKV + (size_t)row * 1536 + c) = (f32x2){a0, a1};
        }
    }
    {
        LAS float* V = (LAS float*)lds;
        LAS unsigned char* mt = lds + 40960;
        const bf16_t* PWT = (const bf16_t*)(p.ws + WS_PWT);
        bf16_t* CAT = (bf16_t*)(p.ws + WS_CAT);
        const int wr = wid >> 1, wc = wid & 1, fr = lane & 15, fq = lane >> 4;
        const int npool = (l == DEPTH - 1) ? 1024 : 1152;
        const int pstep = nwg > 0 ? nwg : (int)gridDim.x;
        for (int u = ((int)blockIdx.x >= wg0) ? (int)blockIdx.x - wg0 : npool; u < npool; u += pstep) {
            int g, r, nrows, ncols, c0, rowbase;
            if (u < 1024) { const int q = u & 255, b = q >> 5; g = (q + (u >> 8)) & 3; r = q & 31; nrows = 32; ncols = 64; c0 = 0; rowbase = b * 2048; }
            else { const int v = u - 1024; const int b = v >> 4; g = (v >> 2) & 3; r = 0; nrows = 1; ncols = 256; c0 = (v & 3) * 64; rowbase = ROWS_LAT + b * 256; }
            const int w = 2 << g, half = w >> 1;
            const int lo_r = max(r - half, 0), hi_r = min(r - half + w, nrows);
            const int cxlo = max(c0 - half, 0), cxhi = min(c0 + 64 + half, ncols);
            const bf16_t* ub = PROJ + 2048 + g * 128;
            const bf16_t* pw = PWT + (size_t)(l * 4 + g) * 128 * 128;
            bf16x8 pwf[4][4];
#pragma unroll
            for (int kk = 0; kk < 4; ++kk)
#pragma unroll
                for (int n = 0; n < 4; ++n) pwf[kk][n] = *(const bf16x8*)(pw + (size_t)(wc * 64 + n * 16 + fr) * 128 + kk * 32 + fq * 8);
            {
                const int npieces = (cxhi - cxlo) * 16;
                const size_t rstep = (size_t)ncols * PN;
                if (g == 0) pool_vsum<2>(ub + (size_t)(rowbase + cxlo) * PN, rstep, lo_r, hi_r, r, npieces, V, lds + 58368, tid);
                else if (g == 1) pool_vsum<4>(ub + (size_t)(rowbase + cxlo) * PN, rstep, lo_r, hi_r, r, npieces, V, lds + 58368, tid);
                else pool_vsum<8>(ub + (size_t)(rowbase + cxlo) * PN, rstep, lo_r, hi_r, r, npieces, V, lds + 58368, tid);
            }
            __syncthreads();
            for (int idx = tid; idx < 64 * 64; idx += NTHREADS) {
                const int ci = idx >> 6, ch = (idx & 63) * 2, c = c0 + ci;
                const int lo_c = max(c - half, 0), hi_c = min(c - half + w, ncols);
                float s0 = 0.f, s1 = 0.f;
                for (int cx = lo_c; cx < hi_c; ++cx) { s0 += V[(cx - cxlo) * 128 + ch]; s1 += V[(cx - cxlo) * 128 + ch + 1]; }
                const float inv = __builtin_amdgcn_rcpf((float)((hi_r - lo_r) * (hi_c - lo_c)));
                const unsigned v = *(const LAS unsigned*)(lds + 58368 + (c - cxlo) * 256 + ch * 2);
                *(LAS unsigned*)(mt + ci * 272 + ch * 2) = pk_bf16(s0 * inv - bf_lo(v), s1 * inv - bf_hi(v));
            }
            __syncthreads();
            f32x4 acc[4];
#pragma unroll
            for (int n = 0; n < 4; ++n) acc[n] = (f32x4){0.f, 0.f, 0.f, 0.f};
#pragma unroll
            for (int kk = 0; kk < 4; ++kk) {
                const bf16x8 a = *(const LAS bf16x8*)(mt + (wr * 16 + fr) * 272 + (kk * 32 + fq * 8) * 2);
#pragma unroll
                for (int n = 0; n < 4; ++n) acc[n] = __builtin_amdgcn_mfma_f32_16x16x32_bf16(pwf[kk][n], a, acc[n], 0, 0, 0);
            }
            const size_t row = (size_t)rowbase + r * ncols + c0 + wr * 16 + fr;
#pragma unroll
            for (int n = 0; n < 4; ++n) {
                const int dcol = g * 128 + wc * 64 + n * 16 + fq * 4;
                const f32x4 s = *(const f32x4*)(p.pool_scale + l * 512 + dcol);
                u32x2 o; o[0] = pk_bf16(acc[n][0] * s[0], acc[n][1] * s[1]); o[1] = pk_bf16(acc[n][2] * s[2], acc[n][3] * s[3]);
                *(u32x2*)(CAT + row * D + 512 + dcol) = o;
            }
            __syncthreads();
        }
    }
}


__device__ __forceinline__ int img256(int row, int col) { return row * 256 + ((((col >> 3) ^ row) & 15) << 4) + (col & 7) * 2; }
__device__ __forceinline__ int img128(int row, int col) { return (row >> 1) * 256 + (row & 1) * 128 + ((((col >> 3) ^ (row >> 1)) & 7) << 4) + (col & 7) * 2; }

__device__ __forceinline__ void prep_tchain(const int lane, LAS float* MT, LAS float* XS) {
    const int fr = lane & 15, fq = lane >> 4;
    {
        const int bb = lane >> 4, c = lane & 15;
        float tc[16];
#pragma unroll
        for (int a = 0; a < 16; ++a) {
            float sv = (a == c) ? 1.f : 0.f;
#pragma unroll
            for (int q = 0; q < (a + 3) / 4; ++q) {
                const f32x4 m4 = *(const LAS f32x4*)(MT + (bb * 16 + a) * 68 + bb * 16 + q * 4);
#pragma unroll
                for (int e = 0; e < 4; ++e) if (q * 4 + e < a) sv -= m4[e] * tc[q * 4 + e];
            }
            tc[a] = sv;
        }
#pragma unroll
        for (int a = 0; a < 16; ++a) MT[(bb * 16 + a) * 68 + bb * 16 + c] = tc[a];
    }
    {
        f32x4 x0 = (f32x4){0.f, 0.f, 0.f, 0.f}, x1 = (f32x4){0.f, 0.f, 0.f, 0.f};
#pragma unroll
        for (int ks = 0; ks < 4; ++ks) {
            x0 = __builtin_amdgcn_mfma_f32_16x16x4f32(MT[(16 + fr) * 68 + ks * 4 + fq], MT[(ks * 4 + fq) * 68 + fr], x0, 0, 0, 0);
            x1 = __builtin_amdgcn_mfma_f32_16x16x4f32(MT[(48 + fr) * 68 + 32 + ks * 4 + fq], MT[(32 + ks * 4 + fq) * 68 + 32 + fr], x1, 0, 0, 0);
        }
#pragma unroll
        for (int r = 0; r < 4; ++r) { XS[(fq * 4 + r) * 17 + fr] = x0[r]; XS[272 + (fq * 4 + r) * 17 + fr] = x1[r]; }
        f32x4 y0 = (f32x4){0.f, 0.f, 0.f, 0.f}, y1 = (f32x4){0.f, 0.f, 0.f, 0.f};
#pragma unroll
        for (int ks = 0; ks < 4; ++ks) {
            y0 = __builtin_amdgcn_mfma_f32_16x16x4f32(MT[(16 + fr) * 68 + 16 + ks * 4 + fq], XS[(ks * 4 + fq) * 17 + fr], y0, 0, 0, 0);
            y1 = __builtin_amdgcn_mfma_f32_16x16x4f32(MT[(48 + fr) * 68 + 48 + ks * 4 + fq], XS[272 + (ks * 4 + fq) * 17 + fr], y1, 0, 0, 0);
        }
#pragma unroll
        for (int r = 0; r < 4; ++r) { MT[(16 + fq * 4 + r) * 68 + fr] = -y0[r]; MT[(48 + fq * 4 + r) * 68 + 32 + fr] = -y1[r]; }
    }
    {
        f32x4 y[2][2];
#pragma unroll
        for (int ti = 0; ti < 2; ++ti)
#pragma unroll
            for (int tj = 0; tj < 2; ++tj) y[ti][tj] = (f32x4){0.f, 0.f, 0.f, 0.f};
#pragma unroll
        for (int ks = 0; ks < 8; ++ks) {
            const float b0 = MT[(ks * 4 + fq) * 68 + fr], b1 = MT[(ks * 4 + fq) * 68 + 16 + fr];
#pragma unroll
            for (int ti = 0; ti < 2; ++ti) {
                const float a = MT[(32 + ti * 16 + fr) * 68 + ks * 4 + fq];
                y[ti][0] = __builtin_amdgcn_mfma_f32_16x16x4f32(a, b0, y[ti][0], 0, 0, 0);
                y[ti][1] = __builtin_amdgcn_mfma_f32_16x16x4f32(a, b1, y[ti][1], 0, 0, 0);
            }
        }
#pragma unroll
        for (int ti = 0; ti < 2; ++ti)
#pragma unroll
            for (int tj = 0; tj < 2; ++tj)
#pragma unroll
                for (int r = 0; r < 4; ++r) XS[(ti * 16 + fq * 4 + r) * 33 + tj * 16 + fr] = y[ti][tj][r];
        f32x4 z[2][2];
#pragma unroll
        for (int ti = 0; ti < 2; ++ti)
#pragma unroll
            for (int tj = 0; tj < 2; ++tj) z[ti][tj] = (f32x4){0.f, 0.f, 0.f, 0.f};
#pragma unroll
        for (int ks = 0; ks < 8; ++ks) {
            const float b0 = XS[(ks * 4 + fq) * 33 + fr], b1 = XS[(ks * 4 + fq) * 33 + 16 + fr];
#pragma unroll
            for (int ti = 0; ti < 2; ++ti) {
                const float a = MT[(32 + ti * 16 + fr) * 68 + 32 + ks * 4 + fq];
                z[ti][0] = __builtin_amdgcn_mfma_f32_16x16x4f32(a, b0, z[ti][0], 0, 0, 0);
                z[ti][1] = __builtin_amdgcn_mfma_f32_16x16x4f32(a, b1, z[ti][1], 0, 0, 0);
            }
        }
#pragma unroll
        for (int ti = 0; ti < 2; ++ti)
#pragma unroll
            for (int tj = 0; tj < 2; ++tj)
#pragma unroll
                for (int r = 0; r < 4; ++r) MT[(32 + ti * 16 + fq * 4 + r) * 68 + tj * 16 + fr] = -z[ti][tj][r];
    }
}

__device__ __forceinline__ int imgT(int i, int j) { return i * 128 + ((((j >> 3) ^ i) & 7) << 4) + (j & 7) * 2; }

__device__ __forceinline__ void phase_prep(const Params& p, const int l, LAS unsigned char* lds) {
    int tid = opaque_tid(), wid = __builtin_amdgcn_readfirstlane(tid >> 6), lane = tid & 63, fr = lane & 15, fq = lane >> 4;
#define RELAUNDER() do { asm volatile("" : "+v"(tid)); wid = __builtin_amdgcn_readfirstlane(tid >> 6); lane = tid & 63; fr = lane & 15; fq = lane >> 4; } while (0)
    constexpr int R_MT0 = 0, R_MT1 = 17408, R_QK = 34816, R_QN = 53248, R_KN = 70656, R_KNT = 88064, R_VT = 106496, R_G = 143360;
    constexpr int R_T0 = R_QK, R_T1 = 124928;
    LAS float* QK = (LAS float*)(lds + R_QK);
    LAS float* G_LA = (LAS float*)(lds + R_G);
    LAS float* G_BT = G_LA + 128;
    LAS float* G_GC = G_BT + 128;
    LAS float* G_TOT = G_GC + 128;
    LAS float* G_E1 = G_TOT + 16;
    LAS float* G_E2 = G_E1 + 128;
    LAS float* XS = G_E2 + 128;
    LAS float* CW = XS + 2176;
    static_assert(R_G + (128 * 5 + 16 + 2176 + 1536) * 4 <= LDS_WORK, "prep LDS");
    const bf16_t* PROJ = (const bf16_t*)(p.ws + WS_PROJ);
    const float* LOGA = (const float*)(p.ws + WS_LOGA); const float* BETA = (const float*)(p.ws + WS_BETA);
    int cur_h = -1;
    for (int u = blockIdx.x; u < NB * 4 * NCHUNK; u += gridDim.x) {
        const int h = u & 3, b = (u >> 2) / 36, cc = (u >> 2) % 36;
        if (h != cur_h) {
            __syncthreads();
            for (int idx = tid; idx < 1536; idx += NTHREADS) { const int j = idx / 384, rm = idx % 384, seg = rm >> 7, c = rm & 127; CW[idx] = p.conv_w[(size_t)(l * 4 + j) * 1536 + seg * 512 + h * 128 + c]; }
            cur_h = h;
        }
        int rowbase, seqlen, cpos;
        if (cc < 32) { rowbase = b * SEQ; seqlen = SEQ; cpos = cc; } else { rowbase = ROWS_LAT + b * CTXL; seqlen = CTXL; cpos = cc - 32; }
        const int t0 = cpos * 64;
        RELAUNDER();
        {
            u32x4 rv[7];
#pragma unroll
            for (int it = 0; it < 7; ++it) {
                const int idx = tid + it * NTHREADS, rr = idx / 48, pc = idx % 48, seg = pc >> 4, po = pc & 15, tok = t0 - 2 + rr;
                rv[it] = (u32x4){0u, 0u, 0u, 0u};
                if (idx < 67 * 48 && tok >= 0 && tok < seqlen) rv[it] = *(const u32x4*)(PROJ + (size_t)(rowbase + tok) * PN + seg * 512 + h * 128 + po * 8);
            }
#pragma unroll
            for (int it = 0; it < 7; ++it) {
                const int idx = tid + it * NTHREADS, rr = idx / 48, pc = idx % 48, seg = pc >> 4, po = pc & 15;
                if (idx < 67 * 48) *(LAS u32x4*)(lds + rr * 784 + seg * 256 + po * 16) = rv[it];
            }
        }
        if (tid < 128) { const int d = tid >> 6; const size_t gi = (size_t)(rowbase + t0 + lane) * 8 + d * 4 + h; G_LA[tid] = LOGA[gi]; G_BT[tid] = BETA[gi]; }
        __syncthreads();
        RELAUNDER();
        if (wid < 2) {
            const int d = wid, pos = d ? 63 - lane : lane;
            float v = G_LA[d * 64 + pos];
#pragma unroll
            for (int o = 1; o < 64; o <<= 1) { const float t = shup(v, o, lane); if (lane >= o) v += t; }
            G_GC[d * 64 + pos] = v;
            if (lane == 63) G_TOT[d] = v;
            const float tot = __int_as_float(__builtin_amdgcn_readlane(__float_as_int(v), 63));
            G_E1[d * 64 + pos] = __expf(tot - v); G_E2[d * 64 + pos] = __expf(v);
        }
        RELAUNDER();
        {
            const int r = tid >> 3, cs = tid & 7;
            const LAS float* cw = CW + cs * 16;
#pragma unroll
            for (int seg = 0; seg < 3; ++seg) {
                float a[16];
#pragma unroll
                for (int e = 0; e < 16; ++e) a[e] = 0.f;
#pragma unroll
                for (int j = 0; j < 4; ++j) {
                    const u32x4 x0 = *(const LAS u32x4*)(lds + (r + j) * 784 + seg * 256 + cs * 32), x1 = *(const LAS u32x4*)(lds + (r + j) * 784 + seg * 256 + cs * 32 + 16);
                    const LAS float* wj = cw + j * 384 + seg * 128;
                    const f32x4 w0 = *(const LAS f32x4*)(wj), w1 = *(const LAS f32x4*)(wj + 4), w2 = *(const LAS f32x4*)(wj + 8), w3 = *(const LAS f32x4*)(wj + 12);
                    a[0] += w0[0] * bf_lo(x0[0]); a[1] += w0[1] * bf_hi(x0[0]); a[2] += w0[2] * bf_lo(x0[1]); a[3] += w0[3] * bf_hi(x0[1]);
                    a[4] += w1[0] * bf_lo(x0[2]); a[5] += w1[1] * bf_hi(x0[2]); a[6] += w1[2] * bf_lo(x0[3]); a[7] += w1[3] * bf_hi(x0[3]);
                    a[8] += w2[0] * bf_lo(x1[0]); a[9] += w2[1] * bf_hi(x1[0]); a[10] += w2[2] * bf_lo(x1[1]); a[11] += w2[3] * bf_hi(x1[1]);
                    a[12] += w3[0] * bf_lo(x1[2]); a[13] += w3[1] * bf_hi(x1[2]); a[14] += w3[2] * bf_lo(x1[3]); a[15] += w3[3] * bf_hi(x1[3]);
                    if (j & 1) __builtin_amdgcn_sched_barrier(0);
                }
                float ss = 0.f;
#pragma unroll
                for (int e = 0; e < 16; ++e) { a[e] = silu_f(a[e]); ss += a[e] * a[e]; }
                if (seg < 2) {
                    ss += shx(ss, 1, lane); ss += shx(ss, 2, lane); ss += shx(ss, 4, lane);
                    float sc = rsqrtf(ss + EPS); if (seg == 0) sc *= 0.08838834764831845f;
#pragma unroll
                    for (int e = 0; e < 16; ++e) a[e] *= sc;
                }
                unsigned pk[8];
#pragma unroll
                for (int e = 0; e < 8; ++e) pk[e] = pk_bf16(a[2 * e], a[2 * e + 1]);
                if (seg < 2) {
                    LAS unsigned char* dst = lds + (seg == 0 ? R_QN : R_KN) + r * 272 + cs * 32;
                    *(LAS u32x4*)dst = (u32x4){pk[0], pk[1], pk[2], pk[3]}; *(LAS u32x4*)(dst + 16) = (u32x4){pk[4], pk[5], pk[6], pk[7]};
                }
                if (seg >= 1) {
                    LAS unsigned char* dt = lds + (seg == 1 ? R_KNT : R_VT) + (cs * 16) * 144 + ((((r >> 3) ^ cs) & 7) << 4) + (r & 7) * 2;
#pragma unroll
                    for (int e = 0; e < 8; ++e) { *(LAS unsigned short*)(dt + (2 * e) * 144) = (unsigned short)(pk[e] & 0xffffu); *(LAS unsigned short*)(dt + (2 * e + 1) * 144) = (unsigned short)(pk[e] >> 16); }
                }
            }
        }
        __syncthreads();
        RELAUNDER();
        {
            const int ib = wid & 3, pr = wid >> 2;
            LAS unsigned char* Ab = lds + (pr ? R_QN : R_KN) + (ib * 16 + fr) * 272 + fq * 16;
            bf16x8 a[4];
#pragma unroll
            for (int kk = 0; kk < 4; ++kk) a[kk] = *(const LAS bf16x8*)(Ab + kk * 64);
#pragma unroll
            for (int jb = 0; jb < 4; ++jb) {
                f32x4 acc = (f32x4){0.f, 0.f, 0.f, 0.f};
#pragma unroll
                for (int kk = 0; kk < 4; ++kk) { const bf16x8 bb = *(const LAS bf16x8*)(lds + R_KN + (jb * 16 + fr) * 272 + fq * 16 + kk * 64); acc = __builtin_amdgcn_mfma_f32_16x16x32_bf16(a[kk], bb, acc, 0, 0, 0); }
                if (pr) {
#pragma unroll
                    for (int r = 0; r < 4; ++r) QK[(ib * 16 + fq * 4 + r) * 65 + jb * 16 + fr] = acc[r];
                } else {
                    const int j = jb * 16 + fr;
                    const float g0j = G_GC[j], g1j = G_GC[64 + j];
#pragma unroll
                    for (int r = 0; r < 4; ++r) {
                        const int i = ib * 16 + fq * 4 + r;
                        ((LAS float*)(lds + R_MT0))[i * 68 + j] = (j < i) ? G_BT[i] * acc[r] * __expf(G_GC[i] - g0j) : 0.f;
                        ((LAS float*)(lds + R_MT1))[(63 - i) * 68 + (63 - j)] = (j > i) ? G_BT[64 + i] * acc[r] * __expf(G_GC[64 + i] - g1j) : 0.f;
                    }
                }
            }
        }
        __syncthreads();
        RELAUNDER();
        unsigned char* recd[2];
#pragma unroll
        for (int d = 0; d < 2; ++d) { const int cposn = (cc < 32) ? 4 + (d ? 31 - cpos : cpos) : (d ? 3 - cpos : cpos);
            recd[d] = p.ws + WS_SCN + ((size_t)((b * 4 + h) * 2 + d) * NCHUNK + cposn) * REC_BYTES; }
        if ((wid & 3) == 0) {
            const int d = wid >> 2;
            prep_tchain(lane, (LAS float*)(lds + (d ? R_MT1 : R_MT0)), XS + d * 1088);
        } else {
            const int wt = (wid - 1 - (wid > 4 ? 1 : 0)) * 64 + lane;
            for (int it = wt; it < 5120; it += 384) {
                const int d = it >= 2560 ? 1 : 0, r = it - d * 2560;
                const LAS float* gc = G_GC + d * 64;
                unsigned char* rec = d ? recd[1] : recd[0];
                if (r < 1024) {
                    const int dk = r >> 3, i8 = (r & 7) * 8;
                    const u32x4 kv = *(const LAS u32x4*)(lds + R_KNT + dk * 144 + ((((i8 >> 3) ^ (dk >> 4)) & 7) << 4));
                    const LAS float* e1 = G_E1 + d * 64 + i8;
                    const f32x4 ea = *(const LAS f32x4*)e1, eb = *(const LAS f32x4*)(e1 + 4);
                    u32x4 o;
                    o[0] = pk_bf16(bf_lo(kv[0]) * ea[0], bf_hi(kv[0]) * ea[1]); o[1] = pk_bf16(bf_lo(kv[1]) * ea[2], bf_hi(kv[1]) * ea[3]);
                    o[2] = pk_bf16(bf_lo(kv[2]) * eb[0], bf_hi(kv[2]) * eb[1]); o[3] = pk_bf16(bf_lo(kv[3]) * eb[2], bf_hi(kv[3]) * eb[3]);
                    *(u32x4*)(rec + REC_KT + img128(dk, i8)) = o;
                } else if (r < 2048) {
                    const int i = (r - 1024) >> 4, k8 = (r & 15) * 8;
                    const u32x4 qv = *(const LAS u32x4*)(lds + R_QN + i * 272 + k8 * 2);
                    const float eg = G_E2[d * 64 + i];
                    u32x4 o;
#pragma unroll
                    for (int e = 0; e < 4; ++e) o[e] = pk_bf16(bf_lo(qv[e]) * eg, bf_hi(qv[e]) * eg);
                    *(u32x4*)(rec + REC_QD + img256(i, k8)) = o;
                } else {
                    const int i = (r - 2048) >> 3, j8 = (r & 7) * 8;
                    float v[8];
#pragma unroll
                    for (int e = 0; e < 8; ++e) { const int j = j8 + e; const bool ok = d ? (j >= i) : (j <= i); v[e] = ok ? QK[i * 65 + j] * __expf(gc[i] - gc[j]) : 0.f; }
                    u32x4 o; o[0] = pk_bf16(v[0], v[1]); o[1] = pk_bf16(v[2], v[3]); o[2] = pk_bf16(v[4], v[5]); o[3] = pk_bf16(v[6], v[7]);
                    *(u32x4*)(rec + REC_QK + img128(i, j8)) = o;
                }
            }
            if (wt < 2) { *(float*)(recd[wt] + REC_MISC) = __expf(G_TOT[wt]); *(int*)(recd[wt] + REC_MISC + 4) = rowbase + t0; }
        }
        __syncthreads();
        RELAUNDER();
        for (int idx = tid; idx < 4096; idx += NTHREADS) {
            const int d = idx >> 11, q = idx & 2047, i = q >> 5, j = (q & 31) * 2, i2 = d ? 63 - i : i, j2 = d ? 63 - j : j, j3 = d ? j2 - 1 : j2 + 1;
            const LAS float* TBd = (const LAS float*)(lds + (d ? R_MT1 : R_MT0));
            const LAS float* e2 = G_E2 + d * 64; const LAS float* bt = G_BT + d * 64;
            const float t0v = TBd[i2 * 68 + j2], t1v = TBd[i2 * 68 + j3];
            const float c0 = bt[j], c1 = bt[j + 1];
            LAS unsigned char* tw = lds + (d ? R_T1 : R_T0);
            *(LAS unsigned*)(tw + 8192 + imgT(i, j)) = pk_bf16(t0v * c0, t1v * c1);
            *(LAS unsigned*)(tw + imgT(i, j)) = pk_bf16(t0v * c0 * e2[j], t1v * c1 * e2[j + 1]);
        }
        __syncthreads();
        RELAUNDER();
        {
            const int d = wid >> 2;
            unsigned char* rec = d ? recd[1] : recd[0];
            const LAS unsigned char* tw = lds + (d ? R_T1 : R_T0);
#pragma unroll
            for (int hb = 0; hb < 2; ++hb) {
                const int blk = (wid & 3) * 2 + hb;
                bf16x8 ak[2], av[2];
#pragma unroll
                for (int kk = 0; kk < 2; ++kk) { const int so = (((kk * 4 + fq) ^ blk) & 7) << 4; ak[kk] = *(const LAS bf16x8*)(lds + R_KNT + (blk * 16 + fr) * 144 + so); av[kk] = *(const LAS bf16x8*)(lds + R_VT + (blk * 16 + fr) * 144 + so); }
#pragma unroll
                for (int ib = 0; ib < 4; ++ib) {
                    f32x4 aw = (f32x4){0.f, 0.f, 0.f, 0.f}, au = (f32x4){0.f, 0.f, 0.f, 0.f};
#pragma unroll
                    for (int kk = 0; kk < 2; ++kk) {
                        const bf16x8 twf = *(const LAS bf16x8*)(tw + imgT(ib * 16 + fr, kk * 32 + fq * 8)), tuf = *(const LAS bf16x8*)(tw + 8192 + imgT(ib * 16 + fr, kk * 32 + fq * 8));
                        aw = __builtin_amdgcn_mfma_f32_16x16x32_bf16(ak[kk], twf, aw, 0, 0, 0);
                        au = __builtin_amdgcn_mfma_f32_16x16x32_bf16(tuf, av[kk], au, 0, 0, 0);
                    }
                    u32x2 ow; ow[0] = pk_bf16(aw[0], aw[1]); ow[1] = pk_bf16(aw[2], aw[3]);
                    *(u32x2*)(rec + REC_W + img256(ib * 16 + fr, blk * 16 + fq * 4)) = ow;
                    u32x2 ou; ou[0] = pk_bf16(au[0], au[1]); ou[1] = pk_bf16(au[2], au[3]);
                    *(u32x2*)(rec + REC_UT + (blk * 16 + fr) * 128 + (ib * 16 + fq * 4) * 2) = ou;
                }
            }
        }
        __syncthreads();
    }
}
#undef RELAUNDER

__device__ __forceinline__ void phase_scan(const Params& p, const int l, LAS unsigned char* lds) {
    const int tid = opaque_tid(), wid = __builtin_amdgcn_readfirstlane(tid >> 6), lane = tid & 63, fr = lane & 15, fq = lane >> 4;
    constexpr int NSL = 2, DV = 128 / NSL, NBT = DV / 16;
    constexpr int UTB = DV * 128, MISC_O = 57344 + UTB, BUFB = MISC_O + 256, R_ST = 2 * BUFB, R_UTL = R_ST + DV * 272, R_DUM = R_UTL + DV * 144;
    static_assert(R_DUM + 8 * 256 <= LDS_WORK && NBT == 4, "scan LDS / tile assumptions");
    for (int id = blockIdx.x; id < 64 * NSL; id += gridDim.x) {
        const int bhd = (id & 7) * 8 + (id >> 4), sl = (id >> 3) & 1, h = (bhd >> 1) & 3, d = bhd & 1;
        bf16_t* O = (bf16_t*)(p.ws + (d ? WS_OB : WS_OF));
        const unsigned char* rec0 = p.ws + WS_SCN + (size_t)bhd * NCHUNK * REC_BYTES;
        __syncthreads();
        for (int i = tid; i < DV * 272 / 4; i += NTHREADS) ((LAS unsigned*)(lds + R_ST))[i] = 0u;
        f32x4 sacc[NBT];
#pragma unroll
        for (int n2 = 0; n2 < NBT; ++n2) sacc[n2] = (f32x4){0.f, 0.f, 0.f, 0.f};
#define S_ISSUE(n, bufo) do { const unsigned char* _r = rec0 + (size_t)(n) * REC_BYTES; \
        _Pragma("unroll") for (int _q = 0; _q < 7; ++_q) __builtin_amdgcn_global_load_lds((const unsigned*)(_r + lane * 16 + (wid + 8 * _q) * 1024), (LAS unsigned*)(lds + (bufo) + (wid + 8 * _q) * 1024), 16, 0, 0); \
        __builtin_amdgcn_global_load_lds((const unsigned*)(_r + lane * 16 + REC_UT + sl * UTB + wid * 1024), (LAS unsigned*)(lds + (bufo) + 57344 + wid * 1024), 16, 0, 0); \
        __builtin_amdgcn_global_load_lds((const unsigned*)(_r + REC_MISC + lane * 4), (LAS unsigned*)(lds + (bufo) + MISC_O), 4, 0, 0); } while (0)
#define S_TOUCH(n) do { const int _n = (n) < NCHUNK ? (n) : NCHUNK - 1; const int _ln = wid * 64 + lane; \
        const unsigned char* _t = rec0 + (size_t)_n * REC_BYTES + (_ln < 448 ? _ln * 128 : REC_UT + sl * UTB + (_ln - 448) * 128); \
        __builtin_amdgcn_global_load_lds((const unsigned*)_t, (LAS unsigned*)(lds + R_DUM + wid * 256), 4, 0, 0); } while (0)
        S_ISSUE(0, 0); S_TOUCH(1);
        const int ib = wid >> 1, nb0 = (wid & 1) * (NBT / 2);
        for (int n = 0; n < NCHUNK; ++n) {
            if (n == 0) asm volatile("s_waitcnt vmcnt(1)" ::: "memory"); else asm volatile("s_waitcnt vmcnt(3)" ::: "memory");
            asm volatile("s_waitcnt lgkmcnt(0)" ::: "memory");
            __builtin_amdgcn_s_barrier();
            LAS unsigned char* buf = lds + (n & 1) * BUFB;
            f32x4 accP[NBT / 2], accQ[NBT / 2];
#pragma unroll
            for (int t = 0; t < NBT / 2; ++t) { accP[t] = (f32x4){0.f, 0.f, 0.f, 0.f}; accQ[t] = (f32x4){0.f, 0.f, 0.f, 0.f}; }
            bf16x8 aw[4], aq[4], sb[NBT / 2][4];
#pragma unroll
            for (int kk = 0; kk < 4; ++kk) {
                aw[kk] = *(const LAS bf16x8*)(buf + REC_W + img256(ib * 16 + fr, kk * 32 + fq * 8));
                aq[kk] = *(const LAS bf16x8*)(buf + REC_QD + img256(ib * 16 + fr, kk * 32 + fq * 8));
#pragma unroll
                for (int t = 0; t < NBT / 2; ++t) sb[t][kk] = *(const LAS bf16x8*)(lds + R_ST + ((nb0 + t) * 16 + fr) * 272 + kk * 64 + fq * 16);
            }
            u32x2 uv[NBT / 2];
#pragma unroll
            for (int t = 0; t < NBT / 2; ++t) uv[t] = *(const LAS u32x2*)(buf + REC_UT + ((nb0 + t) * 16 + fr) * 128 + (ib * 16 + fq * 4) * 2);
            __builtin_amdgcn_sched_barrier(0);
#pragma unroll
            for (int kk = 0; kk < 4; ++kk)
#pragma unroll
                for (int t = 0; t < NBT / 2; ++t) accP[t] = __builtin_amdgcn_mfma_f32_16x16x32_bf16(aw[kk], sb[t][kk], accP[t], 0, 0, 0);
            if (n + 1 < NCHUNK) { if ((n + 1) & 1) S_ISSUE(n + 1, BUFB); else S_ISSUE(n + 1, 0); S_TOUCH(n + 2); }
            bf16x8 aqk[2], ak[2];
#pragma unroll
            for (int kk = 0; kk < 2; ++kk) { aqk[kk] = *(const LAS bf16x8*)(buf + REC_QK + img128(ib * 16 + fr, kk * 32 + fq * 8)); ak[kk] = *(const LAS bf16x8*)(buf + REC_KT + img128(wid * 16 + fr, kk * 32 + fq * 8)); }
            const float sd = *(const LAS float*)(buf + MISC_O); const int rowstart = *(const LAS int*)(buf + MISC_O + 4);
#pragma unroll
            for (int t = 0; t < NBT / 2; ++t) {
                u32x2 o; o[0] = pk_bf16(bf_lo(uv[t][0]) - accP[t][0], bf_hi(uv[t][0]) - accP[t][1]); o[1] = pk_bf16(bf_lo(uv[t][1]) - accP[t][2], bf_hi(uv[t][1]) - accP[t][3]);
                *(LAS u32x2*)(lds + R_UTL + ((nb0 + t) * 16 + fr) * 144 + (ib * 16 + fq * 4) * 2) = o;
            }
#pragma unroll
            for (int kk = 0; kk < 4; ++kk)
#pragma unroll
                for (int t = 0; t < NBT / 2; ++t) accQ[t] = __builtin_amdgcn_mfma_f32_16x16x32_bf16(sb[t][kk], aq[kk], accQ[t], 0, 0, 0);
            asm volatile("s_waitcnt lgkmcnt(0)" ::: "memory");
            __builtin_amdgcn_s_barrier();
            bf16x8 ub[NBT][2];
#pragma unroll
            for (int n2 = 0; n2 < NBT; ++n2)
#pragma unroll
                for (int kk = 0; kk < 2; ++kk) ub[n2][kk] = *(const LAS bf16x8*)(lds + R_UTL + (n2 * 16 + fr) * 144 + kk * 64 + fq * 16);
            bf16x8 un[NBT / 2][2];
#pragma unroll
            for (int t = 0; t < NBT / 2; ++t)
#pragma unroll
                for (int kk = 0; kk < 2; ++kk) un[t][kk] = *(const LAS bf16x8*)(lds + R_UTL + ((nb0 + t) * 16 + fr) * 144 + kk * 64 + fq * 16);
            __builtin_amdgcn_sched_barrier(0);
#pragma unroll
            for (int n2 = 0; n2 < NBT; ++n2) {
                sacc[n2] *= sd;
#pragma unroll
                for (int kk = 0; kk < 2; ++kk) sacc[n2] = __builtin_amdgcn_mfma_f32_16x16x32_bf16(ak[kk], ub[n2][kk], sacc[n2], 0, 0, 0);
            }
#pragma unroll
            for (int kk = 0; kk < 2; ++kk)
#pragma unroll
                for (int t = 0; t < NBT / 2; ++t) accQ[t] = __builtin_amdgcn_mfma_f32_16x16x32_bf16(un[t][kk], aqk[kk], accQ[t], 0, 0, 0);
#pragma unroll
            for (int n2 = 0; n2 < NBT; ++n2) {
                u32x2 o; o[0] = pk_bf16(sacc[n2][0], sacc[n2][1]); o[1] = pk_bf16(sacc[n2][2], sacc[n2][3]);
                *(LAS u32x2*)(lds + R_ST + (n2 * 16 + fr) * 272 + (wid * 16 + fq * 4) * 2) = o;
            }
#pragma unroll
            for (int t = 0; t < NBT / 2; ++t) {
                u32x2 o; o[0] = pk_bf16(accQ[t][0], accQ[t][1]); o[1] = pk_bf16(accQ[t][2], accQ[t][3]);
                *(u32x2*)(O + (size_t)(rowstart + ib * 16 + fr) * 512 + h * 128 + sl * DV + (nb0 + t) * 16 + fq * 4) = o;
            }
        }
#undef S_ISSUE
#undef S_TOUCH
        asm volatile("s_waitcnt vmcnt(0)" ::: "memory");
        __syncthreads();
    }
}

__device__ __forceinline__ void phase_scan_naive(const Params& p, const int l, LAS unsigned char* lds) {
    const int tid = opaque_tid();
    const int lane = tid & 63;
    LAS float* ks = (LAS float*)lds;
    LAS float* qs = ks + 4096;
    LAS float* vs = qs + 4096;
    LAS float* as = vs + 4096;
    LAS float* bs = as + 32;
    LAS int* rws = (LAS int*)(bs + 32);
    const float* QKV = (const float*)(p.ws + WS_QKV);
    const float* LOGA = (const float*)(p.ws + WS_LOGA);
    const float* BETA = (const float*)(p.ws + WS_BETA);
    for (int u = blockIdx.x; u < 64; u += gridDim.x) {
        const int b = u >> 3, h = (u >> 1) & 3, d = u & 1;
        float* O = (float*)(p.ws + (d ? WS_OB : WS_OF));
        const int col = tid >> 2, part = tid & 3;
        float S[32];
#pragma unroll
        for (int i = 0; i < 32; ++i) S[i] = 0.f;
        for (int n0 = 0; n0 < CTXL + SEQ; n0 += 32) {
            __syncthreads();
            if (tid < 32) {
                const int n = n0 + tid; int row;
                if (n < CTXL) row = ROWS_LAT + b * CTXL + (d ? CTXL - 1 - n : n);
                else { const int m = n - CTXL; row = b * SEQ + (d ? SEQ - 1 - m : m); }
                rws[tid] = row;
                as[tid] = __expf(LOGA[(size_t)row * 8 + d * 4 + h]);
                bs[tid] = BETA[(size_t)row * 8 + d * 4 + h];
            }
            __syncthreads();
            for (int i = tid; i < 4096; i += NTHREADS) {
                const int tok = i >> 7, cc = i & 127; const size_t base = (size_t)rws[tok] * 1536 + h * 128 + cc;
                qs[i] = QKV[base]; ks[i] = QKV[base + 512]; vs[i] = QKV[base + 1024];
            }
            __syncthreads();
            for (int tok = 0; tok < 32; ++tok) {
                float kk[32];
#pragma unroll
                for (int i = 0; i < 8; ++i) { const f32x4 v = *(const LAS f32x4*)(ks + tok * 128 + part * 32 + i * 4); kk[i * 4] = v[0]; kk[i * 4 + 1] = v[1]; kk[i * 4 + 2] = v[2]; kk[i * 4 + 3] = v[3]; }
                float kp = 0.f;
#pragma unroll
                for (int i = 0; i < 32; ++i) kp += kk[i] * S[i];
                kp += shx(kp, 1, lane); kp += shx(kp, 2, lane);
                const float a = as[tok], bt = bs[tok];
                const float bv = bt * (vs[tok * 128 + col] - a * kp);
#pragma unroll
                for (int i = 0; i < 32; ++i) S[i] = a * S[i] + kk[i] * bv;
                float op = 0.f;
#pragma unroll
                for (int i = 0; i < 8; ++i) { const f32x4 v = *(const LAS f32x4*)(qs + tok * 128 + part * 32 + i * 4); op += v[0] * S[i * 4] + v[1] * S[i * 4 + 1] + v[2] * S[i * 4 + 2] + v[3] * S[i * 4 + 3]; }
                op += shx(op, 1, lane); op += shx(op, 2, lane);
                if (part == 0) O[(size_t)rws[tok] * 512 + h * 128 + col] = op;
            }
        }
        __syncthreads();
    }
}

__device__ __forceinline__ void phase_onorm(const Params& p, const int l) {
    const int tid = opaque_tid(), wid = tid >> 6, lane = tid & 63;
    const bf16_t* OF = (const bf16_t*)(p.ws + WS_OF); const bf16_t* OB = (const bf16_t*)(p.ws + WS_OB);
    const bf16_t* PROJ = (const bf16_t*)(p.ws + WS_PROJ);
    bf16_t* CAT = (bf16_t*)(p.ws + WS_CAT);
    const int c = lane * 8;
    const f32x4 w0 = *(const f32x4*)(p.dn_norm + l * 128 + (c & 127)), w1 = *(const f32x4*)(p.dn_norm + l * 128 + (c & 127) + 4);
    const int nrows = (l == DEPTH - 1) ? ROWS_LAT : MT;
    constexpr int R = 3;
    const int rstride = gridDim.x * 8;
    for (int base = blockIdx.x * 8 + wid; base < nrows; base += rstride * R) {
        u32x4 a[R], b[R], gv[R];
#pragma unroll
        for (int k = 0; k < R; ++k) {
            const int row = base + k * rstride; const int rr = row < nrows ? row : base;
            a[k] = *(const u32x4*)(OF + (size_t)rr * 512 + c); b[k] = *(const u32x4*)(OB + (size_t)rr * 512 + c); gv[k] = *(const u32x4*)(PROJ + (size_t)rr * PN + 1536 + c);
        }
#pragma unroll
        for (int k = 0; k < R; ++k) {
            const int row = base + k * rstride;
            const f32x4 v0 = (f32x4){bf_lo(a[k][0]) + bf_lo(b[k][0]), bf_hi(a[k][0]) + bf_hi(b[k][0]), bf_lo(a[k][1]) + bf_lo(b[k][1]), bf_hi(a[k][1]) + bf_hi(b[k][1])};
            const f32x4 v1 = (f32x4){bf_lo(a[k][2]) + bf_lo(b[k][2]), bf_hi(a[k][2]) + bf_hi(b[k][2]), bf_lo(a[k][3]) + bf_lo(b[k][3]), bf_hi(a[k][3]) + bf_hi(b[k][3])};
            float ss = v0[0] * v0[0] + v0[1] * v0[1] + v0[2] * v0[2] + v0[3] * v0[3] + v1[0] * v1[0] + v1[1] * v1[1] + v1[2] * v1[2] + v1[3] * v1[3];
            ss += shx(ss, 1, lane); ss += shx(ss, 2, lane); ss += shx(ss, 4, lane); ss += shx(ss, 8, lane);
            const float rs = rsqrtf(ss * (1.f / 128.f) + EPS);
            u32x4 out;
            out[0] = pk_bf16(v0[0] * rs * w0[0] * silu_f(bf_lo(gv[k][0])), v0[1] * rs * w0[1] * silu_f(bf_hi(gv[k][0])));
            out[1] = pk_bf16(v0[2] * rs * w0[2] * silu_f(bf_lo(gv[k][1])), v0[3] * rs * w0[3] * silu_f(bf_hi(gv[k][1])));
            out[2] = pk_bf16(v1[0] * rs * w1[0] * silu_f(bf_lo(gv[k][2])), v1[1] * rs * w1[1] * silu_f(bf_hi(gv[k][2])));
            out[3] = pk_bf16(v1[2] * rs * w1[2] * silu_f(bf_lo(gv[k][3])), v1[3] * rs * w1[3] * silu_f(bf_hi(gv[k][3])));
            if (row < nrows) *(u32x4*)(CAT + (size_t)row * D + c) = out;
        }
    }
}

__device__ __forceinline__ unsigned block_incl_scan(unsigned v, const int tid, LAS unsigned* wsum, unsigned& total) {
    const int lane = tid & 63, wv = tid >> 6;
#pragma unroll
    for (int o = 1; o < 64; o <<= 1) { const unsigned t = (unsigned)__builtin_amdgcn_ds_bpermute(((lane - o) & 63) << 2, (int)v); if (lane >= o) v += t; }
    if (lane == 63) wsum[wv] = v;
    __syncthreads();
    unsigned base = 0u, tot = 0u;
#pragma unroll
    for (int w = 0; w < 8; ++w) { const unsigned x = wsum[w]; tot += x; base += (w < wv) ? x : 0u; }
    total = tot;
    return v + base;
}

__device__ __forceinline__ void phase_topk(const Params& p, const int l, LAS unsigned char* lds) {
    const int tid = opaque_tid();
    LAS unsigned* hist = (LAS unsigned*)lds;
    LAS unsigned* wsum = hist + 4096;
    LAS unsigned* misc = wsum + 8;
    LAS unsigned long long* cand = (LAS unsigned long long*)(misc + 8);
    LAS unsigned char* selb = (LAS unsigned char*)(cand + 2048);
    const float* AFF = (const float*)(p.ws + WS_AFF);
    int* SEL = (int*)(p.ws + WS_SEL); float* SELAFF = (float*)(p.ws + WS_SELAFF); int* SLOTOF = (int*)(p.ws + WS_SLOTOF);
    const int ntk = (l == DEPTH - 1) ? 128 : 256;
    for (int u = blockIdx.x; u < ntk; u += gridDim.x) {
        int e, n, C, rowbase, slotbase;
        if (u < 128) { e = u >> 3; const int b = u & 7; n = SEQ; C = 256; rowbase = b * SEQ; slotbase = u * 256; }
        else { const int v = u - 128; e = v >> 3; const int b = v & 7; n = CTXL; C = 32; rowbase = ROWS_LAT + b * CTXL; slotbase = (128 + e) * 256 + b * 32; }
        unsigned kb[4];
#pragma unroll
        for (int k = 0; k < 4; ++k) { const int i = tid * 4 + k; kb[k] = (i < n) ? __float_as_uint(AFF[(size_t)(rowbase + i) * 16 + e]) : 0u; }
#pragma unroll
        for (int k = 0; k < 8; ++k) hist[tid * 8 + k] = 0u;
        if (tid == 0) misc[2] = 0u;
        __syncthreads();
#pragma unroll
        for (int k = 0; k < 4; ++k) if (tid * 4 + k < n) __hip_atomic_fetch_add(&hist[kb[k] >> 19], 1u, __ATOMIC_RELAXED, __HIP_MEMORY_SCOPE_WORKGROUP);
        __syncthreads();
        unsigned hl[8], s8 = 0u;
#pragma unroll
        for (int k = 0; k < 8; ++k) { hl[k] = hist[tid * 8 + k]; s8 += hl[k]; }
        unsigned total;
        const unsigned incl = block_incl_scan(s8, tid, wsum, total);
        unsigned cum = total - incl;
#pragma unroll
        for (int k = 7; k >= 0; --k) { if (cum < (unsigned)C && cum + hl[k] >= (unsigned)C) { misc[0] = (unsigned)(tid * 8 + k); misc[1] = cum; } cum += hl[k]; }
        __syncthreads();
        const unsigned thr = misc[0], G = misc[1], R = (unsigned)C - G;
#pragma unroll
        for (int k = 0; k < 4; ++k) { const int i = tid * 4 + k; if (i < n && (kb[k] >> 19) == thr) { const unsigned q = __hip_atomic_fetch_add(&misc[2], 1u, __ATOMIC_RELAXED, __HIP_MEMORY_SCOPE_WORKGROUP); cand[q] = ((unsigned long long)kb[k] << 32) | (unsigned long long)(0xFFFFFFFFu - (unsigned)i); } }
        __syncthreads();
        const unsigned E = misc[2];
        for (unsigned j = tid; j < E; j += NTHREADS) {
            const unsigned long long me = cand[j]; unsigned rank = 0u;
            for (unsigned k = 0; k < E; ++k) rank += (cand[k] > me) ? 1u : 0u;
            selb[0xFFFFFFFFu - (unsigned)(me & 0xFFFFFFFFull)] = (rank < R) ? 1 : 0;
        }
        __syncthreads();
        unsigned fl = 0u, cnt = 0u;
#pragma unroll
        for (int k = 0; k < 4; ++k) { const int i = tid * 4 + k; const unsigned bin = kb[k] >> 19;
            const bool in = (i < n) && (bin > thr || (bin == thr && selb[i] != 0)); fl |= in ? (1u << k) : 0u; cnt += in ? 1u : 0u; }
        unsigned tot2;
        unsigned pos = block_incl_scan(cnt, tid, wsum, tot2) - cnt;
#pragma unroll
        for (int k = 0; k < 4; ++k) { const int i = tid * 4 + k;
            if (i < n) { const bool in = (fl >> k) & 1u;
                SLOTOF[(size_t)(rowbase + i) * 16 + e] = in ? slotbase + (int)pos : -1;
                if (in) { SEL[slotbase + pos] = rowbase + i; SELAFF[slotbase + pos] = __uint_as_float(kb[k]); ++pos; } } }
        __syncthreads();
    }
}

#ifndef DUMP
#define DUMP 0
#endif
#if DUMP
__device__ __forceinline__ void phase_dump(const Params& p, const size_t off, const int is_bf16, const size_t n_avail) {
    const int tid = opaque_tid();
    const size_t n = (size_t)ROWS_LAT * D;
    for (size_t i = (size_t)blockIdx.x * NTHREADS + tid; i < n; i += (size_t)gridDim.x * NTHREADS) {
        float v = 0.f;
        if (i < n_avail) v = is_bf16 ? __uint_as_float((unsigned)((const bf16_t*)(p.ws + off))[i] << 16) : ((const float*)(p.ws + off))[i];
        p.out[i] = v;
    }
}
#endif

__global__ void __launch_bounds__(NTHREADS, 2) fwd(const Params p) {
    extern __shared__ __attribute__((aligned(16))) unsigned char smem[];
    LAS unsigned char* lds = (LAS unsigned char*)smem + LDS_OFF;
    XcdBarrier bar; bar.bar = (unsigned*)(p.ws + WS_BAR); bar.x = 0; bar.st = nullptr;
    const bool multi = (p.ph_hi - p.ph_lo) > 1;
    if (multi) {
        if (threadIdx.x == 0) *(LAS u32x4*)((LAS unsigned char*)smem) = (u32x4){0u, 0u, 0u, 0u};
        __syncthreads();
        bar = xcd_barrier_post((unsigned*)(p.ws + WS_BAR), (volatile LAS unsigned*)((LAS unsigned char*)smem));
    }
#if DUMP
    if (p.ph_lo == 100) { phase_dump(p, (size_t)(DUMP_OFF), DUMP_BF16, (size_t)(DUMP_N)); return; }
#endif
    int ph = 0;
#define PHASE(body) do { if (ph >= p.ph_lo && ph < p.ph_hi) { const int l = opaque_s(lv); body; if (ph + 1 < p.ph_hi) xcd_barrier(bar); } ++ph; } while (0)
    int lv = 0;
    PHASE(phase_prologue(p, lds));
    for (lv = 0; lv < DEPTH; ++lv) {
        PHASE(phase_norm<1>(p, l, lds));
        PHASE(GEMM8 ? phase_gemm8<0>(p, l, lds) : phase_gemm<0>(p, l, lds));
#if NAIVE_SCAN
        PHASE(phase_conv_pool(p, l, lds));
        PHASE(phase_scan_naive(p, l, lds));
#else
        PHASE(phase_prep(p, l, lds));
        PHASE(phase_scan(p, l, lds); phase_conv_pool(p, l, lds, (int)gridDim.x >= 256 ? 128 : 0, (int)gridDim.x >= 256 ? (int)gridDim.x - 128 : (int)gridDim.x));
#endif
        PHASE(phase_onorm(p, l));
        PHASE(GEMM8 ? phase_gemm8<1>(p, l, lds) : phase_gemm<1>(p, l, lds));
        PHASE(phase_norm<2>(p, l, lds));
        PHASE(phase_topk(p, l, lds));
        PHASE(GEMM8 ? phase_gemm8<2>(p, l, lds) : phase_gemm<2>(p, l, lds));
        PHASE(GEMM8 ? phase_gemm8<3>(p, l, lds) : phase_gemm<3>(p, l, lds));
    }
    lv = 0;
    PHASE(phase_norm<3>(p, l, lds));
#undef PHASE
}
constexpr int N_PHASES = 2 + DEPTH * 10;

extern "C" void kernel_launch(void* const* d_in, const int* in_sizes, int n_in, void* d_out, int out_size, void* d_ws, size_t ws_size, hipStream_t stream) {
    static int grid = 0;
    if (grid == 0) {
        if (n_in != 21 || out_size != ROWS_LAT * D || ws_size < WS_END) { fprintf(stderr, "kernel_launch: unexpected shapes (n_in %d out %d ws %zu need %zu)\n", n_in, out_size, ws_size, (size_t)WS_END); grid = -1; return; }
        int dev = 0, cus = 0, per_cu = 0;
        if (hipGetDevice(&dev) != hipSuccess || hipDeviceGetAttribute(&cus, hipDeviceAttributeMultiprocessorCount, dev) != hipSuccess) { grid = -1; return; }
        if (hipFuncSetAttribute((const void*)fwd, hipFuncAttributeMaxDynamicSharedMemorySize, LDS_BYTES) != hipSuccess) { fprintf(stderr, "kernel_launch: hipFuncSetAttribute failed\n"); grid = -1; return; }
        if (hipOccupancyMaxActiveBlocksPerMultiprocessor(&per_cu, (const void*)fwd, NTHREADS, LDS_BYTES) != hipSuccess || per_cu < 1) { fprintf(stderr, "kernel_launch: occupancy query says %d\n", per_cu); per_cu = 1; }
        (void)hipGetLastError();
        grid = cus;
    }
    if (grid < 0) return;
    (void)hipMemsetAsync((char*)d_ws + WS_BAR, 0, 16384, stream);
    Params p; memset(&p, 0, sizeof(p));
    const float** pp = (const float**)&p;
    for (int i = 0; i < 21; ++i) pp[i] = (const float*)d_in[i];
    p.out = (float*)d_out; p.ws = (unsigned char*)d_ws;
#if DUMP
    for (int ph = 0; ph <= DUMP_LAST; ++ph) { p.ph_lo = ph; p.ph_hi = ph + 1; hipLaunchKernelGGL(fwd, dim3(grid), dim3(NTHREADS), LDS_BYTES, stream, p); }
    p.ph_lo = 100; p.ph_hi = 101; hipLaunchKernelGGL(fwd, dim3(grid), dim3(NTHREADS), LDS_BYTES, stream, p);
#elif ONE_LAUNCH
    p.ph_lo = 0; p.ph_hi = N_PHASES;
    hipLaunchKernelGGL(fwd, dim3(grid), dim3(NTHREADS), LDS_BYTES, stream, p);
#else
    for (int ph = 0; ph < N_PHASES; ++ph) { p.ph_lo = ph; p.ph_hi = ph + 1; hipLaunchKernelGGL(fwd, dim3(grid), dim3(NTHREADS), LDS_BYTES, stream, p); }
#endif
}
```

```cpp
#include <hip/hip_runtime.h>
#include <stdint.h>
#include <stdio.h>
#include <string.h>

#ifndef ONE_LAUNCH
#define ONE_LAUNCH 1
#endif
#ifndef NAIVE_SCAN
#define NAIVE_SCAN 0
#endif
#ifndef GEMM8
#define GEMM8 1
#endif
#ifndef MOE_FP8
#define MOE_FP8 1
#endif
#ifndef REGSTAGE
#define REGSTAGE 0
#endif

#define LAS __attribute__((address_space(3)))
typedef unsigned short bf16_t;
typedef short bf16x8 __attribute__((ext_vector_type(8)));
typedef float f32x4 __attribute__((ext_vector_type(4)));
typedef float f32x2 __attribute__((ext_vector_type(2)));
typedef unsigned u32x2 __attribute__((ext_vector_type(2)));
typedef unsigned u32x4 __attribute__((ext_vector_type(4)));
typedef long i64x2 __attribute__((ext_vector_type(2)));

constexpr int D = 1024, NB = 8, SEQ = 2048, DEPTH = 4, CTXL = 256;
constexpr int ROWS_LAT = NB * SEQ;
constexpr int ROWS_CTX = NB * CTXL;
constexpr int MT = ROWS_LAT + ROWS_CTX;
constexpr int INC = 2576;
constexpr int PN = 2560;
constexpr int NE = 16;
constexpr int NGROUPS = 144;
constexpr int NSLOTS = NGROUPS * 256;
constexpr int NTHREADS = 512;
constexpr float EPS = 1e-6f;

constexpr size_t al256(size_t x) { return (x + 255) & ~(size_t)255; }
constexpr size_t WS_BAR = 0;
constexpr size_t WS_MOD = 16384;
constexpr size_t WS_X = WS_MOD + al256((size_t)DEPTH * 9 * 6144 * 4);
constexpr size_t WS_H = WS_X + (size_t)MT * D * 4;
constexpr size_t WS_PROJ = WS_H + (size_t)MT * D * 2;
constexpr size_t WS_YE = WS_PROJ;
constexpr size_t WS_LOGA = WS_PROJ + (size_t)MT * PN * 2;
constexpr size_t WS_BETA = WS_LOGA + (size_t)MT * 8 * 4;
constexpr size_t WS_QKV = WS_BETA + (size_t)MT * 8 * 4;
constexpr size_t WS_HID = WS_QKV;
constexpr size_t WS_OF = WS_QKV + (NAIVE_SCAN ? (size_t)MT * 1536 * 4 : (size_t)NSLOTS * D * 2);
constexpr size_t WS_OB = WS_OF + (size_t)MT * 512 * 4;
constexpr size_t WS_CAT = WS_OB + (size_t)MT * 512 * 4;
constexpr size_t WS_AFF = WS_CAT + (size_t)MT * D * 2;
constexpr size_t WS_SEL = WS_AFF + (size_t)MT * 16 * 4;
constexpr size_t WS_SELAFF = WS_SEL + (size_t)NSLOTS * 4;
constexpr size_t WS_SLOTOF = WS_SELAFF + (size_t)NSLOTS * 4;
constexpr size_t WS_WINT = WS_SLOTOF + (size_t)MT * 16 * 4;
constexpr size_t WS_WOUTT = WS_WINT + (size_t)DEPTH * PN * D * 2;
constexpr size_t WS_WGUT = WS_WOUTT + (size_t)DEPTH * D * D * 2;
constexpr size_t WS_WDT = WS_WGUT + (size_t)DEPTH * NE * 2048 * D * 2;
constexpr size_t WS_PWT = WS_WDT + (size_t)DEPTH * NE * D * D * 2;
constexpr size_t WS_W16T = WS_PWT + (size_t)DEPTH * 4 * 128 * 128 * 2;
constexpr size_t WS_SCN = WS_W16T + (size_t)DEPTH * 2 * 16 * D * 4;
constexpr int REC_W = 0, REC_KT = 16384, REC_QD = 32768, REC_QK = 49152, REC_UT = 57344, REC_MISC = 73728, REC_BYTES = 73984;
constexpr int NCHUNK = 36;
constexpr size_t WS_END = WS_SCN + (size_t)NB * 4 * 2 * NCHUNK * REC_BYTES + 4096;

constexpr int LDS_OFF = 1024;
constexpr int LDS_WORK = 161792;
constexpr int LDS_BYTES = LDS_OFF + LDS_WORK;

struct Params {
    const float *x, *c, *ctx, *c_ctx, *w_mod, *b_mod, *norm1, *norm2, *w_in, *conv_w, *a_log, *dt_bias, *dn_norm, *pool_w, *pool_scale, *w_out, *w_router, *w_gate, *w_up, *w_down, *norm_f;
    float* out;
    unsigned char* ws;
    int ph_lo, ph_hi;
};

#define XB_TMO      128
#define XB_XCNT(j)  (256  + 64 * (j))
#define XB_XSUB(j)  (1280 + 64 * (j))
#define XB_XGEN(j)  (2304 + 64 * (j))
#define XB_TOP      3328
#define XB_TOPGEN   3392
#define XCD_BAR_WORDS 3456
#define XB_SPIN_CAP (1u << 22)

__device__ __forceinline__ unsigned xb_ld(unsigned* p)              { return __hip_atomic_load(p, __ATOMIC_RELAXED, __HIP_MEMORY_SCOPE_AGENT); }
__device__ __forceinline__ unsigned xb_add(unsigned* p, unsigned v) { return __hip_atomic_fetch_add(p, v, __ATOMIC_RELAXED, __HIP_MEMORY_SCOPE_AGENT); }
__device__ __forceinline__ unsigned xb_xcc_id() { return (unsigned)__builtin_amdgcn_s_getreg((3 << 11) | 20) & 0xFu; }
#define XB_SPIN(cond, bar) do { unsigned _sp = 0; while (cond) { __builtin_amdgcn_s_sleep(1); \
    if ((++_sp & 255u) == 0u) { if (xb_ld(&(bar)[XB_TMO])) break; if (_sp > XB_SPIN_CAP) { atomicAdd(&(bar)[XB_TMO], 1u); break; } } } } while (0)

struct XcdBarrier { unsigned* bar; unsigned x; volatile LAS unsigned* st; };

__device__ __forceinline__ XcdBarrier xcd_barrier_post(unsigned* bar, volatile LAS unsigned* st) {
    XcdBarrier b; b.bar = bar; b.x = xb_xcc_id(); b.st = st;
    if (threadIdx.x == 0) (void)xb_add(&bar[XB_XCNT(b.x)], 1u);
    return b;
}
__device__ __forceinline__ void xcd_barrier_complete(unsigned* bar, unsigned x, unsigned& nloc, unsigned& nx) {
    const unsigned G = gridDim.x * gridDim.y * gridDim.z;
    unsigned sum, cnt, mine, sp = 0u;
    for (;;) {
        sum = 0u; cnt = 0u; mine = 0u;
#pragma unroll
        for (unsigned j = 0; j < 16; ++j) { const unsigned c = xb_ld(&bar[XB_XCNT(j)]); sum += c; cnt += (c > 0u) ? 1u : 0u; mine = (j == x) ? c : mine; }
        if (sum == G) break;
        __builtin_amdgcn_s_sleep(1);
        if ((++sp & 255u) == 0u) { if (xb_ld(&bar[XB_TMO])) break; if (sp > XB_SPIN_CAP) { atomicAdd(&bar[XB_TMO], 1u); break; } }
    }
    nloc = mine > 0u ? mine : 1u; nx = cnt > 0u ? cnt : 1u;
}
__device__ __forceinline__ void xcd_barrier(const XcdBarrier& b) {
    asm volatile("s_waitcnt vmcnt(0)" ::: "memory");
    __syncthreads();
    if (threadIdx.x == 0) {
        unsigned* bar = b.bar;
        __builtin_amdgcn_s_waitcnt(0);
        unsigned nloc = b.st[0], nx = b.st[1];
        if (nloc == 0u) { xcd_barrier_complete(bar, b.x, nloc, nx); b.st[0] = nloc; b.st[1] = nx; }
        const unsigned old = xb_add(&bar[XB_XSUB(b.x)], 1u);
        const unsigned gen = old / nloc;
        if (old + 1u == (gen + 1u) * nloc) {
            __builtin_amdgcn_fence(__ATOMIC_RELEASE, "agent");
            asm volatile("s_waitcnt vmcnt(0)" ::: "memory");
            const unsigned og = xb_add(&bar[XB_TOP], 1u);
            const unsigned tg = og / nx;
            if (og + 1u == (tg + 1u) * nx) xb_add(&bar[XB_TOPGEN], 1u);
            else XB_SPIN(xb_ld(&bar[XB_TOPGEN]) == tg, bar);
            __builtin_amdgcn_fence(__ATOMIC_ACQUIRE, "agent");
            xb_add(&bar[XB_XGEN(b.x)], 1u);
            asm volatile("s_waitcnt vmcnt(0)" ::: "memory");
        } else {
            XB_SPIN(xb_ld(&bar[XB_XGEN(b.x)]) == gen, bar);
            __builtin_amdgcn_fence(__ATOMIC_ACQUIRE, "agent");
            asm volatile("s_waitcnt vmcnt(0)" ::: "memory");
        }
    }
    __syncthreads();
}

typedef __bf16 bf16x2_t __attribute__((ext_vector_type(2)));
__device__ __forceinline__ unsigned pk_bf16(float lo, float hi) { const f32x2 v = {lo, hi}; const bf16x2_t b = __builtin_convertvector(v, bf16x2_t); return __builtin_bit_cast(unsigned, b); }
__device__ __forceinline__ unsigned pk_fp8x4(float a, float b, float c, float d) {
    a = __builtin_amdgcn_fmed3f(a, -448.f, 448.f); b = __builtin_amdgcn_fmed3f(b, -448.f, 448.f); c = __builtin_amdgcn_fmed3f(c, -448.f, 448.f); d = __builtin_amdgcn_fmed3f(d, -448.f, 448.f);
    int w = 0; w = __builtin_amdgcn_cvt_pk_fp8_f32(a, b, w, false); w = __builtin_amdgcn_cvt_pk_fp8_f32(c, d, w, true); return (unsigned)w; }
constexpr float F8_SW = 64.f, F8_SHID = 8.f;
__device__ __forceinline__ float bf_lo(unsigned u) { return __uint_as_float(u << 16); }
__device__ __forceinline__ float bf_hi(unsigned u) { return __uint_as_float(u & 0xffff0000u); }
__device__ __forceinline__ float shx(float v, int mask, int lane) { return __int_as_float(__builtin_amdgcn_ds_bpermute((lane ^ mask) << 2, __float_as_int(v))); }
__device__ __forceinline__ float shup(float v, int o, int lane) { return __int_as_float(__builtin_amdgcn_ds_bpermute(((lane - o) & 63) << 2, __float_as_int(v))); }
__device__ __forceinline__ float wave_sum(float v, int lane) {
#pragma unroll
    for (int o = 32; o > 0; o >>= 1) v += shx(v, o, lane);
    return v;
}
__device__ __forceinline__ int opaque_tid() { int t = threadIdx.x; asm volatile("" : "+v"(t)); return t; }
__device__ __forceinline__ int opaque_s(int v) { asm volatile("" : "+s"(v)); return v; }
__device__ __forceinline__ float silu_f(float v) { return v * __builtin_amdgcn_rcpf(1.f + __expf(-v)); }

__device__ __forceinline__ int lds_byte(int r, int c) { const int st = (r >> 4) * 2 + (c >> 5), rr = r & 15, cc = c & 31, ob = rr * 64 + cc * 2; return st * 1024 + (ob ^ (((ob >> 9) & 1) << 5)); }
__device__ __forceinline__ void stage_rc(int b, int& R, int& C) { const int st = b >> 10, sb = b & 1023, swz = sb ^ (((sb >> 9) & 1) << 5); R = (st >> 1) * 16 + (swz >> 6); C = (st & 1) * 32 + ((swz & 63) >> 1); }

constexpr int T_IN = 10 * 16, T_OUT = 4 * 16, T_EXP = NE * 4 * 16, T_LAYER = T_IN + T_OUT + 3 * T_EXP;
__device__ __forceinline__ void convert_tiles(const Params& p, const int l, const int first, const int count, const int f, const int nf, LAS unsigned char* lds) {
    const int tid = opaque_tid();
    bf16_t* WINT = (bf16_t*)(p.ws + WS_WINT); bf16_t* WOUTT = (bf16_t*)(p.ws + WS_WOUTT); bf16_t* WGUT = (bf16_t*)(p.ws + WS_WGUT); bf16_t* WDT = (bf16_t*)(p.ws + WS_WDT);
    const int lane = tid & 63, wv = tid >> 6, ko = lane & 7, nq = wv * 8 + (lane >> 3);
    f32x4 rv[8]; const float* src = nullptr; size_t sld = 0;
#define CT_DECODE(t, SRC, SLD, DST, RS, F8) do { int i = (t); RS = 16; F8 = 0; \
        if (i < T_IN) { const int nt = i >> 4, kt = i & 15; const int n0 = nt < 6 ? nt * 256 : 1552 + (nt - 6) * 256; \
            SRC = p.w_in + ((size_t)l * D + kt * 64) * INC + n0; SLD = INC; DST = WINT + ((size_t)l * PN + nt * 256) * D + kt * 64; } \
        else if (i < T_IN + T_OUT) { i -= T_IN; const int nt = i >> 4, kt = i & 15; \
            SRC = p.w_out + ((size_t)l * D + kt * 64) * D + nt * 256; SLD = D; DST = WOUTT + ((size_t)l * D + nt * 256) * D + kt * 64; } \
        else { i -= T_IN + T_OUT; const int which = i / T_EXP; i %= T_EXP; const int e = i >> 6, nt = (i >> 4) & 3, kt = i & 15; \
            const size_t mo = ((size_t)(l * NE + e) * D + kt * 64) * D + nt * 256; \
            F8 = MOE_FP8; \
            if (which == 2) { SRC = p.w_down + mo; DST = WDT + (((size_t)(l * NE + e) * D + nt * 256) * D + kt * 64) / (MOE_FP8 ? 2 : 1); } \
            else { SRC = (which == 0 ? p.w_gate : p.w_up) + mo; RS = 32; DST = WGUT + (((size_t)(l * NE + e) * 2048 + nt * 512 + which * 16) * D + kt * 64) / (MOE_FP8 ? 2 : 1); } \
            SLD = D; } } while (0)
#define CT_LOAD() do { _Pragma("unroll") for (int j = 0; j < 8; ++j) rv[j] = *(const f32x4*)(src + (size_t)(ko * 8 + j) * sld + nq * 4); } while (0)
    bf16_t* dst = nullptr; int rs = 16, f8 = 0;
    int t = first + f;
    if (t < first + count) { CT_DECODE(t, src, sld, dst, rs, f8); CT_LOAD(); }
    for (; t < first + count; t += nf) {
        u32x4 o[4];
        const int fcur = f8;
        if (fcur) {
#pragma unroll
            for (int e = 0; e < 4; ++e) { o[e][0] = pk_fp8x4(rv[0][e] * F8_SW, rv[1][e] * F8_SW, rv[2][e] * F8_SW, rv[3][e] * F8_SW); o[e][1] = pk_fp8x4(rv[4][e] * F8_SW, rv[5][e] * F8_SW, rv[6][e] * F8_SW, rv[7][e] * F8_SW); o[e][2] = 0u; o[e][3] = 0u; }
        } else {
#pragma unroll
            for (int e = 0; e < 4; ++e) { o[e][0] = pk_bf16(rv[0][e], rv[1][e]); o[e][1] = pk_bf16(rv[2][e], rv[3][e]); o[e][2] = pk_bf16(rv[4][e], rv[5][e]); o[e][3] = pk_bf16(rv[6][e], rv[7][e]); }
        }
        bf16_t* dcur = dst; const int rcur = rs;
        if (t + nf < first + count) { CT_DECODE(t + nf, src, sld, dst, rs, f8); CT_LOAD(); }
        if (fcur) {
#pragma unroll
            for (int e = 0; e < 4; ++e) { const int n = nq * 4 + e; u32x2 o2; o2[0] = o[e][0]; o2[1] = o[e][1];
                *(u32x2*)((unsigned char*)dcur + (size_t)((n >> 4) * rcur + (n & 15)) * D + ko * 8) = o2; }
        } else {
#pragma unroll
            for (int e = 0; e < 4; ++e) { const int n = nq * 4 + e; *(u32x4*)(dcur + (size_t)((n >> 4) * rcur + (n & 15)) * D + ko * 8) = o[e]; }
        }
    }
#undef CT_DECODE
#undef CT_LOAD
}

__device__ __forceinline__ void phase_prologue(const Params& p, LAS unsigned char* lds) {
    const int tid = opaque_tid();
    {
        LAS float* sc = (LAS float*)lds;
        LAS float* red = sc + 9 * 1024;
        for (int idx = tid; idx < 9 * 1024; idx += NTHREADS) {
            const int r = idx >> 10, k = idx & 1023;
            const float v = r < 8 ? p.c[r * 1024 + k] : p.c_ctx[k];
            sc[idx] = silu_f(v);
        }
        __syncthreads();
        float* MOD = (float*)(p.ws + WS_MOD);
        for (int u = blockIdx.x; u < DEPTH * 192; u += gridDim.x) {
            const int l = u / 192, c0 = (u % 192) * 32, col = tid & 31, kg = tid >> 5;
            float acc[9];
#pragma unroll
            for (int r = 0; r < 9; ++r) acc[r] = 0.f;
            const float* W = p.w_mod + ((size_t)l * 1024 + kg * 64) * 6144 + c0 + col;
            for (int k0 = 0; k0 < 64; k0 += 8) {
                float w[8];
#pragma unroll
                for (int j = 0; j < 8; ++j) w[j] = W[(size_t)(k0 + j) * 6144];
#pragma unroll
                for (int r = 0; r < 9; ++r) {
                    const f32x4 s0 = *(const LAS f32x4*)(sc + r * 1024 + kg * 64 + k0), s1 = *(const LAS f32x4*)(sc + r * 1024 + kg * 64 + k0 + 4);
                    acc[r] += s0[0] * w[0] + s0[1] * w[1] + s0[2] * w[2] + s0[3] * w[3] + s1[0] * w[4] + s1[1] * w[5] + s1[2] * w[6] + s1[3] * w[7];
                }
            }
#pragma unroll
            for (int r = 0; r < 9; ++r) red[(kg * 9 + r) * 32 + col] = acc[r];
            __syncthreads();
            if (tid < 288) {
                const int r = tid >> 5, cc = tid & 31;
                float sv = 0.f;
#pragma unroll
                for (int g = 0; g < 16; ++g) sv += red[(g * 9 + r) * 32 + cc];
                MOD[((size_t)l * 9 + r) * 6144 + c0 + cc] = sv + p.b_mod[l * 6144 + c0 + cc];
            }
            __syncthreads();
        }
    }
    {
        convert_tiles(p, 0, 0, T_LAYER, (int)blockIdx.x, (int)gridDim.x, lds);
        {
            float* W16T = (float*)(p.ws + WS_W16T);
            for (int i = blockIdx.x * NTHREADS + tid; i < DEPTH * 2 * 16 * D; i += gridDim.x * NTHREADS) {
                const int l2 = i >> 15, wh = (i >> 14) & 1, j = (i >> 10) & 15, k = i & 1023;
                W16T[i] = wh ? p.w_router[((size_t)l2 * D + k) * NE + j] : p.w_in[((size_t)l2 * D + k) * INC + 1536 + j];
            }
        }
        bf16_t* PWT = (bf16_t*)(p.ws + WS_PWT);
        for (int i = blockIdx.x * NTHREADS + tid; i < DEPTH * 4 * 128 * 128; i += gridDim.x * NTHREADS) {
            const int lg = i >> 14, d = (i >> 7) & 127, c = i & 127;
            PWT[i] = (bf16_t)(pk_bf16(p.pool_w[((size_t)lg * 128 + c) * 128 + d], 0.f) & 0xffffu);
        }
    }
}

__device__ __forceinline__ float reduce4(const float v0, const float v1, const float v2, const float v3, const int lane) {
    const bool b5 = lane & 32, b4 = lane & 16;
    const float a0 = (b5 ? v2 : v0) + shx(b5 ? v0 : v2, 32, lane), a1 = (b5 ? v3 : v1) + shx(b5 ? v1 : v3, 32, lane);
    float c = (b4 ? a1 : a0) + shx(b4 ? a0 : a1, 16, lane);
    c += shx(c, 8, lane); c += shx(c, 4, lane); c += shx(c, 2, lane); c += shx(c, 1, lane);
    return c;
}

template <int WHICH>
__device__ __forceinline__ void phase_norm(const Params& p, const int l, LAS unsigned char* lds) {
    const int tid = opaque_tid(), wid = tid >> 6, lane = tid & 63;
    LAS float* wsm = (LAS float*)lds;
    if (WHICH != 3) {
        const f32x4* src = (const f32x4*)(p.ws + WS_W16T) + (size_t)(l * 2 + (WHICH == 2 ? 1 : 0)) * 4096;
        f32x4 fv[8];
#pragma unroll
        for (int i = 0; i < 8; ++i) fv[i] = src[tid + i * NTHREADS];
#pragma unroll
        for (int i = 0; i < 8; ++i) *(LAS f32x4*)(wsm + (tid + i * NTHREADS) * 4) = fv[i];
        {
            const float* nwp = WHICH == 1 ? p.norm1 + l * D : p.norm2 + l * D;
            const float* mdp = (const float*)(p.ws + WS_MOD) + (size_t)l * 9 * 6144 + (WHICH == 1 ? 0 : 3072);
            for (int idx = tid; idx < 9 * 256; idx += NTHREADS) {
                const int sm = idx >> 8, c = (idx & 255) * 4;
                const f32x4 w = *(const f32x4*)(nwp + c), sh = *(const f32x4*)(mdp + (size_t)sm * 6144 + c), scl = *(const f32x4*)(mdp + (size_t)sm * 6144 + 1024 + c);
                *(LAS f32x4*)(wsm + 16384 + sm * 1024 + c) = w * (scl + 1.f);
                *(LAS f32x4*)(wsm + 16384 + 9216 + sm * 1024 + c) = sh;
            }
        }
        __syncthreads();
    }
    const float* nw = WHICH == 1 ? p.norm1 + l * D : (WHICH == 2 ? p.norm2 + l * D : p.norm_f);
    float* X = (float*)(p.ws + WS_X);
    const float* MOD = (const float*)(p.ws + WS_MOD);
    bf16_t* H = (bf16_t*)(p.ws + WS_H);
    const int nrows = (WHICH == 3 || (WHICH == 2 && l == DEPTH - 1)) ? ROWS_LAT : MT;
    constexpr int R = 3;
    const int rstride = gridDim.x * 8;
    const bool comb = (WHICH == 1 && l > 0) || WHICH == 3;
    const bool first_layer = (WHICH == 1 && l == 0);
    f32x4 xn[R][4]; int svn[R];
#define NORM_LOAD(b0) do { _Pragma("unroll") for (int k = 0; k < R; ++k) { const int row = (b0) + k * rstride; svn[k] = -1; \
        if (row < nrows) { const float* xr = first_layer ? (row < ROWS_LAT ? p.x + (size_t)row * D : p.ctx + (size_t)(row - ROWS_LAT) * D) : X + (size_t)row * D; \
            _Pragma("unroll") for (int i = 0; i < 4; ++i) xn[k][i] = *(const f32x4*)(xr + i * 256 + lane * 4); \
            if (comb && lane < 16) svn[k] = ((const int*)(p.ws + WS_SLOTOF))[(size_t)row * 16 + lane]; } \
        else { _Pragma("unroll") for (int i = 0; i < 4; ++i) xn[k][i] = (f32x4){0.f, 0.f, 0.f, 0.f}; } } } while (0)
    NORM_LOAD(blockIdx.x * 8 + wid);
    for (int base = blockIdx.x * 8 + wid; base < nrows; base += rstride * R) {
        f32x4 xv[R][4]; int sv[R]; bool ok[R];
#pragma unroll
        for (int k = 0; k < R; ++k) { ok[k] = (base + k * rstride) < nrows; sv[k] = svn[k];
#pragma unroll
            for (int i = 0; i < 4; ++i) xv[k][i] = xn[k][i]; }
        if (first_layer) {
#pragma unroll
            for (int k = 0; k < R; ++k) if (ok[k]) {
#pragma unroll
                for (int i = 0; i < 4; ++i) *(f32x4*)(X + (size_t)(base + k * rstride) * D + i * 256 + lane * 4) = xv[k][i]; }
        }
        if (comb) {
            const bf16_t* YE = (const bf16_t*)(p.ws + WS_YE);
            f32x4 a[R][4]; unsigned long long msk[R];
#pragma unroll
            for (int k = 0; k < R; ++k) { msk[k] = __ballot(sv[k] >= 0);
#pragma unroll
                for (int i = 0; i < 4; ++i) a[k][i] = (f32x4){0.f, 0.f, 0.f, 0.f}; }
            while (msk[0] | msk[1] | msk[2]) {
                u32x2 t[R][2][4]; bool has[R][2];
#pragma unroll
                for (int k = 0; k < R; ++k)
#pragma unroll
                    for (int q = 0; q < 2; ++q) {
                        has[k][q] = msk[k] != 0ull;
                        if (has[k][q]) {
                            const int e = __builtin_ctzll(msk[k]); msk[k] &= msk[k] - 1ull;
                            const int sl = __builtin_amdgcn_readlane(sv[k], e);
                            const bf16_t* yr = YE + (size_t)sl * D;
#pragma unroll
                            for (int i = 0; i < 4; ++i) t[k][q][i] = *(const u32x2*)(yr + i * 256 + lane * 4);
                        }
                    }
#pragma unroll
                for (int k = 0; k < R; ++k)
#pragma unroll
                    for (int q = 0; q < 2; ++q) if (has[k][q]) {
#pragma unroll
                        for (int i = 0; i < 4; ++i) { a[k][i][0] += bf_lo(t[k][q][i][0]); a[k][i][1] += bf_hi(t[k][q][i][0]); a[k][i][2] += bf_lo(t[k][q][i][1]); a[k][i][3] += bf_hi(t[k][q][i][1]); }
                    }
            }
#pragma unroll
            for (int k = 0; k < R; ++k) if (ok[k]) {
                const int row = base + k * rstride;
#pragma unroll
                for (int i = 0; i < 4; ++i) { xv[k][i] += a[k][i];
                    if (WHICH == 1) *(f32x4*)(X + (size_t)row * D + i * 256 + lane * 4) = xv[k][i]; }
            }
        }
        float rstd[R];
#pragma unroll
        for (int k = 0; k < R; ++k) {
            float ss = 0.f;
#pragma unroll
            for (int i = 0; i < 4; ++i) ss += xv[k][i][0] * xv[k][i][0] + xv[k][i][1] * xv[k][i][1] + xv[k][i][2] * xv[k][i][2] + xv[k][i][3] * xv[k][i][3];
            rstd[k] = rsqrtf(wave_sum(ss, lane) * (1.f / 1024.f) + EPS);
        }
        if (WHICH == 3) {
            if (base + rstride * R < nrows) NORM_LOAD(base + rstride * R);
#pragma unroll
            for (int k = 0; k < R; ++k) if (ok[k]) {
                const int row = base + k * rstride;
#pragma unroll
                for (int i = 0; i < 4; ++i) { const f32x4 w = *(const f32x4*)(nw + i * 256 + lane * 4); *(f32x4*)(p.out + (size_t)row * D + i * 256 + lane * 4) = xv[k][i] * rstd[k] * w; }
            }
            continue;
        }
#pragma unroll
        for (int k = 0; k < R; ++k) {
            const int row = base + k * rstride, bidx = row < ROWS_LAT ? (row >> 11) : 8;
#pragma unroll
            for (int i = 0; i < 4; ++i) {
                const int c = i * 256 + lane * 4;
                const f32x4 av = *(const LAS f32x4*)(wsm + 16384 + bidx * 1024 + c), sh = *(const LAS f32x4*)(wsm + 16384 + 9216 + bidx * 1024 + c);
                xv[k][i] = (xv[k][i] * rstd[k]) * av + sh;
                if (ok[k]) {
                    if (MOE_FP8 && WHICH == 2) *(unsigned*)((unsigned char*)H + (size_t)row * D + c) = pk_fp8x4(xv[k][i][0], xv[k][i][1], xv[k][i][2], xv[k][i][3]);
                    else { u32x2 o; o[0] = pk_bf16(xv[k][i][0], xv[k][i][1]); o[1] = pk_bf16(xv[k][i][2], xv[k][i][3]); *(u32x2*)(H + (size_t)row * D + c) = o; }
                }
            }
        }
        if (base + rstride * R < nrows) NORM_LOAD(base + rstride * R);
        float dj[R][4];
#pragma unroll
        for (int jg = 0; jg < 4; ++jg) {
            float sp[R][4];
#pragma unroll
            for (int jj = 0; jj < 4; ++jj) {
                const int j = jg * 4 + jj;
                f32x2 s0 = {0.f, 0.f}, s1 = {0.f, 0.f}, s2 = {0.f, 0.f};
#pragma unroll
                for (int i = 0; i < 4; ++i) { const f32x4 w = *(const LAS f32x4*)(wsm + j * 1024 + i * 256 + lane * 4);
                    const f32x2 wl = {w[0], w[1]}, wh = {w[2], w[3]};
                    s0 += (f32x2){xv[0][i][0], xv[0][i][1]} * wl; s0 += (f32x2){xv[0][i][2], xv[0][i][3]} * wh;
                    s1 += (f32x2){xv[1][i][0], xv[1][i][1]} * wl; s1 += (f32x2){xv[1][i][2], xv[1][i][3]} * wh;
                    s2 += (f32x2){xv[2][i][0], xv[2][i][1]} * wl; s2 += (f32x2){xv[2][i][2], xv[2][i][3]} * wh; }
                sp[0][jj] = s0[0] + s0[1]; sp[1][jj] = s1[0] + s1[1]; sp[2][jj] = s2[0] + s2[1];
            }
#pragma unroll
            for (int k = 0; k < R; ++k) dj[k][jg] = reduce4(sp[k][0], sp[k][1], sp[k][2], sp[k][3], lane);
            __builtin_amdgcn_sched_barrier(0);
        }
        const int q = lane >> 4;
#pragma unroll
        for (int k = 0; k < R; ++k) {
            const int row = base + k * rstride;
            if (WHICH == 1) {
                if (ok[k] && (lane & 15) == 0) {
#pragma unroll
                    for (int jg = 0; jg < 4; ++jg) {
                        const int j = jg * 4 + q; const float v = dj[k][jg];
                        if (jg < 2) { const float xa = v + p.dt_bias[l * 8 + j]; const float sp2 = xa > 20.f ? xa : log1pf(__expf(xa));
                            ((float*)(p.ws + WS_LOGA))[(size_t)row * 8 + j] = -__expf(p.a_log[l * 8 + j]) * sp2; }
                        else ((float*)(p.ws + WS_BETA))[(size_t)row * 8 + (j - 8)] = 1.f / (1.f + __expf(-v));
                    }
                }
            } else {
                float m = fmaxf(fmaxf(dj[k][0], dj[k][1]), fmaxf(dj[k][2], dj[k][3]));
                m = fmaxf(m, shx(m, 16, lane)); m = fmaxf(m, shx(m, 32, lane));
                float e[4], sum = 0.f;
#pragma unroll
                for (int jg = 0; jg < 4; ++jg) { e[jg] = __expf(dj[k][jg] - m); sum += e[jg]; }
                sum += shx(sum, 16, lane); sum += shx(sum, 32, lane);
                const float inv = 1.f / sum;
                if (ok[k] && (lane & 15) == 0) {
#pragma unroll
                    for (int jg = 0; jg < 4; ++jg) ((float*)(p.ws + WS_AFF))[(size_t)row * 16 + jg * 4 + q] = e[jg] * inv;
                }
            }
        }
    }
}

#undef NORM_LOAD
__device__ __forceinline__ void gemm_core(const unsigned char* Ab, const unsigned (&aoff)[4], const unsigned char* Bb, const unsigned (&boff)[2], const int nt,
                                          LAS unsigned char* lds, f32x4 (&acc)[4][4], const int wid, const int lane) {
    const int wr = wid >> 1, wc = wid & 1, fr = lane & 15, fq = lane >> 4;
    const int ar = lds_byte(wr * 64 + fr, fq * 8), br = lds_byte(wc * 64 + fr, fq * 8);
    const unsigned ldsw = (unsigned)wid * 1024u;
#define G_STAGE(t, buf) do { const unsigned _ko = (unsigned)(t) * 128u; \
        _Pragma("unroll") for (int _i = 0; _i < 4; ++_i) __builtin_amdgcn_global_load_lds((const unsigned*)(Ab + aoff[_i] + _ko), (LAS unsigned*)(lds + (buf) * 49152 + ldsw + _i * 8192), 16, 0, 0); \
        _Pragma("unroll") for (int _i = 0; _i < 2; ++_i) __builtin_amdgcn_global_load_lds((const unsigned*)(Bb + boff[_i] + _ko), (LAS unsigned*)(lds + (buf) * 49152 + 32768 + ldsw + _i * 8192), 16, 0, 0); } while (0)
#pragma unroll
    for (int m = 0; m < 4; ++m)
#pragma unroll
        for (int n = 0; n < 4; ++n) acc[m][n] = (f32x4){0.f, 0.f, 0.f, 0.f};
#if REGSTAGE
    u32x4 ra[4], rb[2];
#pragma unroll
    for (int i = 0; i < 4; ++i) ra[i] = *(const u32x4*)(Ab + aoff[i]);
#pragma unroll
    for (int i = 0; i < 2; ++i) rb[i] = *(const u32x4*)(Bb + boff[i]);
    const unsigned tb = (unsigned)(wid * 64 + lane) * 16u;
    for (int t = 0; t < nt; ++t) {
        __syncthreads();
#pragma unroll
        for (int i = 0; i < 4; ++i) *(LAS u32x4*)(lds + tb + i * 8192) = ra[i];
#pragma unroll
        for (int i = 0; i < 2; ++i) *(LAS u32x4*)(lds + 32768 + tb + i * 8192) = rb[i];
        __syncthreads();
        if (t + 1 < nt) {
            const unsigned ko = (unsigned)(t + 1) * 128u;
#pragma unroll
            for (int i = 0; i < 4; ++i) ra[i] = *(const u32x4*)(Ab + aoff[i] + ko);
#pragma unroll
            for (int i = 0; i < 2; ++i) rb[i] = *(const u32x4*)(Bb + boff[i] + ko);
        }
        LAS unsigned char* bA = lds; LAS unsigned char* bB = bA + 32768;
        bf16x8 af[4][2], bfr[4][2];
#pragma unroll
        for (int m = 0; m < 4; ++m)
#pragma unroll
            for (int k = 0; k < 2; ++k) af[m][k] = *(const LAS bf16x8*)(bA + ar + m * 2048 + k * 1024);
#pragma unroll
        for (int n = 0; n < 4; ++n)
#pragma unroll
            for (int k = 0; k < 2; ++k) bfr[n][k] = *(const LAS bf16x8*)(bB + br + n * 2048 + k * 1024);
#pragma unroll
        for (int k = 0; k < 2; ++k)
#pragma unroll
            for (int m = 0; m < 4; ++m)
#pragma unroll
                for (int n = 0; n < 4; ++n) acc[m][n] = __builtin_amdgcn_mfma_f32_16x16x32_bf16(bfr[n][k], af[m][k], acc[m][n], 0, 0, 0);
    }
#else
    G_STAGE(0, 0);
    for (int t = 0; t < nt; ++t) {
        asm volatile("s_waitcnt vmcnt(0)" ::: "memory");
        __syncthreads();
        if (t + 1 < nt) { if ((t + 1) & 1) G_STAGE(t + 1, 1); else G_STAGE(t + 1, 0); }
        LAS unsigned char* bA = lds + (t & 1) * 49152; LAS unsigned char* bB = bA + 32768;
        bf16x8 af[4][2], bfr[4][2];
#pragma unroll
        for (int m = 0; m < 4; ++m)
#pragma unroll
            for (int k = 0; k < 2; ++k) af[m][k] = *(const LAS bf16x8*)(bA + ar + m * 2048 + k * 1024);
#pragma unroll
        for (int n = 0; n < 4; ++n)
#pragma unroll
            for (int k = 0; k < 2; ++k) bfr[n][k] = *(const LAS bf16x8*)(bB + br + n * 2048 + k * 1024);
#pragma unroll
        for (int k = 0; k < 2; ++k)
#pragma unroll
            for (int m = 0; m < 4; ++m)
#pragma unroll
                for (int n = 0; n < 4; ++n) acc[m][n] = __builtin_amdgcn_mfma_f32_16x16x32_bf16(bfr[n][k], af[m][k], acc[m][n], 0, 0, 0);
    }
#endif
    __syncthreads();
#undef G_STAGE
}

template <int MODE>
__device__ __forceinline__ void phase_gemm(const Params& p, const int l, LAS unsigned char* lds) {
    const int tid = opaque_tid(), wid = __builtin_amdgcn_readfirstlane(tid >> 6), lane = tid & 63;
    const int wr = wid >> 1, wc = wid & 1, fr = lane & 15, fq = lane >> 4;
    int R0, C0; stage_rc(tid * 16, R0, C0);
    constexpr int nN = MODE == 0 ? 20 : (MODE == 1 ? 8 : (MODE == 2 ? 16 : 8));
    constexpr int nM = (MODE <= 1) ? MT / 256 : NGROUPS;
    const bf16_t* H = (const bf16_t*)(p.ws + WS_H);
    for (int u = blockIdx.x; u < nM * nN; u += gridDim.x) {
        const int pm = u / nN, pn = u % nN;
        const unsigned char* Ab; const unsigned char* Bb; unsigned aoff[4], boff[2];
#pragma unroll
        for (int i = 0; i < 2; ++i) boff[i] = (unsigned)((R0 + 64 * i) * D + C0) * 2u;
        int e = 0;
        if (MODE == 0) {
            Ab = (const unsigned char*)(H + (size_t)pm * 256 * D); Bb = (const unsigned char*)((const bf16_t*)(p.ws + WS_WINT) + ((size_t)l * PN + pn * 128) * D);
#pragma unroll
            for (int i = 0; i < 4; ++i) aoff[i] = (unsigned)((R0 + 64 * i) * D + C0) * 2u;
        } else if (MODE == 1) {
            Ab = (const unsigned char*)((const bf16_t*)(p.ws + WS_CAT) + (size_t)pm * 256 * D); Bb = (const unsigned char*)((const bf16_t*)(p.ws + WS_WOUTT) + ((size_t)l * D + pn * 128) * D);
#pragma unroll
            for (int i = 0; i < 4; ++i) aoff[i] = (unsigned)((R0 + 64 * i) * D + C0) * 2u;
        } else if (MODE == 2) {
            e = pm < 128 ? (pm >> 3) : (pm - 128);
            const int* SEL = (const int*)(p.ws + WS_SEL) + pm * 256;
            Ab = (const unsigned char*)H; Bb = (const unsigned char*)((const bf16_t*)(p.ws + WS_WGUT) + ((size_t)(l * NE + e) * 2048 + pn * 128) * D);
#pragma unroll
            for (int i = 0; i < 4; ++i) aoff[i] = (unsigned)(SEL[R0 + 64 * i] * D + C0) * 2u;
        } else {
            e = pm < 128 ? (pm >> 3) : (pm - 128);
            Ab = (const unsigned char*)((const bf16_t*)(p.ws + WS_HID) + (size_t)pm * 256 * D); Bb = (const unsigned char*)((const bf16_t*)(p.ws + WS_WDT) + ((size_t)(l * NE + e) * D + pn * 128) * D);
#pragma unroll
            for (int i = 0; i < 4; ++i) aoff[i] = (unsigned)((R0 + 64 * i) * D + C0) * 2u;
        }
        f32x4 acc[4][4];
        gemm_core(Ab, aoff, Bb, boff, D / 64, lds, acc, wid, lane);
        if (MODE == 0) {
            bf16_t* PROJ = (bf16_t*)(p.ws + WS_PROJ);
#pragma unroll
            for (int m = 0; m < 4; ++m) { const size_t row = (size_t)pm * 256 + wr * 64 + m * 16 + fr;
#pragma unroll
                for (int n = 0; n < 4; ++n) { u32x2 o; o[0] = pk_bf16(acc[m][n][0], acc[m][n][1]); o[1] = pk_bf16(acc[m][n][2], acc[m][n][3]);
                    *(u32x2*)(PROJ + row * PN + pn * 128 + wc * 64 + n * 16 + fq * 4) = o; } }
        } else if (MODE == 1) {
            float* X = (float*)(p.ws + WS_X);
            const int bidx = pm < 64 ? (pm >> 3) : 8;
            const float* g1 = (const float*)(p.ws + WS_MOD) + ((size_t)l * 9 + bidx) * 6144 + 2048;
#pragma unroll
            for (int n = 0; n < 4; ++n) { const int col = pn * 128 + wc * 64 + n * 16 + fq * 4; const f32x4 g = *(const f32x4*)(g1 + col);
#pragma unroll
                for (int m = 0; m < 4; ++m) { float* xp = X + ((size_t)pm * 256 + wr * 64 + m * 16 + fr) * D + col; *(f32x4*)xp = *(const f32x4*)xp + g * acc[m][n]; } }
        } else if (MODE == 2) {
            bf16_t* HID = (bf16_t*)(p.ws + WS_HID);
#pragma unroll
            for (int m = 0; m < 4; ++m) { const size_t slot = (size_t)pm * 256 + wr * 64 + m * 16 + fr;
#pragma unroll
                for (int q = 0; q < 2; ++q) { const f32x4 g = acc[m][2 * q], uu = acc[m][2 * q + 1];
                    u32x2 o; o[0] = pk_bf16(silu_f(g[0]) * uu[0], silu_f(g[1]) * uu[1]); o[1] = pk_bf16(silu_f(g[2]) * uu[2], silu_f(g[3]) * uu[3]);
                    *(u32x2*)(HID + slot * D + pn * 64 + wc * 32 + q * 16 + fq * 4) = o; } }
        } else {
            bf16_t* YE = (bf16_t*)(p.ws + WS_YE);
            const float* SELAFF = (const float*)(p.ws + WS_SELAFF);
#pragma unroll
            for (int m = 0; m < 4; ++m) { const size_t slot = (size_t)pm * 256 + wr * 64 + m * 16 + fr; const float a = SELAFF[slot];
#pragma unroll
                for (int n = 0; n < 4; ++n) { const f32x4 g = *(const f32x4*)((const float*)(p.ws + WS_MOD) + ((size_t)l * 9 + (pm < 128 ? (pm & 7) : 8)) * 6144 + 5 * 1024 + pn * 128 + wc * 64 + n * 16 + fq * 4);
                    u32x2 o; o[0] = pk_bf16(acc[m][n][0] * a * g[0], acc[m][n][1] * a * g[1]); o[1] = pk_bf16(acc[m][n][2] * a * g[2], acc[m][n][3] * a * g[3]);
                    *(u32x2*)(YE + slot * D + pn * 128 + wc * 64 + n * 16 + fq * 4) = o; } }
        }
    }
}

struct UnitOps { const unsigned char* A; const unsigned char* B; unsigned va[2][2]; int pm, pn; };

template <int MODE> __device__ __forceinline__ int gemm_nunits(const int l) {
    const bool last = (l == DEPTH - 1);
    if (MODE == 0) return last ? 640 + 8 * 6 : 720;
    if (MODE == 1) return last ? 256 : 288;
    if (MODE == 2) return last ? 1024 : 1152;
    return last ? 512 : 576;
}
template <int MODE>
__device__ __forceinline__ bool gemm_unit(const Params& p, const int l, const int i, const int R0, const int C0, UnitOps& u) {
    constexpr int nN = MODE == 0 ? 10 : (MODE == 1 ? 4 : (MODE == 2 ? 8 : 4));
    const int G = gridDim.x, c = (G & 7) == 0 ? (int)(blockIdx.x & 7) * (G >> 3) + (int)(blockIdx.x >> 3) : (int)blockIdx.x;
    const int idx = c + i * G;
    if (idx >= gemm_nunits<MODE>(l)) return false;
    int pm = idx / nN, pn = idx % nN;
    if (MODE == 0 && idx >= 640 && l == DEPTH - 1) { pm = 64 + (idx - 640) / 6; pn = (idx - 640) % 6; }
    u.pm = pm; u.pn = pn;
    constexpr unsigned RB = (MOE_FP8 && MODE >= 2) ? D : 2 * D;
    if (MODE == 2) {
        const int e = pm < 128 ? (pm >> 3) : (pm - 128);
        const int* SEL = (const int*)(p.ws + WS_SEL) + pm * 256;
        u.A = p.ws + WS_H; u.B = p.ws + WS_WGUT + ((size_t)(l * NE + e) * 2048 + pn * 256) * RB;
#pragma unroll
        for (int h = 0; h < 2; ++h)
#pragma unroll
            for (int k = 0; k < 2; ++k) u.va[h][k] = (unsigned)SEL[h * 128 + R0 + 64 * k] * RB + (unsigned)C0 * 2u;
    } else {
        if (MODE == 0) { u.A = p.ws + WS_H + (size_t)pm * 256 * RB; u.B = p.ws + WS_WINT + ((size_t)l * PN + pn * 256) * RB; }
        else if (MODE == 1) { u.A = p.ws + WS_CAT + (size_t)pm * 256 * RB; u.B = p.ws + WS_WOUTT + ((size_t)l * D + pn * 256) * RB; }
        else { const int e = pm < 128 ? (pm >> 3) : (pm - 128); u.A = p.ws + WS_HID + (size_t)pm * 256 * RB; u.B = p.ws + WS_WDT + ((size_t)(l * NE + e) * D + pn * 256) * RB; }
#pragma unroll
        for (int h = 0; h < 2; ++h)
#pragma unroll
            for (int k = 0; k < 2; ++k) u.va[h][k] = (unsigned)(h * 128 + R0 + 64 * k) * RB + (unsigned)C0 * 2u;
    }
    return true;
}

template <int MODE>
__device__ __forceinline__ void gemm_epilogue(const Params& p, const int l, const f32x4 (&acc)[2][2][4][2], const UnitOps& u, const int wr, const int wc, const int fr, const int fq) {
    const int row0 = u.pm * 256 + wr * 64 + fr, col0 = u.pn * 256 + wc * 32 + (MODE == 2 ? 4 : 8) * fq;
    if (MODE == 0) {
        bf16_t* PROJ = (bf16_t*)(p.ws + WS_PROJ);
#pragma unroll
        for (int ai = 0; ai < 2; ++ai)
#pragma unroll
            for (int m = 0; m < 4; ++m) { bf16_t* rp = PROJ + (size_t)(row0 + ai * 128 + m * 16) * PN + col0;
#pragma unroll
                for (int bj = 0; bj < 2; ++bj) { const f32x4 v0 = acc[ai][bj][m][0], v1 = acc[ai][bj][m][1];
                    u32x4 o; o[0] = pk_bf16(v0[0], v0[1]); o[1] = pk_bf16(v0[2], v0[3]); o[2] = pk_bf16(v1[0], v1[1]); o[3] = pk_bf16(v1[2], v1[3]); *(u32x4*)(rp + bj * 128) = o; } }
    } else if (MODE == 1) {
        float* X = (float*)(p.ws + WS_X);
        const int bidx = u.pm < 64 ? (u.pm >> 3) : 8;
        const float* g1 = (const float*)(p.ws + WS_MOD) + ((size_t)l * 9 + bidx) * 6144 + 2048 + col0;
        f32x4 gv[2][2];
#pragma unroll
        for (int bj = 0; bj < 2; ++bj)
#pragma unroll
            for (int n = 0; n < 2; ++n) gv[bj][n] = *(const f32x4*)(g1 + bj * 128 + n * 4);
#pragma unroll
        for (int ai = 0; ai < 2; ++ai)
#pragma unroll
            for (int m = 0; m < 4; ++m) { float* rp = X + (size_t)(row0 + ai * 128 + m * 16) * D + col0;
#pragma unroll
                for (int bj = 0; bj < 2; ++bj)
#pragma unroll
                    for (int n = 0; n < 2; ++n) { float* xp = rp + bj * 128 + n * 4; *(f32x4*)xp = *(const f32x4*)xp + gv[bj][n] * acc[ai][bj][m][n]; } }
    } else if (MODE == 2) {
        const int f0 = u.pn * 128 + wc * 16 + 4 * fq;
        if (MOE_FP8) {
            unsigned char* HID8 = p.ws + WS_HID;
            constexpr float us = 1.f / F8_SW;
#pragma unroll
            for (int ai = 0; ai < 2; ++ai)
#pragma unroll
                for (int m = 0; m < 4; ++m) { unsigned char* rp = HID8 + (size_t)(row0 + ai * 128 + m * 16) * D + f0;
#pragma unroll
                    for (int bj = 0; bj < 2; ++bj) { const f32x4 g = acc[ai][bj][m][0] * us, uu = acc[ai][bj][m][1] * (us * F8_SHID);
                        *(unsigned*)(rp + bj * 64) = pk_fp8x4(silu_f(g[0]) * uu[0], silu_f(g[1]) * uu[1], silu_f(g[2]) * uu[2], silu_f(g[3]) * uu[3]); } }
        } else {
        bf16_t* HID = (bf16_t*)(p.ws + WS_HID);
#pragma unroll
        for (int ai = 0; ai < 2; ++ai)
#pragma unroll
            for (int m = 0; m < 4; ++m) { bf16_t* rp = HID + (size_t)(row0 + ai * 128 + m * 16) * D + f0;
#pragma unroll
                for (int bj = 0; bj < 2; ++bj) { const f32x4 g = acc[ai][bj][m][0], uu = acc[ai][bj][m][1];
                    u32x2 o; o[0] = pk_bf16(silu_f(g[0]) * uu[0], silu_f(g[1]) * uu[1]); o[1] = pk_bf16(silu_f(g[2]) * uu[2], silu_f(g[3]) * uu[3]);
                    *(u32x2*)(rp + bj * 64) = o; } }
        }
    } else {
        bf16_t* YE = (bf16_t*)(p.ws + WS_YE);
        const float* SELAFF = (const float*)(p.ws + WS_SELAFF);
        const int bidx = u.pm < 128 ? (u.pm & 7) : 8;
        const float* g2 = (const float*)(p.ws + WS_MOD) + ((size_t)l * 9 + bidx) * 6144 + 5 * 1024 + col0;
        f32x4 gv[2][2];
#pragma unroll
        for (int bj = 0; bj < 2; ++bj)
#pragma unroll
            for (int n = 0; n < 2; ++n) gv[bj][n] = *(const f32x4*)(g2 + bj * 128 + n * 4);
#pragma unroll
        for (int ai = 0; ai < 2; ++ai)
#pragma unroll
            for (int m = 0; m < 4; ++m) { const size_t slot = (size_t)(row0 + ai * 128 + m * 16); const float a = SELAFF[slot] * (MOE_FP8 ? 1.f / (F8_SW * F8_SHID) : 1.f); bf16_t* rp = YE + slot * D + col0;
#pragma unroll
                for (int bj = 0; bj < 2; ++bj) { const f32x4 v0 = acc[ai][bj][m][0] * gv[bj][0] * a, v1 = acc[ai][bj][m][1] * gv[bj][1] * a;
                    u32x4 o; o[0] = pk_bf16(v0[0], v0[1]); o[1] = pk_bf16(v0[2], v0[3]); o[2] = pk_bf16(v1[0], v1[1]); o[3] = pk_bf16(v1[2], v1[3]); *(u32x4*)(rp + bj * 128) = o; } }
    }
}

template <int MODE>
__device__ __forceinline__ void gemm_filler(const Params& p, const int l, LAS unsigned char* lds) {
    if (MODE == 0 || l >= DEPTH - 1) return;
    const int G = gridDim.x, c = (G & 7) == 0 ? (int)(blockIdx.x & 7) * (G >> 3) + (int)(blockIdx.x >> 3) : (int)blockIdx.x;
    const int rem = gemm_nunits<MODE>(l) % G;
    if (rem == 0 || c < rem) return;
    constexpr int first = MODE == 1 ? 0 : (MODE == 2 ? 1344 : 2240), count = MODE == 1 ? 1344 : (MODE == 2 ? 896 : 1056);
    convert_tiles(p, l + 1, first, count, c - rem, G - rem, lds);
}

template <int MODE>
__device__ __forceinline__ void phase_gemm8(const Params& p, const int l, LAS unsigned char* lds) {
    const int tid = opaque_tid(), wid = __builtin_amdgcn_readfirstlane(tid >> 6), lane = tid & 63, wr = wid >> 2, wc = wid & 3, fr = lane & 15, fq = lane >> 4;
    constexpr int HTB = 16384;
    constexpr bool F8 = MOE_FP8 && MODE >= 2;
    constexpr int nt = F8 ? D / 128 : D / 64;
    constexpr unsigned RB = F8 ? D : 2 * D;
    constexpr unsigned kstep = 128u, hstepB = 128u * RB;
    int R0, C0; stage_rc(tid * 16, R0, C0);
    constexpr bool PERM = (MODE != 2);
    unsigned vb[2];
#pragma unroll
    for (int k = 0; k < 2; ++k) { const int R = R0 + 64 * k, rho = R & 31, Rb = PERM ? ((R & ~31) + 8 * ((rho & 15) >> 2) + 4 * (rho >> 4) + (rho & 3)) : R; vb[k] = (unsigned)Rb * RB + (unsigned)C0 * 2u; }
    const unsigned ldsw = (unsigned)wid * 1024u;
    const int aoff = lds_byte(wr * 64 + fr, fq * 8), boff = lds_byte(wc * 32 + fr, fq * 8);
#define G8_SA(b, h) (((b) * 2 + (h)) * HTB)
#define G8_SB(b, h) ((4 + (b) * 2 + (h)) * HTB)
#define G8_STAGE_A(bufoff, U, h, ko) do { _Pragma("unroll") for (int _i = 0; _i < 2; ++_i) \
        __builtin_amdgcn_global_load_lds((const unsigned*)((U).A + (U).va[h][_i] + (ko)), (LAS unsigned*)(lds + (bufoff) + ldsw + _i * 8192), 16, 0, 0); } while (0)
#define G8_STAGE_B(bufoff, U, h, ko) do { _Pragma("unroll") for (int _i = 0; _i < 2; ++_i) \
        __builtin_amdgcn_global_load_lds((const unsigned*)((U).B + vb[_i] + (h) * hstepB + (ko)), (LAS unsigned*)(lds + (bufoff) + ldsw + _i * 8192), 16, 0, 0); } while (0)
#define G8_LDA(dst, b, h) do { _Pragma("unroll") for (int m = 0; m < 4; ++m) _Pragma("unroll") for (int k = 0; k < 2; ++k) dst[m][k] = *(const LAS bf16x8*)(lds + G8_SA(b, h) + aoff + m * 2048 + k * 1024); } while (0)
#define G8_LDB(dst, b, h) do { _Pragma("unroll") for (int n = 0; n < 2; ++n) _Pragma("unroll") for (int k = 0; k < 2; ++k) dst[n][k] = *(const LAS bf16x8*)(lds + G8_SB(b, h) + boff + n * 2048 + k * 1024); } while (0)
#define G8_MMA(ai, bj, At, Bt) do { __builtin_amdgcn_s_setprio(1); _Pragma("unroll") for (int m = 0; m < 4; ++m) _Pragma("unroll") for (int n = 0; n < 2; ++n) _Pragma("unroll") for (int k = 0; k < 2; ++k) { \
        if (F8) { const i64x2 _a = __builtin_bit_cast(i64x2, At[m][k]), _b = __builtin_bit_cast(i64x2, Bt[n][k]); \
            acc[ai][bj][m][n] = __builtin_amdgcn_mfma_f32_16x16x32_fp8_fp8(_b[0], _a[0], acc[ai][bj][m][n], 0, 0, 0); \
            acc[ai][bj][m][n] = __builtin_amdgcn_mfma_f32_16x16x32_fp8_fp8(_b[1], _a[1], acc[ai][bj][m][n], 0, 0, 0); } \
        else acc[ai][bj][m][n] = __builtin_amdgcn_mfma_f32_16x16x32_bf16(Bt[n][k], At[m][k], acc[ai][bj][m][n], 0, 0, 0); } __builtin_amdgcn_s_setprio(0); } while (0)
#define G8_WAIT_V(n) asm volatile("s_waitcnt vmcnt(" #n ")" ::: "memory")
#define G8_WAIT_L(n) asm volatile("s_waitcnt lgkmcnt(" #n ")" ::: "memory")
#define G8_BAR __builtin_amdgcn_s_barrier()
#define G8_SCHED __builtin_amdgcn_sched_barrier(0)
    UnitOps cur, nxt; int ui = 0;
    if (!gemm_unit<MODE>(p, l, 0, R0, C0, cur)) { gemm_filler<MODE>(p, l, lds); return; }
    f32x4 acc[2][2][4][2];
#pragma unroll
    for (int a = 0; a < 2; ++a)
#pragma unroll
        for (int b = 0; b < 2; ++b)
#pragma unroll
            for (int m = 0; m < 4; ++m)
#pragma unroll
                for (int n = 0; n < 2; ++n) acc[a][b][m][n] = (f32x4){0.f, 0.f, 0.f, 0.f};
    bf16x8 At[4][2], B0[2][2], B1[2][2];
    bool has_next = gemm_unit<MODE>(p, l, 1, R0, C0, nxt);
    if (!has_next) nxt = cur;
    G8_STAGE_B(G8_SB(0, 0), cur, 0, 0u); G8_STAGE_A(G8_SA(0, 0), cur, 0, 0u); G8_STAGE_B(G8_SB(0, 1), cur, 1, 0u); G8_STAGE_A(G8_SA(0, 1), cur, 1, 0u);
    if (wr == 1) G8_BAR;
    G8_WAIT_V(4); G8_BAR;
    G8_STAGE_B(G8_SB(1, 0), cur, 0, kstep); G8_STAGE_A(G8_SA(1, 0), cur, 0, kstep); G8_STAGE_B(G8_SB(1, 1), cur, 1, kstep);
    G8_WAIT_V(6); G8_BAR;
    for (;;) {
#pragma unroll 1
        for (int t = 0; t < nt; t += 2) {
            const bool last = (t == nt - 2);
            const unsigned k1 = (unsigned)(t + 1) * kstep, k2 = last ? 0u : (unsigned)(t + 2) * kstep, k3 = k2 + kstep;
            UnitOps& U2 = last ? nxt : cur;
            G8_LDB(B0, 0, 0); G8_SCHED; G8_LDA(At, 0, 0); G8_STAGE_A(G8_SA(1, 1), cur, 1, k1);
            G8_WAIT_L(8); G8_BAR; G8_WAIT_L(0); G8_MMA(0, 0, At, B0); G8_BAR; G8_SCHED;
            G8_LDB(B1, 0, 1); G8_STAGE_B(G8_SB(0, 0), U2, 0, k2);
            G8_BAR; G8_WAIT_L(0); G8_MMA(0, 1, At, B1); G8_BAR;
            G8_LDA(At, 0, 1); G8_STAGE_A(G8_SA(0, 0), U2, 0, k2);
            G8_BAR; G8_WAIT_L(0); G8_MMA(1, 0, At, B0); G8_BAR; G8_SCHED;
            G8_STAGE_B(G8_SB(0, 1), U2, 1, k2);
            G8_WAIT_V(6); G8_BAR; G8_MMA(1, 1, At, B1); G8_BAR;
            G8_LDB(B0, 1, 0); G8_SCHED; G8_LDA(At, 1, 0); G8_STAGE_A(G8_SA(0, 1), U2, 1, k2);
            G8_WAIT_L(8); G8_BAR; G8_WAIT_L(0); G8_MMA(0, 0, At, B0); G8_BAR; G8_SCHED;
            G8_LDB(B1, 1, 1); G8_STAGE_B(G8_SB(1, 0), U2, 0, k3);
            G8_BAR; G8_WAIT_L(0); G8_MMA(0, 1, At, B1); G8_BAR;
            G8_LDA(At, 1, 1); G8_STAGE_A(G8_SA(1, 0), U2, 0, k3);
            G8_BAR; G8_WAIT_L(0); G8_MMA(1, 0, At, B0); G8_BAR; G8_SCHED;
            G8_STAGE_B(G8_SB(1, 1), U2, 1, k3);
            G8_WAIT_V(6); G8_BAR; G8_MMA(1, 1, At, B1); G8_BAR;
        }
        gemm_epilogue<MODE>(p, l, acc, cur, wr, wc, fr, fq);
        if (!has_next) break;
#pragma unroll
        for (int a = 0; a < 2; ++a)
#pragma unroll
            for (int b = 0; b < 2; ++b)
#pragma unroll
                for (int m = 0; m < 4; ++m)
#pragma unroll
                    for (int n = 0; n < 2; ++n) acc[a][b][m][n] = (f32x4){0.f, 0.f, 0.f, 0.f};
        cur = nxt; ++ui;
        has_next = gemm_unit<MODE>(p, l, ui + 1, R0, C0, nxt);
        if (!has_next) nxt = cur;
    }
    G8_WAIT_V(0);
    if (wr == 0) G8_BAR;
    G8_BAR;
    gemm_filler<MODE>(p, l, lds);
#undef G8_SA
#undef G8_SB
#undef G8_STAGE_A
#undef G8_STAGE_B
#undef G8_LDA
#undef G8_LDB
#undef G8_MMA
#undef G8_WAIT_V
#undef G8_WAIT_L
#undef G8_BAR
#undef G8_SCHED
}

template <int B>
__device__ __forceinline__ void pool_vsum(const bf16_t* src0, const size_t rstep, const int lo_r, const int hi_r, const int rc, const int npieces, LAS float* V, LAS unsigned char* U, const int tid) {
    for (int p0 = tid; p0 < npieces; p0 += 2 * NTHREADS) {
        const int p1 = p0 + NTHREADS; const bool two = p1 < npieces;
        const bf16_t* sa = src0 + (size_t)(p0 >> 4) * PN + (p0 & 15) * 8;
        const bf16_t* sb = src0 + (size_t)((two ? p1 : p0) >> 4) * PN + ((two ? p1 : p0) & 15) * 8;
        float aa[8], ab[8];
#pragma unroll
        for (int e = 0; e < 8; ++e) { aa[e] = 0.f; ab[e] = 0.f; }
        for (int r0 = lo_r; r0 < hi_r; r0 += B) {
            u32x4 va[B], vb[B];
#pragma unroll
            for (int k = 0; k < B; ++k) { const int rr = min(r0 + k, hi_r - 1); va[k] = *(const u32x4*)(sa + (size_t)rr * rstep); vb[k] = *(const u32x4*)(sb + (size_t)rr * rstep); }
#pragma unroll
            for (int k = 0; k < B; ++k) if (r0 + k < hi_r) {
                if (r0 + k == rc) { *(LAS u32x4*)(U + (p0 >> 4) * 256 + (p0 & 15) * 16) = va[k]; if (two) *(LAS u32x4*)(U + (p1 >> 4) * 256 + (p1 & 15) * 16) = vb[k]; }
#pragma unroll
                for (int e = 0; e < 4; ++e) { aa[2 * e] += bf_lo(va[k][e]); aa[2 * e + 1] += bf_hi(va[k][e]); ab[2 * e] += bf_lo(vb[k][e]); ab[2 * e + 1] += bf_hi(vb[k][e]); }
            }
        }
        *(LAS f32x4*)(V + (p0 >> 4) * 128 + (p0 & 15) * 8) = (f32x4){aa[0], aa[1], aa[2], aa[3]};
        *(LAS f32x4*)(V + (p0 >> 4) * 128 + (p0 & 15) * 8 + 4) = (f32x4){aa[4], aa[5], aa[6], aa[7]};
        if (two) { *(LAS f32x4*)(V + (p1 >> 4) * 128 + (p1 & 15) * 8) = (f32x4){ab[0], ab[1], ab[2], ab[3]};
                   *(LAS f32x4*)(V + (p1 >> 4) * 128 + (p1 & 15) * 8 + 4) = (f32x4){ab[4], ab[5], ab[6], ab[7]}; }
    }
}

__device__ __forceinline__ void phase_conv_pool(const Params& p, const int l, LAS unsigned char* lds, const int wg0 = 0, const int nwg = 0) {
    const int tid = opaque_tid(), wid = tid >> 6, lane = tid & 63;
    const bf16_t* PROJ = (const bf16_t*)(p.ws + WS_PROJ);
    if (NAIVE_SCAN) {
        float* QKV = (float*)(p.ws + WS_QKV);
        const float* cw = p.conv_w + (size_t)l * 4 * 1536;
        for (int task = blockIdx.x * 8 + wid; task < MT * 12; task += gridDim.x * 8) {
            const int row = task / 12, part = task % 12;
            int s0, len;
            if (row < ROWS_LAT) { s0 = row & ~2047; len = 2048; } else { s0 = ROWS_LAT + ((row - ROWS_LAT) & ~255); len = 256; }
            const int c = part * 128 + lane * 2;
            float a0 = 0.f, a1 = 0.f;
#pragma unroll
            for (int j = 0; j < 4; ++j) {
                const int r2 = row + j - 2;
                if (r2 >= s0 && r2 < s0 + len) {
                    const unsigned v = *(const unsigned*)(PROJ + (size_t)r2 * PN + c);
                    const f32x2 w = *(const f32x2*)(cw + j * 1536 + c);
                    a0 += w[0] * bf_lo(v); a1 += w[1] * bf_hi(v);
                }
            }
            a0 = silu_f(a0); a1 = silu_f(a1);
            if (part < 8) {
                const float ss = wave_sum(a0 * a0 + a1 * a1, lane);
                float sc = rsqrtf(ss + EPS);
                if (part < 4) sc *= 0.08838834764831845f;
                a0 *= sc; a1 *= sc;
            }
            *(f32x2*)(QKV + (size_t)row * 1536 + c) = (f32x2){a0, a1};
        }
    }
    {
        LAS float* V = (LAS float*)lds;
        LAS unsigned char* mt = lds + 40960;
        const bf16_t* PWT = (const bf16_t*)(p.ws + WS_PWT);
        bf16_t* CAT = (bf16_t*)(p.ws + WS_CAT);
        const int wr = wid >> 1, wc = wid & 1, fr = lane & 15, fq = lane >> 4;
        const int npool = (l == DEPTH - 1) ? 1024 : 1152;
        const int pstep = nwg > 0 ? nwg : (int)gridDim.x;
        for (int u = ((int)blockIdx.x >= wg0) ? (int)blockIdx.x - wg0 : npool; u < npool; u += pstep) {
            int g, r, nrows, ncols, c0, rowbase;
            if (u < 1024) { const int q = u & 255, b = q >> 5; g = (q + (u >> 8)) & 3; r = q & 31; nrows = 32; ncols = 64; c0 = 0; rowbase = b * 2048; }
            else { const int v = u - 1024; const int b = v >> 4; g = (v >> 2) & 3; r = 0; nrows = 1; ncols = 256; c0 = (v & 3) * 64; rowbase = ROWS_LAT + b * 256; }
            const int w = 2 << g, half = w >> 1;
            const int lo_r = max(r - half, 0), hi_r = min(r - half + w, nrows);
            const int cxlo = max(c0 - half, 0), cxhi = min(c0 + 64 + half, ncols);
            const bf16_t* ub = PROJ + 2048 + g * 128;
            const bf16_t* pw = PWT + (size_t)(l * 4 + g) * 128 * 128;
            bf16x8 pwf[4][4];
#pragma unroll
            for (int kk = 0; kk < 4; ++kk)
#pragma unroll
                for (int n = 0; n < 4; ++n) pwf[kk][n] = *(const bf16x8*)(pw + (size_t)(wc * 64 + n * 16 + fr) * 128 + kk * 32 + fq * 8);
            {
                const int npieces = (cxhi - cxlo) * 16;
                const size_t rstep = (size_t)ncols * PN;
                if (g == 0) pool_vsum<2>(ub + (size_t)(rowbase + cxlo) * PN, rstep, lo_r, hi_r, r, npieces, V, lds + 58368, tid);
                else if (g == 1) pool_vsum<4>(ub + (size_t)(rowbase + cxlo) * PN, rstep, lo_r, hi_r, r, npieces, V, lds + 58368, tid);
                else pool_vsum<8>(ub + (size_t)(rowbase + cxlo) * PN, rstep, lo_r, hi_r, r, npieces, V, lds + 58368, tid);
            }
            __syncthreads();
            for (int idx = tid; idx < 64 * 64; idx += NTHREADS) {
                const int ci = idx >> 6, ch = (idx & 63) * 2, c = c0 + ci;
                const int lo_c = max(c - half, 0), hi_c = min(c - half + w, ncols);
                float s0 = 0.f, s1 = 0.f;
                for (int cx = lo_c; cx < hi_c; ++cx) { s0 += V[(cx - cxlo) * 128 + ch]; s1 += V[(cx - cxlo) * 128 + ch + 1]; }
                const float inv = __builtin_amdgcn_rcpf((float)((hi_r - lo_r) * (hi_c - lo_c)));
                const unsigned v = *(const LAS unsigned*)(lds + 58368 + (c - cxlo) * 256 + ch * 2);
                *(LAS unsigned*)(mt + ci * 272 + ch * 2) = pk_bf16(s0 * inv - bf_lo(v), s1 * inv - bf_hi(v));
            }
            __syncthreads();
            f32x4 acc[4];
#pragma unroll
            for (int n = 0; n < 4; ++n) acc[n] = (f32x4){0.f, 0.f, 0.f, 0.f};
#pragma unroll
            for (int kk = 0; kk < 4; ++kk) {
                const bf16x8 a = *(const LAS bf16x8*)(mt + (wr * 16 + fr) * 272 + (kk * 32 + fq * 8) * 2);
#pragma unroll
                for (int n = 0; n < 4; ++n) acc[n] = __builtin_amdgcn_mfma_f32_16x16x32_bf16(pwf[kk][n], a, acc[n], 0, 0, 0);
            }
            const size_t row = (size_t)rowbase + r * ncols + c0 + wr * 16 + fr;
#pragma unroll
            for (int n = 0; n < 4; ++n) {
                const int dcol = g * 128 + wc * 64 + n * 16 + fq * 4;
                const f32x4 s = *(const f32x4*)(p.pool_scale + l * 512 + dcol);
                u32x2 o; o[0] = pk_bf16(acc[n][0] * s[0], acc[n][1] * s[1]); o[1] = pk_bf16(acc[n][2] * s[2], acc[n][3] * s[3]);
                *(u32x2*)(CAT + row * D + 512 + dcol) = o;
            }
            __syncthreads();
        }
    }
}


__device__ __forceinline__ int img256(int row, int col) { return row * 256 + ((((col >> 3) ^ row) & 15) << 4) + (col & 7) * 2; }
__device__ __forceinline__ int img128(int row, int col) { return (row >> 1) * 256 + (row & 1) * 128 + ((((col >> 3) ^ (row >> 1)) & 7) << 4) + (col & 7) * 2; }

__device__ __forceinline__ void prep_tchain(const int lane, LAS float* MT, LAS float* XS) {
    const int fr = lane & 15, fq = lane >> 4;
    {
        const int bb = lane >> 4, c = lane & 15;
        float tc[16];
#pragma unroll
        for (int a = 0; a < 16; ++a) {
            float sv = (a == c) ? 1.f : 0.f;
#pragma unroll
            for (int q = 0; q < (a + 3) / 4; ++q) {
                const f32x4 m4 = *(const LAS f32x4*)(MT + (bb * 16 + a) * 68 + bb * 16 + q * 4);
#pragma unroll
                for (int e = 0; e < 4; ++e) if (q * 4 + e < a) sv -= m4[e] * tc[q * 4 + e];
            }
            tc[a] = sv;
        }
#pragma unroll
        for (int a = 0; a < 16; ++a) MT[(bb * 16 + a) * 68 + bb * 16 + c] = tc[a];
    }
    {
        f32x4 x0 = (f32x4){0.f, 0.f, 0.f, 0.f}, x1 = (f32x4){0.f, 0.f, 0.f, 0.f};
#pragma unroll
        for (int ks = 0; ks < 4; ++ks) {
            x0 = __builtin_amdgcn_mfma_f32_16x16x4f32(MT[(16 + fr) * 68 + ks * 4 + fq], MT[(ks * 4 + fq) * 68 + fr], x0, 0, 0, 0);
            x1 = __builtin_amdgcn_mfma_f32_16x16x4f32(MT[(48 + fr) * 68 + 32 + ks * 4 + fq], MT[(32 + ks * 4 + fq) * 68 + 32 + fr], x1, 0, 0, 0);
        }
#pragma unroll
        for (int r = 0; r < 4; ++r) { XS[(fq * 4 + r) * 17 + fr] = x0[r]; XS[272 + (fq * 4 + r) * 17 + fr] = x1[r]; }
        f32x4 y0 = (f32x4){0.f, 0.f, 0.f, 0.f}, y1 = (f32x4){0.f, 0.f, 0.f, 0.f};
#pragma unroll
        for (int ks = 0; ks < 4; ++ks) {
            y0 = __builtin_amdgcn_mfma_f32_16x16x4f32(MT[(16 + fr) * 68 + 16 + ks * 4 + fq], XS[(ks * 4 + fq) * 17 + fr], y0, 0, 0, 0);
            y1 = __builtin_amdgcn_mfma_f32_16x16x4f32(MT[(48 + fr) * 68 + 48 + ks * 4 + fq], XS[272 + (ks * 4 + fq) * 17 + fr], y1, 0, 0, 0);
        }
#pragma unroll
        for (int r = 0; r < 4; ++r) { MT[(16 + fq * 4 + r) * 68 + fr] = -y0[r]; MT[(48 + fq * 4 + r) * 68 + 32 + fr] = -y1[r]; }
    }
    {
        f32x4 y[2][2];
#pragma unroll
        for (int ti = 0; ti < 2; ++ti)
#pragma unroll
            for (int tj = 0; tj < 2; ++tj) y[ti][tj] = (f32x4){0.f, 0.f, 0.f, 0.f};
#pragma unroll
        for (int ks = 0; ks < 8; ++ks) {
            const float b0 = MT[(ks * 4 + fq) * 68 + fr], b1 = MT[(ks * 4 + fq) * 68 + 16 + fr];
#pragma unroll
            for (int ti = 0; ti < 2; ++ti) {
                const float a = MT[(32 + ti * 16 + fr) * 68 + ks * 4 + fq];
                y[ti][0] = __builtin_amdgcn_mfma_f32_16x16x4f32(a, b0, y[ti][0], 0, 0, 0);
                y[ti][1] = __builtin_amdgcn_mfma_f32_16x16x4f32(a, b1, y[ti][1], 0, 0, 0);
            }
        }
#pragma unroll
        for (int ti = 0; ti < 2; ++ti)
#pragma unroll
            for (int tj = 0; tj < 2; ++tj)
#pragma unroll
                for (int r = 0; r < 4; ++r) XS[(ti * 16 + fq * 4 + r) * 33 + tj * 16 + fr] = y[ti][tj][r];
        f32x4 z[2][2];
#pragma unroll
        for (int ti = 0; ti < 2; ++ti)
#pragma unroll
            for (int tj = 0; tj < 2; ++tj) z[ti][tj] = (f32x4){0.f, 0.f, 0.f, 0.f};
#pragma unroll
        for (int ks = 0; ks < 8; ++ks) {
            const float b0 = XS[(ks * 4 + fq) * 33 + fr], b1 = XS[(ks * 4 + fq) * 33 + 16 + fr];
#pragma unroll
            for (int ti = 0; ti < 2; ++ti) {
                const float a = MT[(32 + ti * 16 + fr) * 68 + 32 + ks * 4 + fq];
                z[ti][0] = __builtin_amdgcn_mfma_f32_16x16x4f32(a, b0, z[ti][0], 0, 0, 0);
                z[ti][1] = __builtin_amdgcn_mfma_f32_16x16x4f32(a, b1, z[ti][1], 0, 0, 0);
            }
        }
#pragma unroll
        for (int ti = 0; ti < 2; ++ti)
#pragma unroll
            for (int tj = 0; tj < 2; ++tj)
#pragma unroll
                for (int r = 0; r < 4; ++r) MT[(32 + ti * 16 + fq * 4 + r) * 68 + tj * 16 + fr] = -z[ti][tj][r];
    }
}

__device__ __forceinline__ int imgT(int i, int j) { return i * 128 + ((((j >> 3) ^ i) & 7) << 4) + (j & 7) * 2; }

__device__ __forceinline__ void phase_prep(const Params& p, const int l, LAS unsigned char* lds) {
    int tid = opaque_tid(), wid = __builtin_amdgcn_readfirstlane(tid >> 6), lane = tid & 63, fr = lane & 15, fq = lane >> 4;
#define RELAUNDER() do { asm volatile("" : "+v"(tid)); wid = __builtin_amdgcn_readfirstlane(tid >> 6); lane = tid & 63; fr = lane & 15; fq = lane >> 4; } while (0)
    constexpr int R_MT0 = 0, R_MT1 = 17408, R_QK = 34816, R_QN = 53248, R_KN = 70656, R_KNT = 88064, R_VT = 106496, R_G = 143360;
    constexpr int R_T0 = R_QK, R_T1 = 124928;
    LAS float* QK = (LAS float*)(lds + R_QK);
    LAS float* G_LA = (LAS float*)(lds + R_G);
    LAS float* G_BT = G_LA + 128;
    LAS float* G_GC = G_BT + 128;
    LAS float* G_TOT = G_GC + 128;
    LAS float* G_E1 = G_TOT + 16;
    LAS float* G_E2 = G_E1 + 128;
    LAS float* XS = G_E2 + 128;
    LAS float* CW = XS + 2176;
    static_assert(R_G + (128 * 5 + 16 + 2176 + 1536) * 4 <= LDS_WORK, "prep LDS");
    const bf16_t* PROJ = (const bf16_t*)(p.ws + WS_PROJ);
    const float* LOGA = (const float*)(p.ws + WS_LOGA); const float* BETA = (const float*)(p.ws + WS_BETA);
    int cur_h = -1;
    for (int u = blockIdx.x; u < NB * 4 * NCHUNK; u += gridDim.x) {
        const int h = u & 3, b = (u >> 2) / 36, cc = (u >> 2) % 36;
        if (h != cur_h) {
            __syncthreads();
            for (int idx = tid; idx < 1536; idx += NTHREADS) { const int j = idx / 384, rm = idx % 384, seg = rm >> 7, c = rm & 127; CW[idx] = p.conv_w[(size_t)(l * 4 + j) * 1536 + seg * 512 + h * 128 + c]; }
            cur_h = h;
        }
        int rowbase, seqlen, cpos;
        if (cc < 32) { rowbase = b * SEQ; seqlen = SEQ; cpos = cc; } else { rowbase = ROWS_LAT + b * CTXL; seqlen = CTXL; cpos = cc - 32; }
        const int t0 = cpos * 64;
        RELAUNDER();
        {
            u32x4 rv[7];
#pragma unroll
            for (int it = 0; it < 7; ++it) {
                const int idx = tid + it * NTHREADS, rr = idx / 48, pc = idx % 48, seg = pc >> 4, po = pc & 15, tok = t0 - 2 + rr;
                rv[it] = (u32x4){0u, 0u, 0u, 0u};
                if (idx < 67 * 48 && tok >= 0 && tok < seqlen) rv[it] = *(const u32x4*)(PROJ + (size_t)(rowbase + tok) * PN + seg * 512 + h * 128 + po * 8);
            }
#pragma unroll
            for (int it = 0; it < 7; ++it) {
                const int idx = tid + it * NTHREADS, rr = idx / 48, pc = idx % 48, seg = pc >> 4, po = pc & 15;
                if (idx < 67 * 48) *(LAS u32x4*)(lds + rr * 784 + seg * 256 + po * 16) = rv[it];
            }
        }
        if (tid < 128) { const int d = tid >> 6; const size_t gi = (size_t)(rowbase + t0 + lane) * 8 + d * 4 + h; G_LA[tid] = LOGA[gi]; G_BT[tid] = BETA[gi]; }
        __syncthreads();
        RELAUNDER();
        if (wid < 2) {
            const int d = wid, pos = d ? 63 - lane : lane;
            float v = G_LA[d * 64 + pos];
#pragma unroll
            for (int o = 1; o < 64; o <<= 1) { const float t = shup(v, o, lane); if (lane >= o) v += t; }
            G_GC[d * 64 + pos] = v;
            if (lane == 63) G_TOT[d] = v;
            const float tot = __int_as_float(__builtin_amdgcn_readlane(__float_as_int(v), 63));
            G_E1[d * 64 + pos] = __expf(tot - v); G_E2[d * 64 + pos] = __expf(v);
        }
        RELAUNDER();
        {
            const int r = tid >> 3, cs = tid & 7;
            const LAS float* cw = CW + cs * 16;
#pragma unroll
            for (int seg = 0; seg < 3; ++seg) {
                float a[16];
#pragma unroll
                for (int e = 0; e < 16; ++e) a[e] = 0.f;
#pragma unroll
                for (int j = 0; j < 4; ++j) {
                    const u32x4 x0 = *(const LAS u32x4*)(lds + (r + j) * 784 + seg * 256 + cs * 32), x1 = *(const LAS u32x4*)(lds + (r + j) * 784 + seg * 256 + cs * 32 + 16);
                    const LAS float* wj = cw + j * 384 + seg * 128;
                    const f32x4 w0 = *(const LAS f32x4*)(wj), w1 = *(const LAS f32x4*)(wj + 4), w2 = *(const LAS f32x4*)(wj + 8), w3 = *(const LAS f32x4*)(wj + 12);
                    a[0] += w0[0] * bf_lo(x0[0]); a[1] += w0[1] * bf_hi(x0[0]); a[2] += w0[2] * bf_lo(x0[1]); a[3] += w0[3] * bf_hi(x0[1]);
                    a[4] += w1[0] * bf_lo(x0[2]); a[5] += w1[1] * bf_hi(x0[2]); a[6] += w1[2] * bf_lo(x0[3]); a[7] += w1[3] * bf_hi(x0[3]);
                    a[8] += w2[0] * bf_lo(x1[0]); a[9] += w2[1] * bf_hi(x1[0]); a[10] += w2[2] * bf_lo(x1[1]); a[11] += w2[3] * bf_hi(x1[1]);
                    a[12] += w3[0] * bf_lo(x1[2]); a[13] += w3[1] * bf_hi(x1[2]); a[14] += w3[2] * bf_lo(x1[3]); a[15] += w3[3] * bf_hi(x1[3]);
                    if (j & 1) __builtin_amdgcn_sched_barrier(0);
                }
                float ss = 0.f;
#pragma unroll
                for (int e = 0; e < 16; ++e) { a[e] = silu_f(a[e]); ss += a[e] * a[e]; }
                if (seg < 2) {
                    ss += shx(ss, 1, lane); ss += shx(ss, 2, lane); ss += shx(ss, 4, lane);
                    float sc = rsqrtf(ss + EPS); if (seg == 0) sc *= 0.08838834764831845f;
#pragma unroll
                    for (int e = 0; e < 16; ++e) a[e] *= sc;
                }
                unsigned pk[8];
#pragma unroll
                for (int e = 0; e < 8; ++e) pk[e] = pk_bf16(a[2 * e], a[2 * e + 1]);
                if (seg < 2) {
                    LAS unsigned char* dst = lds + (seg == 0 ? R_QN : R_KN) + r * 272 + cs * 32;
                    *(LAS u32x4*)dst = (u32x4){pk[0], pk[1], pk[2], pk[3]}; *(LAS u32x4*)(dst + 16) = (u32x4){pk[4], pk[5], pk[6], pk[7]};
                }
                if (seg >= 1) {
                    LAS unsigned char* dt = lds + (seg == 1 ? R_KNT : R_VT) + (cs * 16) * 144 + ((((r >> 3) ^ cs) & 7) << 4) + (r & 7) * 2;
#pragma unroll
                    for (int e = 0; e < 8; ++e) { *(LAS unsigned short*)(dt + (2 * e) * 144) = (unsigned short)(pk[e] & 0xffffu); *(LAS unsigned short*)(dt + (2 * e + 1) * 144) = (unsigned short)(pk[e] >> 16); }
                }
            }
        }
        __syncthreads();
        RELAUNDER();
        {
            const int ib = wid & 3, pr = wid >> 2;
            LAS unsigned char* Ab = lds + (pr ? R_QN : R_KN) + (ib * 16 + fr) * 272 + fq * 16;
            bf16x8 a[4];
#pragma unroll
            for (int kk = 0; kk < 4; ++kk) a[kk] = *(const LAS bf16x8*)(Ab + kk * 64);
#pragma unroll
            for (int jb = 0; jb < 4; ++jb) {
                f32x4 acc = (f32x4){0.f, 0.f, 0.f, 0.f};
#pragma unroll
                for (int kk = 0; kk < 4; ++kk) { const bf16x8 bb = *(const LAS bf16x8*)(lds + R_KN + (jb * 16 + fr) * 272 + fq * 16 + kk * 64); acc = __builtin_amdgcn_mfma_f32_16x16x32_bf16(a[kk], bb, acc, 0, 0, 0); }
                if (pr) {
#pragma unroll
                    for (int r = 0; r < 4; ++r) QK[(ib * 16 + fq * 4 + r) * 65 + jb * 16 + fr] = acc[r];
                } else {
                    const int j = jb * 16 + fr;
                    const float g0j = G_GC[j], g1j = G_GC[64 + j];
#pragma unroll
                    for (int r = 0; r < 4; ++r) {
                        const int i = ib * 16 + fq * 4 + r;
                        ((LAS float*)(lds + R_MT0))[i * 68 + j] = (j < i) ? G_BT[i] * acc[r] * __expf(G_GC[i] - g0j) : 0.f;
                        ((LAS float*)(lds + R_MT1))[(63 - i) * 68 + (63 - j)] = (j > i) ? G_BT[64 + i] * acc[r] * __expf(G_GC[64 + i] - g1j) : 0.f;
                    }
                }
            }
        }
        __syncthreads();
        RELAUNDER();
        unsigned char* recd[2];
#pragma unroll
        for (int d = 0; d < 2; ++d) { const int cposn = (cc < 32) ? 4 + (d ? 31 - cpos : cpos) : (d ? 3 - cpos : cpos);
            recd[d] = p.ws + WS_SCN + ((size_t)((b * 4 + h) * 2 + d) * NCHUNK + cposn) * REC_BYTES; }
        if ((wid & 3) == 0) {
            const int d = wid >> 2;
            prep_tchain(lane, (LAS float*)(lds + (d ? R_MT1 : R_MT0)), XS + d * 1088);
        } else {
            const int wt = (wid - 1 - (wid > 4 ? 1 : 0)) * 64 + lane;
            for (int it = wt; it < 5120; it += 384) {
                const int d = it >= 2560 ? 1 : 0, r = it - d * 2560;
                const LAS float* gc = G_GC + d * 64;
                unsigned char* rec = d ? recd[1] : recd[0];
                if (r < 1024) {
                    const int dk = r >> 3, i8 = (r & 7) * 8;
                    const u32x4 kv = *(const LAS u32x4*)(lds + R_KNT + dk * 144 + ((((i8 >> 3) ^ (dk >> 4)) & 7) << 4));
                    const LAS float* e1 = G_E1 + d * 64 + i8;
                    const f32x4 ea = *(const LAS f32x4*)e1, eb = *(const LAS f32x4*)(e1 + 4);
                    u32x4 o;
                    o[0] = pk_bf16(bf_lo(kv[0]) * ea[0], bf_hi(kv[0]) * ea[1]); o[1] = pk_bf16(bf_lo(kv[1]) * ea[2], bf_hi(kv[1]) * ea[3]);
                    o[2] = pk_bf16(bf_lo(kv[2]) * eb[0], bf_hi(kv[2]) * eb[1]); o[3] = pk_bf16(bf_lo(kv[3]) * eb[2], bf_hi(kv[3]) * eb[3]);
                    *(u32x4*)(rec + REC_KT + img128(dk, i8)) = o;
                } else if (r < 2048) {
                    const int i = (r - 1024) >> 4, k8 = (r & 15) * 8;
                    const u32x4 qv = *(const LAS u32x4*)(lds + R_QN + i * 272 + k8 * 2);
                    const float eg = G_E2[d * 64 + i];
                    u32x4 o;
#pragma unroll
                    for (int e = 0; e < 4; ++e) o[e] = pk_bf16(bf_lo(qv[e]) * eg, bf_hi(qv[e]) * eg);
                    *(u32x4*)(rec + REC_QD + img256(i, k8)) = o;
                } else {
                    const int i = (r - 2048) >> 3, j8 = (r & 7) * 8;
                    float v[8];
#pragma unroll
                    for (int e = 0; e < 8; ++e) { const int j = j8 + e; const bool ok = d ? (j >= i) : (j <= i); v[e] = ok ? QK[i * 65 + j] * __expf(gc[i] - gc[j]) : 0.f; }
                    u32x4 o; o[0] = pk_bf16(v[0], v[1]); o[1] = pk_bf16(v[2], v[3]); o[2] = pk_bf16(v[4], v[5]); o[3] = pk_bf16(v[6], v[7]);
                    *(u32x4*)(rec + REC_QK + img128(i, j8)) = o;
                }
            }
            if (wt < 2) { *(float*)(recd[wt] + REC_MISC) = __expf(G_TOT[wt]); *(int*)(recd[wt] + REC_MISC + 4) = rowbase + t0; }
        }
        __syncthreads();
        RELAUNDER();
        for (int idx = tid; idx < 4096; idx += NTHREADS) {
            const int d = idx >> 11, q = idx & 2047, i = q >> 5, j = (q & 31) * 2, i2 = d ? 63 - i : i, j2 = d ? 63 - j : j, j3 = d ? j2 - 1 : j2 + 1;
            const LAS float* TBd = (const LAS float*)(lds + (d ? R_MT1 : R_MT0));
            const LAS float* e2 = G_E2 + d * 64; const LAS float* bt = G_BT + d * 64;
            const float t0v = TBd[i2 * 68 + j2], t1v = TBd[i2 * 68 + j3];
            const float c0 = bt[j], c1 = bt[j + 1];
            LAS unsigned char* tw = lds + (d ? R_T1 : R_T0);
            *(LAS unsigned*)(tw + 8192 + imgT(i, j)) = pk_bf16(t0v * c0, t1v * c1);
            *(LAS unsigned*)(tw + imgT(i, j)) = pk_bf16(t0v * c0 * e2[j], t1v * c1 * e2[j + 1]);
        }
        __syncthreads();
        RELAUNDER();
        {
            const int d = wid >> 2;
            unsigned char* rec = d ? recd[1] : recd[0];
            const LAS unsigned char* tw = lds + (d ? R_T1 : R_T0);
#pragma unroll
            for (int hb = 0; hb < 2; ++hb) {
                const int blk = (wid & 3) * 2 + hb;
                bf16x8 ak[2], av[2];
#pragma unroll
                for (int kk = 0; kk < 2; ++kk) { const int so = (((kk * 4 + fq) ^ blk) & 7) << 4; ak[kk] = *(const LAS bf16x8*)(lds + R_KNT + (blk * 16 + fr) * 144 + so); av[kk] = *(const LAS bf16x8*)(lds + R_VT + (blk * 16 + fr) * 144 + so); }
#pragma unroll
                for (int ib = 0; ib < 4; ++ib) {
                    f32x4 aw = (f32x4){0.f, 0.f, 0.f, 0.f}, au = (f32x4){0.f, 0.f, 0.f, 0.f};
#pragma unroll
                    for (int kk = 0; kk < 2; ++kk) {
                        const bf16x8 twf = *(const LAS bf16x8*)(tw + imgT(ib * 16 + fr, kk * 32 + fq * 8)), tuf = *(const LAS bf16x8*)(tw + 8192 + imgT(ib * 16 + fr, kk * 32 + fq * 8));
                        aw = __builtin_amdgcn_mfma_f32_16x16x32_bf16(ak[kk], twf, aw, 0, 0, 0);
                        au = __builtin_amdgcn_mfma_f32_16x16x32_bf16(tuf, av[kk], au, 0, 0, 0);
                    }
                    u32x2 ow; ow[0] = pk_bf16(aw[0], aw[1]); ow[1] = pk_bf16(aw[2], aw[3]);
                    *(u32x2*)(rec + REC_W + img256(ib * 16 + fr, blk * 16 + fq * 4)) = ow;
                    u32x2 ou; ou[0] = pk_bf16(au[0], au[1]); ou[1] = pk_bf16(au[2], au[3]);
                    *(u32x2*)(rec + REC_UT + (blk * 16 + fr) * 128 + (ib * 16 + fq * 4) * 2) = ou;
                }
            }
        }
        __syncthreads();
    }
}
#undef RELAUNDER

__device__ __forceinline__ void phase_scan(const Params& p, const int l, LAS unsigned char* lds) {
    const int tid = opaque_tid(), wid = __builtin_amdgcn_readfirstlane(tid >> 6), lane = tid & 63, fr = lane & 15, fq = lane >> 4;
    constexpr int NSL = 2, DV = 128 / NSL, NBT = DV / 16;
    constexpr int UTB = DV * 128, MISC_O = 57344 + UTB, BUFB = MISC_O + 256, R_ST = 2 * BUFB, R_UTL = R_ST + DV * 272, R_DUM = R_UTL + DV * 144;
    static_assert(R_DUM + 8 * 256 <= LDS_WORK && NBT == 4, "scan LDS / tile assumptions");
    for (int id = blockIdx.x; id < 64 * NSL; id += gridDim.x) {
        const int bhd = (id & 7) * 8 + (id >> 4), sl = (id >> 3) & 1, h = (bhd >> 1) & 3, d = bhd & 1;
        bf16_t* O = (bf16_t*)(p.ws + (d ? WS_OB : WS_OF));
        const unsigned char* rec0 = p.ws + WS_SCN + (size_t)bhd * NCHUNK * REC_BYTES;
        __syncthreads();
        for (int i = tid; i < DV * 272 / 4; i += NTHREADS) ((LAS unsigned*)(lds + R_ST))[i] = 0u;
        f32x4 sacc[NBT];
#pragma unroll
        for (int n2 = 0; n2 < NBT; ++n2) sacc[n2] = (f32x4){0.f, 0.f, 0.f, 0.f};
#define S_ISSUE(n, bufo) do { const unsigned char* _r = rec0 + (size_t)(n) * REC_BYTES; \
        _Pragma("unroll") for (int _q = 0; _q < 7; ++_q) __builtin_amdgcn_global_load_lds((const unsigned*)(_r + lane * 16 + (wid + 8 * _q) * 1024), (LAS unsigned*)(lds + (bufo) + (wid + 8 * _q) * 1024), 16, 0, 0); \
        __builtin_amdgcn_global_load_lds((const unsigned*)(_r + lane * 16 + REC_UT + sl * UTB + wid * 1024), (LAS unsigned*)(lds + (bufo) + 57344 + wid * 1024), 16, 0, 0); \
        __builtin_amdgcn_global_load_lds((const unsigned*)(_r + REC_MISC + lane * 4), (LAS unsigned*)(lds + (bufo) + MISC_O), 4, 0, 0); } while (0)
#define S_TOUCH(n) do { const int _n = (n) < NCHUNK ? (n) : NCHUNK - 1; const int _ln = wid * 64 + lane; \
        const unsigned char* _t = rec0 + (size_t)_n * REC_BYTES + (_ln < 448 ? _ln * 128 : REC_UT + sl * UTB + (_ln - 448) * 128); \
        __builtin_amdgcn_global_load_lds((const unsigned*)_t, (LAS unsigned*)(lds + R_DUM + wid * 256), 4, 0, 0); } while (0)
        S_ISSUE(0, 0); S_TOUCH(1);
        const int ib = wid >> 1, nb0 = (wid & 1) * (NBT / 2);
        for (int n = 0; n < NCHUNK; ++n) {
            if (n == 0) asm volatile("s_waitcnt vmcnt(1)" ::: "memory"); else asm volatile("s_waitcnt vmcnt(3)" ::: "memory");
            asm volatile("s_waitcnt lgkmcnt(0)" ::: "memory");
            __builtin_amdgcn_s_barrier();
            LAS unsigned char* buf = lds + (n & 1) * BUFB;
            f32x4 accP[NBT / 2], accQ[NBT / 2];
#pragma unroll
            for (int t = 0; t < NBT / 2; ++t) { accP[t] = (f32x4){0.f, 0.f, 0.f, 0.f}; accQ[t] = (f32x4){0.f, 0.f, 0.f, 0.f}; }
            bf16x8 aw[4], aq[4], sb[NBT / 2][4];
#pragma unroll
            for (int kk = 0; kk < 4; ++kk) {
                aw[kk] = *(const LAS bf16x8*)(buf + REC_W + img256(ib * 16 + fr, kk * 32 + fq * 8));
                aq[kk] = *(const LAS bf16x8*)(buf + REC_QD + img256(ib * 16 + fr, kk * 32 + fq * 8));
#pragma unroll
                for (int t = 0; t < NBT / 2; ++t) sb[t][kk] = *(const LAS bf16x8*)(lds + R_ST + ((nb0 + t) * 16 + fr) * 272 + kk * 64 + fq * 16);
            }
            u32x2 uv[NBT / 2];
#pragma unroll
            for (int t = 0; t < NBT / 2; ++t) uv[t] = *(const LAS u32x2*)(buf + REC_UT + ((nb0 + t) * 16 + fr) * 128 + (ib * 16 + fq * 4) * 2);
            __builtin_amdgcn_sched_barrier(0);
#pragma unroll
            for (int kk = 0; kk < 4; ++kk)
#pragma unroll
                for (int t = 0; t < NBT / 2; ++t) accP[t] = __builtin_amdgcn_mfma_f32_16x16x32_bf16(aw[kk], sb[t][kk], accP[t], 0, 0, 0);
            if (n + 1 < NCHUNK) { if ((n + 1) & 1) S_ISSUE(n + 1, BUFB); else S_ISSUE(n + 1, 0); S_TOUCH(n + 2); }
            bf16x8 aqk[2], ak[2];
#pragma unroll
            for (int kk = 0; kk < 2; ++kk) { aqk[kk] = *(const LAS bf16x8*)(buf + REC_QK + img128(ib * 16 + fr, kk * 32 + fq * 8)); ak[kk] = *(const LAS bf16x8*)(buf + REC_KT + img128(wid * 16 + fr, kk * 32 + fq * 8)); }
            const float sd = *(const LAS float*)(buf + MISC_O); const int rowstart = *(const LAS int*)(buf + MISC_O + 4);
#pragma unroll
            for (int t = 0; t < NBT / 2; ++t) {
                u32x2 o; o[0] = pk_bf16(bf_lo(uv[t][0]) - accP[t][0], bf_hi(uv[t][0]) - accP[t][1]); o[1] = pk_bf16(bf_lo(uv[t][1]) - accP[t][2], bf_hi(uv[t][1]) - accP[t][3]);
                *(LAS u32x2*)(lds + R_UTL + ((nb0 + t) * 16 + fr) * 144 + (ib * 16 + fq * 4) * 2) = o;
            }
#pragma unroll
            for (int kk = 0; kk < 4; ++kk)
#pragma unroll
                for (int t = 0; t < NBT / 2; ++t) accQ[t] = __builtin_amdgcn_mfma_f32_16x16x32_bf16(sb[t][kk], aq[kk], accQ[t], 0, 0, 0);
            asm volatile("s_waitcnt lgkmcnt(0)" ::: "memory");
            __builtin_amdgcn_s_barrier();
            bf16x8 ub[NBT][2];
#pragma unroll
            for (int n2 = 0; n2 < NBT; ++n2)
#pragma unroll
                for (int kk = 0; kk < 2; ++kk) ub[n2][kk] = *(const LAS bf16x8*)(lds + R_UTL + (n2 * 16 + fr) * 144 + kk * 64 + fq * 16);
            bf16x8 un[NBT / 2][2];
#pragma unroll
            for (int t = 0; t < NBT / 2; ++t)
#pragma unroll
                for (int kk = 0; kk < 2; ++kk) un[t][kk] = *(const LAS bf16x8*)(lds + R_UTL + ((nb0 + t) * 16 + fr) * 144 + kk * 64 + fq * 16);
            __builtin_amdgcn_sched_barrier(0);
#pragma unroll
            for (int n2 = 0; n2 < NBT; ++n2) {
                sacc[n2] *= sd;
#pragma unroll
                for (int kk = 0; kk < 2; ++kk) sacc[n2] = __builtin_amdgcn_mfma_f32_16x16x32_bf16(ak[kk], ub[n2][kk], sacc[n2], 0, 0, 0);
            }
#pragma unroll
            for (int kk = 0; kk < 2; ++kk)
#pragma unroll
                for (int t = 0; t < NBT / 2; ++t) accQ[t] = __builtin_amdgcn_mfma_f32_16x16x32_bf16(un[t][kk], aqk[kk], accQ[t], 0, 0, 0);
#pragma unroll
            for (int n2 = 0; n2 < NBT; ++n2) {
                u32x2 o; o[0] = pk_bf16(sacc[n2][0], sacc[n2][1]); o[1] = pk_bf16(sacc[n2][2], sacc[n2][3]);
                *(LAS u32x2*)(lds + R_ST + (n2 * 16 + fr) * 272 + (wid * 16 + fq * 4) * 2) = o;
            }
#pragma unroll
            for (int t = 0; t < NBT / 2; ++t) {
                u32x2 o; o[0] = pk_bf16(accQ[t][0], accQ[t][1]); o[1] = pk_bf16(accQ[t][2], accQ[t][3]);
                *(u32x2*)(O + (size_t)(rowstart + ib * 16 + fr) * 512 + h * 128 + sl * DV + (nb0 + t) * 16 + fq * 4) = o;
            }
        }
#undef S_ISSUE
#undef S_TOUCH
        asm volatile("s_waitcnt vmcnt(0)" ::: "memory");
        __syncthreads();
    }
}

__device__ __forceinline__ void phase_scan_naive(const Params& p, const int l, LAS unsigned char* lds) {
    const int tid = opaque_tid();
    const int lane = tid & 63;
    LAS float* ks = (LAS float*)lds;
    LAS float* qs = ks + 4096;
    LAS float* vs = qs + 4096;
    LAS float* as = vs + 4096;
    LAS float* bs = as + 32;
    LAS int* rws = (LAS int*)(bs + 32);
    const float* QKV = (const float*)(p.ws + WS_QKV);
    const float* LOGA = (const float*)(p.ws + WS_LOGA);
    const float* BETA = (const float*)(p.ws + WS_BETA);
    for (int u = blockIdx.x; u < 64; u += gridDim.x) {
        const int b = u >> 3, h = (u >> 1) & 3, d = u & 1;
        float* O = (float*)(p.ws + (d ? WS_OB : WS_OF));
        const int col = tid >> 2, part = tid & 3;
        float S[32];
#pragma unroll
        for (int i = 0; i < 32; ++i) S[i] = 0.f;
        for (int n0 = 0; n0 < CTXL + SEQ; n0 += 32) {
            __syncthreads();
            if (tid < 32) {
                const int n = n0 + tid; int row;
                if (n < CTXL) row = ROWS_LAT + b * CTXL + (d ? CTXL - 1 - n : n);
                else { const int m = n - CTXL; row = b * SEQ + (d ? SEQ - 1 - m : m); }
                rws[tid] = row;
                as[tid] = __expf(LOGA[(size_t)row * 8 + d * 4 + h]);
                bs[tid] = BETA[(size_t)row * 8 + d * 4 + h];
            }
            __syncthreads();
            for (int i = tid; i < 4096; i += NTHREADS) {
                const int tok = i >> 7, cc = i & 127; const size_t base = (size_t)rws[tok] * 1536 + h * 128 + cc;
                qs[i] = QKV[base]; ks[i] = QKV[base + 512]; vs[i] = QKV[base + 1024];
            }
            __syncthreads();
            for (int tok = 0; tok < 32; ++tok) {
                float kk[32];
#pragma unroll
                for (int i = 0; i < 8; ++i) { const f32x4 v = *(const LAS f32x4*)(ks + tok * 128 + part * 32 + i * 4); kk[i * 4] = v[0]; kk[i * 4 + 1] = v[1]; kk[i * 4 + 2] = v[2]; kk[i * 4 + 3] = v[3]; }
                float kp = 0.f;
#pragma unroll
                for (int i = 0; i < 32; ++i) kp += kk[i] * S[i];
                kp += shx(kp, 1, lane); kp += shx(kp, 2, lane);
                const float a = as[tok], bt = bs[tok];
                const float bv = bt * (vs[tok * 128 + col] - a * kp);
#pragma unroll
                for (int i = 0; i < 32; ++i) S[i] = a * S[i] + kk[i] * bv;
                float op = 0.f;
#pragma unroll
                for (int i = 0; i < 8; ++i) { const f32x4 v = *(const LAS f32x4*)(qs + tok * 128 + part * 32 + i * 4); op += v[0] * S[i * 4] + v[1] * S[i * 4 + 1] + v[2] * S[i * 4 + 2] + v[3] * S[i * 4 + 3]; }
                op += shx(op, 1, lane); op += shx(op, 2, lane);
                if (part == 0) O[(size_t)rws[tok] * 512 + h * 128 + col] = op;
            }
        }
        __syncthreads();
    }
}

__device__ __forceinline__ void phase_onorm(const Params& p, const int l) {
    const int tid = opaque_tid(), wid = tid >> 6, lane = tid & 63;
    const bf16_t* OF = (const bf16_t*)(p.ws + WS_OF); const bf16_t* OB = (const bf16_t*)(p.ws + WS_OB);
    const bf16_t* PROJ = (const bf16_t*)(p.ws + WS_PROJ);
    bf16_t* CAT = (bf16_t*)(p.ws + WS_CAT);
    const int c = lane * 8;
    const f32x4 w0 = *(const f32x4*)(p.dn_norm + l * 128 + (c & 127)), w1 = *(const f32x4*)(p.dn_norm + l * 128 + (c & 127) + 4);
    const int nrows = (l == DEPTH - 1) ? ROWS_LAT : MT;
    constexpr int R = 3;
    const int rstride = gridDim.x * 8;
    for (int base = blockIdx.x * 8 + wid; base < nrows; base += rstride * R) {
        u32x4 a[R], b[R], gv[R];
#pragma unroll
        for (int k = 0; k < R; ++k) {
            const int row = base + k * rstride; const int rr = row < nrows ? row : base;
            a[k] = *(const u32x4*)(OF + (size_t)rr * 512 + c); b[k] = *(const u32x4*)(OB + (size_t)rr * 512 + c); gv[k] = *(const u32x4*)(PROJ + (size_t)rr * PN + 1536 + c);
        }
#pragma unroll
        for (int k = 0; k < R; ++k) {
            const int row = base + k * rstride;
            const f32x4 v0 = (f32x4){bf_lo(a[k][0]) + bf_lo(b[k][0]), bf_hi(a[k][0]) + bf_hi(b[k][0]), bf_lo(a[k][1]) + bf_lo(b[k][1]), bf_hi(a[k][1]) + bf_hi(b[k][1])};
            const f32x4 v1 = (f32x4){bf_lo(a[k][2]) + bf_lo(b[k][2]), bf_hi(a[k][2]) + bf_hi(b[k][2]), bf_lo(a[k][3]) + bf_lo(b[k][3]), bf_hi(a[k][3]) + bf_hi(b[k][3])};
            float ss = v0[0] * v0[0] + v0[1] * v0[1] + v0[2] * v0[2] + v0[3] * v0[3] + v1[0] * v1[0] + v1[1] * v1[1] + v1[2] * v1[2] + v1[3] * v1[3];
            ss += shx(ss, 1, lane); ss += shx(ss, 2, lane); ss += shx(ss, 4, lane); ss += shx(ss, 8, lane);
            const float rs = rsqrtf(ss * (1.f / 128.f) + EPS);
            u32x4 out;
            out[0] = pk_bf16(v0[0] * rs * w0[0] * silu_f(bf_lo(gv[k][0])), v0[1] * rs * w0[1] * silu_f(bf_hi(gv[k][0])));
            out[1] = pk_bf16(v0[2] * rs * w0[2] * silu_f(bf_lo(gv[k][1])), v0[3] * rs * w0[3] * silu_f(bf_hi(gv[k][1])));
            out[2] = pk_bf16(v1[0] * rs * w1[0] * silu_f(bf_lo(gv[k][2])), v1[1] * rs * w1[1] * silu_f(bf_hi(gv[k][2])));
            out[3] = pk_bf16(v1[2] * rs * w1[2] * silu_f(bf_lo(gv[k][3])), v1[3] * rs * w1[3] * silu_f(bf_hi(gv[k][3])));
            if (row < nrows) *(u32x4*)(CAT + (size_t)row * D + c) = out;
        }
    }
}

__device__ __forceinline__ unsigned block_incl_scan(unsigned v, const int tid, LAS unsigned* wsum, unsigned& total) {
    const int lane = tid & 63, wv = tid >> 6;
#pragma unroll
    for (int o = 1; o < 64; o <<= 1) { const unsigned t = (unsigned)__builtin_amdgcn_ds_bpermute(((lane - o) & 63) << 2, (int)v); if (lane >= o) v += t; }
    if (lane == 63) wsum[wv] = v;
    __syncthreads();
    unsigned base = 0u, tot = 0u;
#pragma unroll
    for (int w = 0; w < 8; ++w) { const unsigned x = wsum[w]; tot += x; base += (w < wv) ? x : 0u; }
    total = tot;
    return v + base;
}

__device__ __forceinline__ void phase_topk(const Params& p, const int l, LAS unsigned char* lds) {
    const int tid = opaque_tid();
    LAS unsigned* hist = (LAS unsigned*)lds;
    LAS unsigned* wsum = hist + 4096;
    LAS unsigned* misc = wsum + 8;
    LAS unsigned long long* cand = (LAS unsigned long long*)(misc + 8);
    LAS unsigned char* selb = (LAS unsigned char*)(cand + 2048);
    const float* AFF = (const float*)(p.ws + WS_AFF);
    int* SEL = (int*)(p.ws + WS_SEL); float* SELAFF = (float*)(p.ws + WS_SELAFF); int* SLOTOF = (int*)(p.ws + WS_SLOTOF);
    const int ntk = (l == DEPTH - 1) ? 128 : 256;
    for (int u = blockIdx.x; u < ntk; u += gridDim.x) {
        int e, n, C, rowbase, slotbase;
        if (u < 128) { e = u >> 3; const int b = u & 7; n = SEQ; C = 256; rowbase = b * SEQ; slotbase = u * 256; }
        else { const int v = u - 128; e = v >> 3; const int b = v & 7; n = CTXL; C = 32; rowbase = ROWS_LAT + b * CTXL; slotbase = (128 + e) * 256 + b * 32; }
        unsigned kb[4];
#pragma unroll
        for (int k = 0; k < 4; ++k) { const int i = tid * 4 + k; kb[k] = (i < n) ? __float_as_uint(AFF[(size_t)(rowbase + i) * 16 + e]) : 0u; }
#pragma unroll
        for (int k = 0; k < 8; ++k) hist[tid * 8 + k] = 0u;
        if (tid == 0) misc[2] = 0u;
        __syncthreads();
#pragma unroll
        for (int k = 0; k < 4; ++k) if (tid * 4 + k < n) __hip_atomic_fetch_add(&hist[kb[k] >> 19], 1u, __ATOMIC_RELAXED, __HIP_MEMORY_SCOPE_WORKGROUP);
        __syncthreads();
        unsigned hl[8], s8 = 0u;
#pragma unroll
        for (int k = 0; k < 8; ++k) { hl[k] = hist[tid * 8 + k]; s8 += hl[k]; }
        unsigned total;
        const unsigned incl = block_incl_scan(s8, tid, wsum, total);
        unsigned cum = total - incl;
#pragma unroll
        for (int k = 7; k >= 0; --k) { if (cum < (unsigned)C && cum + hl[k] >= (unsigned)C) { misc[0] = (unsigned)(tid * 8 + k); misc[1] = cum; } cum += hl[k]; }
        __syncthreads();
        const unsigned thr = misc[0], G = misc[1], R = (unsigned)C - G;
#pragma unroll
        for (int k = 0; k < 4; ++k) { const int i = tid * 4 + k; if (i < n && (kb[k] >> 19) == thr) { const unsigned q = __hip_atomic_fetch_add(&misc[2], 1u, __ATOMIC_RELAXED, __HIP_MEMORY_SCOPE_WORKGROUP); cand[q] = ((unsigned long long)kb[k] << 32) | (unsigned long long)(0xFFFFFFFFu - (unsigned)i); } }
        __syncthreads();
        const unsigned E = misc[2];
        for (unsigned j = tid; j < E; j += NTHREADS) {
            const unsigned long long me = cand[j]; unsigned rank = 0u;
            for (unsigned k = 0; k < E; ++k) rank += (cand[k] > me) ? 1u : 0u;
            selb[0xFFFFFFFFu - (unsigned)(me & 0xFFFFFFFFull)] = (rank < R) ? 1 : 0;
        }
        __syncthreads();
        unsigned fl = 0u, cnt = 0u;
#pragma unroll
        for (int k = 0; k < 4; ++k) { const int i = tid * 4 + k; const unsigned bin = kb[k] >> 19;
            const bool in = (i < n) && (bin > thr || (bin == thr && selb[i] != 0)); fl |= in ? (1u << k) : 0u; cnt += in ? 1u : 0u; }
        unsigned tot2;
        unsigned pos = block_incl_scan(cnt, tid, wsum, tot2) - cnt;
#pragma unroll
        for (int k = 0; k < 4; ++k) { const int i = tid * 4 + k;
            if (i < n) { const bool in = (fl >> k) & 1u;
                SLOTOF[(size_t)(rowbase + i) * 16 + e] = in ? slotbase + (int)pos : -1;
                if (in) { SEL[slotbase + pos] = rowbase + i; SELAFF[slotbase + pos] = __uint_as_float(kb[k]); ++pos; } } }
        __syncthreads();
    }
}

#ifndef DUMP
#define DUMP 0
#endif
#if DUMP
__device__ __forceinline__ void phase_dump(const Params& p, const size_t off, const int is_bf16, const size_t n_avail) {
    const int tid = opaque_tid();
    const size_t n = (size_t)ROWS_LAT * D;
    for (size_t i = (size_t)blockIdx.x * NTHREADS + tid; i < n; i += (size_t)gridDim.x * NTHREADS) {
        float v = 0.f;
        if (i < n_avail) v = is_bf16 ? __uint_as_float((unsigned)((const bf16_t*)(p.ws + off))[i] << 16) : ((const float*)(p.ws + off))[i];
        p.out[i] = v;
    }
}
#endif

__global__ void __launch_bounds__(NTHREADS, 2) fwd(const Params p) {
    extern __shared__ __attribute__((aligned(16))) unsigned char smem[];
    LAS unsigned char* lds = (LAS unsigned char*)smem + LDS_OFF;
    XcdBarrier bar; bar.bar = (unsigned*)(p.ws + WS_BAR); bar.x = 0; bar.st = nullptr;
    const bool multi = (p.ph_hi - p.ph_lo) > 1;
    if (multi) {
        if (threadIdx.x == 0) *(LAS u32x4*)((LAS unsigned char*)smem) = (u32x4){0u, 0u, 0u, 0u};
        __syncthreads();
        bar = xcd_barrier_post((unsigned*)(p.ws + WS_BAR), (volatile LAS unsigned*)((LAS unsigned char*)smem));
    }
#if DUMP
    if (p.ph_lo == 100) { phase_dump(p, (size_t)(DUMP_OFF), DUMP_BF16, (size_t)(DUMP_N)); return; }
#endif
    int ph = 0;
#define PHASE(body) do { if (ph >= p.ph_lo && ph < p.ph_hi) { const int l = opaque_s(lv); body; if (ph + 1 < p.ph_hi) xcd_barrier(bar); } ++ph; } while (0)
    int lv = 0;
    PHASE(phase_prologue(p, lds));
    for (lv = 0; lv < DEPTH; ++lv) {
        PHASE(phase_norm<1>(p, l, lds));
        PHASE(GEMM8 ? phase_gemm8<0>(p, l, lds) : phase_gemm<0>(p, l, lds));
#if NAIVE_SCAN
        PHASE(phase_conv_pool(p, l, lds));
        PHASE(phase_scan_naive(p, l, lds));
#else
        PHASE(phase_prep(p, l, lds));
        PHASE(phase_scan(p, l, lds); phase_conv_pool(p, l, lds, (int)gridDim.x >= 256 ? 128 : 0, (int)gridDim.x >= 256 ? (int)gridDim.x - 128 : (int)gridDim.x));
#endif
        PHASE(phase_onorm(p, l));
        PHASE(GEMM8 ? phase_gemm8<1>(p, l, lds) : phase_gemm<1>(p, l, lds));
        PHASE(phase_norm<2>(p, l, lds));
        PHASE(phase_topk(p, l, lds));
        PHASE(GEMM8 ? phase_gemm8<2>(p, l, lds) : phase_gemm<2>(p, l, lds));
        PHASE(GEMM8 ? phase_gemm8<3>(p, l, lds) : phase_gemm<3>(p, l, lds));
    }
    lv = 0;
    PHASE(phase_norm<3>(p, l, lds));
#undef PHASE
}
constexpr int N_PHASES = 2 + DEPTH * 10;

extern "C" void kernel_launch(void* const* d_in, const int* in_sizes, int n_in, void* d_out, int out_size, void* d_ws, size_t ws_size, hipStream_t stream) {
    static int grid = 0;
    if (grid == 0) {
        if (n_in != 21 || out_size != ROWS_LAT * D || ws_size < WS_END) { fprintf(stderr, "kernel_launch: unexpected shapes (n_in %d out %d ws %zu need %zu)\n", n_in, out_size, ws_size, (size_t)WS_END); grid = -1; return; }
        int dev = 0, cus = 0, per_cu = 0;
        if (hipGetDevice(&dev) != hipSuccess || hipDeviceGetAttribute(&cus, hipDeviceAttributeMultiprocessorCount, dev) != hipSuccess) { grid = -1; return; }
        if (hipFuncSetAttribute((const void*)fwd, hipFuncAttributeMaxDynamicSharedMemorySize, LDS_BYTES) != hipSuccess) { fprintf(stderr, "kernel_launch: hipFuncSetAttribute failed\n"); grid = -1; return; }
        if (hipOccupancyMaxActiveBlocksPerMultiprocessor(&per_cu, (const void*)fwd, NTHREADS, LDS_BYTES) != hipSuccess || per_cu < 1) { fprintf(stderr, "kernel_launch: occupancy query says %d\n", per_cu); per_cu = 1; }
        (void)hipGetLastError();
        grid = cus;
    }
    if (grid < 0) return;
    (void)hipMemsetAsync((char*)d_ws + WS_BAR, 0, 16384, stream);
    Params p; memset(&p, 0, sizeof(p));
    const float** pp = (const float**)&p;
    for (int i = 0; i < 21; ++i) pp[i] = (const float*)d_in[i];
    p.out = (float*)d_out; p.ws = (unsigned char*)d_ws;
#if DUMP
    for (int ph = 0; ph <= DUMP_LAST; ++ph) { p.ph_lo = ph; p.ph_hi = ph + 1; hipLaunchKernelGGL(fwd, dim3(grid), dim3(NTHREADS), LDS_BYTES, stream, p); }
    p.ph_lo = 100; p.ph_hi = 101; hipLaunchKernelGGL(fwd, dim3(grid), dim3(NTHREADS), LDS_BYTES, stream, p);
#elif ONE_LAUNCH
    p.ph_lo = 0; p.ph_hi = N_PHASES;
    hipLaunchKernelGGL(fwd, dim3(grid), dim3(NTHREADS), LDS_BYTES, stream, p);
#else
    for (int ph = 0; ph < N_PHASES; ++ph) { p.ph_lo = ph; p.ph_hi = ph + 1; hipLaunchKernelGGL(fwd, dim3(grid), dim3(NTHREADS), LDS_BYTES, stream, p); }
#endif
}
```

```cpp
#include <hip/hip_runtime.h>
#include <stdint.h>
#include <stdio.h>
#include <string.h>

#ifndef ONE_LAUNCH
#define ONE_LAUNCH 1
#endif
#ifndef NAIVE_SCAN
#define NAIVE_SCAN 0
#endif
#ifndef GEMM8
#define GEMM8 1
#endif
#ifndef MOE_FP8
#define MOE_FP8 1
#endif
#ifndef REGSTAGE
#define REGSTAGE 0
#endif

#define LAS __attribute__((address_space(3)))
typedef unsigned short bf16_t;
typedef short bf16x8 __attribute__((ext_vector_type(8)));
typedef float f32x4 __attribute__((ext_vector_type(4)));
typedef float f32x2 __attribute__((ext_vector_type(2)));
typedef unsigned u32x2 __attribute__((ext_vector_type(2)));
typedef unsigned u32x4 __attribute__((ext_vector_type(4)));
typedef long i64x2 __attribute__((ext_vector_type(2)));
typedef int i32x8 __attribute__((ext_vector_type(8)));

constexpr int D = 1024, NB = 8, SEQ = 2048, DEPTH = 4, CTXL = 256;
constexpr int ROWS_LAT = NB * SEQ;
constexpr int ROWS_CTX = NB * CTXL;
constexpr int MT = ROWS_LAT + ROWS_CTX;
constexpr int INC = 2576;
constexpr int PN = 2560;
constexpr int NE = 16;
constexpr int NGROUPS = 144;
constexpr int NSLOTS = NGROUPS * 256;
constexpr int NTHREADS = 512;
constexpr float EPS = 1e-6f;

constexpr size_t al256(size_t x) { return (x + 255) & ~(size_t)255; }
constexpr size_t WS_BAR = 0;
constexpr size_t WS_MOD = 16384;
constexpr size_t WS_X = WS_MOD + al256((size_t)DEPTH * 9 * 6144 * 4);
constexpr size_t WS_H = WS_X + (size_t)MT * D * 4;
constexpr size_t WS_PROJ = WS_H + (size_t)MT * D * 2;
constexpr size_t WS_YE = WS_PROJ;
constexpr size_t WS_LOGA = WS_PROJ + (size_t)MT * PN * 2;
constexpr size_t WS_BETA = WS_LOGA + (size_t)MT * 8 * 4;
constexpr size_t WS_QKV = WS_BETA + (size_t)MT * 8 * 4;
constexpr size_t WS_HID = WS_QKV;
constexpr size_t WS_OF = WS_QKV + (NAIVE_SCAN ? (size_t)MT * 1536 * 4 : (size_t)NSLOTS * D * 2);
constexpr size_t WS_OB = WS_OF + (size_t)MT * 512 * 4;
constexpr size_t WS_CAT = WS_OB + (size_t)MT * 512 * 4;
constexpr size_t WS_AFF = WS_CAT + (size_t)MT * D * 2;
constexpr size_t WS_SEL = WS_AFF + (size_t)MT * 16 * 4;
constexpr size_t WS_SELAFF = WS_SEL + (size_t)NSLOTS * 4;
constexpr size_t WS_SLOTOF = WS_SELAFF + (size_t)NSLOTS * 4;
constexpr size_t WS_WINT = WS_SLOTOF + (size_t)MT * 16 * 4;
constexpr size_t WS_WOUTT = WS_WINT + (size_t)DEPTH * PN * D * 2;
constexpr size_t WS_WGUT = WS_WOUTT + (size_t)DEPTH * D * D * 2;
constexpr size_t WS_WDT = WS_WGUT + (size_t)DEPTH * NE * 2048 * D * 2;
constexpr size_t WS_PWT = WS_WDT + (size_t)DEPTH * NE * D * D * 2;
constexpr size_t WS_W16T = WS_PWT + (size_t)DEPTH * 4 * 128 * 128 * 2;
constexpr size_t WS_SCN = WS_W16T + (size_t)DEPTH * 2 * 16 * D * 4;
constexpr int REC_W = 0, REC_KT = 16384, REC_QD = 32768, REC_QK = 49152, REC_UT = 57344, REC_MISC = 73728, REC_BYTES = 73984;
constexpr int NCHUNK = 36;
constexpr size_t WS_END = WS_SCN + (size_t)NB * 4 * 2 * NCHUNK * REC_BYTES + 4096;

constexpr int LDS_OFF = 1024;
constexpr int LDS_WORK = 161792;
constexpr int LDS_BYTES = LDS_OFF + LDS_WORK;

struct Params {
    const float *x, *c, *ctx, *c_ctx, *w_mod, *b_mod, *norm1, *norm2, *w_in, *conv_w, *a_log, *dt_bias, *dn_norm, *pool_w, *pool_scale, *w_out, *w_router, *w_gate, *w_up, *w_down, *norm_f;
    float* out;
    unsigned char* ws;
    int ph_lo, ph_hi;
};

#define XB_TMO      128
#define XB_XCNT(j)  (256  + 64 * (j))
#define XB_XSUB(j)  (1280 + 64 * (j))
#define XB_XGEN(j)  (2304 + 64 * (j))
#define XB_TOP      3328
#define XB_TOPGEN   3392
#define XCD_BAR_WORDS 3456
#define XB_PANELCNT 3456
#define XB_SPIN_CAP (1u << 22)

__device__ __forceinline__ unsigned xb_ld(unsigned* p)              { return __hip_atomic_load(p, __ATOMIC_RELAXED, __HIP_MEMORY_SCOPE_AGENT); }
__device__ __forceinline__ unsigned xb_add(unsigned* p, unsigned v) { return __hip_atomic_fetch_add(p, v, __ATOMIC_RELAXED, __HIP_MEMORY_SCOPE_AGENT); }
__device__ __forceinline__ unsigned xb_xcc_id() { return (unsigned)__builtin_amdgcn_s_getreg((3 << 11) | 20) & 0xFu; }
#define XB_SPIN(cond, bar) do { unsigned _sp = 0; while (cond) { __builtin_amdgcn_s_sleep(1); \
    if ((++_sp & 255u) == 0u) { if (xb_ld(&(bar)[XB_TMO])) break; if (_sp > XB_SPIN_CAP) { atomicAdd(&(bar)[XB_TMO], 1u); break; } } } } while (0)

struct XcdBarrier { unsigned* bar; unsigned x; volatile LAS unsigned* st; };

__device__ __forceinline__ XcdBarrier xcd_barrier_post(unsigned* bar, volatile LAS unsigned* st) {
    XcdBarrier b; b.bar = bar; b.x = xb_xcc_id(); b.st = st;
    if (threadIdx.x == 0) (void)xb_add(&bar[XB_XCNT(b.x)], 1u);
    return b;
}
__device__ __forceinline__ void xcd_barrier_complete(unsigned* bar, unsigned x, unsigned& nloc, unsigned& nx) {
    const unsigned G = gridDim.x * gridDim.y * gridDim.z;
    unsigned sum, cnt, mine, sp = 0u;
    for (;;) {
        sum = 0u; cnt = 0u; mine = 0u;
#pragma unroll
        for (unsigned j = 0; j < 16; ++j) { const unsigned c = xb_ld(&bar[XB_XCNT(j)]); sum += c; cnt += (c > 0u) ? 1u : 0u; mine = (j == x) ? c : mine; }
        if (sum == G) break;
        __builtin_amdgcn_s_sleep(1);
        if ((++sp & 255u) == 0u) { if (xb_ld(&bar[XB_TMO])) break; if (sp > XB_SPIN_CAP) { atomicAdd(&bar[XB_TMO], 1u); break; } }
    }
    nloc = mine > 0u ? mine : 1u; nx = cnt > 0u ? cnt : 1u;
}
__device__ __forceinline__ void xcd_barrier(const XcdBarrier& b) {
    asm volatile("s_waitcnt vmcnt(0)" ::: "memory");
    __syncthreads();
    if (threadIdx.x == 0) {
        unsigned* bar = b.bar;
        __builtin_amdgcn_s_waitcnt(0);
        unsigned nloc = b.st[0], nx = b.st[1];
        if (nloc == 0u) { xcd_barrier_complete(bar, b.x, nloc, nx); b.st[0] = nloc; b.st[1] = nx; }
        const unsigned old = xb_add(&bar[XB_XSUB(b.x)], 1u);
        const unsigned gen = old / nloc;
        if (old + 1u == (gen + 1u) * nloc) {
            __builtin_amdgcn_fence(__ATOMIC_RELEASE, "agent");
            asm volatile("s_waitcnt vmcnt(0)" ::: "memory");
            const unsigned og = xb_add(&bar[XB_TOP], 1u);
            const unsigned tg = og / nx;
            if (og + 1u == (tg + 1u) * nx) xb_add(&bar[XB_TOPGEN], 1u);
            else XB_SPIN(xb_ld(&bar[XB_TOPGEN]) == tg, bar);
            __builtin_amdgcn_fence(__ATOMIC_ACQUIRE, "agent");
            xb_add(&bar[XB_XGEN(b.x)], 1u);
            asm volatile("s_waitcnt vmcnt(0)" ::: "memory");
        } else {
            XB_SPIN(xb_ld(&bar[XB_XGEN(b.x)]) == gen, bar);
            __builtin_amdgcn_fence(__ATOMIC_ACQUIRE, "agent");
            asm volatile("s_waitcnt vmcnt(0)" ::: "memory");
        }
    }
    __syncthreads();
}

typedef __bf16 bf16x2_t __attribute__((ext_vector_type(2)));
__device__ __forceinline__ unsigned pk_bf16(float lo, float hi) { const f32x2 v = {lo, hi}; const bf16x2_t b = __builtin_convertvector(v, bf16x2_t); return __builtin_bit_cast(unsigned, b); }
__device__ __forceinline__ unsigned pk_fp8x4(float a, float b, float c, float d) {
    a = __builtin_amdgcn_fmed3f(a, -448.f, 448.f); b = __builtin_amdgcn_fmed3f(b, -448.f, 448.f); c = __builtin_amdgcn_fmed3f(c, -448.f, 448.f); d = __builtin_amdgcn_fmed3f(d, -448.f, 448.f);
    int w = 0; w = __builtin_amdgcn_cvt_pk_fp8_f32(a, b, w, false); w = __builtin_amdgcn_cvt_pk_fp8_f32(c, d, w, true); return (unsigned)w; }
constexpr float YE_S = 128.f;
constexpr float F8_SW = 64.f, F8_SHID = 8.f;
__device__ __forceinline__ float bf_lo(unsigned u) { return __uint_as_float(u << 16); }
__device__ __forceinline__ float bf_hi(unsigned u) { return __uint_as_float(u & 0xffff0000u); }
__device__ __forceinline__ float shx(float v, int mask, int lane) { return __int_as_float(__builtin_amdgcn_ds_bpermute((lane ^ mask) << 2, __float_as_int(v))); }
__device__ __forceinline__ float shup(float v, int o, int lane) { return __int_as_float(__builtin_amdgcn_ds_bpermute(((lane - o) & 63) << 2, __float_as_int(v))); }
template <int CTRL> __device__ __forceinline__ float dppf(float v) { return __int_as_float(__builtin_amdgcn_update_dpp(0, __float_as_int(v), CTRL, 0xF, 0xF, true)); }
__device__ __forceinline__ float sum4(float v) { v += dppf<0xB1>(v); v += dppf<0x4E>(v); return v; }
__device__ __forceinline__ float sum8(float v) { v = sum4(v); v += dppf<0x141>(v); return v; }
__device__ __forceinline__ float sum16(float v) { v = sum8(v); v += dppf<0x140>(v); return v; }
__device__ __forceinline__ void swap16(float v, float& even_rows, float& odd_rows) { const auto r = __builtin_amdgcn_permlane16_swap(__float_as_uint(v), __float_as_uint(v), false, false); even_rows = __uint_as_float(r[0]); odd_rows = __uint_as_float(r[1]); }
__device__ __forceinline__ void swap32(float v, float& lo_half, float& hi_half) { const auto r = __builtin_amdgcn_permlane32_swap(__float_as_uint(v), __float_as_uint(v), false, false); lo_half = __uint_as_float(r[0]); hi_half = __uint_as_float(r[1]); }
__device__ __forceinline__ float xsum16(float v) { float a, b; swap16(v, a, b); return a + b; }
__device__ __forceinline__ float xsum32(float v) { float a, b; swap32(v, a, b); return a + b; }
__device__ __forceinline__ float xmax16(float v) { float a, b; swap16(v, a, b); return fmaxf(a, b); }
__device__ __forceinline__ float xmax32(float v) { float a, b; swap32(v, a, b); return fmaxf(a, b); }
__device__ __forceinline__ float wave_sum(float v, int lane) { v = sum16(v); v = xsum16(v); v = xsum32(v); return v; }
__device__ __forceinline__ int opaque_tid() { int t = threadIdx.x; asm volatile("" : "+v"(t)); return t; }
__device__ __forceinline__ int opaque_s(int v) { asm volatile("" : "+s"(v)); return v; }
__device__ __forceinline__ float silu_f(float v) { return v * __builtin_amdgcn_rcpf(1.f + __expf(-v)); }

__device__ __forceinline__ int lds_byte(int r, int c) { const int st = (r >> 4) * 2 + (c >> 5), rr = r & 15, cc = c & 31, ob = rr * 64 + cc * 2; return st * 1024 + (ob ^ (((ob >> 9) & 1) << 5)); }
__device__ __forceinline__ void stage_rc(int b, int& R, int& C) { const int st = b >> 10, sb = b & 1023, swz = sb ^ (((sb >> 9) & 1) << 5); R = (st >> 1) * 16 + (swz >> 6); C = (st & 1) * 32 + ((swz & 63) >> 1); }

constexpr int T_IN = 10 * 16, T_OUT = 4 * 16, T_EXP = NE * 4 * 16, T_LAYER = T_IN + T_OUT + 3 * T_EXP;
constexpr int TF_PREP = 1344, TF_POOL = 1984, TF_P8 = 1984, TF_P9 = 2240;
constexpr int T_PRO = T_IN + T_OUT + 2 * T_EXP;
__device__ __forceinline__ void convert_tiles(const Params& p, const int l, const int first, const int count, const int f, const int nf, LAS unsigned char* lds) {
    const int tid = opaque_tid();
    bf16_t* WINT = (bf16_t*)(p.ws + WS_WINT); bf16_t* WOUTT = (bf16_t*)(p.ws + WS_WOUTT); bf16_t* WGUT = (bf16_t*)(p.ws + WS_WGUT); bf16_t* WDT = (bf16_t*)(p.ws + WS_WDT);
    const int lane = tid & 63, wv = tid >> 6, ko = lane & 7, nq = wv * 8 + (lane >> 3);
    f32x4 rv[8]; const float* src = nullptr; size_t sld = 0;
#define CT_DECODE(t, SRC, SLD, DST, RS, F8) do { int i = (t); RS = 16; F8 = 0; \
        if (i < T_IN) { const int nt = i >> 4, kt = i & 15; const int n0 = nt < 6 ? nt * 256 : 1552 + (nt - 6) * 256; \
            SRC = p.w_in + ((size_t)l * D + kt * 64) * INC + n0; SLD = INC; DST = WINT + ((size_t)l * PN + nt * 256) * D + kt * 64; } \
        else if (i < T_IN + T_OUT) { i -= T_IN; const int nt = i >> 4, kt = i & 15; \
            SRC = p.w_out + ((size_t)l * D + kt * 64) * D + nt * 256; SLD = D; DST = WOUTT + ((size_t)l * D + nt * 256) * D + kt * 64; } \
        else { i -= T_IN + T_OUT; const int which = i / T_EXP; i %= T_EXP; const int e = i >> 6, nt = (i >> 4) & 3, kt = i & 15; \
            const size_t mo = ((size_t)(l * NE + e) * D + kt * 64) * D + nt * 256; \
            F8 = MOE_FP8; \
            if (which == 2) { SRC = p.w_down + mo; DST = WDT + (((size_t)(l * NE + e) * D + nt * 256) * D + kt * 64) / (MOE_FP8 ? 2 : 1); } \
            else { SRC = (which == 0 ? p.w_gate : p.w_up) + mo; RS = 32; DST = WGUT + (((size_t)(l * NE + e) * 2048 + nt * 512 + which * 16) * D + kt * 64) / (MOE_FP8 ? 2 : 1); } \
            SLD = D; } } while (0)
#define CT_LOAD() do { _Pragma("unroll") for (int j = 0; j < 8; ++j) rv[j] = *(const f32x4*)(src + (size_t)(ko * 8 + j) * sld + nq * 4); } while (0)
    bf16_t* dst = nullptr; int rs = 16, f8 = 0;
    int t = first + f;
    if (t < first + count) { CT_DECODE(t, src, sld, dst, rs, f8); CT_LOAD(); }
    for (; t < first + count; t += nf) {
        u32x4 o[4];
        const int fcur = f8;
        if (fcur) {
#pragma unroll
            for (int e = 0; e < 4; ++e) { o[e][0] = pk_fp8x4(rv[0][e] * F8_SW, rv[1][e] * F8_SW, rv[2][e] * F8_SW, rv[3][e] * F8_SW); o[e][1] = pk_fp8x4(rv[4][e] * F8_SW, rv[5][e] * F8_SW, rv[6][e] * F8_SW, rv[7][e] * F8_SW); o[e][2] = 0u; o[e][3] = 0u; }
        } else {
#pragma unroll
            for (int e = 0; e < 4; ++e) { o[e][0] = pk_bf16(rv[0][e], rv[1][e]); o[e][1] = pk_bf16(rv[2][e], rv[3][e]); o[e][2] = pk_bf16(rv[4][e], rv[5][e]); o[e][3] = pk_bf16(rv[6][e], rv[7][e]); }
        }
        bf16_t* dcur = dst; const int rcur = rs;
        if (t + nf < first + count) { CT_DECODE(t + nf, src, sld, dst, rs, f8); CT_LOAD(); }
        if (fcur) {
#pragma unroll
            for (int e = 0; e < 4; ++e) { const int n = nq * 4 + e; u32x2 o2; o2[0] = o[e][0]; o2[1] = o[e][1];
                *(u32x2*)((unsigned char*)dcur + (size_t)((n >> 4) * rcur + (n & 15)) * D + ko * 8) = o2; }
        } else {
#pragma unroll
            for (int e = 0; e < 4; ++e) { const int n = nq * 4 + e; *(u32x4*)(dcur + (size_t)((n >> 4) * rcur + (n & 15)) * D + ko * 8) = o[e]; }
        }
    }
#undef CT_DECODE
#undef CT_LOAD
}

constexpr int CS_PRO = 456, CS_P2 = 352, CS_PREP = 704, CS_P5 = 1344, CS_P5_0 = 2208, CS_P9 = 1120, CS_P2_L = 600, CS_PREP_L = 704;
static_assert(CS_PRO + (DEPTH - 1) * (CS_P2 + CS_PREP + CS_P9) + CS_P5_0 + (DEPTH - 2) * CS_P5 + CS_P2_L + CS_PREP_L == DEPTH * T_LAYER, "the stream covers every tile exactly once");
static_assert(CS_PRO + CS_P2 + CS_PREP + CS_P5_0 >= T_LAYER, "layer 0 complete before its gate/up phase");
__device__ __forceinline__ int cs_layer_start(const int l) { return l == 0 ? CS_PRO : CS_PRO + (CS_P2 + CS_PREP + CS_P9) * l + CS_P5_0 + CS_P5 * (l - 1); }
__device__ __forceinline__ void convert_stream(const Params& p, const int g0, const int cnt, const int f, const int nf, LAS unsigned char* lds) {
    const int L0 = g0 / T_LAYER, t0 = g0 - L0 * T_LAYER;
    const int c0 = cnt < T_LAYER - t0 ? cnt : T_LAYER - t0;
    convert_tiles(p, L0, t0, c0, f, nf, lds);
    if (cnt > c0) { const int f2 = (((f - c0) % nf) + nf) % nf; convert_tiles(p, L0 + 1, 0, cnt - c0, f2, nf, lds); }
}

__device__ __forceinline__ void adaln_gemv(const Params& p, LAS unsigned char* lds, const int l, const int f, const int nf) {
    const int tid = opaque_tid();
    if (f >= 192) return;
    LAS float* sc = (LAS float*)lds;
    LAS float* red = sc + 9 * 1024;
    const int lane = tid & 63, wv = tid >> 6, c4 = tid & 7, kg = tid >> 3;
    f32x4 w[16];
#define GV_LOAD(uu) do { const float* _W = p.w_mod + ((size_t)l * 1024 + kg * 16) * 6144 + (uu) * 32 + c4 * 4; \
        _Pragma("unroll") for (int k = 0; k < 16; ++k) w[k] = *(const f32x4*)(_W + (size_t)k * 6144); } while (0)
    GV_LOAD(f);
    __syncthreads();
    for (int idx = tid; idx < 9 * 1024; idx += NTHREADS) {
        const int r = idx >> 10, k = idx & 1023;
        const float v = r < 8 ? p.c[r * 1024 + k] : p.c_ctx[k];
        sc[idx] = silu_f(v);
    }
    __syncthreads();
    float* MOD = (float*)(p.ws + WS_MOD);
    for (int u = f; u < 192; u += nf) {
        const int c0 = u * 32;
        if (u != f) GV_LOAD(u);
        f32x4 acc[9];
#pragma unroll
        for (int r = 0; r < 9; ++r) {
            acc[r] = (f32x4){0.f, 0.f, 0.f, 0.f};
#pragma unroll
            for (int k4 = 0; k4 < 4; ++k4) {
                const f32x4 sv = *(const LAS f32x4*)(sc + r * 1024 + kg * 16 + k4 * 4);
                acc[r] += w[k4 * 4] * sv[0] + w[k4 * 4 + 1] * sv[1] + w[k4 * 4 + 2] * sv[2] + w[k4 * 4 + 3] * sv[3];
            }
        }
#pragma unroll
        for (int r = 0; r < 9; ++r)
#pragma unroll
            for (int e = 0; e < 4; ++e) { float v = acc[r][e]; v += dppf<0x128>(v); v = xsum16(v); v = xsum32(v); acc[r][e] = v; }
        if (lane < 8) {
#pragma unroll
            for (int r = 0; r < 9; ++r) *(LAS f32x4*)(red + (wv * 9 + r) * 32 + c4 * 4) = acc[r];
        }
        __syncthreads();
        if (tid < 288) {
            const int r = tid >> 5, cc = tid & 31;
            float sv = 0.f;
#pragma unroll
            for (int g = 0; g < 8; ++g) sv += red[(g * 9 + r) * 32 + cc];
            MOD[((size_t)l * 9 + r) * 6144 + c0 + cc] = sv + p.b_mod[l * 6144 + c0 + cc];
        }
        __syncthreads();
    }
#undef GV_LOAD
}

__device__ __forceinline__ void phase_prologue(const Params& p, LAS unsigned char* lds) {
    const int tid = opaque_tid();
    const bool g256 = (int)gridDim.x == 256;
    adaln_gemv(p, lds, 0, (int)blockIdx.x, (int)gridDim.x);
    adaln_gemv(p, lds, 1, g256 ? (int)((blockIdx.x + 64u) & 255u) : (int)blockIdx.x, (int)gridDim.x);
    if (!g256) { adaln_gemv(p, lds, 2, (int)blockIdx.x, (int)gridDim.x); adaln_gemv(p, lds, 3, (int)blockIdx.x, (int)gridDim.x); }
    {
        if (g256) {
            constexpr int T_X = 2 * 128;
            convert_stream(p, 0, CS_PRO - T_X, (int)blockIdx.x, 256, lds);
            if ((int)blockIdx.x >= 128) convert_stream(p, CS_PRO - T_X, T_X, (int)blockIdx.x - 128, 128, lds);
        } else convert_stream(p, 0, CS_PRO, (int)blockIdx.x, (int)gridDim.x, lds);
        {
            float* W16T = (float*)(p.ws + WS_W16T);
            for (int i = blockIdx.x * NTHREADS + tid; i < DEPTH * 2 * 16 * D; i += gridDim.x * NTHREADS) {
                const int l2 = i >> 15, wh = (i >> 14) & 1, j = (i >> 10) & 15, k = i & 1023;
                W16T[i] = wh ? p.w_router[((size_t)l2 * D + k) * NE + j] : p.w_in[((size_t)l2 * D + k) * INC + 1536 + j];
            }
        }
        bf16_t* PWT = (bf16_t*)(p.ws + WS_PWT);
        for (int i = blockIdx.x * NTHREADS + tid; i < DEPTH * 4 * 128 * 128; i += gridDim.x * NTHREADS) {
            const int lg = i >> 14, d = (i >> 7) & 127, c = i & 127;
            PWT[i] = (bf16_t)(pk_bf16(p.pool_w[((size_t)lg * 128 + c) * 128 + d], 0.f) & 0xffffu);
        }
    }
}

__device__ __forceinline__ float reduce4(const float v0, const float v1, const float v2, const float v3, const int lane) {
    const bool b5 = lane & 32, b4 = lane & 16;
    float l0, h0, l1, h1;
    swap32(b5 ? v0 : v2, l0, h0); swap32(b5 ? v1 : v3, l1, h1);
    const float a0 = (b5 ? v2 : v0) + (b5 ? l0 : h0), a1 = (b5 ? v3 : v1) + (b5 ? l1 : h1);
    float e, o; swap16(b4 ? a0 : a1, e, o);
    float c = (b4 ? a1 : a0) + (b4 ? e : o);
    c = sum16(c);
    return c;
}

template <int WHICH>
__device__ __forceinline__ void phase_norm(const Params& p, const int l, LAS unsigned char* lds) {
    const int tid = opaque_tid(), wid = tid >> 6, lane = tid & 63;
    LAS float* wsm = (LAS float*)lds;
    if (WHICH != 3) {
        const f32x4* src = (const f32x4*)(p.ws + WS_W16T) + (size_t)(l * 2 + (WHICH == 2 ? 1 : 0)) * 4096;
        f32x4 fv[8];
#pragma unroll
        for (int i = 0; i < 8; ++i) fv[i] = src[tid + i * NTHREADS];
#pragma unroll
        for (int i = 0; i < 8; ++i) *(LAS f32x4*)(wsm + (tid + i * NTHREADS) * 4) = fv[i];
        {
            const float* nwp = WHICH == 1 ? p.norm1 + l * D : p.norm2 + l * D;
            const float* mdp = (const float*)(p.ws + WS_MOD) + (size_t)l * 9 * 6144 + (WHICH == 1 ? 0 : 3072);
            f32x4 tw[5], tsh[5], tsc[5];
#pragma unroll
            for (int it = 0; it < 5; ++it) { const int idx0 = tid + it * NTHREADS, idx = idx0 < 9 * 256 ? idx0 : 9 * 256 - 1, sm = idx >> 8, c = (idx & 255) * 4;
                tw[it] = *(const f32x4*)(nwp + c); tsh[it] = *(const f32x4*)(mdp + (size_t)sm * 6144 + c); tsc[it] = *(const f32x4*)(mdp + (size_t)sm * 6144 + 1024 + c); }
#pragma unroll
            for (int it = 0; it < 5; ++it) { const int idx = tid + it * NTHREADS, sm = idx >> 8, c = (idx & 255) * 4;
                if (idx < 9 * 256) { *(LAS f32x4*)(wsm + 16384 + sm * 1024 + c) = tw[it] * (tsc[it] + 1.f); *(LAS f32x4*)(wsm + 16384 + 9216 + sm * 1024 + c) = tsh[it]; } }
        }
        __syncthreads();
    }
    const float* nw = WHICH == 1 ? p.norm1 + l * D : (WHICH == 2 ? p.norm2 + l * D : p.norm_f);
    bf16_t* X = (bf16_t*)(p.ws + WS_X);
    const float* MOD = (const float*)(p.ws + WS_MOD);
    bf16_t* H = (bf16_t*)(p.ws + WS_H);
    const int nrows = (WHICH == 3 || (WHICH == 2 && l == DEPTH - 1)) ? ROWS_LAT : MT;
    constexpr int R = 3;
    const int rstride = gridDim.x * 8;
    const bool comb = (WHICH == 1 && l > 0) || WHICH == 3;
    const bool first_layer = (WHICH == 1 && l == 0);
    f32x4 xn[R][4]; int svn[R];
#define NORM_LOAD(b0) do { _Pragma("unroll") for (int k = 0; k < R; ++k) { const int row = (b0) + k * rstride; svn[k] = -1; \
        if (row < nrows) { \
            if (first_layer) { const float* xr = row < ROWS_LAT ? p.x + (size_t)row * D : p.ctx + (size_t)(row - ROWS_LAT) * D; \
                _Pragma("unroll") for (int i = 0; i < 4; ++i) xn[k][i] = *(const f32x4*)(xr + i * 256 + lane * 4); } \
            else { _Pragma("unroll") for (int i = 0; i < 4; ++i) { const u32x2 _t = *(const u32x2*)(X + (size_t)row * D + i * 256 + lane * 4);   \
                xn[k][i] = (f32x4){__uint_as_float(_t[0]), __uint_as_float(_t[1]), 0.f, 0.f}; } } \
            if (comb && lane < 16) svn[k] = ((const int*)(p.ws + WS_SLOTOF))[(size_t)row * 16 + lane]; } \
        else { _Pragma("unroll") for (int i = 0; i < 4; ++i) xn[k][i] = (f32x4){0.f, 0.f, 0.f, 0.f}; } } } while (0)
    NORM_LOAD(blockIdx.x * 8 + wid);
    for (int base = blockIdx.x * 8 + wid; base < nrows; base += rstride * R) {
        f32x4 xv[R][4]; int sv[R]; bool ok[R];
#pragma unroll
        for (int k = 0; k < R; ++k) { ok[k] = (base + k * rstride) < nrows; sv[k] = svn[k];
#pragma unroll
            for (int i = 0; i < 4; ++i) { const unsigned b0 = __float_as_uint(xn[k][i][0]), b1 = __float_as_uint(xn[k][i][1]);
                xv[k][i] = first_layer ? xn[k][i] : (f32x4){bf_lo(b0), bf_hi(b0), bf_lo(b1), bf_hi(b1)}; } }
        if (first_layer) {
#pragma unroll
            for (int k = 0; k < R; ++k) if (ok[k]) {
#pragma unroll
                for (int i = 0; i < 4; ++i) { u32x2 o; o[0] = pk_bf16(xv[k][i][0], xv[k][i][1]); o[1] = pk_bf16(xv[k][i][2], xv[k][i][3]); *(u32x2*)(X + (size_t)(base + k * rstride) * D + i * 256 + lane * 4) = o; } }
        }
        if (comb) {
            const unsigned char* YE = p.ws + WS_YE;
            f32x4 a[R][4]; unsigned long long msk[R];
#pragma unroll
            for (int k = 0; k < R; ++k) { msk[k] = __ballot(sv[k] >= 0);
#pragma unroll
                for (int i = 0; i < 4; ++i) a[k][i] = (f32x4){0.f, 0.f, 0.f, 0.f}; }
            while (msk[0] | msk[1] | msk[2]) {
                unsigned t[R][2][4]; bool has[R][2];
#pragma unroll
                for (int k = 0; k < R; ++k)
#pragma unroll
                    for (int q = 0; q < 2; ++q) {
                        has[k][q] = msk[k] != 0ull;
                        if (has[k][q]) {
                            const int e = __builtin_ctzll(msk[k]); msk[k] &= msk[k] - 1ull;
                            const int sl = __builtin_amdgcn_readlane(sv[k], e);
                            const unsigned char* yr = YE + (size_t)sl * D;
#pragma unroll
                            for (int i = 0; i < 4; ++i) t[k][q][i] = *(const unsigned*)(yr + i * 256 + lane * 4);
                        }
                    }
#pragma unroll
                for (int k = 0; k < R; ++k)
#pragma unroll
                    for (int q = 0; q < 2; ++q) if (has[k][q]) {
#pragma unroll
                        for (int i = 0; i < 4; ++i) { const f32x2 lo = __builtin_amdgcn_cvt_pk_f32_fp8((int)t[k][q][i], false), hi = __builtin_amdgcn_cvt_pk_f32_fp8((int)t[k][q][i], true);
                            a[k][i][0] += lo[0]; a[k][i][1] += lo[1]; a[k][i][2] += hi[0]; a[k][i][3] += hi[1]; }
                    }
            }
#pragma unroll
            for (int k = 0; k < R; ++k) if (ok[k]) {
                const int row = base + k * rstride;
#pragma unroll
                for (int i = 0; i < 4; ++i) { xv[k][i] += a[k][i] * (1.f / YE_S);
                    if (WHICH == 1) { u32x2 o; o[0] = pk_bf16(xv[k][i][0], xv[k][i][1]); o[1] = pk_bf16(xv[k][i][2], xv[k][i][3]); *(u32x2*)(X + (size_t)row * D + i * 256 + lane * 4) = o; } }
            }
        }
        float rstd[R];
#pragma unroll
        for (int k = 0; k < R; ++k) {
            float ss = 0.f;
#pragma unroll
            for (int i = 0; i < 4; ++i) ss += xv[k][i][0] * xv[k][i][0] + xv[k][i][1] * xv[k][i][1] + xv[k][i][2] * xv[k][i][2] + xv[k][i][3] * xv[k][i][3];
            rstd[k] = rsqrtf(wave_sum(ss, lane) * (1.f / 1024.f) + EPS);
        }
        if (WHICH == 3) {
            if (base + rstride * R < nrows) NORM_LOAD(base + rstride * R);
#pragma unroll
            for (int k = 0; k < R; ++k) if (ok[k]) {
                const int row = base + k * rstride;
#pragma unroll
                for (int i = 0; i < 4; ++i) { const f32x4 w = *(const f32x4*)(nw + i * 256 + lane * 4); *(f32x4*)(p.out + (size_t)row * D + i * 256 + lane * 4) = xv[k][i] * rstd[k] * w; }
            }
            continue;
        }
#pragma unroll
        for (int k = 0; k < R; ++k) {
            const int row = base + k * rstride, bidx = row < ROWS_LAT ? (row >> 11) : 8;
#pragma unroll
            for (int i = 0; i < 4; ++i) {
                const int c = i * 256 + lane * 4;
                const f32x4 av = *(const LAS f32x4*)(wsm + 16384 + bidx * 1024 + c), sh = *(const LAS f32x4*)(wsm + 16384 + 9216 + bidx * 1024 + c);
                xv[k][i] = (xv[k][i] * rstd[k]) * av + sh;
                if (ok[k]) {
                    if (MOE_FP8 && WHICH == 2) *(unsigned*)((unsigned char*)H + (size_t)row * D + c) = pk_fp8x4(xv[k][i][0], xv[k][i][1], xv[k][i][2], xv[k][i][3]);
                    else { u32x2 o; o[0] = pk_bf16(xv[k][i][0], xv[k][i][1]); o[1] = pk_bf16(xv[k][i][2], xv[k][i][3]); *(u32x2*)(H + (size_t)row * D + c) = o; }
                }
            }
        }
        if (base + rstride * R < nrows) NORM_LOAD(base + rstride * R);
        float dj[R][4];
#pragma unroll
        for (int jg = 0; jg < 4; ++jg) {
            float sp[R][4];
#pragma unroll
            for (int jj = 0; jj < 4; ++jj) {
                const int j = jg * 4 + jj;
                f32x2 s0 = {0.f, 0.f}, s1 = {0.f, 0.f}, s2 = {0.f, 0.f};
#pragma unroll
                for (int i = 0; i < 4; ++i) { const f32x4 w = *(const LAS f32x4*)(wsm + j * 1024 + i * 256 + lane * 4);
                    const f32x2 wl = {w[0], w[1]}, wh = {w[2], w[3]};
                    s0 += (f32x2){xv[0][i][0], xv[0][i][1]} * wl; s0 += (f32x2){xv[0][i][2], xv[0][i][3]} * wh;
                    s1 += (f32x2){xv[1][i][0], xv[1][i][1]} * wl; s1 += (f32x2){xv[1][i][2], xv[1][i][3]} * wh;
                    s2 += (f32x2){xv[2][i][0], xv[2][i][1]} * wl; s2 += (f32x2){xv[2][i][2], xv[2][i][3]} * wh; }
                sp[0][jj] = s0[0] + s0[1]; sp[1][jj] = s1[0] + s1[1]; sp[2][jj] = s2[0] + s2[1];
            }
#pragma unroll
            for (int k = 0; k < R; ++k) dj[k][jg] = reduce4(sp[k][0], sp[k][1], sp[k][2], sp[k][3], lane);
            __builtin_amdgcn_sched_barrier(0);
        }
        const int q = lane >> 4;
#pragma unroll
        for (int k = 0; k < R; ++k) {
            const int row = base + k * rstride;
            if (WHICH == 1) {
                if (ok[k] && (lane & 15) == 0) {
#pragma unroll
                    for (int jg = 0; jg < 4; ++jg) {
                        const int j = jg * 4 + q; const float v = dj[k][jg];
                        if (jg < 2) { const float xa = v + p.dt_bias[l * 8 + j]; const float sp2 = xa > 20.f ? xa : log1pf(__expf(xa));
                            ((float*)(p.ws + WS_LOGA))[(size_t)row * 8 + j] = -__expf(p.a_log[l * 8 + j]) * sp2; }
                        else ((float*)(p.ws + WS_BETA))[(size_t)row * 8 + (j - 8)] = 1.f / (1.f + __expf(-v));
                    }
                }
            } else {
                float m = fmaxf(fmaxf(dj[k][0], dj[k][1]), fmaxf(dj[k][2], dj[k][3]));
                m = xmax16(m); m = xmax32(m);
                float e[4], sum = 0.f;
#pragma unroll
                for (int jg = 0; jg < 4; ++jg) { e[jg] = __expf(dj[k][jg] - m); sum += e[jg]; }
                sum = xsum16(sum); sum = xsum32(sum);
                const float inv = 1.f / sum;
                if (ok[k] && (lane & 15) == 0) {
#pragma unroll
                    for (int jg = 0; jg < 4; ++jg) ((float*)(p.ws + WS_AFF))[(size_t)row * 16 + jg * 4 + q] = e[jg] * inv;
                }
            }
        }
    }
}

#undef NORM_LOAD
__device__ __forceinline__ void gemm_core(const unsigned char* Ab, const unsigned (&aoff)[4], const unsigned char* Bb, const unsigned (&boff)[2], const int nt,
                                          LAS unsigned char* lds, f32x4 (&acc)[4][4], const int wid, const int lane) {
    const int wr = wid >> 1, wc = wid & 1, fr = lane & 15, fq = lane >> 4;
    const int ar = lds_byte(wr * 64 + fr, fq * 8), br = lds_byte(wc * 64 + fr, fq * 8);
    const unsigned ldsw = (unsigned)wid * 1024u;
#define G_STAGE(t, buf) do { const unsigned _ko = (unsigned)(t) * 128u; \
        _Pragma("unroll") for (int _i = 0; _i < 4; ++_i) __builtin_amdgcn_global_load_lds((const unsigned*)(Ab + aoff[_i] + _ko), (LAS unsigned*)(lds + (buf) * 49152 + ldsw + _i * 8192), 16, 0, 0); \
        _Pragma("unroll") for (int _i = 0; _i < 2; ++_i) __builtin_amdgcn_global_load_lds((const unsigned*)(Bb + boff[_i] + _ko), (LAS unsigned*)(lds + (buf) * 49152 + 32768 + ldsw + _i * 8192), 16, 0, 0); } while (0)
#pragma unroll
    for (int m = 0; m < 4; ++m)
#pragma unroll
        for (int n = 0; n < 4; ++n) acc[m][n] = (f32x4){0.f, 0.f, 0.f, 0.f};
#if REGSTAGE
    u32x4 ra[4], rb[2];
#pragma unroll
    for (int i = 0; i < 4; ++i) ra[i] = *(const u32x4*)(Ab + aoff[i]);
#pragma unroll
    for (int i = 0; i < 2; ++i) rb[i] = *(const u32x4*)(Bb + boff[i]);
    const unsigned tb = (unsigned)(wid * 64 + lane) * 16u;
    for (int t = 0; t < nt; ++t) {
        __syncthreads();
#pragma unroll
        for (int i = 0; i < 4; ++i) *(LAS u32x4*)(lds + tb + i * 8192) = ra[i];
#pragma unroll
        for (int i = 0; i < 2; ++i) *(LAS u32x4*)(lds + 32768 + tb + i * 8192) = rb[i];
        __syncthreads();
        if (t + 1 < nt) {
            const unsigned ko = (unsigned)(t + 1) * 128u;
#pragma unroll
            for (int i = 0; i < 4; ++i) ra[i] = *(const u32x4*)(Ab + aoff[i] + ko);
#pragma unroll
            for (int i = 0; i < 2; ++i) rb[i] = *(const u32x4*)(Bb + boff[i] + ko);
        }
        LAS unsigned char* bA = lds; LAS unsigned char* bB = bA + 32768;
        bf16x8 af[4][2], bfr[4][2];
#pragma unroll
        for (int m = 0; m < 4; ++m)
#pragma unroll
            for (int k = 0; k < 2; ++k) af[m][k] = *(const LAS bf16x8*)(bA + ar + m * 2048 + k * 1024);
#pragma unroll
        for (int n = 0; n < 4; ++n)
#pragma unroll
            for (int k = 0; k < 2; ++k) bfr[n][k] = *(const LAS bf16x8*)(bB + br + n * 2048 + k * 1024);
#pragma unroll
        for (int k = 0; k < 2; ++k)
#pragma unroll
            for (int m = 0; m < 4; ++m)
#pragma unroll
                for (int n = 0; n < 4; ++n) acc[m][n] = __builtin_amdgcn_mfma_f32_16x16x32_bf16(bfr[n][k], af[m][k], acc[m][n], 0, 0, 0);
    }
#else
    G_STAGE(0, 0);
    for (int t = 0; t < nt; ++t) {
        asm volatile("s_waitcnt vmcnt(0)" ::: "memory");
        __syncthreads();
        if (t + 1 < nt) { if ((t + 1) & 1) G_STAGE(t + 1, 1); else G_STAGE(t + 1, 0); }
        LAS unsigned char* bA = lds + (t & 1) * 49152; LAS unsigned char* bB = bA + 32768;
        bf16x8 af[4][2], bfr[4][2];
#pragma unroll
        for (int m = 0; m < 4; ++m)
#pragma unroll
            for (int k = 0; k < 2; ++k) af[m][k] = *(const LAS bf16x8*)(bA + ar + m * 2048 + k * 1024);
#pragma unroll
        for (int n = 0; n < 4; ++n)
#pragma unroll
            for (int k = 0; k < 2; ++k) bfr[n][k] = *(const LAS bf16x8*)(bB + br + n * 2048 + k * 1024);
#pragma unroll
        for (int k = 0; k < 2; ++k)
#pragma unroll
            for (int m = 0; m < 4; ++m)
#pragma unroll
                for (int n = 0; n < 4; ++n) acc[m][n] = __builtin_amdgcn_mfma_f32_16x16x32_bf16(bfr[n][k], af[m][k], acc[m][n], 0, 0, 0);
    }
#endif
    __syncthreads();
#undef G_STAGE
}

template <int MODE>
__device__ __forceinline__ void phase_gemm(const Params& p, const int l, LAS unsigned char* lds) {
    const int tid = opaque_tid(), wid = __builtin_amdgcn_readfirstlane(tid >> 6), lane = tid & 63;
    const int wr = wid >> 1, wc = wid & 1, fr = lane & 15, fq = lane >> 4;
    int R0, C0; stage_rc(tid * 16, R0, C0);
    constexpr int nN = MODE == 0 ? 20 : (MODE == 1 ? 8 : (MODE == 2 ? 16 : 8));
    constexpr int nM = (MODE <= 1) ? MT / 256 : NGROUPS;
    const bf16_t* H = (const bf16_t*)(p.ws + WS_H);
    for (int u = blockIdx.x; u < nM * nN; u += gridDim.x) {
        const int pm = u / nN, pn = u % nN;
        const unsigned char* Ab; const unsigned char* Bb; unsigned aoff[4], boff[2];
#pragma unroll
        for (int i = 0; i < 2; ++i) boff[i] = (unsigned)((R0 + 64 * i) * D + C0) * 2u;
        int e = 0;
        if (MODE == 0) {
            Ab = (const unsigned char*)(H + (size_t)pm * 256 * D); Bb = (const unsigned char*)((const bf16_t*)(p.ws + WS_WINT) + ((size_t)l * PN + pn * 128) * D);
#pragma unroll
            for (int i = 0; i < 4; ++i) aoff[i] = (unsigned)((R0 + 64 * i) * D + C0) * 2u;
        } else if (MODE == 1) {
            Ab = (const unsigned char*)((const bf16_t*)(p.ws + WS_CAT) + (size_t)pm * 256 * D); Bb = (const unsigned char*)((const bf16_t*)(p.ws + WS_WOUTT) + ((size_t)l * D + pn * 128) * D);
#pragma unroll
            for (int i = 0; i < 4; ++i) aoff[i] = (unsigned)((R0 + 64 * i) * D + C0) * 2u;
        } else if (MODE == 2) {
            e = pm < 128 ? (pm >> 3) : (pm - 128);
            const int* SEL = (const int*)(p.ws + WS_SEL) + pm * 256;
            Ab = (const unsigned char*)H; Bb = (const unsigned char*)((const bf16_t*)(p.ws + WS_WGUT) + ((size_t)(l * NE + e) * 2048 + pn * 128) * D);
#pragma unroll
            for (int i = 0; i < 4; ++i) aoff[i] = (unsigned)(SEL[R0 + 64 * i] * D + C0) * 2u;
        } else {
            e = pm < 128 ? (pm >> 3) : (pm - 128);
            Ab = (const unsigned char*)((const bf16_t*)(p.ws + WS_HID) + (size_t)pm * 256 * D); Bb = (const unsigned char*)((const bf16_t*)(p.ws + WS_WDT) + ((size_t)(l * NE + e) * D + pn * 128) * D);
#pragma unroll
            for (int i = 0; i < 4; ++i) aoff[i] = (unsigned)((R0 + 64 * i) * D + C0) * 2u;
        }
        f32x4 acc[4][4];
        gemm_core(Ab, aoff, Bb, boff, D / 64, lds, acc, wid, lane);
        if (MODE == 0) {
            bf16_t* PROJ = (bf16_t*)(p.ws + WS_PROJ);
#pragma unroll
            for (int m = 0; m < 4; ++m) { const size_t row = (size_t)pm * 256 + wr * 64 + m * 16 + fr;
#pragma unroll
                for (int n = 0; n < 4; ++n) { u32x2 o; o[0] = pk_bf16(acc[m][n][0], acc[m][n][1]); o[1] = pk_bf16(acc[m][n][2], acc[m][n][3]);
                    *(u32x2*)(PROJ + row * PN + pn * 128 + wc * 64 + n * 16 + fq * 4) = o; } }
        } else if (MODE == 1) {
            float* X = (float*)(p.ws + WS_X);
            const int bidx = pm < 64 ? (pm >> 3) : 8;
            const float* g1 = (const float*)(p.ws + WS_MOD) + ((size_t)l * 9 + bidx) * 6144 + 2048;
#pragma unroll
            for (int n = 0; n < 4; ++n) { const int col = pn * 128 + wc * 64 + n * 16 + fq * 4; const f32x4 g = *(const f32x4*)(g1 + col);
#pragma unroll
                for (int m = 0; m < 4; ++m) { float* xp = X + ((size_t)pm * 256 + wr * 64 + m * 16 + fr) * D + col; *(f32x4*)xp = *(const f32x4*)xp + g * acc[m][n]; } }
        } else if (MODE == 2) {
            bf16_t* HID = (bf16_t*)(p.ws + WS_HID);
#pragma unroll
            for (int m = 0; m < 4; ++m) { const size_t slot = (size_t)pm * 256 + wr * 64 + m * 16 + fr;
#pragma unroll
                for (int q = 0; q < 2; ++q) { const f32x4 g = acc[m][2 * q], uu = acc[m][2 * q + 1];
                    u32x2 o; o[0] = pk_bf16(silu_f(g[0]) * uu[0], silu_f(g[1]) * uu[1]); o[1] = pk_bf16(silu_f(g[2]) * uu[2], silu_f(g[3]) * uu[3]);
                    *(u32x2*)(HID + slot * D + pn * 64 + wc * 32 + q * 16 + fq * 4) = o; } }
        } else {
            bf16_t* YE = (bf16_t*)(p.ws + WS_YE);
            const float* SELAFF = (const float*)(p.ws + WS_SELAFF);
#pragma unroll
            for (int m = 0; m < 4; ++m) { const size_t slot = (size_t)pm * 256 + wr * 64 + m * 16 + fr; const float a = SELAFF[slot];
#pragma unroll
                for (int n = 0; n < 4; ++n) { const f32x4 g = *(const f32x4*)((const float*)(p.ws + WS_MOD) + ((size_t)l * 9 + (pm < 128 ? (pm & 7) : 8)) * 6144 + 5 * 1024 + pn * 128 + wc * 64 + n * 16 + fq * 4);
                    u32x2 o; o[0] = pk_bf16(acc[m][n][0] * a * g[0], acc[m][n][1] * a * g[1]); o[1] = pk_bf16(acc[m][n][2] * a * g[2], acc[m][n][3] * a * g[3]);
                    *(u32x2*)(YE + slot * D + pn * 128 + wc * 64 + n * 16 + fq * 4) = o; } }
        }
    }
}

struct UnitOps { const unsigned char* A; const unsigned char* B; unsigned va[2][2]; int pm, pn; };

template <int MODE> __device__ __forceinline__ int gemm_nunits(const int l) {
    const bool last = (l == DEPTH - 1);
    if (MODE == 0) return last ? 640 + 8 * 6 : 720;
    if (MODE == 1) return 256;
    if (MODE == 2) return 1024;
    return last ? 512 : 576;
}
template <bool TAIL>
__device__ __forceinline__ bool gemm_sel_load(const Params& p, const int l, const int i, const int R0, int (&selp)[2][2]) {
    const int G = gridDim.x, c = (G & 7) == 0 ? (int)(blockIdx.x & 7) * (G >> 3) + (int)(blockIdx.x >> 3) : (int)blockIdx.x;
    const int idx = c + i * G;
    if (TAIL) {
        if (idx >= 256) return false;
        const int* SEL = (const int*)(p.ws + WS_SEL) + (128 + (idx >> 4)) * 256 + ((idx >> 3) & 1) * 128;
#pragma unroll
        for (int h = 0; h < 2; ++h) { const int v = SEL[h * 64 + R0]; selp[h][0] = v; selp[h][1] = v; }
    } else {
        if (idx >= 1024) return false;
        const int* SEL = (const int*)(p.ws + WS_SEL) + (idx >> 3) * 256;
#pragma unroll
        for (int h = 0; h < 2; ++h)
#pragma unroll
            for (int k = 0; k < 2; ++k) selp[h][k] = SEL[h * 128 + R0 + 64 * k];
    }
    return true;
}
template <int MODE, bool TAIL = false>
__device__ __forceinline__ bool gemm_unit(const Params& p, const int l, const int i, const int R0, const int C0, UnitOps& u, const int (*selp)[2] = nullptr) {
    constexpr int nN = MODE == 0 ? 10 : (MODE == 1 ? 4 : (MODE == 2 ? 8 : 4));
    if (TAIL) {
        const int G = gridDim.x, c = (G & 7) == 0 ? (int)(blockIdx.x & 7) * (G >> 3) + (int)(blockIdx.x >> 3) : (int)blockIdx.x;
        const int idx = c + i * G;
        if (MODE == 2) {
            if (idx >= 256) return false;
            const int g = 128 + (idx >> 4), rh = (idx >> 3) & 1;
            u.pm = g * 2 + rh; u.pn = idx & 7;
            const int* SEL = (const int*)(p.ws + WS_SEL) + g * 256 + rh * 128;
            constexpr unsigned RB8 = MOE_FP8 ? D : 2 * D;
            u.A = p.ws + WS_H; u.B = p.ws + WS_WGUT + ((size_t)(l * NE + (g - 128)) * 2048 + u.pn * 256) * RB8;
#pragma unroll
            for (int h = 0; h < 2; ++h)
#pragma unroll
                for (int k = 0; k < 2; ++k) u.va[h][k] = (unsigned)(selp ? selp[h][k] : SEL[h * 64 + R0]) * RB8 + (unsigned)C0 * 2u;
            return true;
        }
        if (idx >= 64) return false;
        u.pm = 128 + (idx >> 2); u.pn = idx & 3;
        u.A = p.ws + WS_CAT + (size_t)u.pm * 128 * (2 * D); u.B = p.ws + WS_WOUTT + ((size_t)l * D + u.pn * 256) * (2 * D);
#pragma unroll
        for (int h = 0; h < 2; ++h)
#pragma unroll
            for (int k = 0; k < 2; ++k) u.va[h][k] = (unsigned)(h * 64 + R0) * (2 * D) + (unsigned)C0 * 2u;
        return true;
    }
    const int G = gridDim.x, c = (G & 7) == 0 ? (int)(blockIdx.x & 7) * (G >> 3) + (int)(blockIdx.x >> 3) : (int)blockIdx.x;
    const int idx = c + i * G;
    if (idx >= gemm_nunits<MODE>(l)) return false;
    int pm = idx / nN, pn = idx % nN;
    if (MODE == 0 && idx >= 640 && l == DEPTH - 1) { pm = 64 + (idx - 640) / 6; pn = (idx - 640) % 6; }
    u.pm = pm; u.pn = pn;
    constexpr unsigned RB = (MOE_FP8 && MODE >= 2) ? D : 2 * D;
    if (MODE == 2) {
        const int e = pm < 128 ? (pm >> 3) : (pm - 128);
        const int* SEL = (const int*)(p.ws + WS_SEL) + pm * 256;
        u.A = p.ws + WS_H; u.B = p.ws + WS_WGUT + ((size_t)(l * NE + e) * 2048 + pn * 256) * RB;
#pragma unroll
        for (int h = 0; h < 2; ++h)
#pragma unroll
            for (int k = 0; k < 2; ++k) u.va[h][k] = (unsigned)(selp ? selp[h][k] : SEL[h * 128 + R0 + 64 * k]) * RB + (unsigned)C0 * 2u;
    } else {
        if (MODE == 0) { u.A = p.ws + WS_H + (size_t)pm * 256 * RB; u.B = p.ws + WS_WINT + ((size_t)l * PN + pn * 256) * RB; }
        else if (MODE == 1) { u.A = p.ws + WS_CAT + (size_t)pm * 256 * RB; u.B = p.ws + WS_WOUTT + ((size_t)l * D + pn * 256) * RB; }
        else { const int e = pm < 128 ? (pm >> 3) : (pm - 128); u.A = p.ws + WS_HID + (size_t)pm * 256 * RB; u.B = p.ws + WS_WDT + ((size_t)(l * NE + e) * D + pn * 256) * RB; }
#pragma unroll
        for (int h = 0; h < 2; ++h)
#pragma unroll
            for (int k = 0; k < 2; ++k) u.va[h][k] = (unsigned)(h * 128 + R0 + 64 * k) * RB + (unsigned)C0 * 2u;
    }
    return true;
}

template <int MODE, int MH = 4>
__device__ __forceinline__ void gemm_epilogue(const Params& p, const int l, const f32x4 (&acc)[2][2][MH][2], const UnitOps& u, const int wr, const int wc, const int fr, const int fq) {
    const int row0 = u.pm * (64 * MH) + wr * (16 * MH) + fr, col0 = u.pn * 256 + wc * 32 + (MODE == 2 ? 4 : 8) * fq;
    if (MODE == 0) {
        bf16_t* PROJ = (bf16_t*)(p.ws + WS_PROJ);
#pragma unroll
        for (int ai = 0; ai < 2; ++ai)
#pragma unroll
            for (int m = 0; m < 4; ++m) { bf16_t* rp = PROJ + (size_t)(row0 + ai * 128 + m * 16) * PN + col0;
#pragma unroll
                for (int bj = 0; bj < 2; ++bj) { const f32x4 v0 = acc[ai][bj][m][0], v1 = acc[ai][bj][m][1];
                    u32x4 o; o[0] = pk_bf16(v0[0], v0[1]); o[1] = pk_bf16(v0[2], v0[3]); o[2] = pk_bf16(v1[0], v1[1]); o[3] = pk_bf16(v1[2], v1[3]); *(u32x4*)(rp + bj * 128) = o; } }
    } else if (MODE == 1) {
        float* X = (float*)(p.ws + WS_X);
        const int bidx = u.pm * (64 * MH) < ROWS_LAT ? ((u.pm * (64 * MH)) >> 11) : 8;
        const float* g1 = (const float*)(p.ws + WS_MOD) + ((size_t)l * 9 + bidx) * 6144 + 2048 + col0;
        f32x4 gv[2][2];
#pragma unroll
        for (int bj = 0; bj < 2; ++bj)
#pragma unroll
            for (int n = 0; n < 2; ++n) gv[bj][n] = *(const f32x4*)(g1 + bj * 128 + n * 4);
#pragma unroll
        for (int ai = 0; ai < 2; ++ai)
#pragma unroll
            for (int m = 0; m < MH; ++m) { float* rp = X + (size_t)(row0 + ai * (32 * MH) + m * 16) * D + col0;
#pragma unroll
                for (int bj = 0; bj < 2; ++bj)
#pragma unroll
                    for (int n = 0; n < 2; ++n) { float* xp = rp + bj * 128 + n * 4; *(f32x4*)xp = *(const f32x4*)xp + gv[bj][n] * acc[ai][bj][m][n]; } }
    } else if (MODE == 2) {
        const int f0 = u.pn * 128 + wc * 16 + 4 * fq;
        if (MOE_FP8) {
            unsigned char* HID8 = p.ws + WS_HID;
            constexpr float us = 1.f / F8_SW;
#pragma unroll
            for (int ai = 0; ai < 2; ++ai)
#pragma unroll
                for (int m = 0; m < MH; ++m) { unsigned char* rp = HID8 + (size_t)(row0 + ai * (32 * MH) + m * 16) * D + f0;
#pragma unroll
                    for (int bj = 0; bj < 2; ++bj) { const f32x4 g = acc[ai][bj][m][0] * us, uu = acc[ai][bj][m][1] * (us * F8_SHID);
                        *(unsigned*)(rp + bj * 64) = pk_fp8x4(silu_f(g[0]) * uu[0], silu_f(g[1]) * uu[1], silu_f(g[2]) * uu[2], silu_f(g[3]) * uu[3]); } }
        } else {
        bf16_t* HID = (bf16_t*)(p.ws + WS_HID);
#pragma unroll
        for (int ai = 0; ai < 2; ++ai)
#pragma unroll
            for (int m = 0; m < MH; ++m) { bf16_t* rp = HID + (size_t)(row0 + ai * (32 * MH) + m * 16) * D + f0;
#pragma unroll
                for (int bj = 0; bj < 2; ++bj) { const f32x4 g = acc[ai][bj][m][0], uu = acc[ai][bj][m][1];
                    u32x2 o; o[0] = pk_bf16(silu_f(g[0]) * uu[0], silu_f(g[1]) * uu[1]); o[1] = pk_bf16(silu_f(g[2]) * uu[2], silu_f(g[3]) * uu[3]);
                    *(u32x2*)(rp + bj * 64) = o; } }
        }
    } else {
        unsigned char* YE = p.ws + WS_YE;
        const float* SELAFF = (const float*)(p.ws + WS_SELAFF);
        const int bidx = u.pm < 128 ? (u.pm & 7) : 8;
        const float* g2 = (const float*)(p.ws + WS_MOD) + ((size_t)l * 9 + bidx) * 6144 + 5 * 1024 + col0;
        f32x4 gv[2][2];
#pragma unroll
        for (int bj = 0; bj < 2; ++bj)
#pragma unroll
            for (int n = 0; n < 2; ++n) gv[bj][n] = *(const f32x4*)(g2 + bj * 128 + n * 4);
        float aff[2][4];
#pragma unroll
        for (int ai = 0; ai < 2; ++ai)
#pragma unroll
            for (int m = 0; m < 4; ++m) aff[ai][m] = SELAFF[row0 + ai * 128 + m * 16];
#pragma unroll
        for (int ai = 0; ai < 2; ++ai)
#pragma unroll
            for (int m = 0; m < 4; ++m) { const size_t slot = (size_t)(row0 + ai * 128 + m * 16); const float a = aff[ai][m] * (YE_S * (MOE_FP8 ? 1.f / (F8_SW * F8_SHID) : 1.f)); unsigned char* rp = YE + slot * D + col0;
#pragma unroll
                for (int bj = 0; bj < 2; ++bj) { const f32x4 v0 = acc[ai][bj][m][0] * gv[bj][0] * a, v1 = acc[ai][bj][m][1] * gv[bj][1] * a;
                    u32x2 o; o[0] = pk_fp8x4(v0[0], v0[1], v0[2], v0[3]); o[1] = pk_fp8x4(v1[0], v1[1], v1[2], v1[3]); *(u32x2*)(rp + bj * 128) = o; } }
    }
}

template <int MODE, bool TAIL = false>
__device__ __forceinline__ void gemm_filler(const Params& p, const int l, LAS unsigned char* lds) {
    if (MODE == 2 || (MODE == 1 && !TAIL) || (MODE != 0 && l >= DEPTH - 1)) return;
    const int G = gridDim.x, c = (G & 7) == 0 ? (int)(blockIdx.x & 7) * (G >> 3) + (int)(blockIdx.x >> 3) : (int)blockIdx.x;
    const int rem = (TAIL ? 64 : gemm_nunits<MODE>(l)) % G;
    if (rem == 0 || c < rem) return;
    const bool lastl = (l == DEPTH - 1);
    const int g0 = cs_layer_start(l) + (MODE == 0 ? 0 : (MODE == 1 ? CS_P2 + CS_PREP : CS_P2 + CS_PREP + (l == 0 ? CS_P5_0 : CS_P5)));
    const int cnt = MODE == 0 ? (lastl ? CS_P2_L : CS_P2) : (MODE == 1 ? (l == 0 ? CS_P5_0 : CS_P5) : CS_P9);
    convert_stream(p, g0, cnt, c - rem, G - rem, lds);
    if (MODE == 1 && l >= 1 && G == 256) adaln_gemv(p, lds, l + 1, c - rem, G - rem);
}

constexpr size_t WS_STATS = WS_SCN;
constexpr int ST_FLOATS = 4608;
__device__ __forceinline__ float max16(float v) { v = fmaxf(v, dppf<0xB1>(v)); v = fmaxf(v, dppf<0x4E>(v)); v = fmaxf(v, dppf<0x141>(v)); v = fmaxf(v, dppf<0x140>(v)); return v; }
__device__ __forceinline__ float ld_sc1(const float* q) { return *q; }
constexpr int OPN_TAB = 131072;
__device__ __forceinline__ void outproj_tab_build(const Params& p, const int l, const UnitOps& u, const int rows, LAS unsigned char* lds) {
    const int tid = opaque_tid();
    const int rowt = u.pm * rows, bidx = rowt < ROWS_LAT ? (rowt >> 11) : 8;
    const float* MODL = (const float*)(p.ws + WS_MOD) + ((size_t)l * 9 + bidx) * 6144;
    const int sfq = tid >> 4, j = tid & 15, cg = u.pn * 256 + sfq * 8;
    const float* wrp = (const float*)(p.ws + WS_W16T) + ((size_t)(l * 2 + 1) * 16 + j) * D + cg;
    LAS unsigned char* BH = lds + OPN_TAB; LAS unsigned char* BL = BH + 8192; LAS float* CJP = (LAS float*)(BL + 8192);
    float cj = 0.f;
#pragma unroll
    for (int hf = 0; hf < 2; ++hf) {
        const f32x4 w = *(const f32x4*)(wrp + hf * 4), nn = *(const f32x4*)(p.norm2 + l * D + cg + hf * 4), sc = *(const f32x4*)(MODL + 4096 + cg + hf * 4), sh = *(const f32x4*)(MODL + 3072 + cg + hf * 4);
        const f32x4 v = nn * (sc + 1.f) * w;
        u32x2 hi, lo;
        hi[0] = pk_bf16(v[0], v[1]); hi[1] = pk_bf16(v[2], v[3]);
        lo[0] = pk_bf16(v[0] - bf_lo(hi[0]), v[1] - bf_hi(hi[0])); lo[1] = pk_bf16(v[2] - bf_lo(hi[1]), v[3] - bf_hi(hi[1]));
        *(LAS u32x2*)(BH + tid * 16 + hf * 8) = hi; *(LAS u32x2*)(BL + tid * 16 + hf * 8) = lo;
        cj += (sh[0] * w[0] + sh[1] * w[1]) + (sh[2] * w[2] + sh[3] * w[3]);
        __builtin_amdgcn_sched_barrier(0);
    }
    CJP[tid] = cj;
}
template <int MH>
__device__ __forceinline__ void outproj_norm2(const Params& p, const int l, f32x4 (&acc)[2][2][MH][2], const UnitOps& u, const int wr, const int wc, const int fr, const int fq, LAS unsigned char* lds) {
    constexpr int ROWS = 64 * MH;
    const int tid = opaque_tid(), lane = tid & 63;
    const int rowt = u.pm * ROWS, bidx = rowt < ROWS_LAT ? (rowt >> 11) : 8;
    const int ps = MH == 4 ? u.pm : 64 + (u.pm - 128);
    const int col0 = u.pn * 256 + wc * 32 + 8 * fq;
    const int r0l = wr * (16 * MH) + fr;
    bf16_t* X = (bf16_t*)(p.ws + WS_X);
    const float* MODL = (const float*)(p.ws + WS_MOD) + ((size_t)l * 9 + bidx) * 6144;
    LAS unsigned char* BH = lds + OPN_TAB;
    LAS unsigned char* BL = BH + 8192;
    LAS float* CJP = (LAS float*)(BL + 8192);
    LAS float* PT = (LAS float*)(lds);
    LAS float* RS = (LAS float*)(lds + 4 * 256 * 17 * 4);
    float* ST = (float*)(p.ws + WS_STATS) + (size_t)(ps * 4) * ST_FLOATS;
    float* STme = ST + (size_t)u.pn * ST_FLOATS;
    {
        const float* g1 = MODL + 2048 + col0;
        f32x4 gv[2][2];
#pragma unroll
        for (int bj = 0; bj < 2; ++bj)
#pragma unroll
            for (int n = 0; n < 2; ++n) gv[bj][n] = *(const f32x4*)(g1 + bj * 128 + n * 4);
#pragma unroll
        for (int aim = 0; aim < MH; ++aim) {
            const int ai = aim / (MH / 2), m0 = (aim % (MH / 2)) * 2;
            u32x4 xb[2][2];
#pragma unroll
            for (int mm = 0; mm < 2; ++mm)
#pragma unroll
                for (int bj = 0; bj < 2; ++bj) xb[mm][bj] = *(const u32x4*)(X + (size_t)(rowt + r0l + ai * (32 * MH) + (m0 + mm) * 16) * D + col0 + bj * 128);
#pragma unroll
            for (int mm = 0; mm < 2; ++mm) { const int m = m0 + mm; bf16_t* rp = X + (size_t)(rowt + r0l + ai * (32 * MH) + m * 16) * D + col0;
#pragma unroll
                for (int bj = 0; bj < 2; ++bj) { const u32x4 x = xb[mm][bj];
                    const f32x4 v0 = (f32x4){bf_lo(x[0]), bf_hi(x[0]), bf_lo(x[1]), bf_hi(x[1])} + gv[bj][0] * acc[ai][bj][m][0];
                    const f32x4 v1 = (f32x4){bf_lo(x[2]), bf_hi(x[2]), bf_lo(x[3]), bf_hi(x[3])} + gv[bj][1] * acc[ai][bj][m][1];
                    acc[ai][bj][m][0] = v0; acc[ai][bj][m][1] = v1;
                    u32x4 o; o[0] = pk_bf16(v0[0], v0[1]); o[1] = pk_bf16(v0[2], v0[3]); o[2] = pk_bf16(v1[0], v1[1]); o[3] = pk_bf16(v1[2], v1[3]);
                    *(u32x4*)(rp + bj * 128) = o; } }
        }
    }
    __builtin_amdgcn_sched_barrier(0);
#pragma unroll
    for (int ai = 0; ai < 2; ++ai)
#pragma unroll
        for (int m = 0; m < MH; ++m) {
            const int rl = r0l + ai * (32 * MH) + m * 16;
            float ss = 0.f; f32x4 R = (f32x4){0.f, 0.f, 0.f, 0.f};
#pragma unroll
            for (int bj = 0; bj < 2; ++bj) {
                const f32x4 a0 = acc[ai][bj][m][0], a1 = acc[ai][bj][m][1];
                ss += (a0[0] * a0[0] + a0[1] * a0[1]) + (a0[2] * a0[2] + a0[3] * a0[3]) + (a1[0] * a1[0] + a1[1] * a1[1]) + (a1[2] * a1[2] + a1[3] * a1[3]);
                u32x4 hi, lo;
                hi[0] = pk_bf16(a0[0], a0[1]); hi[1] = pk_bf16(a0[2], a0[3]); hi[2] = pk_bf16(a1[0], a1[1]); hi[3] = pk_bf16(a1[2], a1[3]);
                lo[0] = pk_bf16(a0[0] - bf_lo(hi[0]), a0[1] - bf_hi(hi[0])); lo[1] = pk_bf16(a0[2] - bf_lo(hi[1]), a0[3] - bf_hi(hi[1]));
                lo[2] = pk_bf16(a1[0] - bf_lo(hi[2]), a1[1] - bf_hi(hi[2])); lo[3] = pk_bf16(a1[2] - bf_lo(hi[3]), a1[3] - bf_hi(hi[3]));
                const int bo = (((bj * 4 + wc) * 4 + fq) * 16 + fr) * 16;
                const bf16x8 bh = *(const LAS bf16x8*)(BH + bo), bl = *(const LAS bf16x8*)(BL + bo);
                const bf16x8 ah = __builtin_bit_cast(bf16x8, hi), al = __builtin_bit_cast(bf16x8, lo);
                R = __builtin_amdgcn_mfma_f32_16x16x32_bf16(ah, bh, R, 0, 0, 0);
                R = __builtin_amdgcn_mfma_f32_16x16x32_bf16(al, bh, R, 0, 0, 0);
                R = __builtin_amdgcn_mfma_f32_16x16x32_bf16(ah, bl, R, 0, 0, 0);
            }
            ss = xsum16(ss); ss = xsum32(ss);
            if (fq == 0) PT[(wc * ROWS + rl) * 17] = ss;
            const int rb = wr * (16 * MH) + ai * (32 * MH) + m * 16 + 4 * fq;
#pragma unroll
            for (int r = 0; r < 4; ++r) PT[(wc * ROWS + rb + r) * 17 + 1 + fr] = R[r];
        }
    __syncthreads();
    {
        const __amdgpu_buffer_rsrc_t srs = __builtin_amdgcn_make_buffer_rsrc(STme, 0, ST_FLOATS * 4, 0x00020000);
#pragma unroll
        for (int k = 0; k < MH / 2; ++k) {
            const int q = tid + k * NTHREADS, row = q >> 2, jq = q & 3;
            f32x4 sv = (f32x4){0.f, 0.f, 0.f, 0.f};
#pragma unroll
            for (int w = 0; w < 4; ++w) { const LAS float* pt = PT + (w * ROWS + row) * 17 + 1 + 4 * jq; sv[0] += pt[0]; sv[1] += pt[1]; sv[2] += pt[2]; sv[3] += pt[3]; }
            __builtin_amdgcn_raw_buffer_store_b128(__builtin_bit_cast(u32x4, sv), srs, (256 + q * 4) * 4, 0, 16);
        }
        if (tid < ROWS / 4) {
            f32x4 sv = (f32x4){0.f, 0.f, 0.f, 0.f};
#pragma unroll
            for (int w = 0; w < 4; ++w)
#pragma unroll
                for (int i = 0; i < 4; ++i) sv[i] += PT[(w * ROWS + tid * 4 + i) * 17];
            __builtin_amdgcn_raw_buffer_store_b128(__builtin_bit_cast(u32x4, sv), srs, tid * 16, 0, 16);
        }
        if (tid >= 64 && tid < 80) {
            const int j = tid - 64; float cj = 0.f;
#pragma unroll
            for (int g = 0; g < 32; ++g) cj += CJP[g * 16 + j];
            __hip_atomic_store((unsigned*)(STme + 256 + 4096 + j), __float_as_uint(cj), __ATOMIC_RELAXED, __HIP_MEMORY_SCOPE_AGENT);
        }
        asm volatile("s_waitcnt vmcnt(0)" ::: "memory");
        unsigned* cnt = (unsigned*)(p.ws + WS_BAR) + XB_PANELCNT + ps * 8;
        if (lane == 0) (void)xb_add(cnt, 1u);
        if (tid < 64) {
            unsigned* bar = (unsigned*)(p.ws + WS_BAR);
            const unsigned want = 32u * (unsigned)(l + 1);
            unsigned sp = 0u;
            while (xb_ld(cnt) < want) {
                __builtin_amdgcn_s_sleep(1);
                if ((++sp & 255u) == 0u) { if (xb_ld(&bar[XB_TMO])) break; if (sp > XB_SPIN_CAP) { atomicAdd(&bar[XB_TMO], 1u); break; } }
            }
            __builtin_amdgcn_fence(__ATOMIC_ACQUIRE, "agent");
            asm volatile("s_waitcnt vmcnt(0)" ::: "memory");
        }
    }
    __syncthreads();
    if (tid < ROWS) {
        float s4[4];
#pragma unroll
        for (int t = 0; t < 4; ++t) s4[t] = ld_sc1(ST + (size_t)t * ST_FLOATS + tid);
        RS[tid] = rsqrtf(((s4[0] + s4[1]) + (s4[2] + s4[3])) * (1.f / 1024.f) + EPS);
    }
    {
        const int j = tid & 15;
        float cv[4], sv[MH / 2][4], pv[MH / 2][4];
#pragma unroll
        for (int t = 0; t < 4; ++t) cv[t] = ld_sc1(ST + (size_t)t * ST_FLOATS + 256 + 4096 + j);
#pragma unroll
        for (int k = 0; k < MH / 2; ++k) {
            const int row = u.pn * (16 * MH) + k * 32 + (tid >> 4);
#pragma unroll
            for (int t = 0; t < 4; ++t) { sv[k][t] = ld_sc1(ST + (size_t)t * ST_FLOATS + row); pv[k][t] = ld_sc1(ST + (size_t)t * ST_FLOATS + 256 + row * 16 + j); }
        }
        const float cj = (cv[0] + cv[1]) + (cv[2] + cv[3]);
#pragma unroll
        for (int k = 0; k < MH / 2; ++k) {
            const int row = u.pn * (16 * MH) + k * 32 + (tid >> 4);
            const float ss = (sv[k][0] + sv[k][1]) + (sv[k][2] + sv[k][3]), pj = (pv[k][0] + pv[k][1]) + (pv[k][2] + pv[k][3]);
            const float lg = rsqrtf(ss * (1.f / 1024.f) + EPS) * pj + cj;
            const float mx = max16(lg), e = __expf(lg - mx), sum = sum16(e);
            ((float*)(p.ws + WS_AFF))[(size_t)(rowt + row) * 16 + j] = e * (1.f / sum);
        }
    }
    __syncthreads();
    {
        f32x4 av[2][2], sh[2][2];
#pragma unroll
        for (int bj = 0; bj < 2; ++bj)
#pragma unroll
            for (int n = 0; n < 2; ++n) { const int c = col0 + bj * 128 + n * 4;
                av[bj][n] = *(const f32x4*)(p.norm2 + l * D + c) * (*(const f32x4*)(MODL + 4096 + c) + 1.f); sh[bj][n] = *(const f32x4*)(MODL + 3072 + c); }
        unsigned char* H8 = p.ws + WS_H;
        int r0h = r0l; asm volatile("" : "+v"(r0h));
#pragma unroll
        for (int ai = 0; ai < 2; ++ai)
#pragma unroll
            for (int m = 0; m < MH; ++m) { const int rl = r0h + ai * (32 * MH) + m * 16; const float rs = RS[rl];
#pragma unroll
                for (int bj = 0; bj < 2; ++bj) { const f32x4 y0 = (acc[ai][bj][m][0] * rs) * av[bj][0] + sh[bj][0], y1 = (acc[ai][bj][m][1] * rs) * av[bj][1] + sh[bj][1];
                    u32x2 o; o[0] = pk_fp8x4(y0[0], y0[1], y0[2], y0[3]); o[1] = pk_fp8x4(y1[0], y1[1], y1[2], y1[3]);
                    *(u32x2*)(H8 + (size_t)(rowt + rl) * D + col0 + bj * 128) = o; } }
    }
    __syncthreads();
}

template <int MODE, bool TAIL = false>
__device__ __forceinline__ void phase_gemm8(const Params& p, const int l, LAS unsigned char* lds) {
    const int tid = opaque_tid(), wid = __builtin_amdgcn_readfirstlane(tid >> 6), lane = tid & 63, wr = wid >> 2, wc = wid & 3, fr = lane & 15, fq = lane >> 4;
    constexpr int MH = TAIL ? 2 : 4, AP = MH / 2;
    constexpr int HTB = 16384;
    constexpr bool F8 = MOE_FP8 && MODE >= 2;
    constexpr int nt = F8 ? D / 128 : D / 64;
    constexpr unsigned RB = F8 ? D : 2 * D;
    constexpr unsigned kstep = 128u, hstepB = 128u * RB;
    const int R0 = 8 * wid + (lane >> 3), C0 = ((lane & 7) ^ ((R0 >> 1) & 7)) * 8;
    constexpr bool PERM = (MODE != 2);
    unsigned vb[2];
#pragma unroll
    for (int k = 0; k < 2; ++k) { const int R = R0 + 64 * k, rho = R & 31, Rb = PERM ? ((R & ~31) + 8 * ((rho & 15) >> 2) + 4 * (rho >> 4) + (rho & 3)) : R; vb[k] = (unsigned)Rb * RB + (unsigned)C0 * 2u; }
    const unsigned ldsw = (unsigned)wid * 1024u;
    const int arow = wr * (16 * MH) + fr, brow = wc * 32 + fr;
    const int aoff0 = arow * 128 + ((fq ^ ((arow >> 1) & 7)) << 4), aoff1 = arow * 128 + (((4 + fq) ^ ((arow >> 1) & 7)) << 4);
    const int boff0 = brow * 128 + ((fq ^ ((brow >> 1) & 7)) << 4), boff1 = brow * 128 + (((4 + fq) ^ ((brow >> 1) & 7)) << 4);
#define G8_SA(b, h) (((b) * 2 + (h)) * HTB)
#define G8_SB(b, h) ((4 + (b) * 2 + (h)) * HTB)
#define G8_STAGE_A(bufoff, U, h, ko) do { _Pragma("unroll") for (int _i = 0; _i < AP; ++_i) \
        __builtin_amdgcn_global_load_lds((const unsigned*)((U).A + (U).va[h][_i] + (ko)), (LAS unsigned*)(lds + (bufoff) + ldsw + _i * 8192), 16, 0, 0); } while (0)
#define G8_STAGE_B(bufoff, U, h, ko) do { _Pragma("unroll") for (int _i = 0; _i < 2; ++_i) \
        __builtin_amdgcn_global_load_lds((const unsigned*)((U).B + vb[_i] + (h) * hstepB + (ko)), (LAS unsigned*)(lds + (bufoff) + ldsw + _i * 8192), 16, 0, 0); } while (0)
#define G8_LD8(dst, p0, p1) do { const u32x4 _lo = *(const LAS u32x4*)(p0), _hi = *(const LAS u32x4*)(p1); \
        dst = (i32x8){(int)_lo[0], (int)_lo[1], (int)_lo[2], (int)_lo[3], (int)_hi[0], (int)_hi[1], (int)_hi[2], (int)_hi[3]}; } while (0)
#define G8_LDA(dst, b, h) do { _Pragma("unroll") for (int m = 0; m < MH; ++m) G8_LD8(dst[m], lds + G8_SA(b, h) + aoff0 + m * 2048, lds + G8_SA(b, h) + aoff1 + m * 2048); } while (0)
#define G8_LDB(dst, b, h) do { _Pragma("unroll") for (int n = 0; n < 2; ++n) G8_LD8(dst[n], lds + G8_SB(b, h) + boff0 + n * 2048, lds + G8_SB(b, h) + boff1 + n * 2048); } while (0)
#define G8_H(v, k) __builtin_bit_cast(bf16x8, __builtin_shufflevector(v, v, 4 * (k), 4 * (k) + 1, 4 * (k) + 2, 4 * (k) + 3))
#define G8_MMA(ai, bj, At, Bt) do { __builtin_amdgcn_s_setprio(1); _Pragma("unroll") for (int m = 0; m < MH; ++m) _Pragma("unroll") for (int n = 0; n < 2; ++n) { \
        if (F8) asm volatile("v_mfma_scale_f32_16x16x128_f8f6f4 %0, %1, %2, %0, %3, %3 op_sel_hi:[0,0,0]" : "+v"(acc[ai][bj][m][n]) : "v"(Bt[n]), "v"(At[m]), "v"(f8scale)); \
        else { acc[ai][bj][m][n] = __builtin_amdgcn_mfma_f32_16x16x32_bf16(G8_H(Bt[n], 0), G8_H(At[m], 0), acc[ai][bj][m][n], 0, 0, 0); \
               acc[ai][bj][m][n] = __builtin_amdgcn_mfma_f32_16x16x32_bf16(G8_H(Bt[n], 1), G8_H(At[m], 1), acc[ai][bj][m][n], 0, 0, 0); } } __builtin_amdgcn_s_setprio(0); } while (0)
#define G8_WAIT_V(n) asm volatile("s_waitcnt vmcnt(" #n ")" ::: "memory")
#define G8_WAIT_V1 do { if (AP == 2) G8_WAIT_V(4); else G8_WAIT_V(3); } while (0)
#define G8_WAIT_V2 do { if (AP == 2) G8_WAIT_V(6); else G8_WAIT_V(5); } while (0)
#define G8_WAIT_L(n) asm volatile("s_waitcnt lgkmcnt(" #n ")" ::: "memory")
#define G8_WAIT_LA do { if (MH == 4) G8_WAIT_L(8); else G8_WAIT_L(4); } while (0)
#define G8_BAR __builtin_amdgcn_s_barrier()
#define G8_SCHED __builtin_amdgcn_sched_barrier(0)
    UnitOps cur, nxt; int ui = 0;
    if (!gemm_unit<MODE, TAIL>(p, l, 0, R0, C0, cur)) { gemm_filler<MODE, TAIL>(p, l, lds); return; }
    f32x4 acc[2][2][MH][2];
#pragma unroll
    for (int a = 0; a < 2; ++a)
#pragma unroll
        for (int b = 0; b < 2; ++b)
#pragma unroll
            for (int m = 0; m < MH; ++m)
#pragma unroll
                for (int n = 0; n < 2; ++n) acc[a][b][m][n] = (f32x4){0.f, 0.f, 0.f, 0.f};
    i32x8 At[MH], B0[2], B1[2];
    int f8scale = 0x7F7F7F7F; asm volatile("" : "+v"(f8scale));
    bool has_next = gemm_unit<MODE, TAIL>(p, l, 1, R0, C0, nxt);
    if (!has_next) nxt = cur;
    G8_STAGE_B(G8_SB(0, 0), cur, 0, 0u); G8_STAGE_A(G8_SA(0, 0), cur, 0, 0u); G8_STAGE_B(G8_SB(0, 1), cur, 1, 0u); G8_STAGE_A(G8_SA(0, 1), cur, 1, 0u);
    if (MODE == 1) outproj_tab_build(p, l, cur, 64 * MH, lds);
    if (wr == 1) G8_BAR;
    G8_WAIT_V1; G8_BAR;
    G8_STAGE_B(G8_SB(1, 0), cur, 0, kstep); G8_STAGE_A(G8_SA(1, 0), cur, 0, kstep); G8_STAGE_B(G8_SB(1, 1), cur, 1, kstep);
    G8_WAIT_V2; G8_BAR;
    for (;;) {
#pragma unroll 1
        for (int t = 0; t < nt; t += 2) {
            const bool last = (t == nt - 2);
            const unsigned k1 = (unsigned)(t + 1) * kstep, k2 = last ? 0u : (unsigned)(t + 2) * kstep, k3 = k2 + kstep;
            UnitOps& U2 = last ? nxt : cur;
            G8_LDB(B0, 0, 0); G8_SCHED; G8_LDA(At, 0, 0); G8_STAGE_A(G8_SA(1, 1), cur, 1, k1);
            G8_WAIT_LA; G8_BAR; G8_WAIT_L(0); G8_MMA(0, 0, At, B0); G8_BAR; G8_SCHED;
            G8_LDB(B1, 0, 1); G8_STAGE_B(G8_SB(0, 0), U2, 0, k2);
            G8_BAR; G8_WAIT_L(0); G8_MMA(0, 1, At, B1); G8_BAR;
            G8_LDA(At, 0, 1); G8_STAGE_A(G8_SA(0, 0), U2, 0, k2);
            G8_BAR; G8_WAIT_L(0); G8_MMA(1, 0, At, B0); G8_BAR; G8_SCHED;
            G8_STAGE_B(G8_SB(0, 1), U2, 1, k2);
            G8_WAIT_V2; G8_BAR; G8_MMA(1, 1, At, B1); G8_BAR;
            G8_LDB(B0, 1, 0); G8_SCHED; G8_LDA(At, 1, 0); G8_STAGE_A(G8_SA(0, 1), U2, 1, k2);
            G8_WAIT_LA; G8_BAR; G8_WAIT_L(0); G8_MMA(0, 0, At, B0); G8_BAR; G8_SCHED;
            G8_LDB(B1, 1, 1); G8_STAGE_B(G8_SB(1, 0), U2, 0, k3);
            G8_BAR; G8_WAIT_L(0); G8_MMA(0, 1, At, B1); G8_BAR;
            G8_LDA(At, 1, 1); G8_STAGE_A(G8_SA(1, 0), U2, 0, k3);
            G8_BAR; G8_WAIT_L(0); G8_MMA(1, 0, At, B0); G8_BAR; G8_SCHED;
            G8_STAGE_B(G8_SB(1, 1), U2, 1, k3);
            G8_WAIT_V2; G8_BAR; G8_MMA(1, 1, At, B1); G8_BAR;
        }
        if (F8) asm volatile("s_nop 15\n\ts_nop 15" ::: "memory");
        if (MODE == 1) {
            G8_WAIT_V(0); if (wr == 0) G8_BAR; G8_BAR;
            outproj_norm2<MH>(p, l, acc, cur, wr, wc, fr, fq, lds);
            gemm_filler<MODE, TAIL>(p, l, lds);
            return;
        }
        int selp[2][2] = {{0, 0}, {0, 0}};
        if (MODE == 2 && has_next) (void)gemm_sel_load<TAIL>(p, l, ui + 2, R0, selp);
        gemm_epilogue<MODE, MH>(p, l, acc, cur, wr, wc, fr, fq);
        if (!has_next) break;
#pragma unroll
        for (int a = 0; a < 2; ++a)
#pragma unroll
            for (int b = 0; b < 2; ++b)
#pragma unroll
                for (int m = 0; m < MH; ++m)
#pragma unroll
                    for (int n = 0; n < 2; ++n) acc[a][b][m][n] = (f32x4){0.f, 0.f, 0.f, 0.f};
        cur = nxt; ++ui;
        has_next = MODE == 2 ? gemm_unit<MODE, TAIL>(p, l, ui + 1, R0, C0, nxt, selp) : gemm_unit<MODE, TAIL>(p, l, ui + 1, R0, C0, nxt);
        if (!has_next) nxt = cur;
    }
    G8_WAIT_V(0);
    if (wr == 0) G8_BAR;
    G8_BAR;
    gemm_filler<MODE, TAIL>(p, l, lds);
#undef G8_SA
#undef G8_SB
#undef G8_STAGE_A
#undef G8_STAGE_B
#undef G8_LDA
#undef G8_LD8
#undef G8_H
#undef G8_LDB
#undef G8_MMA
#undef G8_WAIT_V
#undef G8_WAIT_L
#undef G8_BAR
#undef G8_SCHED
}

template <int B>
__device__ __forceinline__ void pool_vsum(const bf16_t* src0, const size_t rstep, const int lo_r, const int hi_r, const int rc, const int npieces, LAS float* V, LAS unsigned char* U, const int tid) {
    for (int p0 = tid; p0 < npieces; p0 += 2 * NTHREADS) {
        const int p1 = p0 + NTHREADS; const bool two = p1 < npieces;
        const bf16_t* sa = src0 + (size_t)(p0 >> 4) * PN + (p0 & 15) * 8;
        const bf16_t* sb = src0 + (size_t)((two ? p1 : p0) >> 4) * PN + ((two ? p1 : p0) & 15) * 8;
        float aa[8], ab[8];
#pragma unroll
        for (int e = 0; e < 8; ++e) { aa[e] = 0.f; ab[e] = 0.f; }
        for (int r0 = lo_r; r0 < hi_r; r0 += B) {
            u32x4 va[B], vb[B];
#pragma unroll
            for (int k = 0; k < B; ++k) { const int rr = min(r0 + k, hi_r - 1); va[k] = *(const u32x4*)(sa + (size_t)rr * rstep); vb[k] = *(const u32x4*)(sb + (size_t)rr * rstep); }
#pragma unroll
            for (int k = 0; k < B; ++k) if (r0 + k < hi_r) {
                if (r0 + k == rc) { *(LAS u32x4*)(U + (p0 >> 4) * 256 + (p0 & 15) * 16) = va[k]; if (two) *(LAS u32x4*)(U + (p1 >> 4) * 256 + (p1 & 15) * 16) = vb[k]; }
#pragma unroll
                for (int e = 0; e < 4; ++e) { aa[2 * e] += bf_lo(va[k][e]); aa[2 * e + 1] += bf_hi(va[k][e]); ab[2 * e] += bf_lo(vb[k][e]); ab[2 * e + 1] += bf_hi(vb[k][e]); }
            }
        }
        *(LAS f32x4*)(V + (p0 >> 4) * 128 + (p0 & 15) * 8) = (f32x4){aa[0], aa[1], aa[2], aa[3]};
        *(LAS f32x4*)(V + (p0 >> 4) * 128 + (p0 & 15) * 8 + 4) = (f32x4){aa[4], aa[5], aa[6], aa[7]};
        if (two) { *(LAS f32x4*)(V + (p1 >> 4) * 128 + (p1 & 15) * 8) = (f32x4){ab[0], ab[1], ab[2], ab[3]};
                   *(LAS f32x4*)(V + (p1 >> 4) * 128 + (p1 & 15) * 8 + 4) = (f32x4){ab[4], ab[5], ab[6], ab[7]}; }
    }
}

__device__ __forceinline__ void phase_outproj(const Params& p, const int l, LAS unsigned char* lds) {
    phase_gemm8<1, false>(p, l, lds);
    if (l < DEPTH - 1) phase_gemm8<1, true>(p, l, lds);
}

__device__ __forceinline__ void phase_gateup(const Params& p, const int l, LAS unsigned char* lds) {
    phase_gemm8<2, false>(p, l, lds);
    if (l < DEPTH - 1) phase_gemm8<2, true>(p, l, lds);
}

__device__ __forceinline__ void phase_conv_pool(const Params& p, const int l, LAS unsigned char* lds, const int wg0 = 0, const int nwg = 0) {
    const int tid = opaque_tid(), wid = tid >> 6, lane = tid & 63;
    const bf16_t* PROJ = (const bf16_t*)(p.ws + WS_PROJ);
    if (NAIVE_SCAN) {
        float* QKV = (float*)(p.ws + WS_QKV);
        const float* cw = p.conv_w + (size_t)l * 4 * 1536;
        for (int task = blockIdx.x * 8 + wid; task < MT * 12; task += gridDim.x * 8) {
            const int row = task / 12, part = task % 12;
            int s0, len;
            if (row < ROWS_LAT) { s0 = row & ~2047; len = 2048; } else { s0 = ROWS_LAT + ((row - ROWS_LAT) & ~255); len = 256; }
            const int c = part * 128 + lane * 2;
            float a0 = 0.f, a1 = 0.f;
#pragma unroll
            for (int j = 0; j < 4; ++j) {
                const int r2 = row + j - 2;
                if (r2 >= s0 && r2 < s0 + len) {
                    const unsigned v = *(const unsigned*)(PROJ + (size_t)r2 * PN + c);
                    const f32x2 w = *(const f32x2*)(cw + j * 1536 + c);
                    a0 += w[0] * bf_lo(v); a1 += w[1] * bf_hi(v);
                }
            }
            a0 = silu_f(a0); a1 = silu_f(a1);
            if (part < 8) {
                const float ss = wave_sum(a0 * a0 + a1 * a1, lane);
                float sc = rsqrtf(ss + EPS);
                if (part < 4) sc *= 0.08838834764831845f;
                a0 *= sc; a1 *= sc;
            }
            *(f32x2*)(QKV + (size_t)row * 1536 + c) = (f32x2){a0, a1};
        }
    }
    {
        LAS float* V = (LAS float*)lds;
        LAS unsigned char* mt = lds + 40960;
        const bf16_t* PWT = (const bf16_t*)(p.ws + WS_PWT);
        bf16_t* CAT = (bf16_t*)(p.ws + WS_CAT);
        const int wr = wid >> 1, wc = wid & 1, fr = lane & 15, fq = lane >> 4;
        const int npool = (l == DEPTH - 1) ? 1024 : 1152;
        const int pstep = nwg > 0 ? nwg : (int)gridDim.x;
        for (int u = ((int)blockIdx.x >= wg0) ? (int)blockIdx.x - wg0 : npool; u < npool; u += pstep) {
            int g, r, nrows, ncols, c0, rowbase;
            if (u < 1024) { const int q = u & 255, b = q >> 5; g = (q + (u >> 8)) & 3; r = q & 31; nrows = 32; ncols = 64; c0 = 0; rowbase = b * 2048; }
            else { const int v = u - 1024; const int b = v >> 4; g = (v >> 2) & 3; r = 0; nrows = 1; ncols = 256; c0 = (v & 3) * 64; rowbase = ROWS_LAT + b * 256; }
            const int w = 2 << g, half = w >> 1;
            const int lo_r = max(r - half, 0), hi_r = min(r - half + w, nrows);
            const int cxlo = max(c0 - half, 0), cxhi = min(c0 + 64 + half, ncols);
            const bf16_t* ub = PROJ + 2048 + g * 128;
            const bf16_t* pw = PWT + (size_t)(l * 4 + g) * 128 * 128;
            bf16x8 pwf[4][4];
#pragma unroll
            for (int kk = 0; kk < 4; ++kk)
#pragma unroll
                for (int n = 0; n < 4; ++n) pwf[kk][n] = *(const bf16x8*)(pw + (size_t)(wc * 64 + n * 16 + fr) * 128 + kk * 32 + fq * 8);
            {
                const int npieces = (cxhi - cxlo) * 16;
                const size_t rstep = (size_t)ncols * PN;
                if (g == 0) pool_vsum<2>(ub + (size_t)(rowbase + cxlo) * PN, rstep, lo_r, hi_r, r, npieces, V, lds + 58368, tid);
                else if (g == 1) pool_vsum<4>(ub + (size_t)(rowbase + cxlo) * PN, rstep, lo_r, hi_r, r, npieces, V, lds + 58368, tid);
                else pool_vsum<8>(ub + (size_t)(rowbase + cxlo) * PN, rstep, lo_r, hi_r, r, npieces, V, lds + 58368, tid);
            }
            __syncthreads();
            for (int idx = tid; idx < 64 * 64; idx += NTHREADS) {
                const int ci = idx >> 6, ch = (idx & 63) * 2, c = c0 + ci;
                const int lo_c = max(c - half, 0), hi_c = min(c - half + w, ncols);
                float s0 = 0.f, s1 = 0.f;
                for (int cx = lo_c; cx < hi_c; ++cx) { s0 += V[(cx - cxlo) * 128 + ch]; s1 += V[(cx - cxlo) * 128 + ch + 1]; }
                const float inv = __builtin_amdgcn_rcpf((float)((hi_r - lo_r) * (hi_c - lo_c)));
                const unsigned v = *(const LAS unsigned*)(lds + 58368 + (c - cxlo) * 256 + ch * 2);
                *(LAS unsigned*)(mt + ci * 272 + ch * 2) = pk_bf16(s0 * inv - bf_lo(v), s1 * inv - bf_hi(v));
            }
            __syncthreads();
            f32x4 acc[4];
#pragma unroll
            for (int n = 0; n < 4; ++n) acc[n] = (f32x4){0.f, 0.f, 0.f, 0.f};
#pragma unroll
            for (int kk = 0; kk < 4; ++kk) {
                const bf16x8 a = *(const LAS bf16x8*)(mt + (wr * 16 + fr) * 272 + (kk * 32 + fq * 8) * 2);
#pragma unroll
                for (int n = 0; n < 4; ++n) acc[n] = __builtin_amdgcn_mfma_f32_16x16x32_bf16(pwf[kk][n], a, acc[n], 0, 0, 0);
            }
            const size_t row = (size_t)rowbase + r * ncols + c0 + wr * 16 + fr;
#pragma unroll
            for (int n = 0; n < 4; ++n) {
                const int dcol = g * 128 + wc * 64 + n * 16 + fq * 4;
                const f32x4 s = *(const f32x4*)(p.pool_scale + l * 512 + dcol);
                u32x2 o; o[0] = pk_bf16(acc[n][0] * s[0], acc[n][1] * s[1]); o[1] = pk_bf16(acc[n][2] * s[2], acc[n][3] * s[3]);
                *(u32x2*)(CAT + row * D + 512 + dcol) = o;
            }
            __syncthreads();
        }
    }
}


__device__ __forceinline__ void phase_pool_filler(const Params& p, const int l, LAS unsigned char* lds) {
    if (l >= DEPTH - 1) return;
    const int G = gridDim.x, w0 = G >= 256 ? 128 : 0;
    (void)w0; (void)lds;
}

__device__ __forceinline__ int img256(int row, int col) { return row * 256 + ((((col >> 3) ^ row) & 15) << 4) + (col & 7) * 2; }
__device__ __forceinline__ int img128(int row, int col) { return (row >> 1) * 256 + (row & 1) * 128 + ((((col >> 3) ^ (row >> 1)) & 7) << 4) + (col & 7) * 2; }

__device__ __forceinline__ void prep_tchain(const int lane, LAS float* MT, LAS float* XS) {
    const int fr = lane & 15, fq = lane >> 4;
    {
        const int bb = lane >> 4, c = lane & 15;
        float tc[16];
#pragma unroll
        for (int a = 0; a < 16; ++a) {
            float sv = (a == c) ? 1.f : 0.f;
#pragma unroll
            for (int q = 0; q < (a + 3) / 4; ++q) {
                const f32x4 m4 = *(const LAS f32x4*)(MT + (bb * 16 + a) * 68 + bb * 16 + q * 4);
#pragma unroll
                for (int e = 0; e < 4; ++e) if (q * 4 + e < a) sv -= m4[e] * tc[q * 4 + e];
            }
            tc[a] = sv;
        }
#pragma unroll
        for (int a = 0; a < 16; ++a) MT[(bb * 16 + a) * 68 + bb * 16 + c] = tc[a];
    }
    {
        f32x4 x0 = (f32x4){0.f, 0.f, 0.f, 0.f}, x1 = (f32x4){0.f, 0.f, 0.f, 0.f};
#pragma unroll
        for (int ks = 0; ks < 4; ++ks) {
            x0 = __builtin_amdgcn_mfma_f32_16x16x4f32(MT[(16 + fr) * 68 + ks * 4 + fq], MT[(ks * 4 + fq) * 68 + fr], x0, 0, 0, 0);
            x1 = __builtin_amdgcn_mfma_f32_16x16x4f32(MT[(48 + fr) * 68 + 32 + ks * 4 + fq], MT[(32 + ks * 4 + fq) * 68 + 32 + fr], x1, 0, 0, 0);
        }
#pragma unroll
        for (int r = 0; r < 4; ++r) { XS[(fq * 4 + r) * 17 + fr] = x0[r]; XS[272 + (fq * 4 + r) * 17 + fr] = x1[r]; }
        f32x4 y0 = (f32x4){0.f, 0.f, 0.f, 0.f}, y1 = (f32x4){0.f, 0.f, 0.f, 0.f};
#pragma unroll
        for (int ks = 0; ks < 4; ++ks) {
            y0 = __builtin_amdgcn_mfma_f32_16x16x4f32(MT[(16 + fr) * 68 + 16 + ks * 4 + fq], XS[(ks * 4 + fq) * 17 + fr], y0, 0, 0, 0);
            y1 = __builtin_amdgcn_mfma_f32_16x16x4f32(MT[(48 + fr) * 68 + 48 + ks * 4 + fq], XS[272 + (ks * 4 + fq) * 17 + fr], y1, 0, 0, 0);
        }
#pragma unroll
        for (int r = 0; r < 4; ++r) { MT[(16 + fq * 4 + r) * 68 + fr] = -y0[r]; MT[(48 + fq * 4 + r) * 68 + 32 + fr] = -y1[r]; }
    }
    {
        f32x4 y[2][2];
#pragma unroll
        for (int ti = 0; ti < 2; ++ti)
#pragma unroll
            for (int tj = 0; tj < 2; ++tj) y[ti][tj] = (f32x4){0.f, 0.f, 0.f, 0.f};
#pragma unroll
        for (int ks = 0; ks < 8; ++ks) {
            const float b0 = MT[(ks * 4 + fq) * 68 + fr], b1 = MT[(ks * 4 + fq) * 68 + 16 + fr];
#pragma unroll
            for (int ti = 0; ti < 2; ++ti) {
                const float a = MT[(32 + ti * 16 + fr) * 68 + ks * 4 + fq];
                y[ti][0] = __builtin_amdgcn_mfma_f32_16x16x4f32(a, b0, y[ti][0], 0, 0, 0);
                y[ti][1] = __builtin_amdgcn_mfma_f32_16x16x4f32(a, b1, y[ti][1], 0, 0, 0);
            }
        }
#pragma unroll
        for (int ti = 0; ti < 2; ++ti)
#pragma unroll
            for (int tj = 0; tj < 2; ++tj)
#pragma unroll
                for (int r = 0; r < 4; ++r) XS[(ti * 16 + fq * 4 + r) * 33 + tj * 16 + fr] = y[ti][tj][r];
        f32x4 z[2][2];
#pragma unroll
        for (int ti = 0; ti < 2; ++ti)
#pragma unroll
            for (int tj = 0; tj < 2; ++tj) z[ti][tj] = (f32x4){0.f, 0.f, 0.f, 0.f};
#pragma unroll
        for (int ks = 0; ks < 8; ++ks) {
            const float b0 = XS[(ks * 4 + fq) * 33 + fr], b1 = XS[(ks * 4 + fq) * 33 + 16 + fr];
#pragma unroll
            for (int ti = 0; ti < 2; ++ti) {
                const float a = MT[(32 + ti * 16 + fr) * 68 + 32 + ks * 4 + fq];
                z[ti][0] = __builtin_amdgcn_mfma_f32_16x16x4f32(a, b0, z[ti][0], 0, 0, 0);
                z[ti][1] = __builtin_amdgcn_mfma_f32_16x16x4f32(a, b1, z[ti][1], 0, 0, 0);
            }
        }
#pragma unroll
        for (int ti = 0; ti < 2; ++ti)
#pragma unroll
            for (int tj = 0; tj < 2; ++tj)
#pragma unroll
                for (int r = 0; r < 4; ++r) MT[(32 + ti * 16 + fq * 4 + r) * 68 + tj * 16 + fr] = -z[ti][tj][r];
    }
}

__device__ __forceinline__ int imgT(int i, int j) { return i * 128 + ((((j >> 3) ^ i) & 7) << 4) + (j & 7) * 2; }

__device__ __forceinline__ void phase_prep(const Params& p, const int l, LAS unsigned char* lds) {
    int tid = opaque_tid(), wid = __builtin_amdgcn_readfirstlane(tid >> 6), lane = tid & 63, fr = lane & 15, fq = lane >> 4;
#define RELAUNDER() do { asm volatile("" : "+v"(tid)); wid = __builtin_amdgcn_readfirstlane(tid >> 6); lane = tid & 63; fr = lane & 15; fq = lane >> 4; } while (0)
    constexpr int R_MT0 = 0, R_MT1 = 17408, R_QK = 34816, R_QN = 53248, R_KN = 70656, R_KNT = 88064, R_VT = 106496, R_G = 143360;
    constexpr int R_T0 = R_QK, R_T1 = 124928;
    LAS float* QK = (LAS float*)(lds + R_QK);
    LAS float* G_LA = (LAS float*)(lds + R_G);
    LAS float* G_BT = G_LA + 128;
    LAS float* G_GC = G_BT + 128;
    LAS float* G_TOT = G_GC + 128;
    LAS float* G_E1 = G_TOT + 16;
    LAS float* G_E2 = G_E1 + 128;
    LAS float* XS = G_E2 + 128;
    LAS float* CW = XS + 2176;
    static_assert(R_G + (128 * 5 + 16 + 2176 + 1536) * 4 <= LDS_WORK, "prep LDS");
    const bf16_t* PROJ = (const bf16_t*)(p.ws + WS_PROJ);
    const float* LOGA = (const float*)(p.ws + WS_LOGA); const float* BETA = (const float*)(p.ws + WS_BETA);
    int cur_h = -1;
    for (int u = blockIdx.x; u < NB * 4 * NCHUNK; u += gridDim.x) {
        const int h = u & 3, b = (u >> 2) / 36, cc = (u >> 2) % 36;
        if (h != cur_h) {
            __syncthreads();
            for (int idx = tid; idx < 1536; idx += NTHREADS) { const int j = idx / 384, rm = idx % 384, seg = rm >> 7, c = rm & 127; CW[idx] = p.conv_w[(size_t)(l * 4 + j) * 1536 + seg * 512 + h * 128 + c]; }
            cur_h = h;
        }
        int rowbase, seqlen, cpos;
        if (cc < 32) { rowbase = b * SEQ; seqlen = SEQ; cpos = cc; } else { rowbase = ROWS_LAT + b * CTXL; seqlen = CTXL; cpos = cc - 32; }
        const int t0 = cpos * 64;
        RELAUNDER();
        {
            u32x4 rv[7];
#pragma unroll
            for (int it = 0; it < 7; ++it) {
                const int idx = tid + it * NTHREADS, rr = idx / 48, pc = idx % 48, seg = pc >> 4, po = pc & 15, tok = t0 - 2 + rr;
                rv[it] = (u32x4){0u, 0u, 0u, 0u};
                if (idx < 67 * 48 && tok >= 0 && tok < seqlen) rv[it] = *(const u32x4*)(PROJ + (size_t)(rowbase + tok) * PN + seg * 512 + h * 128 + po * 8);
            }
#pragma unroll
            for (int it = 0; it < 7; ++it) {
                const int idx = tid + it * NTHREADS, rr = idx / 48, pc = idx % 48, seg = pc >> 4, po = pc & 15;
                if (idx < 67 * 48) *(LAS u32x4*)(lds + rr * 784 + seg * 256 + po * 16) = rv[it];
            }
        }
        if (tid < 128) { const int d = tid >> 6; const size_t gi = (size_t)(rowbase + t0 + lane) * 8 + d * 4 + h; G_LA[tid] = LOGA[gi]; G_BT[tid] = BETA[gi]; }
        __syncthreads();
        RELAUNDER();
        if (wid < 2) {
            const int d = wid, pos = d ? 63 - lane : lane;
            float v = G_LA[d * 64 + pos];
#pragma unroll
            for (int o = 1; o < 64; o <<= 1) { const float t = shup(v, o, lane); if (lane >= o) v += t; }
            G_GC[d * 64 + pos] = v;
            if (lane == 63) G_TOT[d] = v;
            const float tot = __int_as_float(__builtin_amdgcn_readlane(__float_as_int(v), 63));
            G_E1[d * 64 + pos] = __expf(tot - v); G_E2[d * 64 + pos] = __expf(v);
        }
        RELAUNDER();
        {
            const int r = tid >> 3, cs = tid & 7;
            const LAS float* cw = CW + cs * 16;
#pragma unroll
            for (int seg = 0; seg < 3; ++seg) {
                float a[16];
#pragma unroll
                for (int e = 0; e < 16; ++e) a[e] = 0.f;
#pragma unroll
                for (int j = 0; j < 4; ++j) {
                    const u32x4 x0 = *(const LAS u32x4*)(lds + (r + j) * 784 + seg * 256 + cs * 32), x1 = *(const LAS u32x4*)(lds + (r + j) * 784 + seg * 256 + cs * 32 + 16);
                    const LAS float* wj = cw + j * 384 + seg * 128;
                    const f32x4 w0 = *(const LAS f32x4*)(wj), w1 = *(const LAS f32x4*)(wj + 4), w2 = *(const LAS f32x4*)(wj + 8), w3 = *(const LAS f32x4*)(wj + 12);
                    a[0] += w0[0] * bf_lo(x0[0]); a[1] += w0[1] * bf_hi(x0[0]); a[2] += w0[2] * bf_lo(x0[1]); a[3] += w0[3] * bf_hi(x0[1]);
                    a[4] += w1[0] * bf_lo(x0[2]); a[5] += w1[1] * bf_hi(x0[2]); a[6] += w1[2] * bf_lo(x0[3]); a[7] += w1[3] * bf_hi(x0[3]);
                    a[8] += w2[0] * bf_lo(x1[0]); a[9] += w2[1] * bf_hi(x1[0]); a[10] += w2[2] * bf_lo(x1[1]); a[11] += w2[3] * bf_hi(x1[1]);
                    a[12] += w3[0] * bf_lo(x1[2]); a[13] += w3[1] * bf_hi(x1[2]); a[14] += w3[2] * bf_lo(x1[3]); a[15] += w3[3] * bf_hi(x1[3]);
                    if (j & 1) __builtin_amdgcn_sched_barrier(0);
                }
                float ss = 0.f;
#pragma unroll
                for (int e = 0; e < 16; ++e) { a[e] = silu_f(a[e]); ss += a[e] * a[e]; }
                if (seg < 2) {
                    ss = sum8(ss);
                    float sc = rsqrtf(ss + EPS); if (seg == 0) sc *= 0.08838834764831845f;
#pragma unroll
                    for (int e = 0; e < 16; ++e) a[e] *= sc;
                }
                unsigned pk[8];
#pragma unroll
                for (int e = 0; e < 8; ++e) pk[e] = pk_bf16(a[2 * e], a[2 * e + 1]);
                if (seg < 2) {
                    LAS unsigned char* dst = lds + (seg == 0 ? R_QN : R_KN) + r * 272 + cs * 32;
                    *(LAS u32x4*)dst = (u32x4){pk[0], pk[1], pk[2], pk[3]}; *(LAS u32x4*)(dst + 16) = (u32x4){pk[4], pk[5], pk[6], pk[7]};
                }
                if (seg >= 1) {
                    LAS unsigned char* dt = lds + (seg == 1 ? R_KNT : R_VT) + (cs * 16) * 144 + ((((r >> 3) ^ cs) & 7) << 4) + (r & 7) * 2;
#pragma unroll
                    for (int e = 0; e < 8; ++e) { *(LAS unsigned short*)(dt + (2 * e) * 144) = (unsigned short)(pk[e] & 0xffffu); *(LAS unsigned short*)(dt + (2 * e + 1) * 144) = (unsigned short)(pk[e] >> 16); }
                }
            }
        }
        __syncthreads();
        RELAUNDER();
        {
            const int ib = wid & 3, pr = wid >> 2;
            LAS unsigned char* Ab = lds + (pr ? R_QN : R_KN) + (ib * 16 + fr) * 272 + fq * 16;
            bf16x8 a[4];
#pragma unroll
            for (int kk = 0; kk < 4; ++kk) a[kk] = *(const LAS bf16x8*)(Ab + kk * 64);
            float gci0[4], gci1[4], bti0[4], bti1[4];
#pragma unroll
            for (int r = 0; r < 4; ++r) { const int i = ib * 16 + fq * 4 + r; gci0[r] = G_GC[i]; gci1[r] = G_GC[64 + i]; bti0[r] = G_BT[i]; bti1[r] = G_BT[64 + i]; }
#pragma unroll
            for (int jb = 0; jb < 4; ++jb) {
                f32x4 acc = (f32x4){0.f, 0.f, 0.f, 0.f};
#pragma unroll
                for (int kk = 0; kk < 4; ++kk) { const bf16x8 bb = *(const LAS bf16x8*)(lds + R_KN + (jb * 16 + fr) * 272 + fq * 16 + kk * 64); acc = __builtin_amdgcn_mfma_f32_16x16x32_bf16(a[kk], bb, acc, 0, 0, 0); }
                if (pr) {
#pragma unroll
                    for (int r = 0; r < 4; ++r) QK[(ib * 16 + fq * 4 + r) * 65 + jb * 16 + fr] = acc[r];
                } else {
                    const int j = jb * 16 + fr;
                    const float g0j = G_GC[j], g1j = G_GC[64 + j];
#pragma unroll
                    for (int r = 0; r < 4; ++r) {
                        const int i = ib * 16 + fq * 4 + r;
                        const float v0 = bti0[r] * acc[r] * __expf(fminf(gci0[r] - g0j, 0.f)), v1 = bti1[r] * acc[r] * __expf(fminf(gci1[r] - g1j, 0.f));
                        ((LAS float*)(lds + R_MT0))[i * 68 + j] = (j < i) ? v0 : 0.f;
                        ((LAS float*)(lds + R_MT1))[(63 - i) * 68 + (63 - j)] = (j > i) ? v1 : 0.f;
                    }
                }
            }
        }
        __syncthreads();
        RELAUNDER();
        unsigned char* recd[2];
#pragma unroll
        for (int d = 0; d < 2; ++d) { const int cposn = (cc < 32) ? 4 + (d ? 31 - cpos : cpos) : (d ? 3 - cpos : cpos);
            recd[d] = p.ws + WS_SCN + ((size_t)((b * 4 + h) * 2 + d) * NCHUNK + cposn) * REC_BYTES; }
        if ((wid & 3) == 0) {
            const int d = wid >> 2;
            prep_tchain(lane, (LAS float*)(lds + (d ? R_MT1 : R_MT0)), XS + d * 1088);
        } else {
            const int wt = (wid - 1 - (wid > 4 ? 1 : 0)) * 64 + lane;
            for (int it = wt; it < 5120; it += 384) {
                const int d = it >= 2560 ? 1 : 0, r = it - d * 2560;
                const LAS float* gc = G_GC + d * 64;
                unsigned char* rec = d ? recd[1] : recd[0];
                if (r < 1024) {
                    const int dk = r >> 3, i8 = (r & 7) * 8;
                    const u32x4 kv = *(const LAS u32x4*)(lds + R_KNT + dk * 144 + ((((i8 >> 3) ^ (dk >> 4)) & 7) << 4));
                    const LAS float* e1 = G_E1 + d * 64 + i8;
                    const f32x4 ea = *(const LAS f32x4*)e1, eb = *(const LAS f32x4*)(e1 + 4);
                    u32x4 o;
                    o[0] = pk_bf16(bf_lo(kv[0]) * ea[0], bf_hi(kv[0]) * ea[1]); o[1] = pk_bf16(bf_lo(kv[1]) * ea[2], bf_hi(kv[1]) * ea[3]);
                    o[2] = pk_bf16(bf_lo(kv[2]) * eb[0], bf_hi(kv[2]) * eb[1]); o[3] = pk_bf16(bf_lo(kv[3]) * eb[2], bf_hi(kv[3]) * eb[3]);
                    *(u32x4*)(rec + REC_KT + img128(dk, i8)) = o;
                } else if (r < 2048) {
                    const int i = (r - 1024) >> 4, k8 = (r & 15) * 8;
                    const u32x4 qv = *(const LAS u32x4*)(lds + R_QN + i * 272 + k8 * 2);
                    const float eg = G_E2[d * 64 + i];
                    u32x4 o;
#pragma unroll
                    for (int e = 0; e < 4; ++e) o[e] = pk_bf16(bf_lo(qv[e]) * eg, bf_hi(qv[e]) * eg);
                    *(u32x4*)(rec + REC_QD + img256(i, k8)) = o;
                } else {
                    const int i = (r - 2048) >> 3, j8 = (r & 7) * 8;
                    float v[8];
                    const float gi = gc[i];
                    const f32x4 gja = *(const LAS f32x4*)(gc + j8), gjb = *(const LAS f32x4*)(gc + j8 + 4);
                    float qk[8];
#pragma unroll
                    for (int e = 0; e < 8; ++e) qk[e] = QK[i * 65 + j8 + e];
#pragma unroll
                    for (int e = 0; e < 8; ++e) { const int j = j8 + e; const bool ok = d ? (j >= i) : (j <= i);
                        const float w = qk[e] * __expf(fminf(gi - (e < 4 ? gja[e & 3] : gjb[e & 3]), 0.f));
                        v[e] = ok ? w : 0.f; }
                    u32x4 o; o[0] = pk_bf16(v[0], v[1]); o[1] = pk_bf16(v[2], v[3]); o[2] = pk_bf16(v[4], v[5]); o[3] = pk_bf16(v[6], v[7]);
                    *(u32x4*)(rec + REC_QK + img128(i, j8)) = o;
                }
            }
            if (wt < 2) { *(float*)(recd[wt] + REC_MISC) = __expf(G_TOT[wt]); *(int*)(recd[wt] + REC_MISC + 4) = rowbase + t0; }
        }
        __syncthreads();
        RELAUNDER();
        for (int idx = tid; idx < 4096; idx += NTHREADS) {
            const int d = idx >> 11, q = idx & 2047, i = q >> 5, j = (q & 31) * 2, i2 = d ? 63 - i : i, j2 = d ? 63 - j : j, j3 = d ? j2 - 1 : j2 + 1;
            const LAS float* TBd = (const LAS float*)(lds + (d ? R_MT1 : R_MT0));
            const LAS float* e2 = G_E2 + d * 64; const LAS float* bt = G_BT + d * 64;
            const float t0v = TBd[i2 * 68 + j2], t1v = TBd[i2 * 68 + j3];
            const float c0 = bt[j], c1 = bt[j + 1];
            LAS unsigned char* tw = lds + (d ? R_T1 : R_T0);
            *(LAS unsigned*)(tw + 8192 + imgT(i, j)) = pk_bf16(t0v * c0, t1v * c1);
            *(LAS unsigned*)(tw + imgT(i, j)) = pk_bf16(t0v * c0 * e2[j], t1v * c1 * e2[j + 1]);
        }
        __syncthreads();
        RELAUNDER();
        {
            const int d = wid >> 2;
            unsigned char* rec = d ? recd[1] : recd[0];
            const LAS unsigned char* tw = lds + (d ? R_T1 : R_T0);
#pragma unroll
            for (int hb = 0; hb < 2; ++hb) {
                const int blk = (wid & 3) * 2 + hb;
                bf16x8 ak[2], av[2];
#pragma unroll
                for (int kk = 0; kk < 2; ++kk) { const int so = (((kk * 4 + fq) ^ blk) & 7) << 4; ak[kk] = *(const LAS bf16x8*)(lds + R_KNT + (blk * 16 + fr) * 144 + so); av[kk] = *(const LAS bf16x8*)(lds + R_VT + (blk * 16 + fr) * 144 + so); }
#pragma unroll
                for (int ib = 0; ib < 4; ++ib) {
                    f32x4 aw = (f32x4){0.f, 0.f, 0.f, 0.f}, au = (f32x4){0.f, 0.f, 0.f, 0.f};
#pragma unroll
                    for (int kk = 0; kk < 2; ++kk) {
                        const bf16x8 twf = *(const LAS bf16x8*)(tw + imgT(ib * 16 + fr, kk * 32 + fq * 8)), tuf = *(const LAS bf16x8*)(tw + 8192 + imgT(ib * 16 + fr, kk * 32 + fq * 8));
                        aw = __builtin_amdgcn_mfma_f32_16x16x32_bf16(ak[kk], twf, aw, 0, 0, 0);
                        au = __builtin_amdgcn_mfma_f32_16x16x32_bf16(tuf, av[kk], au, 0, 0, 0);
                    }
                    u32x2 ow; ow[0] = pk_bf16(aw[0], aw[1]); ow[1] = pk_bf16(aw[2], aw[3]);
                    *(u32x2*)(rec + REC_W + img256(ib * 16 + fr, blk * 16 + fq * 4)) = ow;
                    u32x2 ou; ou[0] = pk_bf16(au[0], au[1]); ou[1] = pk_bf16(au[2], au[3]);
                    *(u32x2*)(rec + REC_UT + (blk * 16 + fr) * 128 + (ib * 16 + fq * 4) * 2) = ou;
                }
            }
        }
        __syncthreads();
    }
    {
        const int rem = (NB * 4 * NCHUNK) % (int)gridDim.x;
        const bool lastl = (l == DEPTH - 1);
        if ((int)blockIdx.x >= rem) convert_stream(p, cs_layer_start(l) + (lastl ? CS_P2_L : CS_P2), lastl ? CS_PREP_L : CS_PREP, (int)blockIdx.x - rem, (int)gridDim.x - rem, lds);
    }
}
#undef RELAUNDER

__device__ __forceinline__ void phase_scan(const Params& p, const int l, LAS unsigned char* lds) {
    const int tid = opaque_tid(), wid = __builtin_amdgcn_readfirstlane(tid >> 6), lane = tid & 63, fr = lane & 15, fq = lane >> 4;
    constexpr int NSL = 2, DV = 128 / NSL, NBT = DV / 16;
    constexpr int UTB = DV * 128, MISC_O = 57344 + UTB, BUFB = MISC_O + 256, R_ST = 2 * BUFB, R_UTL = R_ST + DV * 272, R_DUM = R_UTL + DV * 144;
    static_assert(R_DUM + 8 * 256 <= LDS_WORK && NBT == 4, "scan LDS / tile assumptions");
    for (int id = blockIdx.x; id < 64 * NSL; id += gridDim.x) {
        const int bhd = (id & 7) * 8 + (id >> 4), sl = (id >> 3) & 1, h = (bhd >> 1) & 3, d = bhd & 1;
        bf16_t* O = (bf16_t*)(p.ws + (d ? WS_OB : WS_OF));
        const unsigned char* rec0 = p.ws + WS_SCN + (size_t)bhd * NCHUNK * REC_BYTES;
        __syncthreads();
        for (int i = tid; i < DV * 272 / 4; i += NTHREADS) ((LAS unsigned*)(lds + R_ST))[i] = 0u;
        f32x4 sacc[NBT];
#pragma unroll
        for (int n2 = 0; n2 < NBT; ++n2) sacc[n2] = (f32x4){0.f, 0.f, 0.f, 0.f};
#define S_ISSUE(n, bufo) do { const unsigned char* _r = rec0 + (size_t)(n) * REC_BYTES; \
        _Pragma("unroll") for (int _q = 0; _q < 7; ++_q) __builtin_amdgcn_global_load_lds((const unsigned*)(_r + lane * 16 + (wid + 8 * _q) * 1024), (LAS unsigned*)(lds + (bufo) + (wid + 8 * _q) * 1024), 16, 0, 0); \
        __builtin_amdgcn_global_load_lds((const unsigned*)(_r + lane * 16 + REC_UT + sl * UTB + wid * 1024), (LAS unsigned*)(lds + (bufo) + 57344 + wid * 1024), 16, 0, 0); \
        __builtin_amdgcn_global_load_lds((const unsigned*)(_r + REC_MISC + lane * 4), (LAS unsigned*)(lds + (bufo) + MISC_O), 4, 0, 0); } while (0)
#define S_TOUCH(n) do { const int _n = (n) < NCHUNK ? (n) : NCHUNK - 1; const int _ln = wid * 64 + lane; \
        const unsigned char* _t = rec0 + (size_t)_n * REC_BYTES + (_ln < 448 ? _ln * 128 : REC_UT + sl * UTB + (_ln - 448) * 128); \
        __builtin_amdgcn_global_load_lds((const unsigned*)_t, (LAS unsigned*)(lds + R_DUM + wid * 256), 4, 0, 0); } while (0)
        S_ISSUE(0, 0); S_ISSUE(1, BUFB);
        const int ib = wid >> 1, nb0 = (wid & 1) * (NBT / 2);
        for (int n = 0; n < NCHUNK; ++n) {
            if (n == 0) asm volatile("s_waitcnt vmcnt(9)" ::: "memory"); else if (n == 1) asm volatile("s_waitcnt vmcnt(11)" ::: "memory"); else asm volatile("s_waitcnt vmcnt(13)" ::: "memory");
            asm volatile("s_waitcnt lgkmcnt(0)" ::: "memory");
            __builtin_amdgcn_s_barrier();
            LAS unsigned char* buf = lds + (n & 1) * BUFB;
            f32x4 accP[NBT / 2], accQ[NBT / 2];
#pragma unroll
            for (int t = 0; t < NBT / 2; ++t) { accP[t] = (f32x4){0.f, 0.f, 0.f, 0.f}; accQ[t] = (f32x4){0.f, 0.f, 0.f, 0.f}; }
            bf16x8 aw[4], aq[4], sb[NBT / 2][4];
#pragma unroll
            for (int kk = 0; kk < 4; ++kk) {
                aw[kk] = *(const LAS bf16x8*)(buf + REC_W + img256(ib * 16 + fr, kk * 32 + fq * 8));
                aq[kk] = *(const LAS bf16x8*)(buf + REC_QD + img256(ib * 16 + fr, kk * 32 + fq * 8));
#pragma unroll
                for (int t = 0; t < NBT / 2; ++t) sb[t][kk] = *(const LAS bf16x8*)(lds + R_ST + ((nb0 + t) * 16 + fr) * 272 + kk * 64 + fq * 16);
            }
            u32x2 uv[NBT / 2];
#pragma unroll
            for (int t = 0; t < NBT / 2; ++t) uv[t] = *(const LAS u32x2*)(buf + REC_UT + ((nb0 + t) * 16 + fr) * 128 + (ib * 16 + fq * 4) * 2);
            __builtin_amdgcn_sched_barrier(0);
#pragma unroll
            for (int kk = 0; kk < 4; ++kk)
#pragma unroll
                for (int t = 0; t < NBT / 2; ++t) accP[t] = __builtin_amdgcn_mfma_f32_16x16x32_bf16(aw[kk], sb[t][kk], accP[t], 0, 0, 0);
            bf16x8 aqk[2], ak[2];
#pragma unroll
            for (int kk = 0; kk < 2; ++kk) { aqk[kk] = *(const LAS bf16x8*)(buf + REC_QK + img128(ib * 16 + fr, kk * 32 + fq * 8)); ak[kk] = *(const LAS bf16x8*)(buf + REC_KT + img128(wid * 16 + fr, kk * 32 + fq * 8)); }
            const float sd = *(const LAS float*)(buf + MISC_O); const int rowstart = *(const LAS int*)(buf + MISC_O + 4);
#pragma unroll
            for (int t = 0; t < NBT / 2; ++t) {
                u32x2 o; o[0] = pk_bf16(bf_lo(uv[t][0]) - accP[t][0], bf_hi(uv[t][0]) - accP[t][1]); o[1] = pk_bf16(bf_lo(uv[t][1]) - accP[t][2], bf_hi(uv[t][1]) - accP[t][3]);
                *(LAS u32x2*)(lds + R_UTL + ((nb0 + t) * 16 + fr) * 144 + (ib * 16 + fq * 4) * 2) = o;
            }
#pragma unroll
            for (int kk = 0; kk < 4; ++kk)
#pragma unroll
                for (int t = 0; t < NBT / 2; ++t) accQ[t] = __builtin_amdgcn_mfma_f32_16x16x32_bf16(sb[t][kk], aq[kk], accQ[t], 0, 0, 0);
            asm volatile("s_waitcnt lgkmcnt(0)" ::: "memory");
            __builtin_amdgcn_s_barrier();
            { const int nn = (n + 2 < NCHUNK) ? n + 2 : NCHUNK - 1; if (n & 1) S_ISSUE(nn, BUFB); else S_ISSUE(nn, 0); }
            bf16x8 ub[NBT][2];
#pragma unroll
            for (int n2 = 0; n2 < NBT; ++n2)
#pragma unroll
                for (int kk = 0; kk < 2; ++kk) ub[n2][kk] = *(const LAS bf16x8*)(lds + R_UTL + (n2 * 16 + fr) * 144 + kk * 64 + fq * 16);
            bf16x8 un[NBT / 2][2];
#pragma unroll
            for (int t = 0; t < NBT / 2; ++t)
#pragma unroll
                for (int kk = 0; kk < 2; ++kk) un[t][kk] = *(const LAS bf16x8*)(lds + R_UTL + ((nb0 + t) * 16 + fr) * 144 + kk * 64 + fq * 16);
            __builtin_amdgcn_sched_barrier(0);
#pragma unroll
            for (int n2 = 0; n2 < NBT; ++n2) {
                sacc[n2] *= sd;
#pragma unroll
                for (int kk = 0; kk < 2; ++kk) sacc[n2] = __builtin_amdgcn_mfma_f32_16x16x32_bf16(ak[kk], ub[n2][kk], sacc[n2], 0, 0, 0);
            }
#pragma unroll
            for (int kk = 0; kk < 2; ++kk)
#pragma unroll
                for (int t = 0; t < NBT / 2; ++t) accQ[t] = __builtin_amdgcn_mfma_f32_16x16x32_bf16(un[t][kk], aqk[kk], accQ[t], 0, 0, 0);
#pragma unroll
            for (int n2 = 0; n2 < NBT; ++n2) {
                u32x2 o; o[0] = pk_bf16(sacc[n2][0], sacc[n2][1]); o[1] = pk_bf16(sacc[n2][2], sacc[n2][3]);
                *(LAS u32x2*)(lds + R_ST + (n2 * 16 + fr) * 272 + (wid * 16 + fq * 4) * 2) = o;
            }
#pragma unroll
            for (int t = 0; t < NBT / 2; ++t) {
                u32x2 o; o[0] = pk_bf16(accQ[t][0], accQ[t][1]); o[1] = pk_bf16(accQ[t][2], accQ[t][3]);
                *(u32x2*)(O + (size_t)(rowstart + ib * 16 + fr) * 512 + h * 128 + sl * DV + (nb0 + t) * 16 + fq * 4) = o;
            }
        }
#undef S_ISSUE
#undef S_TOUCH
        asm volatile("s_waitcnt vmcnt(0)" ::: "memory");
        __syncthreads();
    }
}

__device__ __forceinline__ void phase_scan_naive(const Params& p, const int l, LAS unsigned char* lds) {
    const int tid = opaque_tid();
    const int lane = tid & 63;
    LAS float* ks = (LAS float*)lds;
    LAS float* qs = ks + 4096;
    LAS float* vs = qs + 4096;
    LAS float* as = vs + 4096;
    LAS float* bs = as + 32;
    LAS int* rws = (LAS int*)(bs + 32);
    const float* QKV = (const float*)(p.ws + WS_QKV);
    const float* LOGA = (const float*)(p.ws + WS_LOGA);
    const float* BETA = (const float*)(p.ws + WS_BETA);
    for (int u = blockIdx.x; u < 64; u += gridDim.x) {
        const int b = u >> 3, h = (u >> 1) & 3, d = u & 1;
        float* O = (float*)(p.ws + (d ? WS_OB : WS_OF));
        const int col = tid >> 2, part = tid & 3;
        float S[32];
#pragma unroll
        for (int i = 0; i < 32; ++i) S[i] = 0.f;
        for (int n0 = 0; n0 < CTXL + SEQ; n0 += 32) {
            __syncthreads();
            if (tid < 32) {
                const int n = n0 + tid; int row;
                if (n < CTXL) row = ROWS_LAT + b * CTXL + (d ? CTXL - 1 - n : n);
                else { const int m = n - CTXL; row = b * SEQ + (d ? SEQ - 1 - m : m); }
                rws[tid] = row;
                as[tid] = __expf(LOGA[(size_t)row * 8 + d * 4 + h]);
                bs[tid] = BETA[(size_t)row * 8 + d * 4 + h];
            }
            __syncthreads();
            for (int i = tid; i < 4096; i += NTHREADS) {
                const int tok = i >> 7, cc = i & 127; const size_t base = (size_t)rws[tok] * 1536 + h * 128 + cc;
                qs[i] = QKV[base]; ks[i] = QKV[base + 512]; vs[i] = QKV[base + 1024];
            }
            __syncthreads();
            for (int tok = 0; tok < 32; ++tok) {
                float kk[32];
#pragma unroll
                for (int i = 0; i < 8; ++i) { const f32x4 v = *(const LAS f32x4*)(ks + tok * 128 + part * 32 + i * 4); kk[i * 4] = v[0]; kk[i * 4 + 1] = v[1]; kk[i * 4 + 2] = v[2]; kk[i * 4 + 3] = v[3]; }
                float kp = 0.f;
#pragma unroll
                for (int i = 0; i < 32; ++i) kp += kk[i] * S[i];
                kp += shx(kp, 1, lane); kp += shx(kp, 2, lane);
                const float a = as[tok], bt = bs[tok];
                const float bv = bt * (vs[tok * 128 + col] - a * kp);
#pragma unroll
                for (int i = 0; i < 32; ++i) S[i] = a * S[i] + kk[i] * bv;
                float op = 0.f;
#pragma unroll
                for (int i = 0; i < 8; ++i) { const f32x4 v = *(const LAS f32x4*)(qs + tok * 128 + part * 32 + i * 4); op += v[0] * S[i * 4] + v[1] * S[i * 4 + 1] + v[2] * S[i * 4 + 2] + v[3] * S[i * 4 + 3]; }
                op += shx(op, 1, lane); op += shx(op, 2, lane);
                if (part == 0) O[(size_t)rws[tok] * 512 + h * 128 + col] = op;
            }
        }
        __syncthreads();
    }
}

__device__ __forceinline__ void phase_onorm(const Params& p, const int l) {
    const int tid = opaque_tid(), wid = tid >> 6, lane = tid & 63;
    const bf16_t* OF = (const bf16_t*)(p.ws + WS_OF); const bf16_t* OB = (const bf16_t*)(p.ws + WS_OB);
    const bf16_t* PROJ = (const bf16_t*)(p.ws + WS_PROJ);
    bf16_t* CAT = (bf16_t*)(p.ws + WS_CAT);
    const int c = lane * 8;
    const f32x4 w0 = *(const f32x4*)(p.dn_norm + l * 128 + (c & 127)), w1 = *(const f32x4*)(p.dn_norm + l * 128 + (c & 127) + 4);
    const int nrows = (l == DEPTH - 1) ? ROWS_LAT : MT;
    constexpr int R = 3;
    const int rstride = gridDim.x * 8;
    for (int base = blockIdx.x * 8 + wid; base < nrows; base += rstride * R) {
        u32x4 a[R], b[R], gv[R];
#pragma unroll
        for (int k = 0; k < R; ++k) {
            const int row = base + k * rstride; const int rr = row < nrows ? row : base;
            a[k] = *(const u32x4*)(OF + (size_t)rr * 512 + c); b[k] = *(const u32x4*)(OB + (size_t)rr * 512 + c); gv[k] = *(const u32x4*)(PROJ + (size_t)rr * PN + 1536 + c);
        }
#pragma unroll
        for (int k = 0; k < R; ++k) {
            const int row = base + k * rstride;
            const f32x4 v0 = (f32x4){bf_lo(a[k][0]) + bf_lo(b[k][0]), bf_hi(a[k][0]) + bf_hi(b[k][0]), bf_lo(a[k][1]) + bf_lo(b[k][1]), bf_hi(a[k][1]) + bf_hi(b[k][1])};
            const f32x4 v1 = (f32x4){bf_lo(a[k][2]) + bf_lo(b[k][2]), bf_hi(a[k][2]) + bf_hi(b[k][2]), bf_lo(a[k][3]) + bf_lo(b[k][3]), bf_hi(a[k][3]) + bf_hi(b[k][3])};
            float ss = v0[0] * v0[0] + v0[1] * v0[1] + v0[2] * v0[2] + v0[3] * v0[3] + v1[0] * v1[0] + v1[1] * v1[1] + v1[2] * v1[2] + v1[3] * v1[3];
            ss = sum16(ss);
            const float rs = rsqrtf(ss * (1.f / 128.f) + EPS);
            u32x4 out;
            out[0] = pk_bf16(v0[0] * rs * w0[0] * silu_f(bf_lo(gv[k][0])), v0[1] * rs * w0[1] * silu_f(bf_hi(gv[k][0])));
            out[1] = pk_bf16(v0[2] * rs * w0[2] * silu_f(bf_lo(gv[k][1])), v0[3] * rs * w0[3] * silu_f(bf_hi(gv[k][1])));
            out[2] = pk_bf16(v1[0] * rs * w1[0] * silu_f(bf_lo(gv[k][2])), v1[1] * rs * w1[1] * silu_f(bf_hi(gv[k][2])));
            out[3] = pk_bf16(v1[2] * rs * w1[2] * silu_f(bf_lo(gv[k][3])), v1[3] * rs * w1[3] * silu_f(bf_hi(gv[k][3])));
            if (row < nrows) *(u32x4*)(CAT + (size_t)row * D + c) = out;
        }
    }
}

__device__ __forceinline__ unsigned block_incl_scan(unsigned v, const int tid, LAS unsigned* wsum, unsigned& total) {
    const int lane = tid & 63, wv = tid >> 6;
#pragma unroll
    for (int o = 1; o < 64; o <<= 1) { const unsigned t = (unsigned)__builtin_amdgcn_ds_bpermute(((lane - o) & 63) << 2, (int)v); if (lane >= o) v += t; }
    if (lane == 63) wsum[wv] = v;
    __syncthreads();
    unsigned base = 0u, tot = 0u;
#pragma unroll
    for (int w = 0; w < 8; ++w) { const unsigned x = wsum[w]; tot += x; base += (w < wv) ? x : 0u; }
    total = tot;
    return v + base;
}

__device__ __forceinline__ void phase_topk(const Params& p, const int l, LAS unsigned char* lds) {
    const int tid = opaque_tid();
    LAS unsigned* hist = (LAS unsigned*)lds;
    LAS unsigned* wsum = hist + 4096;
    LAS unsigned* misc = wsum + 8;
    LAS unsigned long long* cand = (LAS unsigned long long*)(misc + 8);
    LAS unsigned char* selb = (LAS unsigned char*)(cand + 2048);
    const float* AFF = (const float*)(p.ws + WS_AFF);
    int* SEL = (int*)(p.ws + WS_SEL); float* SELAFF = (float*)(p.ws + WS_SELAFF); int* SLOTOF = (int*)(p.ws + WS_SLOTOF);
    const int ntk = (l == DEPTH - 1) ? 128 : 256;
    for (int u = blockIdx.x; u < ntk; u += gridDim.x) {
        int e, n, C, rowbase, slotbase;
        if (u < 128) { e = u >> 3; const int b = u & 7; n = SEQ; C = 256; rowbase = b * SEQ; slotbase = u * 256; }
        else { const int v = u - 128; e = v >> 3; const int b = v & 7; n = CTXL; C = 32; rowbase = ROWS_LAT + b * CTXL; slotbase = (128 + e) * 256 + b * 32; }
        unsigned kb[4];
#pragma unroll
        for (int k = 0; k < 4; ++k) { const int i = tid * 4 + k; kb[k] = (i < n) ? __float_as_uint(AFF[(size_t)(rowbase + i) * 16 + e]) : 0u; }
        { unsigned z = 0u; asm volatile("" : "+v"(z));
#pragma unroll
            for (int k = 0; k < 8; ++k) hist[tid * 8 + k] = z; }
        if (tid == 0) misc[2] = 0u;
        __syncthreads();
#pragma unroll
        for (int k = 0; k < 4; ++k) if (tid * 4 + k < n) __hip_atomic_fetch_add(&hist[kb[k] >> 19], 1u, __ATOMIC_RELAXED, __HIP_MEMORY_SCOPE_WORKGROUP);
        __syncthreads();
        unsigned hl[8], s8 = 0u;
#pragma unroll
        for (int k = 0; k < 8; ++k) { hl[k] = hist[tid * 8 + k]; s8 += hl[k]; }
        unsigned total;
        const unsigned incl = block_incl_scan(s8, tid, wsum, total);
        unsigned cum = total - incl;
#pragma unroll
        for (int k = 7; k >= 0; --k) { if (cum < (unsigned)C && cum + hl[k] >= (unsigned)C) { misc[0] = (unsigned)(tid * 8 + k); misc[1] = cum; } cum += hl[k]; }
        __syncthreads();
        const unsigned thr = misc[0], G = misc[1], R = (unsigned)C - G;
#pragma unroll
        for (int k = 0; k < 4; ++k) { const int i = tid * 4 + k; if (i < n && (kb[k] >> 19) == thr) { const unsigned q = __hip_atomic_fetch_add(&misc[2], 1u, __ATOMIC_RELAXED, __HIP_MEMORY_SCOPE_WORKGROUP); cand[q] = ((unsigned long long)kb[k] << 32) | (unsigned long long)(0xFFFFFFFFu - (unsigned)i); } }
        __syncthreads();
        const unsigned E = misc[2];
        for (unsigned j = tid; j < E; j += NTHREADS) {
            const unsigned long long me = cand[j]; unsigned rank = 0u;
            for (unsigned k = 0; k < E; ++k) rank += (cand[k] > me) ? 1u : 0u;
            selb[0xFFFFFFFFu - (unsigned)(me & 0xFFFFFFFFull)] = (rank < R) ? 1 : 0;
        }
        __syncthreads();
        unsigned fl = 0u, cnt = 0u;
#pragma unroll
        for (int k = 0; k < 4; ++k) { const int i = tid * 4 + k; const unsigned bin = kb[k] >> 19;
            const bool in = (i < n) && (bin > thr || (bin == thr && selb[i] != 0)); fl |= in ? (1u << k) : 0u; cnt += in ? 1u : 0u; }
        unsigned tot2;
        unsigned pos = block_incl_scan(cnt, tid, wsum, tot2) - cnt;
#pragma unroll
        for (int k = 0; k < 4; ++k) { const int i = tid * 4 + k;
            if (i < n) { const bool in = (fl >> k) & 1u;
                SLOTOF[(size_t)(rowbase + i) * 16 + e] = in ? slotbase + (int)pos : -1;
                if (in) { SEL[slotbase + pos] = rowbase + i; SELAFF[slotbase + pos] = __uint_as_float(kb[k]); ++pos; } } }
        __syncthreads();
    }
}

#ifndef DUMP
#define DUMP 0
#endif
#if DUMP
__device__ __forceinline__ void phase_dump(const Params& p, const size_t off, const int is_bf16, const size_t n_avail) {
    const int tid = opaque_tid();
    const size_t n = (size_t)ROWS_LAT * D;
    for (size_t i = (size_t)blockIdx.x * NTHREADS + tid; i < n; i += (size_t)gridDim.x * NTHREADS) {
        float v = 0.f;
        if (i < n_avail) v = is_bf16 ? __uint_as_float((unsigned)((const bf16_t*)(p.ws + off))[i] << 16) : ((const float*)(p.ws + off))[i];
        p.out[i] = v;
    }
}
#endif

__global__ void __launch_bounds__(NTHREADS, 2) fwd(const Params p) {
    extern __shared__ __attribute__((aligned(16))) unsigned char smem[];
    LAS unsigned char* lds = (LAS unsigned char*)smem + LDS_OFF;
    XcdBarrier bar; bar.bar = (unsigned*)(p.ws + WS_BAR); bar.x = 0; bar.st = nullptr;
    const bool multi = (p.ph_hi - p.ph_lo) > 1;
    if (multi) {
        if (threadIdx.x == 0) *(LAS u32x4*)((LAS unsigned char*)smem) = (u32x4){0u, 0u, 0u, 0u};
        __syncthreads();
        bar = xcd_barrier_post((unsigned*)(p.ws + WS_BAR), (volatile LAS unsigned*)((LAS unsigned char*)smem));
    }
#if DUMP
    if (p.ph_lo == 100) { phase_dump(p, (size_t)(DUMP_OFF), DUMP_BF16, (size_t)(DUMP_N)); return; }
#endif
    int ph = 0;
#define PHASE(body) do { if (ph >= p.ph_lo && ph < p.ph_hi) { const int l = opaque_s(lv); body; if (ph + 1 < p.ph_hi) xcd_barrier(bar); } ++ph; } while (0)
    int lv = 0;
    PHASE(phase_prologue(p, lds));
    for (lv = 0; lv < DEPTH; ++lv) {
        PHASE(phase_norm<1>(p, l, lds));
        PHASE(GEMM8 ? phase_gemm8<0>(p, l, lds) : phase_gemm<0>(p, l, lds));
#if NAIVE_SCAN
        PHASE(phase_conv_pool(p, l, lds));
        PHASE(phase_scan_naive(p, l, lds));
#else
        PHASE(phase_prep(p, l, lds));
        PHASE(phase_scan(p, l, lds); phase_conv_pool(p, l, lds, (int)gridDim.x >= 256 ? 128 : 0, (int)gridDim.x >= 256 ? (int)gridDim.x - 128 : (int)gridDim.x); phase_pool_filler(p, l, lds));
#endif
        PHASE(phase_onorm(p, l));
        PHASE(phase_outproj(p, l, lds));
        PHASE(phase_topk(p, l, lds));
        PHASE(phase_gateup(p, l, lds));
        PHASE(GEMM8 ? phase_gemm8<3>(p, l, lds) : phase_gemm<3>(p, l, lds));
    }
    lv = 0;
    PHASE(phase_norm<3>(p, l, lds));
#undef PHASE
}
constexpr int N_PHASES = 2 + DEPTH * 9;

extern "C" void kernel_launch(void* const* d_in, const int* in_sizes, int n_in, void* d_out, int out_size, void* d_ws, size_t ws_size, hipStream_t stream) {
    static int grid = 0;
    if (grid == 0) {
        if (n_in != 21 || out_size != ROWS_LAT * D || ws_size < WS_END) { fprintf(stderr, "kernel_launch: unexpected shapes (n_in %d out %d ws %zu need %zu)\n", n_in, out_size, ws_size, (size_t)WS_END); grid = -1; return; }
        int dev = 0, cus = 0, per_cu = 0;
        if (hipGetDevice(&dev) != hipSuccess || hipDeviceGetAttribute(&cus, hipDeviceAttributeMultiprocessorCount, dev) != hipSuccess) { grid = -1; return; }
        if (hipFuncSetAttribute((const void*)fwd, hipFuncAttributeMaxDynamicSharedMemorySize, LDS_BYTES) != hipSuccess) { fprintf(stderr, "kernel_launch: hipFuncSetAttribute failed\n"); grid = -1; return; }
        if (hipOccupancyMaxActiveBlocksPerMultiprocessor(&per_cu, (const void*)fwd, NTHREADS, LDS_BYTES) != hipSuccess || per_cu < 1) { fprintf(stderr, "kernel_launch: occupancy query says %d\n", per_cu); per_cu = 1; }
        (void)hipGetLastError();
        if (cus < 256) { fprintf(stderr, "kernel_launch: %d CUs, the phase program needs 256 resident workgroups\n", cus); grid = -1; return; }
        grid = 256;
    }
    if (grid < 0) return;
    (void)hipMemsetAsync((char*)d_ws + WS_BAR, 0, 16384, stream);
    Params p; memset(&p, 0, sizeof(p));
    const float** pp = (const float**)&p;
    for (int i = 0; i < 21; ++i) pp[i] = (const float*)d_in[i];
    p.out = (float*)d_out; p.ws = (unsigned char*)d_ws;
#if DUMP
    for (int ph = 0; ph <= DUMP_LAST; ++ph) { p.ph_lo = ph; p.ph_hi = ph + 1; hipLaunchKernelGGL(fwd, dim3(grid), dim3(NTHREADS), LDS_BYTES, stream, p); }
    p.ph_lo = 100; p.ph_hi = 101; hipLaunchKernelGGL(fwd, dim3(grid), dim3(NTHREADS), LDS_BYTES, stream, p);
#elif ONE_LAUNCH
    p.ph_lo = 0; p.ph_hi = N_PHASES;
    hipLaunchKernelGGL(fwd, dim3(grid), dim3(NTHREADS), LDS_BYTES, stream, p);
#else
    for (int ph = 0; ph < N_PHASES; ++ph) { p.ph_lo = ph; p.ph_hi = ph + 1; hipLaunchKernelGGL(fwd, dim3(grid), dim3(NTHREADS), LDS_BYTES, stream, p); }
#endif
}
```
